# Optimizing an MI355X kernel written in HIP

```python
import math
import jax, jax.numpy as jnp
from jax import lax
import numpy as np

D_MODEL = 2048
BATCH = 2
SEQ = 4096
DEPTH = 2

GRID_W = 64
CTX_LEN = 256
N_MIXERS = 2
N_NA_LAYERS = (DEPTH + N_MIXERS - 1) // N_MIXERS
N_S5_LAYERS = DEPTH // N_MIXERS
N_HEADS = 16
HEAD_DIM = D_MODEL // N_HEADS
WIN_R = 8
WIN_C = 16
Q_BLK_C = 16
K_BLK_C = 2 * WIN_C
SSM_GROUP = 16
N_GROUPS = D_MODEL // SSM_GROUP
SSM_STATE = 64
N_EXPERTS = 16
EXPERT_FF = D_MODEL
CAPACITY_FACTOR = 2
DN_ALPHA = (2 * DEPTH) ** 0.25
DN_BETA = (8 * DEPTH) ** -0.25
LN_EPS = 1e-5
NEG_INF = -1e30

kernel_name = 'hybrid_natten_s5_ecmoe_dit_block'


def layer_norm(x, g, b):
    xf = x.astype(jnp.float32)
    mu = jnp.mean(xf, -1, keepdims=True)
    var = jnp.mean(jnp.square(xf - mu), -1, keepdims=True)
    return ((xf - mu) * lax.rsqrt(var + LN_EPS) * g + b).astype(x.dtype)


def neighborhood_attention(q, k, v, k_ctx, v_ctx, rpb):
    B, L, H, dh = q.shape
    rows = L // GRID_W
    kr = min(WIN_R, rows)
    qg = q.reshape(B, rows, GRID_W, H, dh)
    kg = k.reshape(B, rows, GRID_W, H, dh)
    vg = v.reshape(B, rows, GRID_W, H, dh)
    r = jnp.arange(rows)
    rs = jnp.clip(r - kr // 2, 0, rows - kr)
    row_idx = rs[:, None] + jnp.arange(kr)[None, :]
    dr_idx = row_idx - r[:, None] + (WIN_R - 1)
    scale = HEAD_DIM ** -0.5
    n_loc = kr * K_BLK_C
    outs = []
    for j in range(GRID_W // Q_BLK_C):
        c0 = j * Q_BLK_C
        cs = min(max(c0 - WIN_C // 2, 0), GRID_W - K_BLK_C)
        qcol = c0 + jnp.arange(Q_BLK_C)
        kcol = cs + jnp.arange(K_BLK_C)
        cstart = jnp.clip(qcol - WIN_C // 2, 0, GRID_W - WIN_C)
        valid = (kcol[None] >= cstart[:, None]) & (kcol[None] < cstart[:, None] + WIN_C)
        dc_idx = jnp.clip(kcol[None] - qcol[:, None] + WIN_C - 1, 0, 2 * WIN_C - 2)
        bias = rpb[:, dr_idx[:, None, :, None], dc_idx[None, :, None, :]]
        qb = qg[:, :, c0:c0 + Q_BLK_C]
        kb = kg[:, row_idx, cs:cs + K_BLK_C]
        vb = vg[:, row_idx, cs:cs + K_BLK_C]
        s_loc = jnp.einsum('brqhd,brkwhd->bhrqkw', qb, kb).astype(jnp.float32) * scale
        s_loc = s_loc + bias.astype(jnp.float32)[None]
        s_loc = jnp.where(valid[:, None, :], s_loc, NEG_INF).reshape(B, H, rows, Q_BLK_C, n_loc)
        s_ctx = jnp.einsum('brqhd,bchd->bhrqc', qb, k_ctx).astype(jnp.float32) * scale
        p = jax.nn.softmax(jnp.concatenate([s_loc, s_ctx], axis=-1), axis=-1).astype(v.dtype)
        p_loc = p[..., :n_loc].reshape(B, H, rows, Q_BLK_C, kr, K_BLK_C)
        o = (jnp.einsum('bhrqkw,brkwhd->brqhd', p_loc, vb)
             + jnp.einsum('bhrqc,bchd->brqhd', p[..., n_loc:], v_ctx))
        outs.append(o)
    return jnp.concatenate(outs, axis=2).reshape(B, L, H * dh)


def context_attention(q, k, v):
    s = jnp.einsum('bqhd,bkhd->bhqk', q, k).astype(jnp.float32) * (HEAD_DIM ** -0.5)
    p = jax.nn.softmax(s, axis=-1).astype(v.dtype)
    o = jnp.einsum('bhqk,bkhd->bqhd', p, v)
    return o.reshape(q.shape[0], q.shape[1], D_MODEL)


def na_mixer(h_lat, h_ctx, w_qkv, w_o, rpb, need_ctx):
    B, L, _ = h_lat.shape
    Lc = h_ctx.shape[1]
    ql, kl, vl = jnp.split((h_lat @ w_qkv).reshape(B, L, 3 * N_HEADS, HEAD_DIM), 3, axis=2)
    qc, kc, vc = jnp.split((h_ctx @ w_qkv).reshape(B, Lc, 3 * N_HEADS, HEAD_DIM), 3, axis=2)
    o_lat = neighborhood_attention(ql, kl, vl, kc, vc, rpb) @ w_o
    o_ctx = context_attention(qc, kc, vc) @ w_o if need_ctx else None
    return o_lat, o_ctx


def s5_discretize(lam_re, lam_im, log_step, b_re, b_im):
    lr = jnp.minimum(lam_re.astype(jnp.float32), -1e-4)
    li = lam_im.astype(jnp.float32)
    dt = jnp.exp(log_step.astype(jnp.float32))[:, None]
    mag = jnp.exp(lr * dt)
    ar = mag * jnp.cos(li * dt)
    ai = mag * jnp.sin(li * dt)
    nr = ar - 1.0
    den = lr * lr + li * li
    cr = ((nr * lr + ai * li) / den)[..., None]
    ci = ((ai * lr - nr * li) / den)[..., None]
    br = cr * b_re - ci * b_im
    bi = cr * b_im + ci * b_re
    return ar, ai, br, bi


def _scan_op(e1, e2):
    a1r, a1i, b1r, b1i = e1
    a2r, a2i, b2r, b2i = e2
    return (a2r * a1r - a2i * a1i, a2r * a1i + a2i * a1r,
            a2r * b1r - a2i * b1i + b2r, a2r * b1i + a2i * b1r + b2i)


def s5_scan(ar, ai, bur, bui, h0r, h0i, reverse):
    first = bur.shape[1] - 1 if reverse else 0
    bur = bur.at[:, first].add(ar * h0r - ai * h0i)
    bui = bui.at[:, first].add(ar * h0i + ai * h0r)

    def one(br, bi):
        a_r = jnp.broadcast_to(ar, br.shape)
        a_i = jnp.broadcast_to(ai, br.shape)
        _, _, xr, xi = lax.associative_scan(_scan_op, (a_r, a_i, br, bi), reverse=reverse, axis=0)
        return xr, xi

    return jax.vmap(one)(bur, bui)


def s5_readout(xr, xi, c_re, c_im):
    return jnp.einsum('bngp,ghp->bngh', xr, c_re) - jnp.einsum('bngp,ghp->bngh', xi, c_im)


def s5_mixer(h_lat, h_ctx, lam_re, lam_im, log_step, b_re, b_im, c_re, c_im, d_skip,
             w_val, w_gate, need_ctx):
    B, n, _ = h_lat.shape
    nc = h_ctx.shape[1]
    u_lat = h_lat.reshape(B, n, N_GROUPS, SSM_GROUP)
    u_ctx = h_ctx.reshape(B, nc, N_GROUPS, SSM_GROUP)
    d = d_skip.reshape(N_GROUPS, SSM_GROUP)
    y_lat = d * u_lat
    y_ctx = d * u_ctx if need_ctx else None
    zero = jnp.zeros((B, N_GROUPS, SSM_STATE), jnp.float32)
    for direction in range(2):
        rev = direction == 1
        ar, ai, br, bi = s5_discretize(lam_re[direction], lam_im[direction], log_step[direction],
                                       b_re[direction], b_im[direction])
        cbr = jnp.einsum('bngh,gph->bngp', u_ctx, br)
        cbi = jnp.einsum('bngh,gph->bngp', u_ctx, bi)
        xcr, xci = s5_scan(ar, ai, cbr, cbi, zero, zero, rev)
        last = 0 if rev else nc - 1
        lbr = jnp.einsum('bngh,gph->bngp', u_lat, br)
        lbi = jnp.einsum('bngh,gph->bngp', u_lat, bi)
        xlr, xli = s5_scan(ar, ai, lbr, lbi, xcr[:, last], xci[:, last], rev)
        y_lat = y_lat + s5_readout(xlr, xli, c_re[direction], c_im[direction])
        if need_ctx:
            y_ctx = y_ctx + s5_readout(xcr, xci, c_re[direction], c_im[direction])

    def glu(y):
        z = jax.nn.gelu(y.reshape(B, -1, D_MODEL)).astype(h_lat.dtype)
        return (z @ w_val) * jax.nn.sigmoid(z @ w_gate)

    return glu(y_lat), (glu(y_ctx) if need_ctx else None)


def expert_choice_ffn(h, w_router, w_gate, w_up, w_down):
    B, n, D = h.shape
    cap = CAPACITY_FACTOR * n // N_EXPERTS
    logits = jnp.einsum('bnd,de->ben', h, w_router).astype(jnp.float32)
    aff = jax.nn.softmax(logits, axis=1)
    gate, idx = lax.top_k(aff, cap)
    xe = jax.vmap(lambda hb, ib: hb[ib])(h, idx)
    a = jnp.einsum('becd,edf->becf', xe, w_gate)
    u = jnp.einsum('becd,edf->becf', xe, w_up)
    ye = jnp.einsum('becf,efd->becd', jax.nn.silu(a) * u, w_down) * gate[..., None].astype(h.dtype)
    return jax.vmap(lambda ib, yb: jnp.zeros((n, D), yb.dtype).at[ib.reshape(-1)].add(
        yb.reshape(-1, D)))(idx, ye)


def setup_inputs(seed: int = 0) -> dict:
    key = jax.random.key(seed)
    ks = jax.random.split(key, 28)
    f32 = jnp.float32
    D = D_MODEL

    def nrm(k, shape, std):
        return jax.random.normal(k, shape, f32) * std

    s5_shape = (N_S5_LAYERS, 2, N_GROUPS, SSM_STATE)
    return {
        'x': nrm(ks[0], (BATCH, SEQ, D), 1.0),
        'c': nrm(ks[1], (BATCH, D), 1.0),
        'ctx': nrm(ks[2], (BATCH, CTX_LEN, D), 1.0),
        'c_ctx': nrm(ks[3], (D,), 1.0),
        'w_mod': nrm(ks[4], (DEPTH, D, 6 * D), 0.5 * D ** -0.5),
        'b_mod': nrm(ks[5], (DEPTH, 6 * D), 0.02),
        'ln_g': 1.0 + nrm(ks[6], (DEPTH, 2, D), 0.02),
        'ln_b': nrm(ks[7], (DEPTH, 2, D), 0.02),
        'na_w_qkv': nrm(ks[8], (N_NA_LAYERS, D, 3 * D), D ** -0.5),
        'na_w_o': nrm(ks[9], (N_NA_LAYERS, D, D), DN_BETA * D ** -0.5),
        'na_rpb': nrm(ks[10], (N_NA_LAYERS, N_HEADS, 2 * WIN_R - 1, 2 * WIN_C - 1), 0.02),
        's5_lam_re': -0.5 + nrm(ks[11], s5_shape, 0.01),
        's5_lam_im': math.pi * jnp.arange(SSM_STATE, dtype=f32) + nrm(ks[12], s5_shape, 0.01),
        's5_log_step': jax.random.uniform(ks[13], (N_S5_LAYERS, 2, N_GROUPS), f32,
                                          math.log(1e-3), math.log(1e-1)),
        's5_b_re': nrm(ks[14], s5_shape + (SSM_GROUP,), (2 * SSM_GROUP) ** -0.5),
        's5_b_im': nrm(ks[15], s5_shape + (SSM_GROUP,), (2 * SSM_GROUP) ** -0.5),
        's5_c_re': nrm(ks[16], (N_S5_LAYERS, 2, N_GROUPS, SSM_GROUP, SSM_STATE), SSM_STATE ** -0.5),
        's5_c_im': nrm(ks[17], (N_S5_LAYERS, 2, N_GROUPS, SSM_GROUP, SSM_STATE), SSM_STATE ** -0.5),
        's5_d': nrm(ks[18], (N_S5_LAYERS, D), 1.0),
        's5_w_val': nrm(ks[19], (N_S5_LAYERS, D, D), DN_BETA * D ** -0.5),
        's5_w_gate': nrm(ks[20], (N_S5_LAYERS, D, D), D ** -0.5),
        'moe_w_router': nrm(ks[21], (DEPTH, D, N_EXPERTS), D ** -0.5),
        'moe_w_gate': nrm(ks[22], (DEPTH, N_EXPERTS, D, EXPERT_FF), D ** -0.5),
        'moe_w_up': nrm(ks[23], (DEPTH, N_EXPERTS, D, EXPERT_FF), D ** -0.5),
        'moe_w_down': nrm(ks[24], (DEPTH, N_EXPERTS, EXPERT_FF, D), DN_BETA * EXPERT_FF ** -0.5),
    }


def reference(x, c, ctx, c_ctx, w_mod, b_mod, ln_g, ln_b, na_w_qkv, na_w_o, na_rpb,
              s5_lam_re, s5_lam_im, s5_log_step, s5_b_re, s5_b_im, s5_c_re, s5_c_im, s5_d,
              s5_w_val, s5_w_gate, moe_w_router, moe_w_gate, moe_w_up, moe_w_down):
    x_lat = x
    x_ctx = ctx
    for i in range(DEPTH):
        need_ctx = i < DEPTH - 1
        m_lat = (jax.nn.silu(c) @ w_mod[i] + b_mod[i])[:, None, :]
        m_ctx = (jax.nn.silu(c_ctx) @ w_mod[i] + b_mod[i])[None, None, :]
        sh1, sc1, g1, sh2, sc2, g2 = jnp.split(m_lat, 6, axis=-1)
        csh1, csc1, cg1, csh2, csc2, cg2 = jnp.split(m_ctx, 6, axis=-1)
        h_lat = x_lat * (1.0 + sc1) + sh1
        h_ctx = x_ctx * (1.0 + csc1) + csh1
        j = i // N_MIXERS
        if i % N_MIXERS == 0:
            o_lat, o_ctx = na_mixer(h_lat, h_ctx, na_w_qkv[j], na_w_o[j], na_rpb[j], need_ctx)
        else:
            o_lat, o_ctx = s5_mixer(h_lat, h_ctx, s5_lam_re[j], s5_lam_im[j], s5_log_step[j],
                                    s5_b_re[j], s5_b_im[j], s5_c_re[j], s5_c_im[j], s5_d[j],
                                    s5_w_val[j], s5_w_gate[j], need_ctx)
        x_lat = layer_norm(DN_ALPHA * x_lat + g1 * o_lat, ln_g[i, 0], ln_b[i, 0])
        h2 = x_lat * (1.0 + sc2) + sh2
        f_lat = expert_choice_ffn(h2, moe_w_router[i], moe_w_gate[i], moe_w_up[i], moe_w_down[i])
        x_lat = layer_norm(DN_ALPHA * x_lat + g2 * f_lat, ln_g[i, 1], ln_b[i, 1])
        if need_ctx:
            x_ctx = layer_norm(DN_ALPHA * x_ctx + cg1 * o_ctx, ln_g[i, 0], ln_b[i, 0])
            hc2 = x_ctx * (1.0 + csc2) + csh2
            f_ctx = expert_choice_ffn(hc2, moe_w_router[i], moe_w_gate[i], moe_w_up[i], moe_w_down[i])
            x_ctx = layer_norm(DN_ALPHA * x_ctx + cg2 * f_ctx, ln_g[i, 1], ln_b[i, 1])
    return x_lat
```

```cpp
#include <hip/hip_runtime.h>
#include <cstdio>
#include <cstdint>
namespace pg8 {
#define PG8_LAS __attribute__((address_space(3)))
typedef unsigned short bf16_t;
typedef short bf16x8 __attribute__((ext_vector_type(8)));
typedef float f32x4 __attribute__((ext_vector_type(4)));
typedef unsigned u32x4 __attribute__((ext_vector_type(4)));
constexpr int BM = 256, BK = 64, HALF = 128, HTB = HALF * BK * 2  , STAGE_BYTES = 8 * HTB, NXCD = 8, WGM = 8;

__host__ __device__ __forceinline__ int lds_byte(int r, int c) { const int st = (r >> 4) * 2 + (c >> 5), rr = r & 15, cc = c & 31, ob = rr * 64 + cc * 2; return st * 1024 + (ob ^ (((ob >> 9) & 1) << 5)); }
__host__ __device__ __forceinline__ void stage_rc(int b, int& R, int& C) { const int st = b / 1024, sb = b % 1024, swz = sb ^ (((sb >> 9) & 1) << 5); R = (st >> 1) * 16 + swz / 64; C = (st & 1) * 32 + (swz % 64) / 2; }
__host__ __device__ __forceinline__ int perm32(int rho) { const int n = rho >> 4, i = rho & 15; return 8 * (i >> 2) + 4 * n + (i & 3); }

struct Unit { int pm, pn; };
struct Gemm { const bf16_t* A; const bf16_t* Bt; int M, N, K; };

__device__ __forceinline__ unsigned cvt_pk_bf16(float lo, float hi) { unsigned r; asm volatile("v_cvt_pk_bf16_f32 %0, %1, %2" : "=v"(r) : "v"(lo), "v"(hi)); return r; }
template <class Epi, class Sched, bool ALIGN_EPI = false, bool SP2 = false>
__device__ __forceinline__ void gemm_phase(PG8_LAS unsigned char* lds, const Gemm g, const Sched& S, const Epi& E) {
    int tid_ = threadIdx.x; asm volatile("" : "+v"(tid_));
    const int tid = tid_, wid = __builtin_amdgcn_readfirstlane(tid >> 6), lane = tid & 63, wr = wid >> 2, wc = wid & 3, fr = lane & 15, fq = lane >> 4;
    const int K = g.K, nt = K / BK;
    unsigned voffA[2], voffB[2];
#pragma unroll
    for (int i = 0; i < 2; ++i) { int R, C; stage_rc(tid * 16 + i * 8192, R, C); const int Rb = Epi::PERM ? ((R & ~31) + perm32(R & 31)) : R;
        voffA[i] = (unsigned)(R * K + C) * 2u; voffB[i] = (unsigned)(Rb * K + C) * 2u; }
    const size_t kstep = (size_t)(BK * 2);
    const size_t hstep = (size_t)HALF * K * 2;
    const size_t tstep = 2 * hstep;
    const unsigned ldsw = (unsigned)wid * 1024u;
    const int aoff = lds_byte(wr * 64 + fr, fq * 8), boff = lds_byte(wc * 32 + fr, fq * 8);
#define PG8_SA(b, h) (((b) * 2 + (h)) * HTB)
#define PG8_SB(b, h) ((4 + (b) * 2 + (h)) * HTB)
#define PG8_STAGE(bufoff, gbase, voff) do { _Pragma("unroll") for (int _i = 0; _i < 2; ++_i) \
        __builtin_amdgcn_global_load_lds((const unsigned*)((const char*)(gbase) + (voff)[_i]), (PG8_LAS unsigned*)(lds + (bufoff) + ldsw + _i * 8192), 16, 0, 0); } while (0)
#define PG8_LDA(dst, b, h) do { _Pragma("unroll") for (int m = 0; m < 4; ++m) _Pragma("unroll") for (int k = 0; k < 2; ++k) dst[m][k] = *(const PG8_LAS bf16x8*)(lds + PG8_SA(b, h) + aoff + m * 2048 + k * 1024); } while (0)
#define PG8_LDB(dst, b, h) do { _Pragma("unroll") for (int n = 0; n < 2; ++n) _Pragma("unroll") for (int k = 0; k < 2; ++k) dst[n][k] = *(const PG8_LAS bf16x8*)(lds + PG8_SB(b, h) + boff + n * 2048 + k * 1024); } while (0)
#define PG8_MMA(ai, bj, At, Bt) do { __builtin_amdgcn_s_setprio(1); _Pragma("unroll") for (int m = 0; m < 4; ++m) _Pragma("unroll") for (int n = 0; n < 2; ++n) _Pragma("unroll") for (int k = 0; k < 2; ++k) \
        acc[ai][bj][m][n] = __builtin_amdgcn_mfma_f32_16x16x32_bf16(Bt[n][k], At[m][k], acc[ai][bj][m][n], 0, 0, 0); __builtin_amdgcn_s_setprio(0); } while (0)
#define PG8_WAIT_V(n) asm volatile("s_waitcnt vmcnt(" #n ")" ::: "memory")
#define PG8_WAIT_L(n) asm volatile("s_waitcnt lgkmcnt(" #n ")" ::: "memory")
#define PG8_BAR __builtin_amdgcn_s_barrier()
#define PG8_SCHED __builtin_amdgcn_sched_barrier(0)
    Unit cur, nxt; int ui = 0;
    if (!S.next(0, cur)) return;
    f32x4 acc[2][2][4][2];
#pragma unroll
    for (int a = 0; a < 2; ++a)
#pragma unroll
        for (int b = 0; b < 2; ++b)
#pragma unroll
            for (int m = 0; m < 4; ++m)
#pragma unroll
                for (int n = 0; n < 2; ++n) acc[a][b][m][n] = (f32x4){0.f, 0.f, 0.f, 0.f};
    bf16x8 At[4][2], B0[2][2], B1[2][2];
    const char* cA = (const char*)g.A + (size_t)cur.pm * tstep; const char* cB = (const char*)g.Bt + (size_t)cur.pn * tstep;
    S.a_ready(cur);
    if constexpr (SP2) {
        PG8_STAGE(PG8_SB(0, 0), cB, voffB); PG8_STAGE(PG8_SB(0, 1), cB + hstep, voffB); PG8_STAGE(PG8_SA(0, 0), cA, voffA); PG8_STAGE(PG8_SA(0, 1), cA + hstep, voffA);
        if (wr == 1) PG8_BAR;
        PG8_WAIT_V(2); PG8_BAR;
        PG8_STAGE(PG8_SB(1, 0), cB + kstep, voffB); PG8_STAGE(PG8_SA(1, 0), cA + kstep, voffA); PG8_STAGE(PG8_SB(1, 1), cB + hstep + kstep, voffB);
        PG8_WAIT_V(6); PG8_BAR;
    } else {
        PG8_STAGE(PG8_SB(0, 0), cB, voffB); PG8_STAGE(PG8_SA(0, 0), cA, voffA); PG8_STAGE(PG8_SB(0, 1), cB + hstep, voffB); PG8_STAGE(PG8_SA(0, 1), cA + hstep, voffA);
        if (wr == 1) PG8_BAR;
        PG8_WAIT_V(4); PG8_BAR;
        PG8_STAGE(PG8_SB(1, 0), cB + kstep, voffB); PG8_STAGE(PG8_SA(1, 0), cA + kstep, voffA); PG8_STAGE(PG8_SB(1, 1), cB + hstep + kstep, voffB);
        PG8_WAIT_V(6); PG8_BAR;
    }
    for (;;) {
        const bool has_next = S.next(ui + 1, nxt);
        const char* nA = has_next ? (const char*)g.A + (size_t)nxt.pm * tstep : cA; const char* nB = has_next ? (const char*)g.Bt + (size_t)nxt.pn * tstep : cB;
        for (int t = 0; t < nt; t += 2) {
            const bool last = (t == nt - 2);
            const char* a1 = cA + (size_t)(t + 1) * kstep;
            const char* a2 = last ? nA : cA + (size_t)(t + 2) * kstep; const char* b2 = last ? nB : cB + (size_t)(t + 2) * kstep;
            const char* a3 = a2 + kstep; const char* b3 = b2 + kstep;
            if (last && has_next) S.a_ready(nxt);
            if constexpr (SP2) {
            PG8_LDB(B0, 0, 0); PG8_LDB(B1, 0, 1); PG8_SCHED; PG8_LDA(At, 0, 0); PG8_STAGE(PG8_SA(1, 1), a1 + hstep, voffA);
            PG8_WAIT_V(8); PG8_WAIT_L(0); PG8_BAR; PG8_MMA(0, 0, At, B0); PG8_MMA(0, 1, At, B1); PG8_BAR; PG8_SCHED;
            PG8_LDA(At, 0, 1); PG8_STAGE(PG8_SB(0, 0), b2, voffB); PG8_STAGE(PG8_SB(0, 1), b2 + hstep, voffB); PG8_STAGE(PG8_SA(0, 0), a2, voffA);
            PG8_WAIT_V(8); PG8_WAIT_L(0); PG8_BAR; PG8_MMA(1, 0, At, B0); PG8_MMA(1, 1, At, B1); PG8_BAR; PG8_SCHED;
            PG8_LDB(B0, 1, 0); PG8_LDB(B1, 1, 1); PG8_SCHED; PG8_LDA(At, 1, 0); PG8_STAGE(PG8_SA(0, 1), a2 + hstep, voffA);
            PG8_WAIT_V(8); PG8_WAIT_L(0); PG8_BAR; PG8_MMA(0, 0, At, B0); PG8_MMA(0, 1, At, B1); PG8_BAR; PG8_SCHED;
            PG8_LDA(At, 1, 1); PG8_STAGE(PG8_SB(1, 0), b3, voffB); PG8_STAGE(PG8_SB(1, 1), b3 + hstep, voffB); PG8_STAGE(PG8_SA(1, 0), a3, voffA);
            PG8_WAIT_V(8); PG8_WAIT_L(0); PG8_BAR; PG8_MMA(1, 0, At, B0); PG8_MMA(1, 1, At, B1); PG8_BAR; PG8_SCHED;
            } else {
            PG8_LDB(B0, 0, 0); PG8_SCHED; PG8_LDA(At, 0, 0); PG8_STAGE(PG8_SA(1, 1), a1 + hstep, voffA);
            PG8_WAIT_L(8); PG8_BAR; PG8_WAIT_L(0); PG8_MMA(0, 0, At, B0); PG8_BAR; PG8_SCHED;
            PG8_LDB(B1, 0, 1); PG8_STAGE(PG8_SB(0, 0), b2, voffB);
            PG8_BAR; PG8_WAIT_L(0); PG8_MMA(0, 1, At, B1); PG8_BAR;
            PG8_LDA(At, 0, 1); PG8_STAGE(PG8_SA(0, 0), a2, voffA);
            PG8_BAR; PG8_WAIT_L(0); PG8_MMA(1, 0, At, B0); PG8_BAR; PG8_SCHED;
            PG8_STAGE(PG8_SB(0, 1), b2 + hstep, voffB);
            PG8_WAIT_V(6); PG8_BAR; PG8_MMA(1, 1, At, B1); PG8_BAR;
            PG8_LDB(B0, 1, 0); PG8_SCHED; PG8_LDA(At, 1, 0); PG8_STAGE(PG8_SA(0, 1), a2 + hstep, voffA);
            PG8_WAIT_L(8); PG8_BAR; PG8_WAIT_L(0); PG8_MMA(0, 0, At, B0); PG8_BAR; PG8_SCHED;
            PG8_LDB(B1, 1, 1); PG8_STAGE(PG8_SB(1, 0), b3, voffB);
            PG8_BAR; PG8_WAIT_L(0); PG8_MMA(0, 1, At, B1); PG8_BAR;
            PG8_LDA(At, 1, 1); PG8_STAGE(PG8_SA(1, 0), a3, voffA);
            PG8_BAR; PG8_WAIT_L(0); PG8_MMA(1, 0, At, B0); PG8_BAR; PG8_SCHED;
            PG8_STAGE(PG8_SB(1, 1), b3 + hstep, voffB);
            PG8_WAIT_V(6); PG8_BAR; PG8_MMA(1, 1, At, B1); PG8_BAR;
            }
        }
        if constexpr (ALIGN_EPI) { if (wr == 0) PG8_BAR; }
        if constexpr (!Epi::AFTER_DRAIN) { E(acc, cur, wr, wc, fr, fq); S.done(cur); }
        if (!has_next) break;
#pragma unroll
        for (int a = 0; a < 2; ++a)
#pragma unroll
            for (int b = 0; b < 2; ++b)
#pragma unroll
                for (int m = 0; m < 4; ++m)
#pragma unroll
                    for (int n = 0; n < 2; ++n) acc[a][b][m][n] = (f32x4){0.f, 0.f, 0.f, 0.f};
        cur = nxt; cA = nA; cB = nB; ++ui;
        if constexpr (ALIGN_EPI) { if (wr == 1) PG8_BAR; }
    }
    PG8_WAIT_V(0);
    if constexpr (!ALIGN_EPI) { if (wr == 0) PG8_BAR; }
    PG8_BAR;
    if constexpr (Epi::AFTER_DRAIN) { E.fused(acc, cur, wr, wc, fr, fq, lds, wid, lane); S.done(cur); }
#undef PG8_SA
#undef PG8_SB
#undef PG8_STAGE
#undef PG8_LDA
#undef PG8_LDB
#undef PG8_MMA
#undef PG8_WAIT_V
#undef PG8_WAIT_L
#undef PG8_BAR
#undef PG8_SCHED
}
}

#ifndef PG8_SP2
#define PG8_SP2 true
#endif
#ifndef PG8_ALIGN
#define PG8_ALIGN true
#endif
#ifndef MK_N_LAUNCHES
#define MK_N_LAUNCHES 1
#endif
#ifndef NAIVE_GEMM
#define NAIVE_GEMM 0
#endif

constexpr int D = 2048, SEQ = 4096, CTXL = 256, NLAT = 8192, NCTX = 512, NROWS = 8704;
constexpr int NH = 16, HD = 128, NE = 16, NG = 128, NP = 64, GH = 16, D6 = 6 * D;
constexpr int RPE = 1280;
constexpr float LN_EPS = 1e-5f, ALPHA = 1.4142135623730951f;
constexpr int NWAVES = 8, NTHREADS = 512;
constexpr int LDS_BYTES = 147456, MISC_OFF = 131072 + 320;

constexpr size_t MiB = 1u << 20;
constexpr size_t WS_CTL = 0, CTL_ZERO_BYTES = 1 * MiB;
constexpr size_t WS_MODS = 1 * MiB;
constexpr size_t WS_SPAR = 2 * MiB;
constexpr size_t WS_AFF = 6 * MiB;
constexpr size_t WS_SLOT = 7 * MiB;
constexpr size_t WS_IDX = 8 * MiB;
constexpr size_t WS_GATE = 8 * MiB + 512 * 1024;
constexpr int T_WQKV = 16, T_WO = 40, T_WVG = 48, T_MOE1 = 64, T_MOE2 = 576, T_HB = 832, T_QK = 866, T_VT = 934, T_AO = 968, T_XE = 1002, T_ACT = 1082, T_Z = 1162;
constexpr size_t WS_O = 1194 * MiB, WS_X1 = 1262 * MiB, WS_X2 = 1330 * MiB, WS_YE = 1398 * MiB, WS_YF = 1558 * MiB, WS_YB = 1622 * MiB, WS_XLOC = 1686 * MiB, WS_CARRY = 1718 * MiB, WS_END = 1750 * MiB;
constexpr int CW_BAR = 4096;

#define GAS __attribute__((address_space(1)))
#define LAS __attribute__((address_space(3)))
typedef unsigned short bf16;
typedef unsigned v4u __attribute__((ext_vector_type(4)));
typedef unsigned v2u __attribute__((ext_vector_type(2)));
typedef float f32x4 __attribute__((ext_vector_type(4)));
typedef float f32x2 __attribute__((ext_vector_type(2)));
typedef short bf16x8 __attribute__((ext_vector_type(8)));
typedef GAS unsigned gu32;
#define RLX_AGENT __ATOMIC_RELAXED, __HIP_MEMORY_SCOPE_AGENT

__device__ __forceinline__ float bf2f(unsigned b) { return __uint_as_float(b << 16); }
__device__ __forceinline__ unsigned pk2(float lo, float hi) { typedef __bf16 bf2_t __attribute__((ext_vector_type(2))); f32x2 v = {lo, hi}; return __builtin_bit_cast(unsigned, __builtin_convertvector(v, bf2_t)); }
__device__ __forceinline__ float wave_sum(float v) {
#pragma unroll
    for (int o = 1; o < 64; o <<= 1) v += __shfl_xor(v, o);
    return v;
}
__device__ __forceinline__ float wave_max(float v) {
#pragma unroll
    for (int o = 1; o < 64; o <<= 1) v = fmaxf(v, __shfl_xor(v, o));
    return v;
}
__device__ __forceinline__ float silu_f(float x) { return x / (1.0f + __expf(-x)); }
__device__ __forceinline__ float sigmoid_f(float x) { return 1.0f / (1.0f + __expf(-x)); }
__device__ __forceinline__ float gelu_tanh_f(float x) { const float y = 0.7978845608028654f * (x + 0.044715f * x * x * x); const float t = 1.0f - 2.0f / (1.0f + __expf(2.0f * y)); return 0.5f * x * (1.0f + t); }
#define XB_TMO      128
#define XB_XCNT(j)  (256  + 64 * (j))
#define XB_XSUB(j)  (1280 + 64 * (j))
#define XB_XGEN(j)  (2304 + 64 * (j))
#define XB_TOP      3328
#define XB_TOPGEN   3392
#define XCD_BAR_WORDS 3456
#define XB_SPIN_CAP (1u << 18)

__device__ __forceinline__ unsigned xb_ld(unsigned* p)              { return __hip_atomic_load(p, __ATOMIC_RELAXED, __HIP_MEMORY_SCOPE_AGENT); }
__device__ __forceinline__ unsigned xb_add(unsigned* p, unsigned v) { return __hip_atomic_fetch_add(p, v, __ATOMIC_RELAXED, __HIP_MEMORY_SCOPE_AGENT); }
__device__ __forceinline__ unsigned xb_xcc_id() { return (unsigned)__builtin_amdgcn_s_getreg((3 << 11) | 20) & 0xFu; }
#define XB_SPIN(cond, bar) do { unsigned _sp = 0; while (cond) { __builtin_amdgcn_s_sleep(1); \
    if ((++_sp & 255u) == 0u) { if (xb_ld(&(bar)[XB_TMO])) break; if (_sp > XB_SPIN_CAP) { atomicAdd(&(bar)[XB_TMO], 1u); break; } } } } while (0)

struct XcdBarrier {
    unsigned* bar; unsigned x;
    volatile LAS unsigned* st;
};

__device__ __forceinline__ XcdBarrier xcd_barrier_post(unsigned* bar, volatile LAS unsigned* st) {
    XcdBarrier b; b.bar = bar; b.x = xb_xcc_id(); b.st = st;
    if (threadIdx.x == 0) (void)xb_add(&bar[XB_XCNT(b.x)], 1u);
    return b;
}
__device__ __forceinline__ void xcd_barrier_complete(unsigned* bar, unsigned x, unsigned& nloc, unsigned& nx) {
    const unsigned G = gridDim.x * gridDim.y * gridDim.z;
    unsigned sum, cnt, mine, sp = 0u;
    for (;;) {
        sum = 0u; cnt = 0u; mine = 0u;
#pragma unroll
        for (unsigned j = 0; j < 16; ++j) { const unsigned c = xb_ld(&bar[XB_XCNT(j)]); sum += c; cnt += (c > 0u) ? 1u : 0u; mine = (j == x) ? c : mine; }
        if (sum == G) break;
        __builtin_amdgcn_s_sleep(1);
        if ((++sp & 255u) == 0u) { if (xb_ld(&bar[XB_TMO])) break; if (sp > XB_SPIN_CAP) { atomicAdd(&bar[XB_TMO], 1u); break; } }
    }
    nloc = mine > 0u ? mine : 1u; nx = cnt > 0u ? cnt : 1u;
}

__device__ __forceinline__ void xcd_barrier(const XcdBarrier& b) {
    asm volatile("s_waitcnt vmcnt(0)" ::: "memory");
    __syncthreads();
    if (threadIdx.x == 0) {
        unsigned* bar = b.bar;
        __builtin_amdgcn_s_waitcnt(0);
        unsigned nloc = b.st[0], nx = b.st[1];
        if (nloc == 0u) { xcd_barrier_complete(bar, b.x, nloc, nx); b.st[0] = nloc; b.st[1] = nx; }
        const unsigned old = xb_add(&bar[XB_XSUB(b.x)], 1u);
        const unsigned gen = old / nloc;
        if (old + 1u == (gen + 1u) * nloc) {
            __builtin_amdgcn_fence(__ATOMIC_RELEASE, "agent");
            asm volatile("s_waitcnt vmcnt(0)" ::: "memory");
            const unsigned og = xb_add(&bar[XB_TOP], 1u);
            const unsigned tg = og / nx;
            if (og + 1u == (tg + 1u) * nx) xb_add(&bar[XB_TOPGEN], 1u);
            else XB_SPIN(xb_ld(&bar[XB_TOPGEN]) == tg, bar);
            __builtin_amdgcn_fence(__ATOMIC_ACQUIRE, "agent");
            xb_add(&bar[XB_XGEN(b.x)], 1u);
            asm volatile("s_waitcnt vmcnt(0)" ::: "memory");
        } else {
            XB_SPIN(xb_ld(&bar[XB_XGEN(b.x)]) == gen, bar);
            __builtin_amdgcn_fence(__ATOMIC_ACQUIRE, "agent");
            asm volatile("s_waitcnt vmcnt(0)" ::: "memory");
        }
    }
    __syncthreads();
}

struct Frame {
    LAS unsigned char* lds;
    unsigned char* ws;
    int tid, lane, wave, vcu, G;
    const float* in[25];
    float* out;
};
enum { I_X = 0, I_C, I_CTX, I_CCTX, I_WMOD, I_BMOD, I_LNG, I_LNB, I_WQKV, I_WO, I_RPB, I_LAMRE, I_LAMIM, I_LOGSTEP, I_BRE, I_BIM, I_CRE, I_CIM, I_SD, I_WVAL, I_WGATE, I_ROUTER, I_MGATE, I_MUP, I_MDOWN };

__device__ __forceinline__ bf16* ws_tile(const Frame& F, int t) { return (bf16*)(F.ws + (size_t)t * MiB); }
__device__ __forceinline__ float* ws_f32(const Frame& F, size_t off) { return (float*)(F.ws + off); }
__device__ __forceinline__ const float* mods(const Frame& F, int l, int r, int which) { return (const float*)(F.ws + WS_MODS) + (size_t)((l * 3 + r) * 6 + which) * D; }
__device__ __forceinline__ int row_r(int row) { return row < NLAT ? (row >> 12) : 2; }

struct SegSched {
    int G, cx, n0, ntot, nM0, nN0, pm0, pn0, nM1, nN1, pm1, pn1;
    __device__ __forceinline__ void init(int G_, int cx_, int nM0_, int nN0_, int pm0_, int pn0_, int nM1_, int nN1_, int pm1_, int pn1_) {
        G = G_; cx = cx_; nM0 = nM0_; nN0 = nN0_; pm0 = pm0_; pn0 = pn0_; nM1 = nM1_; nN1 = nN1_; pm1 = pm1_; pn1 = pn1_; n0 = nM0 * nN0; ntot = n0 + nM1 * nN1; }
    __device__ __forceinline__ bool next(int i, pg8::Unit& u) const {
        const int U = i * G + cx; if (U >= ntot) return false;
        const bool s1 = U >= n0; const int loc = s1 ? U - n0 : U, nM = s1 ? nM1 : nM0, nN = s1 ? nN1 : nN0;
        const int nig = 8 * nN, gid = loc / nig, fm = gid * 8, gsz = (nM - fm) < 8 ? (nM - fm) : 8;
        u.pm = (s1 ? pm1 : pm0) + fm + ((loc % nig) % gsz); u.pn = (s1 ? pn1 : pn0) + (loc % nig) / gsz; return true;
    }
    __device__ __forceinline__ void a_ready(const pg8::Unit&) const {}
    __device__ __forceinline__ void done(const pg8::Unit&) const {}
};
struct MoeSched {
    int G, cx, nMe, nNe, pmA, pnB, ntot;
    __device__ __forceinline__ void init(int G_, int cx_, int nMe_, int nNe_, int pmA_, int pnB_) { G = G_; cx = cx_; nMe = nMe_; nNe = nNe_; pmA = pmA_; pnB = pnB_; ntot = NE * nMe * nNe; }
    __device__ __forceinline__ bool next(int i, pg8::Unit& u) const {
        const int U = i * G + cx; if (U >= ntot) return false;
        const int per = nMe * nNe, e = U / per, loc = U % per;
        u.pm = pmA + e * 5 + loc % nMe; u.pn = pnB + e * nNe + loc / nMe; return true;
    }
    __device__ __forceinline__ void a_ready(const pg8::Unit&) const {}
    __device__ __forceinline__ void done(const pg8::Unit&) const {}
};

struct EpiQKV {
    static constexpr bool PERM = true, AFTER_DRAIN = false;
    bf16* QK; bf16* VT;
    __device__ __forceinline__ void operator()(const f32x4 (&acc)[2][2][4][2], const pg8::Unit& u, int wr, int wc, int fr, int fq) const {
        bf16* base; int ldc;
        if (u.pn < T_HB) { base = QK + (size_t)(u.pm - T_HB) * 256 * 4096 + (size_t)(u.pn - T_WQKV) * 256; ldc = 4096; }
        else { base = VT + (size_t)(u.pm - (T_WQKV + 16)) * 256 * NROWS + (size_t)(u.pn - T_HB) * 256; ldc = NROWS; }
#pragma unroll
        for (int ai = 0; ai < 2; ++ai)
#pragma unroll
            for (int m = 0; m < 4; ++m) { bf16* rowp = base + (size_t)(ai * 128 + wr * 64 + m * 16 + fr) * ldc + wc * 32 + 8 * fq;
#pragma unroll
                for (int bj = 0; bj < 2; ++bj) { const f32x4 v0 = acc[ai][bj][m][0], v1 = acc[ai][bj][m][1];
                    v4u w; w.x = pk2(v0[0], v0[1]); w.y = pk2(v0[2], v0[3]); w.z = pk2(v1[0], v1[1]); w.w = pk2(v1[2], v1[3]);
                    *(v4u*)(rowp + bj * 128) = w; } }
    }
};
struct EpiWo {
    static constexpr bool PERM = false, AFTER_DRAIN = false;
    float* O;
    __device__ __forceinline__ void operator()(const f32x4 (&acc)[2][2][4][2], const pg8::Unit& u, int wr, int wc, int fr, int fq) const {
        float* base = O + (size_t)(u.pm - T_AO) * 256 * D + (size_t)(u.pn - T_WO) * 256;
#pragma unroll
        for (int ai = 0; ai < 2; ++ai)
#pragma unroll
            for (int m = 0; m < 4; ++m) { float* rowp = base + (size_t)(ai * 128 + wr * 64 + m * 16 + fr) * D + wc * 32 + 4 * fq;
#pragma unroll
                for (int bj = 0; bj < 2; ++bj)
#pragma unroll
                    for (int n = 0; n < 2; ++n) *(f32x4*)(rowp + bj * 128 + n * 16) = acc[ai][bj][m][n]; }
    }
};
struct EpiGlu {
    static constexpr bool PERM = false, AFTER_DRAIN = false;
    float* O;
    __device__ __forceinline__ void operator()(const f32x4 (&acc)[2][2][4][2], const pg8::Unit& u, int wr, int wc, int fr, int fq) const {
        float* base = O + (size_t)(u.pm - T_Z) * 256 * D + (size_t)(u.pn - T_WVG) * 128;
#pragma unroll
        for (int ai = 0; ai < 2; ++ai)
#pragma unroll
            for (int m = 0; m < 4; ++m) { float* rowp = base + (size_t)(ai * 128 + wr * 64 + m * 16 + fr) * D + wc * 32 + 4 * fq;
#pragma unroll
                for (int n = 0; n < 2; ++n) { const f32x4 a = acc[ai][0][m][n], g = acc[ai][1][m][n]; f32x4 o;
#pragma unroll
                    for (int j = 0; j < 4; ++j) o[j] = a[j] * sigmoid_f(g[j]);
                    *(f32x4*)(rowp + n * 16) = o; } }
    }
};
struct EpiSwiglu {
    static constexpr bool PERM = true, AFTER_DRAIN = false;
    bf16* ACT; int pnB;
    __device__ __forceinline__ void operator()(const f32x4 (&acc)[2][2][4][2], const pg8::Unit& u, int wr, int wc, int fr, int fq) const {
        const int j = (u.pn - pnB) & 15;
        bf16* base = ACT + (size_t)(u.pm - T_XE) * 256 * D + (size_t)j * 128;
#pragma unroll
        for (int ai = 0; ai < 2; ++ai)
#pragma unroll
            for (int m = 0; m < 4; ++m) { bf16* rowp = base + (size_t)(ai * 128 + wr * 64 + m * 16 + fr) * D + wc * 32 + 8 * fq;
                f32x4 o0, o1;
#pragma unroll
                for (int q = 0; q < 4; ++q) { o0[q] = silu_f(acc[ai][0][m][0][q]) * acc[ai][1][m][0][q]; o1[q] = silu_f(acc[ai][0][m][1][q]) * acc[ai][1][m][1][q]; }
                v4u w; w.x = pk2(o0[0], o0[1]); w.y = pk2(o0[2], o0[3]); w.z = pk2(o1[0], o1[1]); w.w = pk2(o1[2], o1[3]);
                *(v4u*)rowp = w; }
    }
};
struct EpiDown {
    static constexpr bool PERM = false, AFTER_DRAIN = false;
    float* YE; const float* GATE; int pnB;
    __device__ __forceinline__ void operator()(const f32x4 (&acc)[2][2][4][2], const pg8::Unit& u, int wr, int wc, int fr, int fq) const {
        const int j = (u.pn - pnB) & 7; const int rt = (u.pm - T_ACT) * 256;
        float* base = YE + (size_t)rt * D + (size_t)j * 256;
#pragma unroll
        for (int ai = 0; ai < 2; ++ai)
#pragma unroll
            for (int m = 0; m < 4; ++m) { const int r = ai * 128 + wr * 64 + m * 16 + fr; const float gt = GATE[rt + r]; float* rowp = base + (size_t)r * D + wc * 32 + 4 * fq;
#pragma unroll
                for (int bj = 0; bj < 2; ++bj)
#pragma unroll
                    for (int n = 0; n < 2; ++n) *(f32x4*)(rowp + bj * 128 + n * 16) = acc[ai][bj][m][n] * gt; }
    }
};

__device__ __forceinline__ float dot_bf16(const bf16* a, const bf16* b, int K) {
    float s = 0.f;
    for (int k = 0; k < K; k += 8) { const v4u x = *(const v4u*)(a + k), y = *(const v4u*)(b + k);
#pragma unroll
        for (int q = 0; q < 4; ++q) { s += bf2f(x[q] & 0xffffu) * bf2f(y[q] & 0xffffu); s += bf2f(x[q] >> 16) * bf2f(y[q] >> 16); } }
    return s;
}
template <class Epi, class Sched>
__device__ __forceinline__ void naive_gemm_phase(const pg8::Gemm g, const Sched& S, const Epi& E) {
    const int tid = threadIdx.x, wid = __builtin_amdgcn_readfirstlane(tid >> 6), lane = tid & 63, wr = wid >> 2, wc = wid & 3, fr = lane & 15, fq = lane >> 4;
    pg8::Unit u;
    for (int i = 0; S.next(i, u); ++i) {
        f32x4 acc[2][2][4][2];
        const bf16* A = g.A + (size_t)u.pm * 256 * g.K; const bf16* B = g.Bt + (size_t)u.pn * 256 * g.K;
#pragma unroll
        for (int ai = 0; ai < 2; ++ai)
#pragma unroll
            for (int m = 0; m < 4; ++m) { const bf16* ar = A + (size_t)(ai * 128 + wr * 64 + m * 16 + fr) * g.K;
#pragma unroll
                for (int bj = 0; bj < 2; ++bj)
#pragma unroll
                    for (int n = 0; n < 2; ++n)
#pragma unroll
                        for (int j = 0; j < 4; ++j) { const int c = Epi::PERM ? (bj * 128 + wc * 32 + 8 * fq + 4 * n + j) : (bj * 128 + wc * 32 + 16 * n + 4 * fq + j);
                            acc[ai][bj][m][n][j] = dot_bf16(ar, B + (size_t)c * g.K, g.K); } }
        E(acc, u, wr, wc, fr, fq);
    }
}
template <class Epi, class Sched>
__device__ __forceinline__ void run_gemm(Frame& F, const Sched& S, const Epi& E) {
    const pg8::Gemm g{(const pg8::bf16_t*)F.ws, (const pg8::bf16_t*)F.ws, 0, 0, D};
#if NAIVE_GEMM
    naive_gemm_phase<Epi, Sched>(g, S, E);
#else
    pg8::gemm_phase<Epi, Sched, PG8_ALIGN, PG8_SP2>((PG8_LAS unsigned char*)F.lds, g, S, E);
#endif
}

#define LDV(p, j) (*(const f32x4*)((p) + 4 * F.lane + 256 * (j)))

__device__ __forceinline__ void p0_mods(Frame& F) {
    LAS float* S = (LAS float*)F.lds;
    LAS float* P = S + 3 * D;
    const float* c = F.in[I_C]; const float* cctx = F.in[I_CCTX];
    for (int i = F.tid; i < 3 * D; i += NTHREADS) { const int r = i / D, k = i % D; const float cv = (r < 2) ? c[r * D + k] : cctx[k]; S[i] = cv / (1.0f + expf(-cv)); }
    __syncthreads();
    const int tl = F.tid & 15, kg = F.tid >> 4;
    float* M = (float*)(F.ws + WS_MODS);
    for (int it = blockIdx.x; it < 2 * 192; it += F.G) {
        const int l = it / 192, cc = it % 192;
        const float* w = F.in[I_WMOD] + (size_t)l * D * D6 + cc * 64 + tl * 4;
        f32x4 a0 = {0.f, 0.f, 0.f, 0.f}, a1 = a0, a2 = a0;
#pragma unroll 8
        for (int kk = 0; kk < 64; ++kk) { const int k = kg * 64 + kk; const f32x4 wv = *(const f32x4*)(w + (size_t)k * D6); a0 += wv * S[k]; a1 += wv * S[D + k]; a2 += wv * S[2 * D + k]; }
#pragma unroll
        for (int j = 0; j < 4; ++j) { P[(kg * 3 + 0) * 64 + tl * 4 + j] = a0[j]; P[(kg * 3 + 1) * 64 + tl * 4 + j] = a1[j]; P[(kg * 3 + 2) * 64 + tl * 4 + j] = a2[j]; }
        __syncthreads();
        if (F.tid < 192) { const int r = F.tid >> 6, col = F.tid & 63; float s = 0.f;
            for (int q = 0; q < 32; ++q) s += P[(q * 3 + r) * 64 + col];
            M[(size_t)(l * 3 + r) * D6 + cc * 64 + col] = s + F.in[I_BMOD][l * D6 + cc * 64 + col]; }
        __syncthreads();
    }
}
__device__ __forceinline__ void p0_s5params(Frame& F) {
    float* AR = (float*)(F.ws + WS_SPAR); float* AI = AR + 2 * NG * NP; float* BB = AI + 2 * NG * NP;
    for (int idx = blockIdx.x * NTHREADS + F.tid; idx < 2 * NG * NP; idx += F.G * NTHREADS) {
        const int dg = idx / NP;
        const double lr = (double)fminf(F.in[I_LAMRE][idx], -1e-4f), li = (double)F.in[I_LAMIM][idx], dt = exp((double)F.in[I_LOGSTEP][dg]);
        const double mag = exp(lr * dt); double sn, cs; sincos(li * dt, &sn, &cs);
        const double ar = mag * cs, ai = mag * sn, nr = ar - 1.0, den = lr * lr + li * li, cr = (nr * lr + ai * li) / den, ci = (ai * lr - nr * li) / den;
        AR[idx] = (float)ar; AI[idx] = (float)ai;
        for (int h = 0; h < GH; ++h) { const double bre = F.in[I_BRE][(size_t)idx * GH + h], bim = F.in[I_BIM][(size_t)idx * GH + h];
            BB[(size_t)idx * 32 + h] = (float)(cr * bre - ci * bim); BB[(size_t)idx * 32 + 16 + h] = (float)(cr * bim + ci * bre); }
    }
}
__device__ __forceinline__ void p0_transpose_item(const float* W, int ldw, bf16* WT, int dst_row0, LAS float* scr, int k0, int lane) {
#pragma unroll 8
    for (int i = 0; i < 32; ++i) { const int kk = 2 * i + (lane >> 5); scr[kk * 33 + (lane & 31)] = W[(size_t)(k0 + kk) * ldw + (lane & 31)]; }
    asm volatile("s_waitcnt lgkmcnt(0)" ::: "memory");
    const int c = lane & 7;
#pragma unroll
    for (int j = 0; j < 4; ++j) { const int n = (lane >> 3) + 8 * j; const LAS float* s = scr + (8 * c) * 33 + n;
        v4u o; o.x = pk2(s[0 * 33], s[1 * 33]); o.y = pk2(s[2 * 33], s[3 * 33]); o.z = pk2(s[4 * 33], s[5 * 33]); o.w = pk2(s[6 * 33], s[7 * 33]);
        *(v4u*)(WT + (size_t)(dst_row0 + n) * D + k0 + 8 * c) = o; }
    asm volatile("s_waitcnt lgkmcnt(0)" ::: "memory");
}
__device__ __forceinline__ void p0_weights(Frame& F) {
    LAS float* scr = (LAS float*)(F.lds + F.wave * 16384);
    const int gw = F.vcu * NWAVES + F.wave, NGW = F.G * NWAVES;
    constexpr int NSQ = 6 + 2 * NE * 3;
    for (int it = gw; it < NSQ * 2048; it += NGW) {
        const int sq = it >> 11, r = it & 2047, kb = r >> 6, nb = r & 63, n0 = nb * 32;
        const float* src; int ldw = D; bf16* dst; int mode = 0, off = 0;
        if (sq < 3) { src = F.in[I_WQKV] + sq * D; ldw = 3 * D; dst = ws_tile(F, T_WQKV) + (size_t)sq * D * D; }
        else if (sq == 3) { src = F.in[I_WO]; dst = ws_tile(F, T_WO); }
        else if (sq == 4) { src = F.in[I_WVAL]; dst = ws_tile(F, T_WVG); mode = 1; }
        else if (sq == 5) { src = F.in[I_WGATE]; dst = ws_tile(F, T_WVG); mode = 1; off = 128; }
        else { const int mm = sq - 6, l = mm / 48, e = (mm % 48) / 3, t = mm % 3; const size_t wofs = (size_t)(l * NE + e) * D * D;
            if (t == 0) { src = F.in[I_MGATE] + wofs; dst = ws_tile(F, T_MOE1 + l * 256) + (size_t)e * 4096 * D; mode = 1; }
            else if (t == 1) { src = F.in[I_MUP] + wofs; dst = ws_tile(F, T_MOE1 + l * 256) + (size_t)e * 4096 * D; mode = 1; off = 128; }
            else { src = F.in[I_MDOWN] + wofs; dst = ws_tile(F, T_MOE2 + l * 128) + (size_t)e * 2048 * D; } }
        const int dr0 = mode ? ((n0 >> 7) * 256 + (n0 & 127) + off) : n0;
        p0_transpose_item(src + n0, ldw, dst, dr0, scr, kb * 64, F.lane);
    }
}
__device__ __forceinline__ void p1_prep(Frame& F) {
    const int gw = F.vcu * NWAVES + F.wave, NGW = F.G * NWAVES;
    bf16* HB = ws_tile(F, T_HB);
    for (int row = gw; row < NROWS; row += NGW) {
        const float* xr = row < NLAT ? F.in[I_X] + (size_t)row * D : F.in[I_CTX] + (size_t)(row - NLAT) * D;
        const int r = row_r(row); const float* sh = mods(F, 0, r, 0); const float* sc = mods(F, 0, r, 1);
#pragma unroll
        for (int j = 0; j < 8; ++j) { const f32x4 v = LDV(xr, j), a = LDV(sh, j), b = LDV(sc, j); const f32x4 h = v * (b + 1.0f) + a;
            v2u w; w.x = pk2(h[0], h[1]); w.y = pk2(h[2], h[3]); *(v2u*)(HB + (size_t)row * D + 4 * F.lane + 256 * j) = w; }
    }
}
__device__ __forceinline__ void p3_attn_naive(Frame& F) {
    const int gw = F.vcu * NWAVES + F.wave, NGW = F.G * NWAVES;
    LAS float* Pl = (LAS float*)(F.lds + F.wave * 4096);
    LAS int* Tl = (LAS int*)(F.lds + F.wave * 4096 + 2048);
    const bf16* QK = ws_tile(F, T_QK); const bf16* VT = ws_tile(F, T_VT); bf16* AO = ws_tile(F, T_AO);
    const float scale = 0.08838834764831845f;
    for (int un = gw; un < NROWS * NH; un += NGW) {
        const int row = un >> 4, h = un & 15; const bool lat = row < NLAT;
        int b, r = 0, qc = 0, rs = 0, cst = 0;
        if (lat) { b = row >> 12; const int t = row & 4095; r = t >> 6; qc = t & 63; rs = min(max(r - 4, 0), 56); cst = min(max(qc - 8, 0), 48); } else b = (row - NLAT) >> 8;
        const int nk = lat ? 384 : 256;
        const bf16* q = QK + (size_t)row * 4096 + h * HD;
        float sv[6]; float mx = -3.0e38f;
#pragma unroll
        for (int i = 0; i < 6; ++i) { const int kk = F.lane + 64 * i; float s = -3.0e38f;
            if (kk < nk) { int krow; float bias = 0.f;
                if (lat && kk < 128) { const int kr = rs + (kk >> 4), kc = cst + (kk & 15); krow = b * SEQ + kr * 64 + kc;
                    const int dc = min(max(kc - qc + 15, 0), 30); bias = F.in[I_RPB][(h * 15 + (kr - r + 7)) * 31 + dc]; }
                else krow = NLAT + b * CTXL + (lat ? kk - 128 : kk);
                s = dot_bf16(q, QK + (size_t)krow * 4096 + D + h * HD, HD) * scale + bias; Tl[kk] = krow; }
            sv[i] = s; mx = fmaxf(mx, s); }
        mx = wave_max(mx); float sum = 0.f;
#pragma unroll
        for (int i = 0; i < 6; ++i) { const int kk = F.lane + 64 * i; const float p = (kk < nk) ? __expf(sv[i] - mx) : 0.f; sv[i] = p; sum += p; }
        sum = wave_sum(sum); const float inv = 1.0f / sum;
#pragma unroll
        for (int i = 0; i < 6; ++i) { const int kk = F.lane + 64 * i; if (kk < nk) Pl[kk] = sv[i] * inv; }
        asm volatile("s_waitcnt lgkmcnt(0)" ::: "memory");
        float o0 = 0.f, o1 = 0.f; const bf16* v0 = VT + (size_t)(h * HD + 2 * F.lane) * NROWS; const bf16* v1 = v0 + NROWS;
        for (int kk = 0; kk < nk; ++kk) { const float p = Pl[kk]; const int kr = Tl[kk]; o0 += p * bf2f(v0[kr]); o1 += p * bf2f(v1[kr]); }
        *(unsigned*)(AO + (size_t)row * D + h * HD + 2 * F.lane) = pk2(o0, o1);
        asm volatile("s_waitcnt lgkmcnt(0)" ::: "memory");
    }
}
__device__ __forceinline__ const float* xin_row(Frame& F, int l, int row) {
    if (l == 0) return row < NLAT ? F.in[I_X] + (size_t)row * D : F.in[I_CTX] + (size_t)(row - NLAT) * D;
    return (const float*)(F.ws + WS_X2) + (size_t)row * D;
}
__device__ __forceinline__ void ln_rows(f32x4 (&v)[8], const float* g, const float* bb, const Frame& F) {
    float s = 0.f;
#pragma unroll
    for (int j = 0; j < 8; ++j) s += (v[j][0] + v[j][1]) + (v[j][2] + v[j][3]);
    const float mean = wave_sum(s) * (1.0f / D); float s2 = 0.f;
#pragma unroll
    for (int j = 0; j < 8; ++j) { v[j] = v[j] - mean; s2 += (v[j][0] * v[j][0] + v[j][1] * v[j][1]) + (v[j][2] * v[j][2] + v[j][3] * v[j][3]); }
    const float rstd = 1.0f / sqrtf(wave_sum(s2) * (1.0f / D) + LN_EPS);
#pragma unroll
    for (int j = 0; j < 8; ++j) v[j] = v[j] * rstd * LDV(g, j) + LDV(bb, j);
}
__device__ __forceinline__ void row_phase(Frame& F, int l) {
    const int gw = F.vcu * NWAVES + F.wave, NGW = F.G * NWAVES, nrows = l ? NLAT : NROWS;
    const float* O = (const float*)(F.ws + WS_O); float* X1 = (float*)(F.ws + WS_X1); bf16* HB = ws_tile(F, T_HB); float* AFF = (float*)(F.ws + WS_AFF);
    const float* lng = F.in[I_LNG] + (size_t)(l * 2 + 0) * D; const float* lnb = F.in[I_LNB] + (size_t)(l * 2 + 0) * D; const float* wr = F.in[I_ROUTER] + (size_t)l * D * NE;
    for (int row = gw; row < nrows; row += NGW) {
        const float* xr = xin_row(F, l, row); const float* orow = O + (size_t)row * D; const int r = row_r(row);
        const float* g1 = mods(F, l, r, 2); const float* sh2 = mods(F, l, r, 3); const float* sc2 = mods(F, l, r, 4);
        f32x4 v[8];
#pragma unroll
        for (int j = 0; j < 8; ++j) v[j] = LDV(xr, j) * ALPHA + LDV(g1, j) * LDV(orow, j);
        ln_rows(v, lng, lnb, F);
        float lg[NE];
#pragma unroll
        for (int e = 0; e < NE; ++e) lg[e] = 0.f;
#pragma unroll
        for (int j = 0; j < 8; ++j) { *(f32x4*)(X1 + (size_t)row * D + 4 * F.lane + 256 * j) = v[j];
            const f32x4 h = v[j] * (LDV(sc2, j) + 1.0f) + LDV(sh2, j);
            v2u w; w.x = pk2(h[0], h[1]); w.y = pk2(h[2], h[3]); *(v2u*)(HB + (size_t)row * D + 4 * F.lane + 256 * j) = w;
#pragma unroll
            for (int q = 0; q < 4; ++q) { const float* wp = wr + (size_t)(4 * F.lane + 256 * j + q) * NE;
#pragma unroll
                for (int e4 = 0; e4 < 4; ++e4) { const f32x4 wv = *(const f32x4*)(wp + 4 * e4);
#pragma unroll
                    for (int t = 0; t < 4; ++t) lg[4 * e4 + t] += h[q] * wv[t]; } } }
        float mx = -3.0e38f;
#pragma unroll
        for (int e = 0; e < NE; ++e) { lg[e] = wave_sum(lg[e]); mx = fmaxf(mx, lg[e]); }
        float sum = 0.f;
#pragma unroll
        for (int e = 0; e < NE; ++e) { lg[e] = expf(lg[e] - mx); sum += lg[e]; }
        float mine = 0.f;
#pragma unroll
        for (int e = 0; e < NE; ++e) mine = (F.lane == e) ? lg[e] / sum : mine;
        if (F.lane < NE) AFF[(size_t)row * NE + F.lane] = mine;
    }
}
__device__ __forceinline__ void topk_phase(Frame& F, int l) {
    LAS float* V = (LAS float*)F.lds;
    const float* AFF = (const float*)(F.ws + WS_AFF); int* SLOT = (int*)(F.ws + WS_SLOT); int* IDX = (int*)(F.ws + WS_IDX); float* GATE = (float*)(F.ws + WS_GATE);
    const int nlat = 2 * NE * 8, ntot = nlat + (l == 0 ? 2 * NE : 0);
    for (int un = blockIdx.x; un < ntot; un += F.G) {
        const bool lat = un < nlat; int b, e, ch, n, cap, rowbase, slotbase;
        if (lat) { b = un >> 7; e = (un >> 3) & 15; ch = un & 7; n = SEQ; cap = 512; rowbase = b * SEQ; slotbase = e * RPE + b * 512; }
        else { const int q = un - nlat; b = q >> 4; e = q & 15; ch = 0; n = CTXL; cap = 32; rowbase = NLAT + b * CTXL; slotbase = e * RPE + 1024 + b * 32; }
        for (int t = F.tid; t < n; t += NTHREADS) V[t] = AFF[(size_t)(rowbase + t) * NE + e];
        __syncthreads();
        const int t = ch * 512 + F.tid;
        if (t < n) { const float v = V[t]; int rank = 0;
            for (int j = 0; j < n; j += 4) { const f32x4 w = *(const LAS f32x4*)(V + j);
                rank += (w[0] > v || (w[0] == v && j + 0 < t)) ? 1 : 0; rank += (w[1] > v || (w[1] == v && j + 1 < t)) ? 1 : 0;
                rank += (w[2] > v || (w[2] == v && j + 2 < t)) ? 1 : 0; rank += (w[3] > v || (w[3] == v && j + 3 < t)) ? 1 : 0; }
            int s = -1;
            if (rank < cap) { s = slotbase + rank; IDX[s] = rowbase + t; GATE[s] = v; }
            SLOT[(size_t)(rowbase + t) * NE + e] = s; }
        __syncthreads();
    }
}
__device__ __forceinline__ void gather_phase(Frame& F, int l) {
    const int gw = F.vcu * NWAVES + F.wave, NGW = F.G * NWAVES, nv = l ? 1024 : 1088;
    const bf16* HB = ws_tile(F, T_HB); bf16* XE = ws_tile(F, T_XE); const int* IDX = (const int*)(F.ws + WS_IDX);
    for (int i = gw; i < NE * nv; i += NGW) { const int e = i / nv, s = e * RPE + i % nv; const int src = IDX[s];
        const v4u* sp = (const v4u*)(HB + (size_t)src * D); v4u* dp = (v4u*)(XE + (size_t)s * D);
#pragma unroll
        for (int j = 0; j < 4; ++j) dp[F.lane + 64 * j] = sp[F.lane + 64 * j]; }
}
__device__ __forceinline__ void combine_phase(Frame& F, int l) {
    const int gw = F.vcu * NWAVES + F.wave, NGW = F.G * NWAVES, nrows = l ? NLAT : NROWS;
    const float* X1 = (const float*)(F.ws + WS_X1); const float* YE = (const float*)(F.ws + WS_YE); const int* SLOT = (const int*)(F.ws + WS_SLOT);
    float* X2 = (float*)(F.ws + WS_X2); bf16* HB = ws_tile(F, T_HB);
    const float* lng = F.in[I_LNG] + (size_t)(l * 2 + 1) * D; const float* lnb = F.in[I_LNB] + (size_t)(l * 2 + 1) * D;
    for (int row = gw; row < nrows; row += NGW) {
        const int r = row_r(row); const float* g2 = mods(F, l, r, 5); const float* x1 = X1 + (size_t)row * D;
        f32x4 f[8];
#pragma unroll
        for (int j = 0; j < 8; ++j) f[j] = (f32x4){0.f, 0.f, 0.f, 0.f};
        for (int e = 0; e < NE; ++e) { const int s = __builtin_amdgcn_readfirstlane(SLOT[(size_t)row * NE + e]);
            if (s >= 0) { const float* yr = YE + (size_t)s * D;
#pragma unroll
                for (int j = 0; j < 8; ++j) f[j] += LDV(yr, j); } }
        f32x4 v[8];
#pragma unroll
        for (int j = 0; j < 8; ++j) v[j] = LDV(x1, j) * ALPHA + LDV(g2, j) * f[j];
        ln_rows(v, lng, lnb, F);
        if (l == 0) { const float* sh = mods(F, 1, r, 0); const float* sc = mods(F, 1, r, 1);
#pragma unroll
            for (int j = 0; j < 8; ++j) { *(f32x4*)(X2 + (size_t)row * D + 4 * F.lane + 256 * j) = v[j];
                const f32x4 h = v[j] * (LDV(sc, j) + 1.0f) + LDV(sh, j);
                v2u w; w.x = pk2(h[0], h[1]); w.y = pk2(h[2], h[3]); *(v2u*)(HB + (size_t)row * D + 4 * F.lane + 256 * j) = w; } }
        else {
#pragma unroll
            for (int j = 0; j < 8; ++j) *(f32x4*)(F.out + (size_t)row * D + 4 * F.lane + 256 * j) = v[j]; }
    }
}
__device__ __forceinline__ void s5_naive(Frame& F) {
    const int gw = F.vcu * NWAVES + F.wave, NGW = F.G * NWAVES;
    const float* AR = (const float*)(F.ws + WS_SPAR); const float* AI = AR + 2 * NG * NP; const float* BB = AI + 2 * NG * NP;
    const bf16* HB = ws_tile(F, T_HB);
    for (int un = gw; un < 2 * NG * 2; un += NGW) {
        const int b = un >> 8, g = (un >> 1) & 127, dir = un & 1; const int idx = (dir * NG + g) * NP + F.lane;
        const float ar = AR[idx], ai = AI[idx]; float br[GH], bi[GH], cr[GH], ci[GH];
#pragma unroll
        for (int h = 0; h < GH; ++h) { br[h] = BB[(size_t)idx * 32 + h]; bi[h] = BB[(size_t)idx * 32 + 16 + h];
            cr[h] = F.in[I_CRE][((size_t)(dir * NG + g) * GH + h) * NP + F.lane]; ci[h] = F.in[I_CIM][((size_t)(dir * NG + g) * GH + h) * NP + F.lane]; }
        float* Y = (float*)(F.ws + (dir ? WS_YB : WS_YF));
        float xr = 0.f, xi = 0.f;
        for (int tau = 0; tau < CTXL + SEQ; ++tau) {
            int row; if (tau < CTXL) row = NLAT + b * CTXL + (dir ? CTXL - 1 - tau : tau); else row = b * SEQ + (dir ? SEQ - 1 - (tau - CTXL) : tau - CTXL);
            const v4u u0 = *(const v4u*)(HB + (size_t)row * D + g * GH), u1 = *(const v4u*)(HB + (size_t)row * D + g * GH + 8);
            float u[GH];
#pragma unroll
            for (int q = 0; q < 4; ++q) { u[2 * q] = bf2f(u0[q] & 0xffffu); u[2 * q + 1] = bf2f(u0[q] >> 16); u[8 + 2 * q] = bf2f(u1[q] & 0xffffu); u[8 + 2 * q + 1] = bf2f(u1[q] >> 16); }
            float pr = 0.f, pi = 0.f;
#pragma unroll
            for (int h = 0; h < GH; ++h) { pr += br[h] * u[h]; pi += bi[h] * u[h]; }
            const float nxr = ar * xr - ai * xi + pr, nxi = ar * xi + ai * xr + pi; xr = nxr; xi = nxi;
            if (tau >= CTXL) { float mine = 0.f;
#pragma unroll
                for (int h = 0; h < GH; ++h) { const float y = wave_sum(cr[h] * xr - ci[h] * xi); mine = (F.lane == h) ? y : mine; }
                if (F.lane < GH) Y[(size_t)row * D + g * GH + F.lane] = mine; }
        }
    }
}
__device__ __forceinline__ void zprep_phase(Frame& F) {
    const int gw = F.vcu * NWAVES + F.wave, NGW = F.G * NWAVES;
    const float* X2 = (const float*)(F.ws + WS_X2); const float* YF = (const float*)(F.ws + WS_YF); const float* YB = (const float*)(F.ws + WS_YB); bf16* Z = ws_tile(F, T_Z);
    const float* dsk = F.in[I_SD];
    for (int row = gw; row < NLAT; row += NGW) {
        const int r = row >> 12; const float* sh = mods(F, 1, r, 0); const float* sc = mods(F, 1, r, 1);
        const float* x2 = X2 + (size_t)row * D; const float* yf = YF + (size_t)row * D; const float* yb = YB + (size_t)row * D;
#pragma unroll
        for (int j = 0; j < 8; ++j) { const f32x4 u = LDV(x2, j) * (LDV(sc, j) + 1.0f) + LDV(sh, j); const f32x4 y = LDV(dsk, j) * u + LDV(yf, j) + LDV(yb, j);
            v2u w; w.x = pk2(gelu_tanh_f(y[0]), gelu_tanh_f(y[1])); w.y = pk2(gelu_tanh_f(y[2]), gelu_tanh_f(y[3]));
            *(v2u*)(Z + (size_t)row * D + 4 * F.lane + 256 * j) = w; }
    }
}

constexpr int NPH = 22;
struct Args { const float* in[25]; float* out; unsigned char* ws; int ph_lo, ph_hi; };
__global__ void __launch_bounds__(NTHREADS, 2) mk_fwd(Args args) {
    extern __shared__ __attribute__((aligned(16))) unsigned char lds[];
    Frame F;
    F.lds = (LAS unsigned char*)lds; F.ws = args.ws; F.out = args.out;
#pragma unroll
    for (int i = 0; i < 25; ++i) F.in[i] = args.in[i];
    F.tid = threadIdx.x; F.lane = F.tid & 63; F.wave = __builtin_amdgcn_readfirstlane(F.tid >> 6);
    F.G = gridDim.x; { const int bx = blockIdx.x; F.vcu = (F.G % 8 == 0) ? (bx % 8) * (F.G / 8) + bx / 8 : bx; }
    const int vcu0 = F.vcu;
    volatile LAS unsigned* MISC = (volatile LAS unsigned*)(F.lds + MISC_OFF);
    for (int u = F.tid; u < 32; u += NTHREADS) MISC[u] = 0u;
    __syncthreads();
    const int lo = args.ph_lo, hi = args.ph_hi;
    const bool multi = (hi - lo) > 1;
    XcdBarrier bar; bar.bar = (unsigned*)(F.ws + WS_CTL) + CW_BAR; bar.x = 0; bar.st = nullptr;
    if (multi) bar = xcd_barrier_post((unsigned*)(F.ws + WS_CTL) + CW_BAR, MISC + 8);
#define IN(k) (lo <= (k) && (k) < hi)
#define PH() do { unsigned char* w_ = args.ws; asm volatile("" : "+s"(w_)); F.ws = w_; int t_ = threadIdx.x; asm volatile("" : "+v"(t_)); F.tid = t_; F.lane = t_ & 63; F.wave = __builtin_amdgcn_readfirstlane(t_ >> 6); int v_ = vcu0; asm volatile("" : "+s"(v_)); F.vcu = v_; } while (0)
#define SEAM(k) do { if (IN(k) && IN((k) + 1)) xcd_barrier(bar); } while (0)

    if (IN(0)) { PH(); p0_mods(F); p0_s5params(F); __syncthreads(); p0_weights(F); __syncthreads(); }
    SEAM(0);
    for (int l = 0; l < 2; ++l) {
        if (l == 0) {
            if (IN(1)) { PH(); p1_prep(F); }
            SEAM(1);
            if (IN(2)) { PH(); SegSched S; S.init(F.G, F.vcu, 34, 16, T_HB, T_WQKV, 8, 34, T_WQKV + 16, T_HB); EpiQKV E{ws_tile(F, T_QK), ws_tile(F, T_VT)}; run_gemm(F, S, E); }
            SEAM(2);
            if (IN(3)) { PH(); p3_attn_naive(F); __syncthreads(); }
            SEAM(3);
            if (IN(4)) { PH(); SegSched S; S.init(F.G, F.vcu, 34, 8, T_AO, T_WO, 0, 0, 0, 0); EpiWo E{(float*)(F.ws + WS_O)}; run_gemm(F, S, E); }
            SEAM(4);
        } else {
            if (IN(11)) { PH(); s5_naive(F); }
            SEAM(11); SEAM(12); SEAM(13);
            if (IN(14)) { PH(); zprep_phase(F); }
            SEAM(14);
            if (IN(15)) { PH(); SegSched S; S.init(F.G, F.vcu, 32, 16, T_Z, T_WVG, 0, 0, 0, 0); EpiGlu E{(float*)(F.ws + WS_O)}; run_gemm(F, S, E); }
            SEAM(15);
        }
        const int pb = l ? 16 : 5;
        if (IN(pb)) { PH(); row_phase(F, l); }
        SEAM(pb);
        if (IN(pb + 1)) { PH(); topk_phase(F, l); }
        SEAM(pb + 1);
        if (IN(pb + 2)) { PH(); gather_phase(F, l); }
        SEAM(pb + 2);
        if (IN(pb + 3)) { PH(); MoeSched S; S.init(F.G, F.vcu, l ? 4 : 5, 16, T_XE, T_MOE1 + l * 256); EpiSwiglu E{ws_tile(F, T_ACT), T_MOE1 + l * 256}; run_gemm(F, S, E); }
        SEAM(pb + 3);
        if (IN(pb + 4)) { PH(); MoeSched S; S.init(F.G, F.vcu, l ? 4 : 5, 8, T_ACT, T_MOE2 + l * 128); EpiDown E{(float*)(F.ws + WS_YE), (const float*)(F.ws + WS_GATE), T_MOE2 + l * 128}; run_gemm(F, S, E); }
        SEAM(pb + 4);
        if (IN(pb + 5)) { PH(); combine_phase(F, l); }
        SEAM(pb + 5);
    }
#undef IN
#undef SEAM
}

extern "C" void kernel_launch(void* const* d_in, const int* in_sizes, int n_in, void* d_out, int out_size, void* d_ws, size_t ws_size, hipStream_t stream) {
    static int grid = 0;
    if (grid == 0) {
        if (n_in != 25 || out_size != NLAT * D || ws_size < WS_END) { fprintf(stderr, "kernel_launch: unexpected shapes (n_in %d out %d ws %zu)\n", n_in, out_size, ws_size); grid = -1; return; }
        int dev = 0, cus = 0, per_cu = 0;
        if (hipGetDevice(&dev) != hipSuccess || hipDeviceGetAttribute(&cus, hipDeviceAttributeMultiprocessorCount, dev) != hipSuccess) { grid = -1; return; }
        if (hipFuncSetAttribute((const void*)mk_fwd, hipFuncAttributeMaxDynamicSharedMemorySize, LDS_BYTES) != hipSuccess) { fprintf(stderr, "kernel_launch: hipFuncSetAttribute failed\n"); grid = -1; return; }
        if (hipOccupancyMaxActiveBlocksPerMultiprocessor(&per_cu, (const void*)mk_fwd, NTHREADS, LDS_BYTES) != hipSuccess || per_cu < 1) { fprintf(stderr, "kernel_launch: occupancy query reports %d\n", per_cu); }
        (void)hipGetLastError();
        grid = cus;
    }
    if (grid < 0) return;
    (void)hipMemsetAsync((char*)d_ws + WS_CTL, 0, CTL_ZERO_BYTES, stream);
    Args a{};
    for (int i = 0; i < 25; ++i) a.in[i] = (const float*)d_in[i];
    a.out = (float*)d_out; a.ws = (unsigned char*)d_ws;
#if MK_N_LAUNCHES == 1
    a.ph_lo = 0; a.ph_hi = NPH;
    hipLaunchKernelGGL(mk_fwd, dim3(grid), dim3(NTHREADS), LDS_BYTES, stream, a);
#else
    for (int p = 0; p < NPH; ++p) { if (p == 12 || p == 13) continue; a.ph_lo = p; a.ph_hi = p + 1; hipLaunchKernelGGL(mk_fwd, dim3(grid), dim3(NTHREADS), LDS_BYTES, stream, a); }
#endif
}
```

```cpp
#include <hip/hip_runtime.h>
#include <cstdio>
#include <cstdint>
namespace pg8 {
#define PG8_LAS __attribute__((address_space(3)))
typedef unsigned short bf16_t;
typedef short bf16x8 __attribute__((ext_vector_type(8)));
typedef float f32x4 __attribute__((ext_vector_type(4)));
typedef unsigned u32x4 __attribute__((ext_vector_type(4)));
constexpr int BM = 256, BK = 64, HALF = 128, HTB = HALF * BK * 2  , STAGE_BYTES = 8 * HTB, NXCD = 8, WGM = 8;

__host__ __device__ __forceinline__ int lds_byte(int r, int c) { const int st = (r >> 4) * 2 + (c >> 5), rr = r & 15, cc = c & 31, ob = rr * 64 + cc * 2; return st * 1024 + (ob ^ (((ob >> 9) & 1) << 5)); }
__host__ __device__ __forceinline__ void stage_rc(int b, int& R, int& C) { const int st = b / 1024, sb = b % 1024, swz = sb ^ (((sb >> 9) & 1) << 5); R = (st >> 1) * 16 + swz / 64; C = (st & 1) * 32 + (swz % 64) / 2; }
__host__ __device__ __forceinline__ int perm32(int rho) { const int n = rho >> 4, i = rho & 15; return 8 * (i >> 2) + 4 * n + (i & 3); }

struct Unit { int pm, pn; };
struct Gemm { const bf16_t* A; const bf16_t* Bt; int M, N, K; };

__device__ __forceinline__ unsigned cvt_pk_bf16(float lo, float hi) { unsigned r; asm volatile("v_cvt_pk_bf16_f32 %0, %1, %2" : "=v"(r) : "v"(lo), "v"(hi)); return r; }
template <class Epi, class Sched, bool ALIGN_EPI = false, bool SP2 = false>
__device__ __forceinline__ void gemm_phase(PG8_LAS unsigned char* lds, const Gemm g, const Sched& S, const Epi& E) {
    int tid_ = threadIdx.x; asm volatile("" : "+v"(tid_));
    const int tid = tid_, wid = __builtin_amdgcn_readfirstlane(tid >> 6), lane = tid & 63, wr = wid >> 2, wc = wid & 3, fr = lane & 15, fq = lane >> 4;
    const int K = g.K, nt = K / BK;
    unsigned voffA[2], voffB[2];
#pragma unroll
    for (int i = 0; i < 2; ++i) { int R, C; stage_rc(tid * 16 + i * 8192, R, C); const int Rb = Epi::PERM ? ((R & ~31) + perm32(R & 31)) : R;
        voffA[i] = (unsigned)(R * K + C) * 2u; voffB[i] = (unsigned)(Rb * K + C) * 2u; }
    const size_t kstep = (size_t)(BK * 2);
    const size_t hstep = (size_t)HALF * K * 2;
    const size_t tstep = 2 * hstep;
    const unsigned ldsw = (unsigned)wid * 1024u;
    const int aoff = lds_byte(wr * 64 + fr, fq * 8), boff = lds_byte(wc * 32 + fr, fq * 8);
#define PG8_SA(b, h) (((b) * 2 + (h)) * HTB)
#define PG8_SB(b, h) ((4 + (b) * 2 + (h)) * HTB)
#define PG8_STAGE(bufoff, gbase, voff) do { _Pragma("unroll") for (int _i = 0; _i < 2; ++_i) \
        __builtin_amdgcn_global_load_lds((const unsigned*)((const char*)(gbase) + (voff)[_i]), (PG8_LAS unsigned*)(lds + (bufoff) + ldsw + _i * 8192), 16, 0, 0); } while (0)
#define PG8_LDA(dst, b, h) do { _Pragma("unroll") for (int m = 0; m < 4; ++m) _Pragma("unroll") for (int k = 0; k < 2; ++k) dst[m][k] = *(const PG8_LAS bf16x8*)(lds + PG8_SA(b, h) + aoff + m * 2048 + k * 1024); } while (0)
#define PG8_LDB(dst, b, h) do { _Pragma("unroll") for (int n = 0; n < 2; ++n) _Pragma("unroll") for (int k = 0; k < 2; ++k) dst[n][k] = *(const PG8_LAS bf16x8*)(lds + PG8_SB(b, h) + boff + n * 2048 + k * 1024); } while (0)
#define PG8_MMA(ai, bj, At, Bt) do { __builtin_amdgcn_s_setprio(1); _Pragma("unroll") for (int m = 0; m < 4; ++m) _Pragma("unroll") for (int n = 0; n < 2; ++n) _Pragma("unroll") for (int k = 0; k < 2; ++k) \
        acc[ai][bj][m][n] = __builtin_amdgcn_mfma_f32_16x16x32_bf16(Bt[n][k], At[m][k], acc[ai][bj][m][n], 0, 0, 0); __builtin_amdgcn_s_setprio(0); } while (0)
#define PG8_WAIT_V(n) asm volatile("s_waitcnt vmcnt(" #n ")" ::: "memory")
#define PG8_WAIT_L(n) asm volatile("s_waitcnt lgkmcnt(" #n ")" ::: "memory")
#define PG8_BAR __builtin_amdgcn_s_barrier()
#define PG8_SCHED __builtin_amdgcn_sched_barrier(0)
    Unit cur, nxt; int ui = 0;
    if (!S.next(0, cur)) return;
    f32x4 acc[2][2][4][2];
#pragma unroll
    for (int a = 0; a < 2; ++a)
#pragma unroll
        for (int b = 0; b < 2; ++b)
#pragma unroll
            for (int m = 0; m < 4; ++m)
#pragma unroll
                for (int n = 0; n < 2; ++n) acc[a][b][m][n] = (f32x4){0.f, 0.f, 0.f, 0.f};
    bf16x8 At[4][2], B0[2][2], B1[2][2];
    const char* cA = (const char*)g.A + (size_t)cur.pm * tstep; const char* cB = (const char*)g.Bt + (size_t)cur.pn * tstep;
    S.a_ready(cur);
    if constexpr (SP2) {
        PG8_STAGE(PG8_SB(0, 0), cB, voffB); PG8_STAGE(PG8_SB(0, 1), cB + hstep, voffB); PG8_STAGE(PG8_SA(0, 0), cA, voffA); PG8_STAGE(PG8_SA(0, 1), cA + hstep, voffA);
        if (wr == 1) PG8_BAR;
        PG8_WAIT_V(2); PG8_BAR;
        PG8_STAGE(PG8_SB(1, 0), cB + kstep, voffB); PG8_STAGE(PG8_SA(1, 0), cA + kstep, voffA); PG8_STAGE(PG8_SB(1, 1), cB + hstep + kstep, voffB);
        PG8_WAIT_V(6); PG8_BAR;
    } else {
        PG8_STAGE(PG8_SB(0, 0), cB, voffB); PG8_STAGE(PG8_SA(0, 0), cA, voffA); PG8_STAGE(PG8_SB(0, 1), cB + hstep, voffB); PG8_STAGE(PG8_SA(0, 1), cA + hstep, voffA);
        if (wr == 1) PG8_BAR;
        PG8_WAIT_V(4); PG8_BAR;
        PG8_STAGE(PG8_SB(1, 0), cB + kstep, voffB); PG8_STAGE(PG8_SA(1, 0), cA + kstep, voffA); PG8_STAGE(PG8_SB(1, 1), cB + hstep + kstep, voffB);
        PG8_WAIT_V(6); PG8_BAR;
    }
    for (;;) {
        const bool has_next = S.next(ui + 1, nxt);
        const char* nA = has_next ? (const char*)g.A + (size_t)nxt.pm * tstep : cA; const char* nB = has_next ? (const char*)g.Bt + (size_t)nxt.pn * tstep : cB;
        for (int t = 0; t < nt; t += 2) {
            const bool last = (t == nt - 2);
            const char* a1 = cA + (size_t)(t + 1) * kstep;
            const char* a2 = last ? nA : cA + (size_t)(t + 2) * kstep; const char* b2 = last ? nB : cB + (size_t)(t + 2) * kstep;
            const char* a3 = a2 + kstep; const char* b3 = b2 + kstep;
            if (last && has_next) S.a_ready(nxt);
            if constexpr (SP2) {
            PG8_LDB(B0, 0, 0); PG8_LDB(B1, 0, 1); PG8_SCHED; PG8_LDA(At, 0, 0); PG8_STAGE(PG8_SA(1, 1), a1 + hstep, voffA);
            PG8_WAIT_V(8); PG8_WAIT_L(0); PG8_BAR; PG8_MMA(0, 0, At, B0); PG8_MMA(0, 1, At, B1); PG8_BAR; PG8_SCHED;
            PG8_LDA(At, 0, 1); PG8_STAGE(PG8_SB(0, 0), b2, voffB); PG8_STAGE(PG8_SB(0, 1), b2 + hstep, voffB); PG8_STAGE(PG8_SA(0, 0), a2, voffA);
            PG8_WAIT_V(8); PG8_WAIT_L(0); PG8_BAR; PG8_MMA(1, 0, At, B0); PG8_MMA(1, 1, At, B1); PG8_BAR; PG8_SCHED;
            PG8_LDB(B0, 1, 0); PG8_LDB(B1, 1, 1); PG8_SCHED; PG8_LDA(At, 1, 0); PG8_STAGE(PG8_SA(0, 1), a2 + hstep, voffA);
            PG8_WAIT_V(8); PG8_WAIT_L(0); PG8_BAR; PG8_MMA(0, 0, At, B0); PG8_MMA(0, 1, At, B1); PG8_BAR; PG8_SCHED;
            PG8_LDA(At, 1, 1); PG8_STAGE(PG8_SB(1, 0), b3, voffB); PG8_STAGE(PG8_SB(1, 1), b3 + hstep, voffB); PG8_STAGE(PG8_SA(1, 0), a3, voffA);
            PG8_WAIT_V(8); PG8_WAIT_L(0); PG8_BAR; PG8_MMA(1, 0, At, B0); PG8_MMA(1, 1, At, B1); PG8_BAR; PG8_SCHED;
            } else {
            PG8_LDB(B0, 0, 0); PG8_SCHED; PG8_LDA(At, 0, 0); PG8_STAGE(PG8_SA(1, 1), a1 + hstep, voffA);
            PG8_WAIT_L(8); PG8_BAR; PG8_WAIT_L(0); PG8_MMA(0, 0, At, B0); PG8_BAR; PG8_SCHED;
            PG8_LDB(B1, 0, 1); PG8_STAGE(PG8_SB(0, 0), b2, voffB);
            PG8_BAR; PG8_WAIT_L(0); PG8_MMA(0, 1, At, B1); PG8_BAR;
            PG8_LDA(At, 0, 1); PG8_STAGE(PG8_SA(0, 0), a2, voffA);
            PG8_BAR; PG8_WAIT_L(0); PG8_MMA(1, 0, At, B0); PG8_BAR; PG8_SCHED;
            PG8_STAGE(PG8_SB(0, 1), b2 + hstep, voffB);
            PG8_WAIT_V(6); PG8_BAR; PG8_MMA(1, 1, At, B1); PG8_BAR;
            PG8_LDB(B0, 1, 0); PG8_SCHED; PG8_LDA(At, 1, 0); PG8_STAGE(PG8_SA(0, 1), a2 + hstep, voffA);
            PG8_WAIT_L(8); PG8_BAR; PG8_WAIT_L(0); PG8_MMA(0, 0, At, B0); PG8_BAR; PG8_SCHED;
            PG8_LDB(B1, 1, 1); PG8_STAGE(PG8_SB(1, 0), b3, voffB);
            PG8_BAR; PG8_WAIT_L(0); PG8_MMA(0, 1, At, B1); PG8_BAR;
            PG8_LDA(At, 1, 1); PG8_STAGE(PG8_SA(1, 0), a3, voffA);
            PG8_BAR; PG8_WAIT_L(0); PG8_MMA(1, 0, At, B0); PG8_BAR; PG8_SCHED;
            PG8_STAGE(PG8_SB(1, 1), b3 + hstep, voffB);
            PG8_WAIT_V(6); PG8_BAR; PG8_MMA(1, 1, At, B1); PG8_BAR;
            }
        }
        if constexpr (ALIGN_EPI) { if (wr == 0) PG8_BAR; }
        if constexpr (!Epi::AFTER_DRAIN) { E(acc, cur, wr, wc, fr, fq); S.done(cur); }
        if (!has_next) break;
#pragma unroll
        for (int a = 0; a < 2; ++a)
#pragma unroll
            for (int b = 0; b < 2; ++b)
#pragma unroll
                for (int m = 0; m < 4; ++m)
#pragma unroll
                    for (int n = 0; n < 2; ++n) acc[a][b][m][n] = (f32x4){0.f, 0.f, 0.f, 0.f};
        cur = nxt; cA = nA; cB = nB; ++ui;
        if constexpr (ALIGN_EPI) { if (wr == 1) PG8_BAR; }
    }
    PG8_WAIT_V(0);
    if constexpr (!ALIGN_EPI) { if (wr == 0) PG8_BAR; }
    PG8_BAR;
    if constexpr (Epi::AFTER_DRAIN) { E.fused(acc, cur, wr, wc, fr, fq, lds, wid, lane); S.done(cur); }
#undef PG8_SA
#undef PG8_SB
#undef PG8_STAGE
#undef PG8_LDA
#undef PG8_LDB
#undef PG8_MMA
#undef PG8_WAIT_V
#undef PG8_WAIT_L
#undef PG8_BAR
#undef PG8_SCHED
}
}

#ifndef PG8_SP2
#define PG8_SP2 true
#endif
#ifndef PG8_ALIGN
#define PG8_ALIGN true
#endif
#ifndef MK_N_LAUNCHES
#define MK_N_LAUNCHES 1
#endif
#ifndef S5_NAIVE
#define S5_NAIVE 0
#endif
#ifndef ATTN_NAIVE
#define ATTN_NAIVE 0
#endif
#ifndef NAIVE_GEMM
#define NAIVE_GEMM 0
#endif

constexpr int D = 2048, SEQ = 4096, CTXL = 256, NLAT = 8192, NCTX = 512, NROWS = 8704;
constexpr int NH = 16, HD = 128, NE = 16, NG = 128, NP = 64, GH = 16, D6 = 6 * D;
constexpr int RPE = 1280;
constexpr float LN_EPS = 1e-5f, ALPHA = 1.4142135623730951f;
constexpr int NWAVES = 8, NTHREADS = 512;
constexpr int LDS_BYTES = 147456, MISC_OFF = 131072 + 320;

constexpr size_t MiB = 1u << 20;
constexpr size_t WS_CTL = 0, CTL_ZERO_BYTES = 1 * MiB;
constexpr size_t WS_MODS = 1 * MiB;
constexpr size_t WS_SPAR = 2 * MiB;
constexpr size_t WS_AFF = 6 * MiB;
constexpr size_t WS_SLOT = 7 * MiB;
constexpr size_t WS_IDX = 8 * MiB;
constexpr size_t WS_GATE = 8 * MiB + 512 * 1024;
constexpr int T_WQKV = 16, T_WO = 40, T_WVG = 48, T_MOE1 = 64, T_MOE2 = 576, T_HB = 832, T_QK = 866, T_VT = 934, T_AO = 968, T_XE = 1002, T_ACT = 1082, T_Z = 1162;
constexpr size_t WS_O = 1194 * MiB, WS_X1 = 1262 * MiB, WS_X2 = 1330 * MiB, WS_YE = 1398 * MiB, WS_YF = 1558 * MiB, WS_YB = 1622 * MiB, WS_XLOC = 1686 * MiB, WS_CARRY = 1718 * MiB, WS_END = 1750 * MiB;
constexpr int CW_BAR = 4096;

#define GAS __attribute__((address_space(1)))
#define LAS __attribute__((address_space(3)))
typedef unsigned short bf16;
typedef unsigned v4u __attribute__((ext_vector_type(4)));
typedef unsigned v2u __attribute__((ext_vector_type(2)));
typedef float f32x4 __attribute__((ext_vector_type(4)));
typedef float f32x2 __attribute__((ext_vector_type(2)));
typedef short bf16x8 __attribute__((ext_vector_type(8)));
typedef GAS unsigned gu32;
#define RLX_AGENT __ATOMIC_RELAXED, __HIP_MEMORY_SCOPE_AGENT

__device__ __forceinline__ float bf2f(unsigned b) { return __uint_as_float(b << 16); }
__device__ __forceinline__ unsigned pk2(float lo, float hi) { typedef __bf16 bf2_t __attribute__((ext_vector_type(2))); f32x2 v = {lo, hi}; return __builtin_bit_cast(unsigned, __builtin_convertvector(v, bf2_t)); }
__device__ __forceinline__ float wave_sum(float v) {
#pragma unroll
    for (int o = 1; o < 64; o <<= 1) v += __shfl_xor(v, o);
    return v;
}
__device__ __forceinline__ float wave_max(float v) {
#pragma unroll
    for (int o = 1; o < 64; o <<= 1) v = fmaxf(v, __shfl_xor(v, o));
    return v;
}
__device__ __forceinline__ float silu_f(float x) { return x / (1.0f + __expf(-x)); }
__device__ __forceinline__ float sigmoid_f(float x) { return 1.0f / (1.0f + __expf(-x)); }
__device__ __forceinline__ float gelu_tanh_f(float x) { const float y = 0.7978845608028654f * (x + 0.044715f * x * x * x); const float t = 1.0f - 2.0f / (1.0f + __expf(2.0f * y)); return 0.5f * x * (1.0f + t); }
#define XB_TMO      128
#define XB_XCNT(j)  (256  + 64 * (j))
#define XB_XSUB(j)  (1280 + 64 * (j))
#define XB_XGEN(j)  (2304 + 64 * (j))
#define XB_TOP      3328
#define XB_TOPGEN   3392
#define XCD_BAR_WORDS 3456
#define XB_SPIN_CAP (1u << 18)

__device__ __forceinline__ unsigned xb_ld(unsigned* p)              { return __hip_atomic_load(p, __ATOMIC_RELAXED, __HIP_MEMORY_SCOPE_AGENT); }
__device__ __forceinline__ unsigned xb_add(unsigned* p, unsigned v) { return __hip_atomic_fetch_add(p, v, __ATOMIC_RELAXED, __HIP_MEMORY_SCOPE_AGENT); }
__device__ __forceinline__ unsigned xb_xcc_id() { return (unsigned)__builtin_amdgcn_s_getreg((3 << 11) | 20) & 0xFu; }
#define XB_SPIN(cond, bar) do { unsigned _sp = 0; while (cond) { __builtin_amdgcn_s_sleep(1); \
    if ((++_sp & 255u) == 0u) { if (xb_ld(&(bar)[XB_TMO])) break; if (_sp > XB_SPIN_CAP) { atomicAdd(&(bar)[XB_TMO], 1u); break; } } } } while (0)

struct XcdBarrier {
    unsigned* bar; unsigned x;
    volatile LAS unsigned* st;
};

__device__ __forceinline__ XcdBarrier xcd_barrier_post(unsigned* bar, volatile LAS unsigned* st) {
    XcdBarrier b; b.bar = bar; b.x = xb_xcc_id(); b.st = st;
    if (threadIdx.x == 0) (void)xb_add(&bar[XB_XCNT(b.x)], 1u);
    return b;
}
__device__ __forceinline__ void xcd_barrier_complete(unsigned* bar, unsigned x, unsigned& nloc, unsigned& nx) {
    const unsigned G = gridDim.x * gridDim.y * gridDim.z;
    unsigned sum, cnt, mine, sp = 0u;
    for (;;) {
        sum = 0u; cnt = 0u; mine = 0u;
#pragma unroll
        for (unsigned j = 0; j < 16; ++j) { const unsigned c = xb_ld(&bar[XB_XCNT(j)]); sum += c; cnt += (c > 0u) ? 1u : 0u; mine = (j == x) ? c : mine; }
        if (sum == G) break;
        __builtin_amdgcn_s_sleep(1);
        if ((++sp & 255u) == 0u) { if (xb_ld(&bar[XB_TMO])) break; if (sp > XB_SPIN_CAP) { atomicAdd(&bar[XB_TMO], 1u); break; } }
    }
    nloc = mine > 0u ? mine : 1u; nx = cnt > 0u ? cnt : 1u;
}

__device__ __forceinline__ void xcd_barrier(const XcdBarrier& b) {
    asm volatile("s_waitcnt vmcnt(0)" ::: "memory");
    __syncthreads();
    if (threadIdx.x == 0) {
        unsigned* bar = b.bar;
        __builtin_amdgcn_s_waitcnt(0);
        unsigned nloc = b.st[0], nx = b.st[1];
        if (nloc == 0u) { xcd_barrier_complete(bar, b.x, nloc, nx); b.st[0] = nloc; b.st[1] = nx; }
        const unsigned old = xb_add(&bar[XB_XSUB(b.x)], 1u);
        const unsigned gen = old / nloc;
        if (old + 1u == (gen + 1u) * nloc) {
            __builtin_amdgcn_fence(__ATOMIC_RELEASE, "agent");
            asm volatile("s_waitcnt vmcnt(0)" ::: "memory");
            const unsigned og = xb_add(&bar[XB_TOP], 1u);
            const unsigned tg = og / nx;
            if (og + 1u == (tg + 1u) * nx) xb_add(&bar[XB_TOPGEN], 1u);
            else XB_SPIN(xb_ld(&bar[XB_TOPGEN]) == tg, bar);
            __builtin_amdgcn_fence(__ATOMIC_ACQUIRE, "agent");
            xb_add(&bar[XB_XGEN(b.x)], 1u);
            asm volatile("s_waitcnt vmcnt(0)" ::: "memory");
        } else {
            XB_SPIN(xb_ld(&bar[XB_XGEN(b.x)]) == gen, bar);
            __builtin_amdgcn_fence(__ATOMIC_ACQUIRE, "agent");
            asm volatile("s_waitcnt vmcnt(0)" ::: "memory");
        }
    }
    __syncthreads();
}

struct Frame {
    LAS unsigned char* lds;
    unsigned char* ws;
    int tid, lane, wave, vcu, G;
    const float* in[25];
    float* out;
};
enum { I_X = 0, I_C, I_CTX, I_CCTX, I_WMOD, I_BMOD, I_LNG, I_LNB, I_WQKV, I_WO, I_RPB, I_LAMRE, I_LAMIM, I_LOGSTEP, I_BRE, I_BIM, I_CRE, I_CIM, I_SD, I_WVAL, I_WGATE, I_ROUTER, I_MGATE, I_MUP, I_MDOWN };

__device__ __forceinline__ bf16* ws_tile(const Frame& F, int t) { return (bf16*)(F.ws + (size_t)t * MiB); }
__device__ __forceinline__ float* ws_f32(const Frame& F, size_t off) { return (float*)(F.ws + off); }
__device__ __forceinline__ const float* mods(const Frame& F, int l, int r, int which) { return (const float*)(F.ws + WS_MODS) + (size_t)((l * 3 + r) * 6 + which) * D; }
__device__ __forceinline__ int row_r(int row) { return row < NLAT ? (row >> 12) : 2; }

struct SegSched {
    int G, cx, n0, ntot, nM0, nN0, pm0, pn0, nM1, nN1, pm1, pn1;
    __device__ __forceinline__ void init(int G_, int cx_, int nM0_, int nN0_, int pm0_, int pn0_, int nM1_, int nN1_, int pm1_, int pn1_) {
        G = G_; cx = cx_; nM0 = nM0_; nN0 = nN0_; pm0 = pm0_; pn0 = pn0_; nM1 = nM1_; nN1 = nN1_; pm1 = pm1_; pn1 = pn1_; n0 = nM0 * nN0; ntot = n0 + nM1 * nN1; }
    __device__ __forceinline__ bool next(int i, pg8::Unit& u) const {
        const int U = i * G + cx; if (U >= ntot) return false;
        const bool s1 = U >= n0; const int loc = s1 ? U - n0 : U, nM = s1 ? nM1 : nM0, nN = s1 ? nN1 : nN0;
        const int nig = 8 * nN, gid = loc / nig, fm = gid * 8, gsz = (nM - fm) < 8 ? (nM - fm) : 8;
        u.pm = (s1 ? pm1 : pm0) + fm + ((loc % nig) % gsz); u.pn = (s1 ? pn1 : pn0) + (loc % nig) / gsz; return true;
    }
    __device__ __forceinline__ void a_ready(const pg8::Unit&) const {}
    __device__ __forceinline__ void done(const pg8::Unit&) const {}
};
struct MoeSched {
    int G, cx, nMe, nNe, pmA, pnB, ntot;
    __device__ __forceinline__ void init(int G_, int cx_, int nMe_, int nNe_, int pmA_, int pnB_) { G = G_; cx = cx_; nMe = nMe_; nNe = nNe_; pmA = pmA_; pnB = pnB_; ntot = NE * nMe * nNe; }
    __device__ __forceinline__ bool next(int i, pg8::Unit& u) const {
        const int U = i * G + cx; if (U >= ntot) return false;
        const int per = nMe * nNe, e = U / per, loc = U % per;
        u.pm = pmA + e * 5 + loc % nMe; u.pn = pnB + e * nNe + loc / nMe; return true;
    }
    __device__ __forceinline__ void a_ready(const pg8::Unit&) const {}
    __device__ __forceinline__ void done(const pg8::Unit&) const {}
};

struct EpiQKV {
    static constexpr bool PERM = true, AFTER_DRAIN = false;
    bf16* QK; bf16* VT;
    __device__ __forceinline__ void operator()(const f32x4 (&acc)[2][2][4][2], const pg8::Unit& u, int wr, int wc, int fr, int fq) const {
        bf16* base; int ldc;
        if (u.pn < T_HB) { base = QK + (size_t)(u.pm - T_HB) * 256 * 4096 + (size_t)(u.pn - T_WQKV) * 256; ldc = 4096; }
        else { base = VT + (size_t)(u.pm - (T_WQKV + 16)) * 256 * NROWS + (size_t)(u.pn - T_HB) * 256; ldc = NROWS; }
#pragma unroll
        for (int ai = 0; ai < 2; ++ai)
#pragma unroll
            for (int m = 0; m < 4; ++m) { bf16* rowp = base + (size_t)(ai * 128 + wr * 64 + m * 16 + fr) * ldc + wc * 32 + 8 * fq;
#pragma unroll
                for (int bj = 0; bj < 2; ++bj) { const f32x4 v0 = acc[ai][bj][m][0], v1 = acc[ai][bj][m][1];
                    v4u w; w.x = pk2(v0[0], v0[1]); w.y = pk2(v0[2], v0[3]); w.z = pk2(v1[0], v1[1]); w.w = pk2(v1[2], v1[3]);
                    *(v4u*)(rowp + bj * 128) = w; } }
    }
};
struct EpiWo {
    static constexpr bool PERM = false, AFTER_DRAIN = false;
    float* O;
    __device__ __forceinline__ void operator()(const f32x4 (&acc)[2][2][4][2], const pg8::Unit& u, int wr, int wc, int fr, int fq) const {
        float* base = O + (size_t)(u.pm - T_AO) * 256 * D + (size_t)(u.pn - T_WO) * 256;
#pragma unroll
        for (int ai = 0; ai < 2; ++ai)
#pragma unroll
            for (int m = 0; m < 4; ++m) { float* rowp = base + (size_t)(ai * 128 + wr * 64 + m * 16 + fr) * D + wc * 32 + 4 * fq;
#pragma unroll
                for (int bj = 0; bj < 2; ++bj)
#pragma unroll
                    for (int n = 0; n < 2; ++n) *(f32x4*)(rowp + bj * 128 + n * 16) = acc[ai][bj][m][n]; }
    }
};
struct EpiGlu {
    static constexpr bool PERM = false, AFTER_DRAIN = false;
    float* O;
    __device__ __forceinline__ void operator()(const f32x4 (&acc)[2][2][4][2], const pg8::Unit& u, int wr, int wc, int fr, int fq) const {
        float* base = O + (size_t)(u.pm - T_Z) * 256 * D + (size_t)(u.pn - T_WVG) * 128;
#pragma unroll
        for (int ai = 0; ai < 2; ++ai)
#pragma unroll
            for (int m = 0; m < 4; ++m) { float* rowp = base + (size_t)(ai * 128 + wr * 64 + m * 16 + fr) * D + wc * 32 + 4 * fq;
#pragma unroll
                for (int n = 0; n < 2; ++n) { const f32x4 a = acc[ai][0][m][n], g = acc[ai][1][m][n]; f32x4 o;
#pragma unroll
                    for (int j = 0; j < 4; ++j) o[j] = a[j] * sigmoid_f(g[j]);
                    *(f32x4*)(rowp + n * 16) = o; } }
    }
};
struct EpiSwiglu {
    static constexpr bool PERM = true, AFTER_DRAIN = false;
    bf16* ACT; int pnB;
    __device__ __forceinline__ void operator()(const f32x4 (&acc)[2][2][4][2], const pg8::Unit& u, int wr, int wc, int fr, int fq) const {
        const int j = (u.pn - pnB) & 15;
        bf16* base = ACT + (size_t)(u.pm - T_XE) * 256 * D + (size_t)j * 128;
#pragma unroll
        for (int ai = 0; ai < 2; ++ai)
#pragma unroll
            for (int m = 0; m < 4; ++m) { bf16* rowp = base + (size_t)(ai * 128 + wr * 64 + m * 16 + fr) * D + wc * 32 + 8 * fq;
                f32x4 o0, o1;
#pragma unroll
                for (int q = 0; q < 4; ++q) { o0[q] = silu_f(acc[ai][0][m][0][q]) * acc[ai][1][m][0][q]; o1[q] = silu_f(acc[ai][0][m][1][q]) * acc[ai][1][m][1][q]; }
                v4u w; w.x = pk2(o0[0], o0[1]); w.y = pk2(o0[2], o0[3]); w.z = pk2(o1[0], o1[1]); w.w = pk2(o1[2], o1[3]);
                *(v4u*)rowp = w; }
    }
};
struct EpiDown {
    static constexpr bool PERM = false, AFTER_DRAIN = false;
    float* YE; const float* GATE; int pnB;
    __device__ __forceinline__ void operator()(const f32x4 (&acc)[2][2][4][2], const pg8::Unit& u, int wr, int wc, int fr, int fq) const {
        const int j = (u.pn - pnB) & 7; const int rt = (u.pm - T_ACT) * 256;
        float* base = YE + (size_t)rt * D + (size_t)j * 256;
#pragma unroll
        for (int ai = 0; ai < 2; ++ai)
#pragma unroll
            for (int m = 0; m < 4; ++m) { const int r = ai * 128 + wr * 64 + m * 16 + fr; const float gt = GATE[rt + r]; float* rowp = base + (size_t)r * D + wc * 32 + 4 * fq;
#pragma unroll
                for (int bj = 0; bj < 2; ++bj)
#pragma unroll
                    for (int n = 0; n < 2; ++n) *(f32x4*)(rowp + bj * 128 + n * 16) = acc[ai][bj][m][n] * gt; }
    }
};

__device__ __forceinline__ float dot_bf16(const bf16* a, const bf16* b, int K) {
    float s = 0.f;
    for (int k = 0; k < K; k += 8) { const v4u x = *(const v4u*)(a + k), y = *(const v4u*)(b + k);
#pragma unroll
        for (int q = 0; q < 4; ++q) { s += bf2f(x[q] & 0xffffu) * bf2f(y[q] & 0xffffu); s += bf2f(x[q] >> 16) * bf2f(y[q] >> 16); } }
    return s;
}
template <class Epi, class Sched>
__device__ __forceinline__ void naive_gemm_phase(const pg8::Gemm g, const Sched& S, const Epi& E) {
    const int tid = threadIdx.x, wid = __builtin_amdgcn_readfirstlane(tid >> 6), lane = tid & 63, wr = wid >> 2, wc = wid & 3, fr = lane & 15, fq = lane >> 4;
    pg8::Unit u;
    for (int i = 0; S.next(i, u); ++i) {
        f32x4 acc[2][2][4][2];
        const bf16* A = g.A + (size_t)u.pm * 256 * g.K; const bf16* B = g.Bt + (size_t)u.pn * 256 * g.K;
#pragma unroll
        for (int ai = 0; ai < 2; ++ai)
#pragma unroll
            for (int m = 0; m < 4; ++m) { const bf16* ar = A + (size_t)(ai * 128 + wr * 64 + m * 16 + fr) * g.K;
#pragma unroll
                for (int bj = 0; bj < 2; ++bj)
#pragma unroll
                    for (int n = 0; n < 2; ++n)
#pragma unroll
                        for (int j = 0; j < 4; ++j) { const int c = Epi::PERM ? (bj * 128 + wc * 32 + 8 * fq + 4 * n + j) : (bj * 128 + wc * 32 + 16 * n + 4 * fq + j);
                            acc[ai][bj][m][n][j] = dot_bf16(ar, B + (size_t)c * g.K, g.K); } }
        E(acc, u, wr, wc, fr, fq);
    }
}
template <class Epi, class Sched>
__device__ __forceinline__ void run_gemm(Frame& F, const Sched& S, const Epi& E) {
    const pg8::Gemm g{(const pg8::bf16_t*)F.ws, (const pg8::bf16_t*)F.ws, 0, 0, D};
#if NAIVE_GEMM
    naive_gemm_phase<Epi, Sched>(g, S, E);
#else
    pg8::gemm_phase<Epi, Sched, PG8_ALIGN, PG8_SP2>((PG8_LAS unsigned char*)F.lds, g, S, E);
#endif
}

#define LDV(p, j) (*(const f32x4*)((p) + 4 * F.lane + 256 * (j)))

__device__ __forceinline__ void p0_mods(Frame& F) {
    LAS float* S = (LAS float*)F.lds;
    LAS float* P = S + 3 * D;
    const float* c = F.in[I_C]; const float* cctx = F.in[I_CCTX];
    for (int i = F.tid; i < 3 * D; i += NTHREADS) { const int r = i / D, k = i % D; const float cv = (r < 2) ? c[r * D + k] : cctx[k]; S[i] = cv / (1.0f + expf(-cv)); }
    __syncthreads();
    const int tl = F.tid & 15, kg = F.tid >> 4;
    float* M = (float*)(F.ws + WS_MODS);
    for (int it = blockIdx.x; it < 2 * 192; it += F.G) {
        const int l = it / 192, cc = it % 192;
        const float* w = F.in[I_WMOD] + (size_t)l * D * D6 + cc * 64 + tl * 4;
        f32x4 a0 = {0.f, 0.f, 0.f, 0.f}, a1 = a0, a2 = a0;
#pragma unroll 8
        for (int kk = 0; kk < 64; ++kk) { const int k = kg * 64 + kk; const f32x4 wv = *(const f32x4*)(w + (size_t)k * D6); a0 += wv * S[k]; a1 += wv * S[D + k]; a2 += wv * S[2 * D + k]; }
#pragma unroll
        for (int j = 0; j < 4; ++j) { P[(kg * 3 + 0) * 64 + tl * 4 + j] = a0[j]; P[(kg * 3 + 1) * 64 + tl * 4 + j] = a1[j]; P[(kg * 3 + 2) * 64 + tl * 4 + j] = a2[j]; }
        __syncthreads();
        if (F.tid < 192) { const int r = F.tid >> 6, col = F.tid & 63; float s = 0.f;
            for (int q = 0; q < 32; ++q) s += P[(q * 3 + r) * 64 + col];
            M[(size_t)(l * 3 + r) * D6 + cc * 64 + col] = s + F.in[I_BMOD][l * D6 + cc * 64 + col]; }
        __syncthreads();
    }
}
__device__ __forceinline__ void p0_s5params(Frame& F) {
    float* AR = (float*)(F.ws + WS_SPAR); float* AI = AR + 2 * NG * NP; float* BB = AI + 2 * NG * NP;
    for (int idx = blockIdx.x * NTHREADS + F.tid; idx < 2 * NG * NP; idx += F.G * NTHREADS) {
        const int dg = idx / NP;
        const double lr = (double)fminf(F.in[I_LAMRE][idx], -1e-4f), li = (double)F.in[I_LAMIM][idx], dt = exp((double)F.in[I_LOGSTEP][dg]);
        const double mag = exp(lr * dt); double sn, cs; sincos(li * dt, &sn, &cs);
        const double ar = mag * cs, ai = mag * sn, nr = ar - 1.0, den = lr * lr + li * li, cr = (nr * lr + ai * li) / den, ci = (ai * lr - nr * li) / den;
        AR[idx] = (float)ar; AI[idx] = (float)ai;
        for (int h = 0; h < GH; ++h) { const double bre = F.in[I_BRE][(size_t)idx * GH + h], bim = F.in[I_BIM][(size_t)idx * GH + h];
            BB[(size_t)idx * 32 + h] = (float)(cr * bre - ci * bim); BB[(size_t)idx * 32 + 16 + h] = (float)(cr * bim + ci * bre); }
    }
}
__device__ __forceinline__ void p0_transpose_item(const float* W, int ldw, bf16* WT, int dst_row0, LAS float* scr, int k0, int lane) {
#pragma unroll 8
    for (int i = 0; i < 32; ++i) { const int kk = 2 * i + (lane >> 5); scr[kk * 33 + (lane & 31)] = W[(size_t)(k0 + kk) * ldw + (lane & 31)]; }
    asm volatile("s_waitcnt lgkmcnt(0)" ::: "memory");
    const int c = lane & 7;
#pragma unroll
    for (int j = 0; j < 4; ++j) { const int n = (lane >> 3) + 8 * j; const LAS float* s = scr + (8 * c) * 33 + n;
        v4u o; o.x = pk2(s[0 * 33], s[1 * 33]); o.y = pk2(s[2 * 33], s[3 * 33]); o.z = pk2(s[4 * 33], s[5 * 33]); o.w = pk2(s[6 * 33], s[7 * 33]);
        *(v4u*)(WT + (size_t)(dst_row0 + n) * D + k0 + 8 * c) = o; }
    asm volatile("s_waitcnt lgkmcnt(0)" ::: "memory");
}
__device__ __forceinline__ void p0_weights(Frame& F) {
    LAS float* scr = (LAS float*)(F.lds + F.wave * 16384);
    const int gw = F.vcu * NWAVES + F.wave, NGW = F.G * NWAVES;
    constexpr int NSQ = 6 + 2 * NE * 3;
    for (int it = gw; it < NSQ * 2048; it += NGW) {
        const int sq = it >> 11, r = it & 2047, kb = r >> 6, nb = r & 63, n0 = nb * 32;
        const float* src; int ldw = D; bf16* dst; int mode = 0, off = 0;
        if (sq < 3) { src = F.in[I_WQKV] + sq * D; ldw = 3 * D; dst = ws_tile(F, T_WQKV) + (size_t)sq * D * D; }
        else if (sq == 3) { src = F.in[I_WO]; dst = ws_tile(F, T_WO); }
        else if (sq == 4) { src = F.in[I_WVAL]; dst = ws_tile(F, T_WVG); mode = 1; }
        else if (sq == 5) { src = F.in[I_WGATE]; dst = ws_tile(F, T_WVG); mode = 1; off = 128; }
        else { const int mm = sq - 6, l = mm / 48, e = (mm % 48) / 3, t = mm % 3; const size_t wofs = (size_t)(l * NE + e) * D * D;
            if (t == 0) { src = F.in[I_MGATE] + wofs; dst = ws_tile(F, T_MOE1 + l * 256) + (size_t)e * 4096 * D; mode = 1; }
            else if (t == 1) { src = F.in[I_MUP] + wofs; dst = ws_tile(F, T_MOE1 + l * 256) + (size_t)e * 4096 * D; mode = 1; off = 128; }
            else { src = F.in[I_MDOWN] + wofs; dst = ws_tile(F, T_MOE2 + l * 128) + (size_t)e * 2048 * D; } }
        const int dr0 = mode ? ((n0 >> 7) * 256 + (n0 & 127) + off) : n0;
        p0_transpose_item(src + n0, ldw, dst, dr0, scr, kb * 64, F.lane);
    }
}
__device__ __forceinline__ void p1_prep(Frame& F) {
    const int gw = F.vcu * NWAVES + F.wave, NGW = F.G * NWAVES;
    bf16* HB = ws_tile(F, T_HB);
    for (int row = gw; row < NROWS; row += NGW) {
        const float* xr = row < NLAT ? F.in[I_X] + (size_t)row * D : F.in[I_CTX] + (size_t)(row - NLAT) * D;
        const int r = row_r(row); const float* sh = mods(F, 0, r, 0); const float* sc = mods(F, 0, r, 1);
#pragma unroll
        for (int j = 0; j < 8; ++j) { const f32x4 v = LDV(xr, j), a = LDV(sh, j), b = LDV(sc, j); const f32x4 h = v * (b + 1.0f) + a;
            v2u w; w.x = pk2(h[0], h[1]); w.y = pk2(h[2], h[3]); *(v2u*)(HB + (size_t)row * D + 4 * F.lane + 256 * j) = w; }
    }
}
__device__ __forceinline__ void p3_attn_naive(Frame& F) {
    const int gw = F.vcu * NWAVES + F.wave, NGW = F.G * NWAVES;
    LAS float* Pl = (LAS float*)(F.lds + F.wave * 4096);
    LAS int* Tl = (LAS int*)(F.lds + F.wave * 4096 + 2048);
    const bf16* QK = ws_tile(F, T_QK); const bf16* VT = ws_tile(F, T_VT); bf16* AO = ws_tile(F, T_AO);
    const float scale = 0.08838834764831845f;
    for (int un = gw; un < NROWS * NH; un += NGW) {
        const int row = un >> 4, h = un & 15; const bool lat = row < NLAT;
        int b, r = 0, qc = 0, rs = 0, cst = 0;
        if (lat) { b = row >> 12; const int t = row & 4095; r = t >> 6; qc = t & 63; rs = min(max(r - 4, 0), 56); cst = min(max(qc - 8, 0), 48); } else b = (row - NLAT) >> 8;
        const int nk = lat ? 384 : 256;
        const bf16* q = QK + (size_t)row * 4096 + h * HD;
        float sv[6]; float mx = -3.0e38f;
#pragma unroll
        for (int i = 0; i < 6; ++i) { const int kk = F.lane + 64 * i; float s = -3.0e38f;
            if (kk < nk) { int krow; float bias = 0.f;
                if (lat && kk < 128) { const int kr = rs + (kk >> 4), kc = cst + (kk & 15); krow = b * SEQ + kr * 64 + kc;
                    const int dc = min(max(kc - qc + 15, 0), 30); bias = F.in[I_RPB][(h * 15 + (kr - r + 7)) * 31 + dc]; }
                else krow = NLAT + b * CTXL + (lat ? kk - 128 : kk);
                s = dot_bf16(q, QK + (size_t)krow * 4096 + D + h * HD, HD) * scale + bias; Tl[kk] = krow; }
            sv[i] = s; mx = fmaxf(mx, s); }
        mx = wave_max(mx); float sum = 0.f;
#pragma unroll
        for (int i = 0; i < 6; ++i) { const int kk = F.lane + 64 * i; const float p = (kk < nk) ? __expf(sv[i] - mx) : 0.f; sv[i] = p; sum += p; }
        sum = wave_sum(sum); const float inv = 1.0f / sum;
#pragma unroll
        for (int i = 0; i < 6; ++i) { const int kk = F.lane + 64 * i; if (kk < nk) Pl[kk] = sv[i] * inv; }
        asm volatile("s_waitcnt lgkmcnt(0)" ::: "memory");
        float o0 = 0.f, o1 = 0.f; const bf16* v0 = VT + (size_t)(h * HD + 2 * F.lane) * NROWS; const bf16* v1 = v0 + NROWS;
        for (int kk = 0; kk < nk; ++kk) { const float p = Pl[kk]; const int kr = Tl[kk]; o0 += p * bf2f(v0[kr]); o1 += p * bf2f(v1[kr]); }
        *(unsigned*)(AO + (size_t)row * D + h * HD + 2 * F.lane) = pk2(o0, o1);
        asm volatile("s_waitcnt lgkmcnt(0)" ::: "memory");
    }
}
__device__ __forceinline__ const float* xin_row(Frame& F, int l, int row) {
    if (l == 0) return row < NLAT ? F.in[I_X] + (size_t)row * D : F.in[I_CTX] + (size_t)(row - NLAT) * D;
    return (const float*)(F.ws + WS_X2) + (size_t)row * D;
}
__device__ __forceinline__ void ln_rows(f32x4 (&v)[8], const float* g, const float* bb, const Frame& F) {
    float s = 0.f;
#pragma unroll
    for (int j = 0; j < 8; ++j) s += (v[j][0] + v[j][1]) + (v[j][2] + v[j][3]);
    const float mean = wave_sum(s) * (1.0f / D); float s2 = 0.f;
#pragma unroll
    for (int j = 0; j < 8; ++j) { v[j] = v[j] - mean; s2 += (v[j][0] * v[j][0] + v[j][1] * v[j][1]) + (v[j][2] * v[j][2] + v[j][3] * v[j][3]); }
    const float rstd = 1.0f / sqrtf(wave_sum(s2) * (1.0f / D) + LN_EPS);
#pragma unroll
    for (int j = 0; j < 8; ++j) v[j] = v[j] * rstd * LDV(g, j) + LDV(bb, j);
}
__device__ __forceinline__ void row_phase(Frame& F, int l) {
    const int gw = F.vcu * NWAVES + F.wave, NGW = F.G * NWAVES, nrows = l ? NLAT : NROWS;
    const float* O = (const float*)(F.ws + WS_O); float* X1 = (float*)(F.ws + WS_X1); bf16* HB = ws_tile(F, T_HB); float* AFF = (float*)(F.ws + WS_AFF);
    const float* lng = F.in[I_LNG] + (size_t)(l * 2 + 0) * D; const float* lnb = F.in[I_LNB] + (size_t)(l * 2 + 0) * D; const float* wr = F.in[I_ROUTER] + (size_t)l * D * NE;
    for (int row = gw; row < nrows; row += NGW) {
        const float* xr = xin_row(F, l, row); const float* orow = O + (size_t)row * D; const int r = row_r(row);
        const float* g1 = mods(F, l, r, 2); const float* sh2 = mods(F, l, r, 3); const float* sc2 = mods(F, l, r, 4);
        f32x4 v[8];
#pragma unroll
        for (int j = 0; j < 8; ++j) v[j] = LDV(xr, j) * ALPHA + LDV(g1, j) * LDV(orow, j);
        ln_rows(v, lng, lnb, F);
        float lg[NE];
#pragma unroll
        for (int e = 0; e < NE; ++e) lg[e] = 0.f;
#pragma unroll
        for (int j = 0; j < 8; ++j) { *(f32x4*)(X1 + (size_t)row * D + 4 * F.lane + 256 * j) = v[j];
            const f32x4 h = v[j] * (LDV(sc2, j) + 1.0f) + LDV(sh2, j);
            v2u w; w.x = pk2(h[0], h[1]); w.y = pk2(h[2], h[3]); *(v2u*)(HB + (size_t)row * D + 4 * F.lane + 256 * j) = w;
#pragma unroll
            for (int q = 0; q < 4; ++q) { const float* wp = wr + (size_t)(4 * F.lane + 256 * j + q) * NE;
#pragma unroll
                for (int e4 = 0; e4 < 4; ++e4) { const f32x4 wv = *(const f32x4*)(wp + 4 * e4);
#pragma unroll
                    for (int t = 0; t < 4; ++t) lg[4 * e4 + t] += h[q] * wv[t]; } } }
        float mx = -3.0e38f;
#pragma unroll
        for (int e = 0; e < NE; ++e) { lg[e] = wave_sum(lg[e]); mx = fmaxf(mx, lg[e]); }
        float sum = 0.f;
#pragma unroll
        for (int e = 0; e < NE; ++e) { lg[e] = expf(lg[e] - mx); sum += lg[e]; }
        float mine = 0.f;
#pragma unroll
        for (int e = 0; e < NE; ++e) mine = (F.lane == e) ? lg[e] / sum : mine;
        if (F.lane < NE) AFF[(size_t)row * NE + F.lane] = mine;
    }
}
__device__ __forceinline__ void topk_phase(Frame& F, int l) {
    LAS float* V = (LAS float*)F.lds;
    const float* AFF = (const float*)(F.ws + WS_AFF); int* SLOT = (int*)(F.ws + WS_SLOT); int* IDX = (int*)(F.ws + WS_IDX); float* GATE = (float*)(F.ws + WS_GATE);
    const int nlat = 2 * NE * 8, ntot = nlat + (l == 0 ? 2 * NE : 0);
    for (int un = blockIdx.x; un < ntot; un += F.G) {
        const bool lat = un < nlat; int b, e, ch, n, cap, rowbase, slotbase;
        if (lat) { b = un >> 7; e = (un >> 3) & 15; ch = un & 7; n = SEQ; cap = 512; rowbase = b * SEQ; slotbase = e * RPE + b * 512; }
        else { const int q = un - nlat; b = q >> 4; e = q & 15; ch = 0; n = CTXL; cap = 32; rowbase = NLAT + b * CTXL; slotbase = e * RPE + 1024 + b * 32; }
        for (int t = F.tid; t < n; t += NTHREADS) V[t] = AFF[(size_t)(rowbase + t) * NE + e];
        __syncthreads();
        const int t = ch * 512 + F.tid;
        if (t < n) { const float v = V[t]; int rank = 0;
            for (int j = 0; j < n; j += 4) { const f32x4 w = *(const LAS f32x4*)(V + j);
                rank += (w[0] > v || (w[0] == v && j + 0 < t)) ? 1 : 0; rank += (w[1] > v || (w[1] == v && j + 1 < t)) ? 1 : 0;
                rank += (w[2] > v || (w[2] == v && j + 2 < t)) ? 1 : 0; rank += (w[3] > v || (w[3] == v && j + 3 < t)) ? 1 : 0; }
            int s = -1;
            if (rank < cap) { s = slotbase + rank; IDX[s] = rowbase + t; GATE[s] = v; }
            SLOT[(size_t)(rowbase + t) * NE + e] = s; }
        __syncthreads();
    }
}
__device__ __forceinline__ void gather_phase(Frame& F, int l) {
    const int gw = F.vcu * NWAVES + F.wave, NGW = F.G * NWAVES, nv = l ? 1024 : 1088;
    const bf16* HB = ws_tile(F, T_HB); bf16* XE = ws_tile(F, T_XE); const int* IDX = (const int*)(F.ws + WS_IDX);
    for (int i = gw; i < NE * nv; i += NGW) { const int e = i / nv, s = e * RPE + i % nv; const int src = IDX[s];
        const v4u* sp = (const v4u*)(HB + (size_t)src * D); v4u* dp = (v4u*)(XE + (size_t)s * D);
#pragma unroll
        for (int j = 0; j < 4; ++j) dp[F.lane + 64 * j] = sp[F.lane + 64 * j]; }
}
__device__ __forceinline__ void combine_phase(Frame& F, int l) {
    const int gw = F.vcu * NWAVES + F.wave, NGW = F.G * NWAVES, nrows = l ? NLAT : NROWS;
    const float* X1 = (const float*)(F.ws + WS_X1); const float* YE = (const float*)(F.ws + WS_YE); const int* SLOT = (const int*)(F.ws + WS_SLOT);
    float* X2 = (float*)(F.ws + WS_X2); bf16* HB = ws_tile(F, T_HB);
    const float* lng = F.in[I_LNG] + (size_t)(l * 2 + 1) * D; const float* lnb = F.in[I_LNB] + (size_t)(l * 2 + 1) * D;
    for (int row = gw; row < nrows; row += NGW) {
        const int r = row_r(row); const float* g2 = mods(F, l, r, 5); const float* x1 = X1 + (size_t)row * D;
        f32x4 f[8];
#pragma unroll
        for (int j = 0; j < 8; ++j) f[j] = (f32x4){0.f, 0.f, 0.f, 0.f};
        for (int e = 0; e < NE; ++e) { const int s = __builtin_amdgcn_readfirstlane(SLOT[(size_t)row * NE + e]);
            if (s >= 0) { const float* yr = YE + (size_t)s * D;
#pragma unroll
                for (int j = 0; j < 8; ++j) f[j] += LDV(yr, j); } }
        f32x4 v[8];
#pragma unroll
        for (int j = 0; j < 8; ++j) v[j] = LDV(x1, j) * ALPHA + LDV(g2, j) * f[j];
        ln_rows(v, lng, lnb, F);
        if (l == 0) { const float* sh = mods(F, 1, r, 0); const float* sc = mods(F, 1, r, 1);
#pragma unroll
            for (int j = 0; j < 8; ++j) { *(f32x4*)(X2 + (size_t)row * D + 4 * F.lane + 256 * j) = v[j];
                const f32x4 h = v[j] * (LDV(sc, j) + 1.0f) + LDV(sh, j);
                v2u w; w.x = pk2(h[0], h[1]); w.y = pk2(h[2], h[3]); *(v2u*)(HB + (size_t)row * D + 4 * F.lane + 256 * j) = w; } }
        else {
#pragma unroll
            for (int j = 0; j < 8; ++j) *(f32x4*)(F.out + (size_t)row * D + 4 * F.lane + 256 * j) = v[j]; }
    }
}
__device__ __forceinline__ void s5_naive(Frame& F) {
    const int gw = F.vcu * NWAVES + F.wave, NGW = F.G * NWAVES;
    const float* AR = (const float*)(F.ws + WS_SPAR); const float* AI = AR + 2 * NG * NP; const float* BB = AI + 2 * NG * NP;
    const bf16* HB = ws_tile(F, T_HB);
    for (int un = gw; un < 2 * NG * 2; un += NGW) {
        const int b = un >> 8, g = (un >> 1) & 127, dir = un & 1; const int idx = (dir * NG + g) * NP + F.lane;
        const float ar = AR[idx], ai = AI[idx]; float br[GH], bi[GH], cr[GH], ci[GH];
#pragma unroll
        for (int h = 0; h < GH; ++h) { br[h] = BB[(size_t)idx * 32 + h]; bi[h] = BB[(size_t)idx * 32 + 16 + h];
            cr[h] = F.in[I_CRE][((size_t)(dir * NG + g) * GH + h) * NP + F.lane]; ci[h] = F.in[I_CIM][((size_t)(dir * NG + g) * GH + h) * NP + F.lane]; }
        float* Y = (float*)(F.ws + (dir ? WS_YB : WS_YF));
        float xr = 0.f, xi = 0.f;
        for (int tau = 0; tau < CTXL + SEQ; ++tau) {
            int row; if (tau < CTXL) row = NLAT + b * CTXL + (dir ? CTXL - 1 - tau : tau); else row = b * SEQ + (dir ? SEQ - 1 - (tau - CTXL) : tau - CTXL);
            const v4u u0 = *(const v4u*)(HB + (size_t)row * D + g * GH), u1 = *(const v4u*)(HB + (size_t)row * D + g * GH + 8);
            float u[GH];
#pragma unroll
            for (int q = 0; q < 4; ++q) { u[2 * q] = bf2f(u0[q] & 0xffffu); u[2 * q + 1] = bf2f(u0[q] >> 16); u[8 + 2 * q] = bf2f(u1[q] & 0xffffu); u[8 + 2 * q + 1] = bf2f(u1[q] >> 16); }
            float pr = 0.f, pi = 0.f;
#pragma unroll
            for (int h = 0; h < GH; ++h) { pr += br[h] * u[h]; pi += bi[h] * u[h]; }
            const float nxr = ar * xr - ai * xi + pr, nxi = ar * xi + ai * xr + pi; xr = nxr; xi = nxi;
            if (tau >= CTXL) { float mine = 0.f;
#pragma unroll
                for (int h = 0; h < GH; ++h) { const float y = wave_sum(cr[h] * xr - ci[h] * xi); mine = (F.lane == h) ? y : mine; }
                if (F.lane < GH) Y[(size_t)row * D + g * GH + F.lane] = mine; }
        }
    }
}
__device__ __forceinline__ void zprep_phase(Frame& F) {
    const int gw = F.vcu * NWAVES + F.wave, NGW = F.G * NWAVES;
    const float* X2 = (const float*)(F.ws + WS_X2); const float* YF = (const float*)(F.ws + WS_YF); const float* YB = (const float*)(F.ws + WS_YB); bf16* Z = ws_tile(F, T_Z);
    const float* dsk = F.in[I_SD];
    for (int row = gw; row < NLAT; row += NGW) {
        const int r = row >> 12; const float* sh = mods(F, 1, r, 0); const float* sc = mods(F, 1, r, 1);
        const float* x2 = X2 + (size_t)row * D; const float* yf = YF + (size_t)row * D; const float* yb = YB + (size_t)row * D;
#pragma unroll
        for (int j = 0; j < 8; ++j) { const f32x4 u = LDV(x2, j) * (LDV(sc, j) + 1.0f) + LDV(sh, j); const f32x4 y = LDV(dsk, j) * u + LDV(yf, j) + LDV(yb, j);
            v2u w; w.x = pk2(gelu_tanh_f(y[0]), gelu_tanh_f(y[1])); w.y = pk2(gelu_tanh_f(y[2]), gelu_tanh_f(y[3]));
            *(v2u*)(Z + (size_t)row * D + 4 * F.lane + 256 * j) = w; }
    }
}

constexpr int S5_T = 34, S5_NCH = 128;
typedef float f32x4s __attribute__((ext_vector_type(4)));
struct S5Consts { bf16x8 abu[8]; float ar[4][4], ai[4][4]; };
__device__ __forceinline__ void s5_load_consts(const Frame& F, int gd, int lane, S5Consts& K) {
    const float* AR = (const float*)(F.ws + WS_SPAR); const float* AI = AR + 2 * NG * NP; const float* BB = AI + 2 * NG * NP;
    const int m = lane & 15, q = lane >> 4;
#pragma unroll
    for (int tt = 0; tt < 8; ++tt) { const int p = 16 * (tt >> 1) + m; v4u w = {0u, 0u, 0u, 0u};
        if (q < 2) { const float* s = BB + (size_t)(gd * NP + p) * 32 + (tt & 1) * 16 + 8 * q; const f32x4 x0 = *(const f32x4*)s, x1 = *(const f32x4*)(s + 4);
            w.x = pk2(x0[0], x0[1]); w.y = pk2(x0[2], x0[3]); w.z = pk2(x1[0], x1[1]); w.w = pk2(x1[2], x1[3]); }
        K.abu[tt] = __builtin_bit_cast(bf16x8, w); }
#pragma unroll
    for (int pb = 0; pb < 4; ++pb) { const f32x4 a = *(const f32x4*)(AR + gd * NP + 16 * pb + 4 * q), b = *(const f32x4*)(AI + gd * NP + 16 * pb + 4 * q);
#pragma unroll
        for (int i = 0; i < 4; ++i) { K.ar[pb][i] = a[i]; K.ai[pb][i] = b[i]; } }
}
__device__ __forceinline__ int s5_row(int b, int dir, int tau) {
    const int ctxrow = NLAT + b * CTXL + (dir ? CTXL - 1 - tau : tau), latrow = b * SEQ + (dir ? (CTXL + SEQ - 1) - tau : tau - CTXL);
    return tau < CTXL ? ctxrow : latrow;
}
template <bool READOUT>
__device__ __forceinline__ void s5_pass(Frame& F) {
    const int gw = F.vcu * NWAVES + F.wave, NGW = F.G * NWAVES, lane = F.lane, n = lane & 15, q = lane >> 4;
    const bf16* HB = ws_tile(F, T_HB);
    float* XLOC = (float*)(F.ws + WS_XLOC); const float* CARRY = (const float*)(F.ws + WS_CARRY);
    for (int pair = gw; pair < 2 * NG * 8; pair += NGW) {
        const int gd = pair >> 3, dir = gd >> 7, g = gd & 127;
        S5Consts K; s5_load_consts(F, gd, lane, K);
        bf16x8 cfr[4];
        if (READOUT) {
#pragma unroll
            for (int s = 0; s < 4; ++s) { const float* cr = F.in[I_CRE] + (size_t)(gd * GH + n) * NP + 16 * s + 4 * q; const float* ci = F.in[I_CIM] + (size_t)(gd * GH + n) * NP + 16 * s + 4 * q;
                const f32x4 a = *(const f32x4*)cr, b = *(const f32x4*)ci; v4u w; w.x = pk2(a[0], a[1]); w.y = pk2(a[2], a[3]); w.z = pk2(-b[0], -b[1]); w.w = pk2(-b[2], -b[3]);
                cfr[s] = __builtin_bit_cast(bf16x8, w); } }
        float* Y = (float*)(F.ws + (dir ? WS_YB : WS_YF));
        for (int k2 = 0; k2 < 2; ++k2) {
            const int cg = (pair & 7) * 2 + k2, chunk = cg * 16 + n, b = chunk >> 7, c = chunk & 127, tau0 = c * S5_T;
            const size_t sbase = ((size_t)gd * 256 + chunk) * 128;
            f32x4s X[8];
            if (READOUT) {
#pragma unroll
                for (int pb = 0; pb < 4; ++pb) { const f32x4 v0 = *(const f32x4*)(CARRY + sbase + (16 * pb + 4 * q) * 2), v1 = *(const f32x4*)(CARRY + sbase + (16 * pb + 4 * q) * 2 + 4);
                    X[2 * pb] = (f32x4s){v0[0], v0[2], v1[0], v1[2]}; X[2 * pb + 1] = (f32x4s){v0[1], v0[3], v1[1], v1[3]}; }
            } else {
#pragma unroll
                for (int tt = 0; tt < 8; ++tt) X[tt] = (f32x4s){0.f, 0.f, 0.f, 0.f};
            }
            constexpr int PD = 6;
            v4u ur[PD];
#pragma unroll
            for (int t = 0; t < PD; ++t) { ur[t] = (v4u){0u, 0u, 0u, 0u}; if (q < 2) ur[t] = *(const v4u*)(HB + (size_t)s5_row(b, dir, tau0 + t) * D + g * GH + 8 * q); }
#pragma unroll
            for (int t = 0; t < S5_T; ++t) {
                const bf16x8 ub = __builtin_bit_cast(bf16x8, ur[t % PD]);
                if (t + PD < S5_T) { ur[t % PD] = (v4u){0u, 0u, 0u, 0u}; if (q < 2) ur[t % PD] = *(const v4u*)(HB + (size_t)s5_row(b, dir, tau0 + t + PD) * D + g * GH + 8 * q); }
#pragma unroll
                for (int pb = 0; pb < 4; ++pb)
#pragma unroll
                    for (int i = 0; i < 4; ++i) { const float re = X[2 * pb][i], im = X[2 * pb + 1][i];
                        X[2 * pb][i] = K.ar[pb][i] * re - K.ai[pb][i] * im; X[2 * pb + 1][i] = K.ar[pb][i] * im + K.ai[pb][i] * re; }
#pragma unroll
                for (int tt = 0; tt < 8; ++tt) X[tt] = __builtin_amdgcn_mfma_f32_16x16x32_bf16(K.abu[tt], ub, X[tt], 0, 0, 0);
                if (READOUT) {
                    f32x4s y0 = {0.f, 0.f, 0.f, 0.f}, y1 = y0;
#pragma unroll
                    for (int s = 0; s < 4; ++s) { v4u w; w.x = pk2(X[2 * s][0], X[2 * s][1]); w.y = pk2(X[2 * s][2], X[2 * s][3]); w.z = pk2(X[2 * s + 1][0], X[2 * s + 1][1]); w.w = pk2(X[2 * s + 1][2], X[2 * s + 1][3]);
                        const bf16x8 xb = __builtin_bit_cast(bf16x8, w);
                        if (s & 1) y1 = __builtin_amdgcn_mfma_f32_16x16x32_bf16(cfr[s], xb, y1, 0, 0, 0); else y0 = __builtin_amdgcn_mfma_f32_16x16x32_bf16(cfr[s], xb, y0, 0, 0, 0); }
                    const int tau = tau0 + t;
                    if (tau >= CTXL) { const f32x4s y = y0 + y1; *(f32x4s*)(Y + (size_t)s5_row(b, dir, tau) * D + g * GH + 4 * q) = y; }
                }
            }
            if (!READOUT) {
#pragma unroll
                for (int pb = 0; pb < 4; ++pb) { const f32x4s re = X[2 * pb], im = X[2 * pb + 1];
                    *(f32x4*)(XLOC + sbase + (16 * pb + 4 * q) * 2) = (f32x4){re[0], im[0], re[1], im[1]}; *(f32x4*)(XLOC + sbase + (16 * pb + 4 * q) * 2 + 4) = (f32x4){re[2], im[2], re[3], im[3]}; }
            }
        }
    }
}
__device__ __forceinline__ void s5_carry(Frame& F) {
    LAS f32x2* AG = (LAS f32x2*)F.lds;
    const float* AR = (const float*)(F.ws + WS_SPAR); const float* AI = AR + 2 * NG * NP;
    const float* XLOC = (const float*)(F.ws + WS_XLOC); float* CARRY = (float*)(F.ws + WS_CARRY);
    const int seg = F.tid >> 6, p = F.tid & 63;
    for (int un = blockIdx.x; un < 2 * NG * 2; un += F.G) {
        const int gd = un >> 1, b = un & 1;
        double ar = AR[gd * NP + p], ai = AI[gd * NP + p];
        double pr = 1.0, pi = 0.0;
        { double sr = ar, si = ai;
          double t; t = sr * sr - si * si; si = 2.0 * sr * si; sr = t;
          pr = sr; pi = si;
          for (int k = 0; k < 4; ++k) { t = sr * sr - si * si; si = 2.0 * sr * si; sr = t; }
          t = pr * sr - pi * si; pi = pr * si + pi * sr; pr = t; }
        const float tr = (float)pr, ti = (float)pi;
        double qr = pr, qi = pi; for (int k = 0; k < 4; ++k) { const double t = qr * qr - qi * qi; qi = 2.0 * qr * qi; qr = t; }
        const float t16r = (float)qr, t16i = (float)qi;
        const size_t base = ((size_t)gd * 256 + b * S5_NCH + seg * 16) * 128 + p * 2;
        f32x2 loc[16];
#pragma unroll
        for (int k = 0; k < 16; ++k) loc[k] = *(const f32x2*)(XLOC + base + (size_t)k * 128);
        float sr = 0.f, si = 0.f;
#pragma unroll
        for (int k = 0; k < 16; ++k) { const float nr = tr * sr - ti * si + loc[k][0], ni = tr * si + ti * sr + loc[k][1]; sr = nr; si = ni; }
        AG[seg * 64 + p] = (f32x2){sr, si};
        __syncthreads();
        float cr = 0.f, ci = 0.f;
        for (int s2 = 0; s2 < seg; ++s2) { const f32x2 a = AG[s2 * 64 + p]; const float nr = t16r * cr - t16i * ci + a[0], ni = t16r * ci + t16i * cr + a[1]; cr = nr; ci = ni; }
#pragma unroll
        for (int k = 0; k < 16; ++k) { *(f32x2*)(CARRY + base + (size_t)k * 128) = (f32x2){cr, ci};
            const float nr = tr * cr - ti * ci + loc[k][0], ni = tr * ci + ti * cr + loc[k][1]; cr = nr; ci = ni; }
        __syncthreads();
    }
}

__device__ __forceinline__ void attn_mfma(Frame& F) {
    const int gw = F.vcu * NWAVES + F.wave, NGW = F.G * NWAVES, lane = F.lane, n = lane & 15, qd = lane >> 4;
    const bf16* QK = ws_tile(F, T_QK); const bf16* VT = ws_tile(F, T_VT); bf16* AO = ws_tile(F, T_AO);
    const float scale = 0.08838834764831845f, NEG = -3.0e38f;
    const int mkey = 8 * (n >> 2) + (n & 3);
    for (int un = gw; un < NLAT + NCTX; un += NGW) {
        const bool lat = un < NLAT;
        int b, h, r = 0, j = 0, qrow0;
        if (lat) { b = un >> 12; h = (un >> 8) & 15; r = (un >> 2) & 63; j = un & 3; qrow0 = b * SEQ + r * 64 + 16 * j; }
        else { const int v = un - NLAT; b = v >> 8; h = (v >> 4) & 15; qrow0 = NLAT + b * CTXL + 16 * (v & 15); }
        bf16x8 qf[4];
        { const bf16* qp = QK + (size_t)(qrow0 + n) * 4096 + h * HD + 8 * qd;
#pragma unroll
          for (int kk = 0; kk < 4; ++kk) qf[kk] = *(const bf16x8*)(qp + 32 * kk); }
        const int rs = min(max(r - 4, 0), 56), cs = min(max(16 * j - 8, 0), 32), qc = 16 * j + n, cst = min(max(qc - 8, 0), 48);
        float S[16][2][4];
        float mx = NEG;
#pragma unroll
        for (int blk = 0; blk < 16; ++blk) {
            const bool loc = blk < 8;
            if (loc && !lat) {
#pragma unroll
                for (int hf = 0; hf < 2; ++hf)
#pragma unroll
                    for (int i = 0; i < 4; ++i) S[blk][hf][i] = NEG;
            } else {
                const int tok0 = loc ? b * SEQ + (rs + blk) * 64 + cs : NLAT + b * CTXL + 32 * (blk - 8);
#pragma unroll
                for (int hf = 0; hf < 2; ++hf) {
                    const bf16* kp = QK + (size_t)(tok0 + mkey + 4 * hf) * 4096 + D + h * HD + 8 * qd;
                    f32x4 acc = {0.f, 0.f, 0.f, 0.f};
#pragma unroll
                    for (int kk = 0; kk < 4; ++kk) acc = __builtin_amdgcn_mfma_f32_16x16x32_bf16(*(const bf16x8*)(kp + 32 * kk), qf[kk], acc, 0, 0, 0);
#pragma unroll
                    for (int i = 0; i < 4; ++i) { float s = acc[i] * scale;
                        if (loc) { const int kc = cs + 8 * qd + 4 * hf + i; const bool valid = (kc >= cst) && (kc < cst + 16); const int dc = min(max(kc - qc + 15, 0), 30);
                            const float bias = F.in[I_RPB][(h * 15 + (rs + blk - r + 7)) * 31 + dc]; s = valid ? s + bias : NEG; }
                        S[blk][hf][i] = s; mx = fmaxf(mx, s); } } }
        }
        mx = fmaxf(mx, __shfl_xor(mx, 16)); mx = fmaxf(mx, __shfl_xor(mx, 32));
        float sum = 0.f; bf16x8 pf[16];
#pragma unroll
        for (int blk = 0; blk < 16; ++blk) { float p[8];
#pragma unroll
            for (int hf = 0; hf < 2; ++hf)
#pragma unroll
                for (int i = 0; i < 4; ++i) { const float e = __expf(S[blk][hf][i] - mx); p[4 * hf + i] = e; sum += e; }
            v4u w; w.x = pk2(p[0], p[1]); w.y = pk2(p[2], p[3]); w.z = pk2(p[4], p[5]); w.w = pk2(p[6], p[7]); pf[blk] = __builtin_bit_cast(bf16x8, w); }
        sum += __shfl_xor(sum, 16); sum += __shfl_xor(sum, 32);
        const float inv = 1.0f / sum;
        f32x4 O[8];
#pragma unroll
        for (int dt = 0; dt < 8; ++dt) O[dt] = (f32x4){0.f, 0.f, 0.f, 0.f};
#pragma unroll
        for (int blk = 0; blk < 16; ++blk) {
            const bool loc = blk < 8;
            if (!(loc && !lat)) {
                const int tok0 = loc ? b * SEQ + (rs + blk) * 64 + cs : NLAT + b * CTXL + 32 * (blk - 8);
                const bf16* vp = VT + (size_t)(h * HD + n) * NROWS + tok0 + 8 * qd;
#pragma unroll
                for (int dt = 0; dt < 8; ++dt) O[dt] = __builtin_amdgcn_mfma_f32_16x16x32_bf16(*(const bf16x8*)(vp + (size_t)dt * 16 * NROWS), pf[blk], O[dt], 0, 0, 0);
            }
        }
        bf16* op = AO + (size_t)(qrow0 + n) * D + h * HD + 4 * qd;
#pragma unroll
        for (int dt = 0; dt < 8; ++dt) { v2u w; w.x = pk2(O[dt][0] * inv, O[dt][1] * inv); w.y = pk2(O[dt][2] * inv, O[dt][3] * inv); *(v2u*)(op + 16 * dt) = w; }
    }
}

constexpr int NPH = 22;
struct Args { const float* in[25]; float* out; unsigned char* ws; int ph_lo, ph_hi; };
__global__ void __launch_bounds__(NTHREADS, 2) mk_fwd(Args args) {
    extern __shared__ __attribute__((aligned(16))) unsigned char lds[];
    Frame F;
    F.lds = (LAS unsigned char*)lds; F.ws = args.ws; F.out = args.out;
#pragma unroll
    for (int i = 0; i < 25; ++i) F.in[i] = args.in[i];
    F.tid = threadIdx.x; F.lane = F.tid & 63; F.wave = __builtin_amdgcn_readfirstlane(F.tid >> 6);
    F.G = gridDim.x; { const int bx = blockIdx.x; F.vcu = (F.G % 8 == 0) ? (bx % 8) * (F.G / 8) + bx / 8 : bx; }
    const int vcu0 = F.vcu;
    volatile LAS unsigned* MISC = (volatile LAS unsigned*)(F.lds + MISC_OFF);
    for (int u = F.tid; u < 32; u += NTHREADS) MISC[u] = 0u;
    __syncthreads();
    const int lo = args.ph_lo, hi = args.ph_hi;
    const bool multi = (hi - lo) > 1;
    XcdBarrier bar; bar.bar = (unsigned*)(F.ws + WS_CTL) + CW_BAR; bar.x = 0; bar.st = nullptr;
    if (multi) bar = xcd_barrier_post((unsigned*)(F.ws + WS_CTL) + CW_BAR, MISC + 8);
#define IN(k) (lo <= (k) && (k) < hi)
#define PH() do { unsigned char* w_ = args.ws; asm volatile("" : "+s"(w_)); F.ws = w_; int t_ = threadIdx.x; asm volatile("" : "+v"(t_)); F.tid = t_; F.lane = t_ & 63; F.wave = __builtin_amdgcn_readfirstlane(t_ >> 6); int v_ = vcu0; asm volatile("" : "+s"(v_)); F.vcu = v_; } while (0)
#define SEAM(k) do { if (IN(k) && IN((k) + 1)) xcd_barrier(bar); } while (0)

    if (IN(0)) { PH(); p0_mods(F); p0_s5params(F); __syncthreads(); p0_weights(F); __syncthreads(); }
    SEAM(0);
    for (int l = 0; l < 2; ++l) {
        if (l == 0) {
            if (IN(1)) { PH(); p1_prep(F); }
            SEAM(1);
            if (IN(2)) { PH(); SegSched S; S.init(F.G, F.vcu, 34, 16, T_HB, T_WQKV, 8, 34, T_WQKV + 16, T_HB); EpiQKV E{ws_tile(F, T_QK), ws_tile(F, T_VT)}; run_gemm(F, S, E); }
            SEAM(2);
            if (IN(3)) { PH();
#if ATTN_NAIVE
                p3_attn_naive(F);
#else
                attn_mfma(F);
#endif
                __syncthreads(); }
            SEAM(3);
            if (IN(4)) { PH(); SegSched S; S.init(F.G, F.vcu, 34, 8, T_AO, T_WO, 0, 0, 0, 0); EpiWo E{(float*)(F.ws + WS_O)}; run_gemm(F, S, E); }
            SEAM(4);
        } else {
#if S5_NAIVE
            if (IN(11)) { PH(); s5_naive(F); }
            SEAM(11); SEAM(12); SEAM(13);
#else
            if (IN(11)) { PH(); s5_pass<false>(F); }
            SEAM(11);
            if (IN(12)) { PH(); s5_carry(F); }
            SEAM(12);
            if (IN(13)) { PH(); s5_pass<true>(F); }
            SEAM(13);
#endif
            if (IN(14)) { PH(); zprep_phase(F); }
            SEAM(14);
            if (IN(15)) { PH(); SegSched S; S.init(F.G, F.vcu, 32, 16, T_Z, T_WVG, 0, 0, 0, 0); EpiGlu E{(float*)(F.ws + WS_O)}; run_gemm(F, S, E); }
            SEAM(15);
        }
        const int pb = l ? 16 : 5;
        if (IN(pb)) { PH(); row_phase(F, l); }
        SEAM(pb);
        if (IN(pb + 1)) { PH(); topk_phase(F, l); }
        SEAM(pb + 1);
        if (IN(pb + 2)) { PH(); gather_phase(F, l); }
        SEAM(pb + 2);
        if (IN(pb + 3)) { PH(); MoeSched S; S.init(F.G, F.vcu, l ? 4 : 5, 16, T_XE, T_MOE1 + l * 256); EpiSwiglu E{ws_tile(F, T_ACT), T_MOE1 + l * 256}; run_gemm(F, S, E); }
        SEAM(pb + 3);
        if (IN(pb + 4)) { PH(); MoeSched S; S.init(F.G, F.vcu, l ? 4 : 5, 8, T_ACT, T_MOE2 + l * 128); EpiDown E{(float*)(F.ws + WS_YE), (const float*)(F.ws + WS_GATE), T_MOE2 + l * 128}; run_gemm(F, S, E); }
        SEAM(pb + 4);
        if (IN(pb + 5)) { PH(); combine_phase(F, l); }
        SEAM(pb + 5);
    }
#undef IN
#undef SEAM
}

extern "C" void kernel_launch(void* const* d_in, const int* in_sizes, int n_in, void* d_out, int out_size, void* d_ws, size_t ws_size, hipStream_t stream) {
    static int grid = 0;
    if (grid == 0) {
        if (n_in != 25 || out_size != NLAT * D || ws_size < WS_END) { fprintf(stderr, "kernel_launch: unexpected shapes (n_in %d out %d ws %zu)\n", n_in, out_size, ws_size); grid = -1; return; }
        int dev = 0, cus = 0, per_cu = 0;
        if (hipGetDevice(&dev) != hipSuccess || hipDeviceGetAttribute(&cus, hipDeviceAttributeMultiprocessorCount, dev) != hipSuccess) { grid = -1; return; }
        if (hipFuncSetAttribute((const void*)mk_fwd, hipFuncAttributeMaxDynamicSharedMemorySize, LDS_BYTES) != hipSuccess) { fprintf(stderr, "kernel_launch: hipFuncSetAttribute failed\n"); grid = -1; return; }
        if (hipOccupancyMaxActiveBlocksPerMultiprocessor(&per_cu, (const void*)mk_fwd, NTHREADS, LDS_BYTES) != hipSuccess || per_cu < 1) { fprintf(stderr, "kernel_launch: occupancy query reports %d\n", per_cu); }
        (void)hipGetLastError();
        grid = cus;
    }
    if (grid < 0) return;
    (void)hipMemsetAsync((char*)d_ws + WS_CTL, 0, CTL_ZERO_BYTES, stream);
    Args a{};
    for (int i = 0; i < 25; ++i) a.in[i] = (const float*)d_in[i];
    a.out = (float*)d_out; a.ws = (unsigned char*)d_ws;
#if MK_N_LAUNCHES == 1
    a.ph_lo = 0; a.ph_hi = NPH;
    hipLaunchKernelGGL(mk_fwd, dim3(grid), dim3(NTHREADS), LDS_BYTES, stream, a);
#else
    for (int p = 0; p < NPH; ++p) { a.ph_lo = p; a.ph_hi = p + 1; hipLaunchKernelGGL(mk_fwd, dim3(grid), dim3(NTHREADS), LDS_BYTES, stream, a); }
#endif
}
```

```cpp
#include <hip/hip_runtime.h>
#include <cstdio>
#include <cstdint>
namespace pg8 {
#define PG8_LAS __attribute__((address_space(3)))
typedef unsigned short bf16_t;
typedef short bf16x8 __attribute__((ext_vector_type(8)));
typedef float f32x4 __attribute__((ext_vector_type(4)));
typedef unsigned u32x4 __attribute__((ext_vector_type(4)));
constexpr int BM = 256, BK = 64, HALF = 128, HTB = HALF * BK * 2  , STAGE_BYTES = 8 * HTB, NXCD = 8, WGM = 8;

__host__ __device__ __forceinline__ int lds_byte(int r, int c) { const int st = (r >> 4) * 2 + (c >> 5), rr = r & 15, cc = c & 31, ob = rr * 64 + cc * 2; return st * 1024 + (ob ^ (((ob >> 9) & 1) << 5)); }
__host__ __device__ __forceinline__ void stage_rc(int b, int& R, int& C) { const int st = b / 1024, sb = b % 1024, swz = sb ^ (((sb >> 9) & 1) << 5); R = (st >> 1) * 16 + swz / 64; C = (st & 1) * 32 + (swz % 64) / 2; }
__host__ __device__ __forceinline__ int perm32(int rho) { const int n = rho >> 4, i = rho & 15; return 8 * (i >> 2) + 4 * n + (i & 3); }

struct Unit { int pm, pn; };
struct Gemm { const bf16_t* A; const bf16_t* Bt; int M, N, K; };

__device__ __forceinline__ unsigned cvt_pk_bf16(float lo, float hi) { unsigned r; asm volatile("v_cvt_pk_bf16_f32 %0, %1, %2" : "=v"(r) : "v"(lo), "v"(hi)); return r; }
#ifndef WT_BKM
#define WT_BKM 0
#endif
template <class Epi, class Sched, bool ALIGN_EPI = false, bool SP2 = false, bool GA = false, bool VR = false, int BAUX = 0, bool BKM = false>
__device__ __forceinline__ void gemm_phase(PG8_LAS unsigned char* lds, const Gemm g, const Sched& S, const Epi& E, int tid_in) {
    int tid_ = tid_in; asm volatile("" : "+v"(tid_));
    const int tid = tid_, wid = __builtin_amdgcn_readfirstlane(tid >> 6), lane = tid & 63, wr = wid >> 2, wc = wid & 3, fr = lane & 15, fq = lane >> 4;
    const int K = g.K, nt = K / BK;
    unsigned voffA[2], voffB[2];
#pragma unroll
    for (int i = 0; i < 2; ++i) { int R, C; stage_rc(tid * 16 + i * 8192, R, C); const int Rb = Epi::PERM ? ((R & ~31) + perm32(R & 31)) : R;
        voffA[i] = (unsigned)(R * K + C) * 2u; voffB[i] = BKM ? (unsigned)(Rb * BK + C) * 2u : (unsigned)(Rb * K + C) * 2u; }
    unsigned vA[2][2] = {{0u, 0u}, {0u, 0u}}, nvA[2][2] = {{0u, 0u}, {0u, 0u}}; int gaR[2] = {0, 0}; unsigned gaC[2] = {0u, 0u};
    if constexpr (GA) {
#pragma unroll
        for (int i = 0; i < 2; ++i) { int R, C; stage_rc(tid * 16 + i * 8192, R, C); gaR[i] = R; gaC[i] = (unsigned)C * 2u; } }
#define PG8_GA_OFFS(dst, unit) do { const int _r0 = S.ga_row0(unit); _Pragma("unroll") for (int _h = 0; _h < 2; ++_h) _Pragma("unroll") for (int _i = 0; _i < 2; ++_i) { \
        const unsigned _ix = (unsigned)S.ga_idx[_r0 + _h * HALF + gaR[_i]]; dst[_h][_i] = (_ix < S.ga_nrows ? _ix : 0u) * (unsigned)(K * 2) + gaC[_i]; } } while (0)
    const size_t kstep = (size_t)(BK * 2);
    const size_t hstep = (size_t)HALF * K * 2;
    const size_t kstepB = BKM ? (size_t)(256 * BK * 2) : kstep, hstepB = BKM ? (size_t)(HALF * BK * 2) : hstep;
    const size_t tstep = 2 * hstep;
    const unsigned ldsw = (unsigned)wid * 1024u;
    const int aoff = lds_byte(wr * 64 + fr, fq * 8), boff = lds_byte(wc * 32 + fr, fq * 8);
#define PG8_SA(b, h) (((b) * 2 + (h)) * HTB)
#define PG8_SB(b, h) ((4 + (b) * 2 + (h)) * HTB)
#define PG8_STAGE(bufoff, gbase, voff) do { _Pragma("unroll") for (int _i = 0; _i < 2; ++_i) \
        __builtin_amdgcn_global_load_lds((const unsigned*)((const char*)(gbase) + (voff)[_i]), (PG8_LAS unsigned*)(lds + (bufoff) + ldsw + _i * 8192), 16, 0, 0); } while (0)
#define PG8_STAGE_B(bufoff, gbase, voff) do { _Pragma("unroll") for (int _i = 0; _i < 2; ++_i) \
        __builtin_amdgcn_global_load_lds((const unsigned*)((const char*)(gbase) + (voff)[_i]), (PG8_LAS unsigned*)(lds + (bufoff) + ldsw + _i * 8192), 16, 0, BAUX); } while (0)
#define PG8_STAGE_A(bufoff, kbase, half, arr) do { if constexpr (GA) PG8_STAGE(bufoff, kbase, arr[half]); else PG8_STAGE(bufoff, (kbase) + (half) * hstep, voffA); } while (0)
#define PG8_LDA(dst, b, h) do { _Pragma("unroll") for (int m = 0; m < 4; ++m) _Pragma("unroll") for (int k = 0; k < 2; ++k) dst[m][k] = *(const PG8_LAS bf16x8*)(lds + PG8_SA(b, h) + aoff + m * 2048 + k * 1024); } while (0)
#define PG8_LDB(dst, b, h) do { _Pragma("unroll") for (int n = 0; n < 2; ++n) _Pragma("unroll") for (int k = 0; k < 2; ++k) dst[n][k] = *(const PG8_LAS bf16x8*)(lds + PG8_SB(b, h) + boff + n * 2048 + k * 1024); } while (0)
#define PG8_MMA(ai, bj, At, Bt) do { if (VR && !((ai) == 0 ? mma_on0 : mma_on1)) break; __builtin_amdgcn_s_setprio(1); _Pragma("unroll") for (int m = 0; m < 4; ++m) _Pragma("unroll") for (int n = 0; n < 2; ++n) _Pragma("unroll") for (int k = 0; k < 2; ++k) \
        acc[ai][bj][m][n] = __builtin_amdgcn_mfma_f32_16x16x32_bf16(Bt[n][k], At[m][k], acc[ai][bj][m][n], 0, 0, 0); __builtin_amdgcn_s_setprio(0); } while (0)
#define PG8_WAIT_V(n) asm volatile("s_waitcnt vmcnt(" #n ")" ::: "memory")
#define PG8_WAIT_L(n) asm volatile("s_waitcnt lgkmcnt(" #n ")" ::: "memory")
#define PG8_BAR __builtin_amdgcn_s_barrier()
#define PG8_SCHED __builtin_amdgcn_sched_barrier(0)
    Unit cur, nxt; int ui = 0;
    if (!S.next(0, cur)) return;
    f32x4 acc[2][2][4][2];
#pragma unroll
    for (int a = 0; a < 2; ++a)
#pragma unroll
        for (int b = 0; b < 2; ++b)
#pragma unroll
            for (int m = 0; m < 4; ++m)
#pragma unroll
                for (int n = 0; n < 2; ++n) acc[a][b][m][n] = (f32x4){0.f, 0.f, 0.f, 0.f};
    bf16x8 At[4][2], B0[2][2], B1[2][2];
    const char* cA = GA ? (const char*)g.A : (const char*)g.A + (size_t)cur.pm * tstep; const char* cB = (const char*)g.Bt + (size_t)cur.pn * tstep;
    if constexpr (GA) PG8_GA_OFFS(vA, cur);
    bool mma_on0 = true, mma_on1 = true;
    if constexpr (VR) { const int vr_ = S.valid_rows(cur); mma_on0 = wr * 64 < vr_; mma_on1 = HALF + wr * 64 < vr_; }
    S.a_ready(cur);
    if constexpr (SP2) {
        PG8_STAGE_B(PG8_SB(0, 0), cB, voffB); PG8_STAGE_B(PG8_SB(0, 1), cB + hstepB, voffB); PG8_STAGE_A(PG8_SA(0, 0), cA, 0, vA); PG8_STAGE_A(PG8_SA(0, 1), cA, 1, vA);
        if (wr == 1) PG8_BAR;
        PG8_WAIT_V(2); PG8_BAR;
        PG8_STAGE_B(PG8_SB(1, 0), cB + kstepB, voffB); PG8_STAGE_A(PG8_SA(1, 0), cA + kstep, 0, vA); PG8_STAGE_B(PG8_SB(1, 1), cB + hstepB + kstepB, voffB);
        PG8_WAIT_V(6); PG8_BAR;
    } else {
        PG8_STAGE_B(PG8_SB(0, 0), cB, voffB); PG8_STAGE_A(PG8_SA(0, 0), cA, 0, vA); PG8_STAGE_B(PG8_SB(0, 1), cB + hstepB, voffB); PG8_STAGE_A(PG8_SA(0, 1), cA, 1, vA);
        if (wr == 1) PG8_BAR;
        PG8_WAIT_V(4); PG8_BAR;
        PG8_STAGE_B(PG8_SB(1, 0), cB + kstepB, voffB); PG8_STAGE_A(PG8_SA(1, 0), cA + kstep, 0, vA); PG8_STAGE_B(PG8_SB(1, 1), cB + hstepB + kstepB, voffB);
        PG8_WAIT_V(6); PG8_BAR;
    }
    for (;;) {
        const bool has_next = S.next(ui + 1, nxt);
        const char* nA = GA ? cA : (has_next ? (const char*)g.A + (size_t)nxt.pm * tstep : cA); const char* nB = has_next ? (const char*)g.Bt + (size_t)nxt.pn * tstep : cB;
        if constexpr (GA) { if (has_next) PG8_GA_OFFS(nvA, nxt); else {
#pragma unroll
            for (int _h = 0; _h < 2; ++_h)
#pragma unroll
                for (int _i = 0; _i < 2; ++_i) nvA[_h][_i] = vA[_h][_i]; } }
        for (int t = 0; t < nt; t += 2) {
            const bool last = (t == nt - 2);
            const char* a1 = cA + (size_t)(t + 1) * kstep;
            const char* a2 = last ? nA : cA + (size_t)(t + 2) * kstep; const char* b2 = last ? nB : cB + (size_t)(t + 2) * kstepB;
            const char* a3 = a2 + kstep; const char* b3 = b2 + kstepB;
            unsigned sA[2][2];
#pragma unroll
            for (int _h = 0; _h < 2; ++_h)
#pragma unroll
                for (int _i = 0; _i < 2; ++_i) sA[_h][_i] = last ? nvA[_h][_i] : vA[_h][_i];
            if (last && has_next) S.a_ready(nxt);
            if constexpr (SP2) {
            PG8_LDB(B0, 0, 0); PG8_LDB(B1, 0, 1); PG8_SCHED; PG8_LDA(At, 0, 0); PG8_STAGE_A(PG8_SA(1, 1), a1, 1, vA);
            PG8_WAIT_V(8); PG8_WAIT_L(0); PG8_BAR; PG8_MMA(0, 0, At, B0); PG8_MMA(0, 1, At, B1); PG8_BAR; PG8_SCHED;
            PG8_LDA(At, 0, 1); PG8_STAGE_B(PG8_SB(0, 0), b2, voffB); PG8_STAGE_B(PG8_SB(0, 1), b2 + hstepB, voffB); PG8_STAGE_A(PG8_SA(0, 0), a2, 0, sA);
            PG8_WAIT_V(8); PG8_WAIT_L(0); PG8_BAR; PG8_MMA(1, 0, At, B0); PG8_MMA(1, 1, At, B1); PG8_BAR; PG8_SCHED;
            PG8_LDB(B0, 1, 0); PG8_LDB(B1, 1, 1); PG8_SCHED; PG8_LDA(At, 1, 0); PG8_STAGE_A(PG8_SA(0, 1), a2, 1, sA);
            PG8_WAIT_V(8); PG8_WAIT_L(0); PG8_BAR; PG8_MMA(0, 0, At, B0); PG8_MMA(0, 1, At, B1); PG8_BAR; PG8_SCHED;
            PG8_LDA(At, 1, 1); PG8_STAGE_B(PG8_SB(1, 0), b3, voffB); PG8_STAGE_B(PG8_SB(1, 1), b3 + hstepB, voffB); PG8_STAGE_A(PG8_SA(1, 0), a3, 0, sA);
            PG8_WAIT_V(8); PG8_WAIT_L(0); PG8_BAR; PG8_MMA(1, 0, At, B0); PG8_MMA(1, 1, At, B1); PG8_BAR; PG8_SCHED;
            } else {
            PG8_LDB(B0, 0, 0); PG8_SCHED; PG8_LDA(At, 0, 0); PG8_STAGE_A(PG8_SA(1, 1), a1, 1, vA);
            PG8_WAIT_L(8); PG8_BAR; PG8_WAIT_L(0); PG8_MMA(0, 0, At, B0); PG8_BAR; PG8_SCHED;
            PG8_LDB(B1, 0, 1); PG8_STAGE_B(PG8_SB(0, 0), b2, voffB);
            PG8_BAR; PG8_WAIT_L(0); PG8_MMA(0, 1, At, B1); PG8_BAR;
            PG8_LDA(At, 0, 1); PG8_STAGE_A(PG8_SA(0, 0), a2, 0, sA);
            PG8_BAR; PG8_WAIT_L(0); PG8_MMA(1, 0, At, B0); PG8_BAR; PG8_SCHED;
            PG8_STAGE_B(PG8_SB(0, 1), b2 + hstepB, voffB);
            PG8_WAIT_V(6); PG8_BAR; PG8_MMA(1, 1, At, B1); PG8_BAR;
            PG8_LDB(B0, 1, 0); PG8_SCHED; PG8_LDA(At, 1, 0); PG8_STAGE_A(PG8_SA(0, 1), a2, 1, sA);
            PG8_WAIT_L(8); PG8_BAR; PG8_WAIT_L(0); PG8_MMA(0, 0, At, B0); PG8_BAR; PG8_SCHED;
            PG8_LDB(B1, 1, 1); PG8_STAGE_B(PG8_SB(1, 0), b3, voffB);
            PG8_BAR; PG8_WAIT_L(0); PG8_MMA(0, 1, At, B1); PG8_BAR;
            PG8_LDA(At, 1, 1); PG8_STAGE_A(PG8_SA(1, 0), a3, 0, sA);
            PG8_BAR; PG8_WAIT_L(0); PG8_MMA(1, 0, At, B0); PG8_BAR; PG8_SCHED;
            PG8_STAGE_B(PG8_SB(1, 1), b3 + hstepB, voffB);
            PG8_WAIT_V(6); PG8_BAR; PG8_MMA(1, 1, At, B1); PG8_BAR;
            }
        }
        if constexpr (ALIGN_EPI) { if (wr == 0) PG8_BAR; }
        if constexpr (!Epi::AFTER_DRAIN) { E(acc, cur, wr, wc, fr, fq); S.done(cur); }
        if (!has_next) break;
#pragma unroll
        for (int a = 0; a < 2; ++a)
#pragma unroll
            for (int b = 0; b < 2; ++b)
#pragma unroll
                for (int m = 0; m < 4; ++m)
#pragma unroll
                    for (int n = 0; n < 2; ++n) acc[a][b][m][n] = (f32x4){0.f, 0.f, 0.f, 0.f};
        cur = nxt; cA = nA; cB = nB; ++ui;
        if constexpr (VR) { const int vr_ = S.valid_rows(cur); mma_on0 = wr * 64 < vr_; mma_on1 = HALF + wr * 64 < vr_; }
        if constexpr (GA) {
#pragma unroll
            for (int _h = 0; _h < 2; ++_h)
#pragma unroll
                for (int _i = 0; _i < 2; ++_i) vA[_h][_i] = nvA[_h][_i]; }
        if constexpr (ALIGN_EPI) { if (wr == 1) PG8_BAR; }
    }
    PG8_WAIT_V(0);
    if constexpr (!ALIGN_EPI) { if (wr == 0) PG8_BAR; }
    PG8_BAR;
    if constexpr (Epi::AFTER_DRAIN) { E.fused(acc, cur, wr, wc, fr, fq, lds, wid, lane); S.done(cur); }
#undef PG8_SA
#undef PG8_SB
#undef PG8_STAGE
#undef PG8_STAGE_B
#undef PG8_STAGE_A
#undef PG8_GA_OFFS
#undef PG8_LDA
#undef PG8_LDB
#undef PG8_MMA
#undef PG8_WAIT_V
#undef PG8_WAIT_L
#undef PG8_BAR
#undef PG8_SCHED
}
}

#ifndef PG8_SP2
#define PG8_SP2 true
#endif
#ifndef PG8_ALIGN
#define PG8_ALIGN true
#endif
#ifndef X1_BF16
#define X1_BF16 1
#endif
#ifndef TOPK_2BIT
#define TOPK_2BIT 0
#endif
#ifndef NT_STREAM
#define NT_STREAM 0
#endif
#ifndef X1_FP16
#define X1_FP16 1
#endif
#if X1_FP16
#define X1PK pkh2
#define X1UNPK h4_to_f32
#else
#define X1PK pk2
#define X1UNPK bf4_to_f32
#endif
#ifndef X2_FP16
#define X2_FP16 1
#endif
#ifndef CV_NT_STORE
#define CV_NT_STORE 1
#endif
#ifndef CV_ROLL
#define CV_ROLL 0
#endif
#ifndef CV_TKN
#define CV_TKN 6
#endif
#ifndef MK_N_LAUNCHES
#define MK_N_LAUNCHES 1
#endif
#ifndef PROBE
#define PROBE 0
#endif
#ifndef PROBE_Q
#define PROBE_Q 6.0f
#define PROBE_OFF 0.0f
#endif
#ifndef PROBE_A
#define PROBE_A 0
#define PROBE_B 0
#endif
#ifndef REPEAT_PH
#define REPEAT_PH (-1)
#define REPEAT_N 2
#endif
#ifndef ATT_W
#define ATT_W 8
#endif
#ifndef DUMMY_VARIANT
#define DUMMY_VARIANT 0
#endif
#ifndef CV_NF_MOE
#define CV_NF_MOE 4
#endif
#ifndef CV_KG1
#define CV_KG1 17
#define CV_KG2 17
#define CV_KG3 27
#define CV_KG4 27
#define CV_N4 950
#endif
#ifndef CV_N1
#define CV_N1 721
#define CV_N2 280
#define CV_N3 500
#endif
#ifndef GATHER_IN_GEMM
#define GATHER_IN_GEMM 1
#endif
#ifndef S5_FUSE_Z
#define S5_FUSE_Z 1
#endif
#ifndef ROW_CTX_COOP
#define ROW_CTX_COOP 1
#endif
#ifndef MOE_BAUX
#define MOE_BAUX 0
#endif
#ifndef CTX_COOP2
#define CTX_COOP2 0
#endif
#ifndef P1_COOP
#define P1_COOP 0
#endif
#ifndef S5_NAIVE
#define S5_NAIVE 0
#endif
#ifndef ATTN_NAIVE
#define ATTN_NAIVE 0
#endif
#ifndef NAIVE_GEMM
#define NAIVE_GEMM 0
#endif

constexpr int D = 2048, SEQ = 4096, CTXL = 256, NLAT = 8192, NCTX = 512, NROWS = 8704;
constexpr int NH = 16, HD = 128, NE = 16, NG = 128, NP = 64, GH = 16, D6 = 6 * D;
constexpr int RPE = 1280;
constexpr float LN_EPS = 1e-5f, ALPHA = 1.4142135623730951f;
constexpr int NWAVES = 8, NTHREADS = 512;
constexpr int LDS_BYTES = 147456, MISC_OFF = LDS_BYTES - 128;

constexpr size_t MiB = 1u << 20;
constexpr size_t WS_CTL = 0, CTL_ZERO_BYTES = 1 * MiB;
constexpr size_t WS_MODS = 1 * MiB;
constexpr size_t WS_SPAR = 2 * MiB;
constexpr size_t WS_AFF = 6 * MiB;
constexpr size_t WS_SLOT = 7 * MiB;
constexpr size_t WS_IDX = 8 * MiB;
constexpr size_t WS_GATE = 8 * MiB + 512 * 1024;
constexpr int T_WQKV = 16, T_WO = 40, T_WVG = 48, T_MOE1 = 64, T_MOE2 = 576, T_HB = 832, T_QK = 866, T_VT = 934, T_AO = 968, T_XE = 1002, T_ACT = 1082, T_Z = 1162;
constexpr size_t WS_O = 1194 * MiB, WS_X1 = 1262 * MiB, WS_X2 = 1330 * MiB, WS_YE = 1398 * MiB, WS_YF = 1558 * MiB, WS_YB = 1622 * MiB, WS_XLOC = 1686 * MiB, WS_CARRY = 1718 * MiB, WS_END = 1750 * MiB;
constexpr int CW_BAR = 4096;
constexpr int CV_NIT_ALL = (6 + 2 * NE * 3) * 2048, CV_TK = 256 * NWAVES * CV_TKN;

#define GAS __attribute__((address_space(1)))
#define LAS __attribute__((address_space(3)))
typedef unsigned short bf16;
typedef unsigned v4u __attribute__((ext_vector_type(4)));
typedef unsigned v2u __attribute__((ext_vector_type(2)));
typedef float f32x4 __attribute__((ext_vector_type(4)));
typedef float f32x2 __attribute__((ext_vector_type(2)));
typedef short bf16x8 __attribute__((ext_vector_type(8)));
typedef GAS unsigned gu32;
#define RLX_AGENT __ATOMIC_RELAXED, __HIP_MEMORY_SCOPE_AGENT

__device__ __forceinline__ float bf2f(unsigned b) { return __uint_as_float(b << 16); }
__device__ __forceinline__ unsigned pk2(float lo, float hi) { typedef __bf16 bf2_t __attribute__((ext_vector_type(2))); f32x2 v = {lo, hi}; return __builtin_bit_cast(unsigned, __builtin_convertvector(v, bf2_t)); }
__device__ __forceinline__ unsigned pkh2(float lo, float hi) { typedef _Float16 h2_t __attribute__((ext_vector_type(2))); f32x2 v = {lo, hi}; return __builtin_bit_cast(unsigned, __builtin_convertvector(v, h2_t)); }
__device__ __forceinline__ f32x4 h4_to_f32(v2u w) { typedef _Float16 h4_t __attribute__((ext_vector_type(4))); return __builtin_convertvector(__builtin_bit_cast(h4_t, w), f32x4); }
template <int CTRL> __device__ __forceinline__ float dpp_f(float x) { return __builtin_bit_cast(float, __builtin_amdgcn_mov_dpp(__builtin_bit_cast(int, x), CTRL, 0xf, 0xf, true)); }
__device__ __forceinline__ float wave_sum(float v) {
    v += dpp_f<0xB1>(v);
    v += dpp_f<0x4E>(v);
    v += dpp_f<0x141>(v);
    v += dpp_f<0x140>(v);
    const float a = __builtin_bit_cast(float, __builtin_amdgcn_readlane(__builtin_bit_cast(int, v), 0)), b = __builtin_bit_cast(float, __builtin_amdgcn_readlane(__builtin_bit_cast(int, v), 16));
    const float c = __builtin_bit_cast(float, __builtin_amdgcn_readlane(__builtin_bit_cast(int, v), 32)), d = __builtin_bit_cast(float, __builtin_amdgcn_readlane(__builtin_bit_cast(int, v), 48));
    return (a + b) + (c + d);
}
__device__ __forceinline__ float wave_max(float v) {
#pragma unroll
    for (int o = 1; o < 64; o <<= 1) v = fmaxf(v, __shfl_xor(v, o));
    return v;
}
__device__ __forceinline__ float silu_f(float x) { return x * __builtin_amdgcn_rcpf(1.0f + __builtin_amdgcn_exp2f(-1.4426950409f * x)); }
__device__ __forceinline__ float sigmoid_f(float x) { return __builtin_amdgcn_rcpf(1.0f + __builtin_amdgcn_exp2f(-1.4426950409f * x)); }
__device__ __forceinline__ float gelu_tanh_f(float x) { const float e = __builtin_amdgcn_exp2f(x * (-2.302208198f - 0.1029432397f * x * x)); return x * __builtin_amdgcn_rcpf(1.0f + e); }
#define XB_TMO      128
#define XB_XCNT(j)  (256  + 64 * (j))
#define XB_XSUB(j)  (1280 + 64 * (j))
#define XB_XGEN(j)  (2304 + 64 * (j))
#define XB_TOP      3328
#define XB_TOPGEN   3392
#define XCD_BAR_WORDS 3456
#define XB_SPIN_CAP (1u << 18)

__device__ __forceinline__ unsigned xb_ld(unsigned* p)              { return __hip_atomic_load(p, __ATOMIC_RELAXED, __HIP_MEMORY_SCOPE_AGENT); }
__device__ __forceinline__ unsigned xb_add(unsigned* p, unsigned v) { return __hip_atomic_fetch_add(p, v, __ATOMIC_RELAXED, __HIP_MEMORY_SCOPE_AGENT); }
__device__ __forceinline__ unsigned xb_xcc_id() { return (unsigned)__builtin_amdgcn_s_getreg((3 << 11) | 20) & 0xFu; }
#define XB_SPIN(cond, bar) do { unsigned _sp = 0; while (cond) { __builtin_amdgcn_s_sleep(1); \
    if ((++_sp & 255u) == 0u) { if (xb_ld(&(bar)[XB_TMO])) break; if (_sp > XB_SPIN_CAP) { atomicAdd(&(bar)[XB_TMO], 1u); break; } } } } while (0)

struct XcdBarrier {
    unsigned* bar; unsigned x;
    volatile LAS unsigned* st;
};

__device__ __forceinline__ XcdBarrier xcd_barrier_post(unsigned* bar, volatile LAS unsigned* st) {
    XcdBarrier b; b.bar = bar; b.x = xb_xcc_id(); b.st = st;
    if (threadIdx.x == 0) (void)xb_add(&bar[XB_XCNT(b.x)], 1u);
    return b;
}
__device__ __forceinline__ void xcd_barrier_complete(unsigned* bar, unsigned x, unsigned& nloc, unsigned& nx) {
    const unsigned G = gridDim.x * gridDim.y * gridDim.z;
    unsigned sum, cnt, mine, sp = 0u;
    for (;;) {
        sum = 0u; cnt = 0u; mine = 0u;
#pragma unroll
        for (unsigned j = 0; j < 16; ++j) { const unsigned c = xb_ld(&bar[XB_XCNT(j)]); sum += c; cnt += (c > 0u) ? 1u : 0u; mine = (j == x) ? c : mine; }
        if (sum == G) break;
        __builtin_amdgcn_s_sleep(1);
        if ((++sp & 255u) == 0u) { if (xb_ld(&bar[XB_TMO])) break; if (sp > XB_SPIN_CAP) { atomicAdd(&bar[XB_TMO], 1u); break; } }
    }
    nloc = mine > 0u ? mine : 1u; nx = cnt > 0u ? cnt : 1u;
}

__device__ __forceinline__ void xcd_barrier(const XcdBarrier& b) {
    asm volatile("s_waitcnt vmcnt(0)" ::: "memory");
    __syncthreads();
    if (threadIdx.x == 0) {
        unsigned* bar = b.bar;
        __builtin_amdgcn_s_waitcnt(0);
        unsigned nloc = b.st[0], nx = b.st[1];
        if (nloc == 0u) { xcd_barrier_complete(bar, b.x, nloc, nx); b.st[0] = nloc; b.st[1] = nx; }
        const unsigned old = xb_add(&bar[XB_XSUB(b.x)], 1u);
        const unsigned gen = old / nloc;
        if (old + 1u == (gen + 1u) * nloc) {
            __builtin_amdgcn_fence(__ATOMIC_RELEASE, "agent");
            asm volatile("s_waitcnt vmcnt(0)" ::: "memory");
            const unsigned og = xb_add(&bar[XB_TOP], 1u);
            const unsigned tg = og / nx;
            if (og + 1u == (tg + 1u) * nx) xb_add(&bar[XB_TOPGEN], 1u);
            else XB_SPIN(xb_ld(&bar[XB_TOPGEN]) == tg, bar);
            __builtin_amdgcn_fence(__ATOMIC_ACQUIRE, "agent");
            xb_add(&bar[XB_XGEN(b.x)], 1u);
            asm volatile("s_waitcnt vmcnt(0)" ::: "memory");
        } else {
            XB_SPIN(xb_ld(&bar[XB_XGEN(b.x)]) == gen, bar);
            __builtin_amdgcn_fence(__ATOMIC_ACQUIRE, "agent");
            asm volatile("s_waitcnt vmcnt(0)" ::: "memory");
        }
    }
    __syncthreads();
}

struct Args { const float* in[25]; float* out; unsigned char* ws; int ph_lo, ph_hi; };
#define CAS __attribute__((address_space(4)))
struct Frame {
    LAS unsigned char* lds;
    GAS unsigned char* ws;
    int tid, lane, wave, vcu, G;
    const CAS Args* ap;
    GAS float* out;
};
__device__ __forceinline__ const GAS float* fin(const Frame& F, int i) { return (const GAS float*)F.ap->in[i]; }
enum { I_X = 0, I_C, I_CTX, I_CCTX, I_WMOD, I_BMOD, I_LNG, I_LNB, I_WQKV, I_WO, I_RPB, I_LAMRE, I_LAMIM, I_LOGSTEP, I_BRE, I_BIM, I_CRE, I_CIM, I_SD, I_WVAL, I_WGATE, I_ROUTER, I_MGATE, I_MUP, I_MDOWN };

__device__ __forceinline__ GAS bf16* ws_tile(const Frame& F, int t) { return (GAS bf16*)(F.ws + (size_t)t * MiB); }
__device__ __forceinline__ GAS float* ws_f32(const Frame& F, size_t off) { return (GAS float*)(F.ws + off); }
__device__ __forceinline__ const GAS float* mods(const Frame& F, int l, int r, int which) { return (const GAS float*)(F.ws + WS_MODS) + (size_t)((l * 3 + r) * 6 + which) * D; }
__device__ __forceinline__ int row_r(int row) { return row < NLAT ? (row >> 12) : 2; }

struct SegSched {
    int G, cx, n0, ntot, nM0, nN0, pm0, pn0, nM1, nN1, pm1, pn1;
    __device__ __forceinline__ void init(int G_, int cx_, int nM0_, int nN0_, int pm0_, int pn0_, int nM1_, int nN1_, int pm1_, int pn1_) {
        G = G_; cx = cx_; nM0 = nM0_; nN0 = nN0_; pm0 = pm0_; pn0 = pn0_; nM1 = nM1_; nN1 = nN1_; pm1 = pm1_; pn1 = pn1_; n0 = nM0 * nN0; ntot = n0 + nM1 * nN1; }
    __device__ __forceinline__ bool next(int i, pg8::Unit& u) const {
        const int U = i * G + cx; if (U >= ntot) return false;
        const bool s1 = U >= n0; const int loc = s1 ? U - n0 : U, nM = s1 ? nM1 : nM0, nN = s1 ? nN1 : nN0;
        const int nig = 8 * nN, gid = loc / nig, fm = gid * 8, gsz = (nM - fm) < 8 ? (nM - fm) : 8;
        u.pm = (s1 ? pm1 : pm0) + fm + ((loc % nig) % gsz); u.pn = (s1 ? pn1 : pn0) + (loc % nig) / gsz; return true;
    }
    __device__ __forceinline__ void a_ready(const pg8::Unit&) const {}
    __device__ __forceinline__ void done(const pg8::Unit&) const {}
};
struct MoeSched {
    int G, cx, nMe, nNe, pmA, pnB, ntot;
    const GAS int* ga_idx; unsigned ga_nrows;
    __device__ __forceinline__ int ga_row0(const pg8::Unit& u) const { return (u.pm - pmA) * 256; }
    __device__ __forceinline__ int valid_rows(const pg8::Unit& u) const { return (nMe == 5 && (u.pm - pmA) % 5 == 4) ? 64 : 256; }
    __device__ __forceinline__ void init(int G_, int cx_, int nMe_, int nNe_, int pmA_, int pnB_) { G = G_; cx = cx_; nMe = nMe_; nNe = nNe_; pmA = pmA_; pnB = pnB_; ntot = NE * nMe * nNe; }
    __device__ __forceinline__ bool next(int i, pg8::Unit& u) const {
        const int U = i * G + cx; if (U >= ntot) return false;
        const int per = nMe * nNe, e = U / per, loc = U % per;
        u.pm = pmA + e * 5 + loc % nMe; u.pn = pnB + e * nNe + loc / nMe; return true;
    }
    __device__ __forceinline__ void a_ready(const pg8::Unit&) const {}
    __device__ __forceinline__ void done(const pg8::Unit&) const {}
};

struct EpiQKV {
    static constexpr bool PERM = true, AFTER_DRAIN = false;
    GAS bf16* QK; GAS bf16* VT;
    __device__ __forceinline__ void operator()(const f32x4 (&acc)[2][2][4][2], const pg8::Unit& u, int wr, int wc, int fr_in, int fq_in) const {
        int fr = fr_in, fq = fq_in; asm volatile("" : "+v"(fr), "+v"(fq));
        GAS bf16* base; int ldc;
        if (u.pn < T_HB) { base = QK + (size_t)(u.pm - T_HB) * 256 * 4096 + (size_t)(u.pn - T_WQKV) * 256; ldc = 4096; }
        else { base = VT + (size_t)(u.pm - (T_WQKV + 16)) * 256 * NROWS + (size_t)(u.pn - T_HB) * 256; ldc = NROWS; }
        int cofs[2];
#pragma unroll
        for (int bj = 0; bj < 2; ++bj) { int c = wc * 32 + 8 * fq + bj * 128;
            if (u.pn >= T_HB) { const int tok = (u.pn - T_HB) * 256 + c; if (tok < NLAT) { const int t = tok & 4095; c += (((t & 63) >> 3) << 9 | (t >> 6) << 3) - t; } }
            cofs[bj] = c; }
#pragma unroll
        for (int ai = 0; ai < 2; ++ai)
#pragma unroll
            for (int m = 0; m < 4; ++m) { GAS bf16* rowp = base + (size_t)(ai * 128 + wr * 64 + m * 16 + fr) * ldc;
#pragma unroll
                for (int bj = 0; bj < 2; ++bj) { const f32x4 v0 = acc[ai][bj][m][0], v1 = acc[ai][bj][m][1];
                    v4u w; w.x = pk2(v0[0], v0[1]); w.y = pk2(v0[2], v0[3]); w.z = pk2(v1[0], v1[1]); w.w = pk2(v1[2], v1[3]);
                    *(GAS v4u*)(rowp + cofs[bj]) = w; } }
    }
};
struct EpiWo {
    static constexpr bool PERM = true, AFTER_DRAIN = false;
    GAS bf16* O;
    __device__ __forceinline__ void operator()(const f32x4 (&acc)[2][2][4][2], const pg8::Unit& u, int wr, int wc, int fr_in, int fq_in) const {
        int fr = fr_in, fq = fq_in; asm volatile("" : "+v"(fr), "+v"(fq));
        GAS bf16* base = O + (size_t)(u.pm - T_AO) * 256 * D + (size_t)(u.pn - T_WO) * 256;
#pragma unroll
        for (int ai = 0; ai < 2; ++ai)
#pragma unroll
            for (int m = 0; m < 4; ++m) { GAS bf16* rowp = base + (size_t)(ai * 128 + wr * 64 + m * 16 + fr) * D + wc * 32 + 8 * fq;
#pragma unroll
                for (int bj = 0; bj < 2; ++bj) { const f32x4 v0 = acc[ai][bj][m][0], v1 = acc[ai][bj][m][1];
                    v4u w; w.x = pk2(v0[0], v0[1]); w.y = pk2(v0[2], v0[3]); w.z = pk2(v1[0], v1[1]); w.w = pk2(v1[2], v1[3]);
                    *(GAS v4u*)(rowp + bj * 128) = w; } }
    }
};
struct EpiGlu {
    static constexpr bool PERM = true, AFTER_DRAIN = false;
    GAS bf16* O;
    __device__ __forceinline__ void operator()(const f32x4 (&acc)[2][2][4][2], const pg8::Unit& u, int wr, int wc, int fr_in, int fq_in) const {
        int fr = fr_in, fq = fq_in; asm volatile("" : "+v"(fr), "+v"(fq));
        GAS bf16* base = O + (size_t)(u.pm - T_Z) * 256 * D + (size_t)(u.pn - T_WVG) * 128;
#pragma unroll
        for (int ai = 0; ai < 2; ++ai)
#pragma unroll
            for (int m = 0; m < 4; ++m) { GAS bf16* rowp = base + (size_t)(ai * 128 + wr * 64 + m * 16 + fr) * D + wc * 32 + 8 * fq;
                f32x4 o0, o1;
#pragma unroll
                for (int q = 0; q < 4; ++q) { o0[q] = acc[ai][0][m][0][q] * sigmoid_f(acc[ai][1][m][0][q]); o1[q] = acc[ai][0][m][1][q] * sigmoid_f(acc[ai][1][m][1][q]); }
                v4u w; w.x = pk2(o0[0], o0[1]); w.y = pk2(o0[2], o0[3]); w.z = pk2(o1[0], o1[1]); w.w = pk2(o1[2], o1[3]);
                *(GAS v4u*)rowp = w; }
    }
};
struct EpiSwiglu {
    static constexpr bool PERM = true, AFTER_DRAIN = false;
    GAS bf16* ACT; int pnB;
    __device__ __forceinline__ void operator()(const f32x4 (&acc)[2][2][4][2], const pg8::Unit& u, int wr, int wc, int fr_in, int fq_in) const {
        int fr = fr_in, fq = fq_in; asm volatile("" : "+v"(fr), "+v"(fq));
        const int j = (u.pn - pnB) & 15;
        GAS bf16* base = ACT + (size_t)(u.pm - T_XE) * 256 * D + (size_t)j * 128;
#pragma unroll
        for (int ai = 0; ai < 2; ++ai)
#pragma unroll
            for (int m = 0; m < 4; ++m) { GAS bf16* rowp = base + (size_t)(ai * 128 + wr * 64 + m * 16 + fr) * D + wc * 32 + 8 * fq;
                f32x4 o0, o1;
#pragma unroll
                for (int q = 0; q < 4; ++q) { o0[q] = silu_f(acc[ai][0][m][0][q]) * acc[ai][1][m][0][q]; o1[q] = silu_f(acc[ai][0][m][1][q]) * acc[ai][1][m][1][q]; }
                v4u w; w.x = pk2(o0[0], o0[1]); w.y = pk2(o0[2], o0[3]); w.z = pk2(o1[0], o1[1]); w.w = pk2(o1[2], o1[3]);
                *(GAS v4u*)rowp = w; }
    }
};
struct EpiDown {
    static constexpr bool PERM = true, AFTER_DRAIN = false;
    GAS bf16* YE; const GAS float* GATE; int pnB;
    __device__ __forceinline__ void operator()(const f32x4 (&acc)[2][2][4][2], const pg8::Unit& u, int wr, int wc, int fr_in, int fq_in) const {
        int fr = fr_in, fq = fq_in; asm volatile("" : "+v"(fr), "+v"(fq));
        const int j = (u.pn - pnB) & 7; const int rt = (u.pm - T_ACT) * 256;
        GAS bf16* base = YE + (size_t)rt * D + (size_t)j * 256;
#pragma unroll
        for (int ai = 0; ai < 2; ++ai)
#pragma unroll
            for (int m = 0; m < 4; ++m) { const int r = ai * 128 + wr * 64 + m * 16 + fr; const float gt = GATE[rt + r]; GAS bf16* rowp = base + (size_t)r * D + wc * 32 + 8 * fq;
#pragma unroll
                for (int bj = 0; bj < 2; ++bj) { const f32x4 v0 = acc[ai][bj][m][0] * gt, v1 = acc[ai][bj][m][1] * gt;
                    v4u w; w.x = pk2(v0[0], v0[1]); w.y = pk2(v0[2], v0[3]); w.z = pk2(v1[0], v1[1]); w.w = pk2(v1[2], v1[3]);
                    *(GAS v4u*)(rowp + bj * 128) = w; } }
    }
};

__device__ __forceinline__ float dot_bf16(const GAS bf16* a, const GAS bf16* b, int K) {
    float s = 0.f;
    for (int k = 0; k < K; k += 8) { const v4u x = *(const GAS v4u*)(a + k), y = *(const GAS v4u*)(b + k);
#pragma unroll
        for (int q = 0; q < 4; ++q) { s += bf2f(x[q] & 0xffffu) * bf2f(y[q] & 0xffffu); s += bf2f(x[q] >> 16) * bf2f(y[q] >> 16); } }
    return s;
}
template <class Epi, class Sched>
__device__ __forceinline__ void naive_gemm_phase(const pg8::Gemm g, const Sched& S, const Epi& E, int tid_in) {
    const int tid = tid_in, wid = __builtin_amdgcn_readfirstlane(tid >> 6), lane = tid & 63, wr = wid >> 2, wc = wid & 3, fr = lane & 15, fq = lane >> 4;
    pg8::Unit u;
    for (int i = 0; S.next(i, u); ++i) {
        f32x4 acc[2][2][4][2];
        const GAS bf16* A = (const GAS bf16*)g.A + (size_t)u.pm * 256 * g.K; const GAS bf16* B = (const GAS bf16*)g.Bt + (size_t)u.pn * 256 * g.K;
#pragma unroll
        for (int ai = 0; ai < 2; ++ai)
#pragma unroll
            for (int m = 0; m < 4; ++m) { const GAS bf16* ar = A + (size_t)(ai * 128 + wr * 64 + m * 16 + fr) * g.K;
#pragma unroll
                for (int bj = 0; bj < 2; ++bj)
#pragma unroll
                    for (int n = 0; n < 2; ++n)
#pragma unroll
                        for (int j = 0; j < 4; ++j) { const int c = Epi::PERM ? (bj * 128 + wc * 32 + 8 * fq + 4 * n + j) : (bj * 128 + wc * 32 + 16 * n + 4 * fq + j);
                            acc[ai][bj][m][n][j] = dot_bf16(ar, B + (size_t)c * g.K, g.K); } }
        E(acc, u, wr, wc, fr, fq);
    }
}
template <class Epi, class Sched>
__device__ __forceinline__ void run_gemm_ga(Frame& F, const Sched& S, const Epi& E, int tA) {
    const pg8::Gemm g{(const pg8::bf16_t*)(const unsigned char*)(F.ws + (size_t)tA * MiB), (const pg8::bf16_t*)(const unsigned char*)F.ws, 0, 0, D};
    pg8::gemm_phase<Epi, Sched, PG8_ALIGN, PG8_SP2, true, false, MOE_BAUX, WT_BKM != 0>((PG8_LAS unsigned char*)F.lds, g, S, E, F.tid);
}
template <class Epi, class Sched, bool VR = false, int BAUX = 0, bool BKM = (WT_BKM != 0)>
__device__ __forceinline__ void run_gemm(Frame& F, const Sched& S, const Epi& E) {
    const pg8::Gemm g{(const pg8::bf16_t*)(const unsigned char*)F.ws, (const pg8::bf16_t*)(const unsigned char*)F.ws, 0, 0, D};
#if NAIVE_GEMM
    naive_gemm_phase<Epi, Sched>(g, S, E, F.tid);
#else
    pg8::gemm_phase<Epi, Sched, PG8_ALIGN, PG8_SP2, false, VR, BAUX, BKM>((PG8_LAS unsigned char*)F.lds, g, S, E, F.tid);
#endif
}

#define LDV(p, j) (*(const GAS f32x4*)((p) + 4 * F.lane + 256 * (j)))
__device__ __forceinline__ f32x4 bf4_to_f32(v2u w) { return (f32x4){bf2f(w.x & 0xffffu), bf2f(w.x >> 16), bf2f(w.y & 0xffffu), bf2f(w.y >> 16)}; }
#define LDVB(p, j) bf4_to_f32(*(const GAS v2u*)((p) + 4 * F.lane + 256 * (j)))
#define LDVL(p, j) (*(const LAS f32x4*)((p) + 4 * F.lane + 256 * (j)))
__device__ __forceinline__ void stage_vec(const Frame& F, LAS float* dst, const GAS float* src) {
    *(LAS f32x4*)(dst + 4 * F.tid) = *(const GAS f32x4*)(src + 4 * F.tid);
}
__device__ __forceinline__ void ln_rows_lds(f32x4 (&v)[8], const LAS float* g, const LAS float* bb, const Frame& F) {
    float s = 0.f;
#pragma unroll
    for (int j = 0; j < 8; ++j) s += (v[j][0] + v[j][1]) + (v[j][2] + v[j][3]);
    const float mean = wave_sum(s) * (1.0f / D); float s2 = 0.f;
#pragma unroll
    for (int j = 0; j < 8; ++j) { v[j] = v[j] - mean; s2 += (v[j][0] * v[j][0] + v[j][1] * v[j][1]) + (v[j][2] * v[j][2] + v[j][3] * v[j][3]); }
    const float rstd = 1.0f / sqrtf(wave_sum(s2) * (1.0f / D) + LN_EPS);
#pragma unroll
    for (int j = 0; j < 8; ++j) v[j] = v[j] * rstd * LDVL(g, j) + LDVL(bb, j);
}

__device__ __forceinline__ void p0_mods(Frame& F) {
    LAS float* S = (LAS float*)F.lds;
    LAS float* P = S + 3 * D;
    const GAS float* c = fin(F, I_C); const GAS float* cctx = fin(F, I_CCTX);
    for (int i = F.tid; i < 3 * D; i += NTHREADS) { const int r = i / D, k = i % D; const float cv = (r < 2) ? c[r * D + k] : cctx[k]; S[i] = cv / (1.0f + expf(-cv)); }
    __syncthreads();
    const int tl = F.tid & 7, kg = F.tid >> 3;
    GAS float* M = (GAS float*)(F.ws + WS_MODS);
    for (int it = blockIdx.x; it < 2 * 384; it += F.G) {
        const int l = it / 384, cc = it % 384;
        const GAS float* w = fin(F, I_WMOD) + (size_t)l * D * D6 + cc * 32 + tl * 4;
        f32x4 a0 = {0.f, 0.f, 0.f, 0.f}, a1 = a0, a2 = a0;
#pragma unroll 8
        for (int kk = 0; kk < 32; ++kk) { const int k = kg * 32 + kk; const f32x4 wv = *(const GAS f32x4*)(w + (size_t)k * D6); a0 += wv * S[k]; a1 += wv * S[D + k]; a2 += wv * S[2 * D + k]; }
#pragma unroll
        for (int j = 0; j < 4; ++j) { P[(kg * 3 + 0) * 32 + tl * 4 + j] = a0[j]; P[(kg * 3 + 1) * 32 + tl * 4 + j] = a1[j]; P[(kg * 3 + 2) * 32 + tl * 4 + j] = a2[j]; }
        __syncthreads();
        if (F.tid < 96) { const int r = F.tid >> 5, col = F.tid & 31; float s = 0.f;
            for (int q = 0; q < 64; ++q) s += P[(q * 3 + r) * 32 + col];
            M[(size_t)(l * 3 + r) * D6 + cc * 32 + col] = s + fin(F, I_BMOD)[l * D6 + cc * 32 + col]; }
        __syncthreads();
    }
}
__device__ __forceinline__ void p0_s5params(Frame& F) {
    GAS float* AR = (GAS float*)(F.ws + WS_SPAR); GAS float* AI = AR + 2 * NG * NP; GAS float* BB = AI + 2 * NG * NP;
    for (int idx = blockIdx.x * NTHREADS + F.tid; idx < 2 * NG * NP; idx += F.G * NTHREADS) {
        const int dg = idx / NP;
        const double lr = (double)fminf(fin(F, I_LAMRE)[idx], -1e-4f), li = (double)fin(F, I_LAMIM)[idx], dt = exp((double)fin(F, I_LOGSTEP)[dg]);
        const double mag = exp(lr * dt); double sn, cs; sincos(li * dt, &sn, &cs);
        const double ar = mag * cs, ai = mag * sn, nr = ar - 1.0, den = lr * lr + li * li, cr = (nr * lr + ai * li) / den, ci = (ai * lr - nr * li) / den;
        AR[idx] = (float)ar; AI[idx] = (float)ai;
        for (int h = 0; h < GH; ++h) { const double bre = fin(F, I_BRE)[(size_t)idx * GH + h], bim = fin(F, I_BIM)[(size_t)idx * GH + h];
            BB[(size_t)idx * 32 + h] = (float)(cr * bre - ci * bim); BB[(size_t)idx * 32 + 16 + h] = (float)(cr * bim + ci * bre); }
    }
}
__device__ __forceinline__ void p0_item_load(const GAS float* W, int ldw, int k0, int lane, f32x4 (&v)[8]) {
    const GAS float* p = W + (size_t)((k0 & ~1) + 8 * (lane >> 3)) * ldw + 4 * (lane & 7);
#pragma unroll
    for (int i = 0; i < 8; ++i) v[i] = __builtin_nontemporal_load((const GAS f32x4*)(p + (size_t)i * ldw));
}
__device__ __forceinline__ void p0_item_store(GAS bf16* WT, int dst_row0, int k0, int lane, const f32x4 (&v)[8]) {
    const int g0 = dst_row0 + 4 * (lane & 7), kq = k0 & ~1; const bool bkm = (k0 & 1) != 0;
    GAS bf16* o = bkm ? WT + (size_t)(g0 >> 8) * (256 * D) + (size_t)(kq >> 6) * (256 * 64) + (g0 & 255) * 64 + 8 * (lane >> 3) : WT + (size_t)g0 * D + kq + 8 * (lane >> 3);
    const int RS = bkm ? 64 : D;
#pragma unroll
    for (int j = 0; j < 4; ++j) { v4u w; w.x = pk2(v[0][j], v[1][j]); w.y = pk2(v[2][j], v[3][j]); w.z = pk2(v[4][j], v[5][j]); w.w = pk2(v[6][j], v[7][j]);
#if CV_NT_STORE
        __builtin_nontemporal_store(w, (GAS v4u*)(o + (size_t)j * RS));
#else
        *(GAS v4u*)(o + (size_t)j * RS) = w;
#endif
    }
}
__device__ __forceinline__ void p0_decode(const Frame& F, int it, const GAS float*& src, int& ldw, GAS bf16*& dst, int& dr0, int& k0) {
    const int sq = it >> 11, r = it & 2047, kb = r >> 6, nb = r & 63, n0 = nb * 32;
    int mode = 0, off = 0; ldw = D;
    if (sq < 3) { src = fin(F, I_WQKV) + sq * D; ldw = 3 * D; dst = ws_tile(F, T_WQKV) + (size_t)sq * D * D; }
    else if (sq == 3) { src = fin(F, I_WO); dst = ws_tile(F, T_WO); }
    else if (sq == 4) { src = fin(F, I_WVAL); dst = ws_tile(F, T_WVG); mode = 1; }
    else if (sq == 5) { src = fin(F, I_WGATE); dst = ws_tile(F, T_WVG); mode = 1; off = 128; }
    else { const int mm = sq - 6, l = mm / 48, e = (mm % 48) / 3, t = mm % 3; const size_t wofs = (size_t)(l * NE + e) * D * D;
        if (t == 0) { src = fin(F, I_MGATE) + wofs; dst = ws_tile(F, T_MOE1 + l * 256) + (size_t)e * 4096 * D; mode = 1; }
        else if (t == 1) { src = fin(F, I_MUP) + wofs; dst = ws_tile(F, T_MOE1 + l * 256) + (size_t)e * 4096 * D; mode = 1; off = 128; }
        else { src = fin(F, I_MDOWN) + wofs; dst = ws_tile(F, T_MOE2 + l * 128) + (size_t)e * 2048 * D; } }
    src += n0; dr0 = mode ? ((n0 >> 7) * 256 + (n0 & 127) + off) : n0; k0 = kb * 64 + ((WT_BKM && sq >= 3) ? 1 : 0);
}
template <int NF>
__device__ __forceinline__ void p0_weights_n(Frame& F, int it0, int NIT, int gw, int NGW) {
    for (int it = it0 + gw; it < NIT; it += NF * NGW) {
        const GAS float* sp[NF]; int lw[NF], dr[NF], kk[NF]; GAS bf16* op[NF]; f32x4 v[NF][8]; bool ok[NF];
#pragma unroll
        for (int q = 0; q < NF; ++q) { ok[q] = it + q * NGW < NIT; if (ok[q]) { p0_decode(F, it + q * NGW, sp[q], lw[q], op[q], dr[q], kk[q]); p0_item_load(sp[q], lw[q], kk[q], F.lane, v[q]); } }
#pragma unroll
        for (int q = 0; q < NF; ++q) if (ok[q]) p0_item_store(op[q], dr[q], kk[q], F.lane, v[q]);
    }
}
__device__ __forceinline__ void p0_weights(Frame& F, int it0, int NIT, int gw, int NGW) {
#if CV_ROLL
    int it = it0 + gw; if (it >= NIT) return;
    const GAS float* s0; const GAS float* s1; int l0, l1, d0, d1, k0, k1; GAS bf16* o0; GAS bf16* o1; f32x4 va[8], vb[8];
    p0_decode(F, it, s0, l0, o0, d0, k0); p0_item_load(s0, l0, k0, F.lane, va);
    for (;;) {
        const bool hb = it + NGW < NIT;
        if (hb) { p0_decode(F, it + NGW, s1, l1, o1, d1, k1); p0_item_load(s1, l1, k1, F.lane, vb); }
        p0_item_store(o0, d0, k0, F.lane, va);
        if (!hb) break;
        const bool ha = it + 2 * NGW < NIT;
        if (ha) { p0_decode(F, it + 2 * NGW, s0, l0, o0, d0, k0); p0_item_load(s0, l0, k0, F.lane, va); }
        p0_item_store(o1, d1, k1, F.lane, vb);
        if (!ha) break;
        it += 2 * NGW;
    }
#else
    for (int it = it0 + gw; it < NIT; it += 2 * NGW) {
        const GAS float* s0; const GAS float* s1; int l0, l1, d0, d1, k0, k1; GAS bf16* o0; GAS bf16* o1; f32x4 va[8], vb[8];
        const bool two = it + NGW < NIT;
        p0_decode(F, it, s0, l0, o0, d0, k0); p0_item_load(s0, l0, k0, F.lane, va);
        if (two) { p0_decode(F, it + NGW, s1, l1, o1, d1, k1); p0_item_load(s1, l1, k1, F.lane, vb); }
        p0_item_store(o0, d0, k0, F.lane, va);
        if (two) p0_item_store(o1, d1, k1, F.lane, vb);
    }
#endif
}
__device__ __forceinline__ const GAS float* xin_row(Frame& F, int l, int row) {
    if (l == 0) return row < NLAT ? fin(F, I_X) + (size_t)row * D : fin(F, I_CTX) + (size_t)(row - NLAT) * D;
    return (const GAS float*)(F.ws + WS_X2) + (size_t)row * D;
}
#define XN_LOAD(dst, l_, row_) do { if (X2_FP16 && (l_)) { const GAS bf16* xh_ = (const GAS bf16*)(F.ws + WS_X2) + (size_t)(row_) * D; \
        _Pragma("unroll") for (int j = 0; j < 8; ++j) { const f32x2 t_ = *(const GAS f32x2*)(xh_ + 4 * F.lane + 256 * j); dst[j][0] = t_[0]; dst[j][1] = t_[1]; } } \
    else { const GAS float* xr_ = xin_row(F, l_, row_); _Pragma("unroll") for (int j = 0; j < 8; ++j) dst[j] = LDV(xr_, j); } } while (0)
__device__ __forceinline__ void p1_prep(Frame& F) {
    const int gw = F.vcu * NWAVES + F.wave, NGW = F.G * NWAVES;
    GAS bf16* HB = ws_tile(F, T_HB);
    LAS float* VL = (LAS float*)F.lds;
#pragma unroll
    for (int r = 0; r < 3; ++r) { stage_vec(F, VL + r * D, mods(F, 0, r, 0)); stage_vec(F, VL + (3 + r) * D, mods(F, 0, r, 1)); }
    f32x4 xn[8];
    if (gw < NROWS) { const GAS float* xr = xin_row(F, 0, gw);
#pragma unroll
        for (int j = 0; j < 8; ++j) xn[j] = LDV(xr, j); }
    __syncthreads();
    const int p1rows = P1_COOP ? NLAT : NROWS;
    for (int row = gw; row < p1rows; row += NGW) {
        const int r = row_r(row); const LAS float* sh = VL + r * D; const LAS float* sc = VL + (3 + r) * D;
        f32x4 h[8];
#pragma unroll
        for (int j = 0; j < 8; ++j) h[j] = xn[j] * (LDVL(sc, j) + 1.0f) + LDVL(sh, j);
        if (row + NGW < p1rows) { const GAS float* xr = xin_row(F, 0, row + NGW);
#pragma unroll
            for (int j = 0; j < 8; ++j) xn[j] = LDV(xr, j); }
#pragma unroll
        for (int j = 0; j < 8; ++j) { v2u w; w.x = pk2(h[j][0], h[j][1]); w.y = pk2(h[j][2], h[j][3]); *(GAS v2u*)(HB + (size_t)row * D + 4 * F.lane + 256 * j) = w; }
    }
#if P1_COOP
    for (int task = gw; task < 4 * NCTX; task += NGW) { const int row = NLAT + (task >> 2), qq = task & 3; const GAS float* xr = xin_row(F, 0, row);
        const LAS float* sh = VL + 2 * D; const LAS float* sc = VL + 5 * D;
#pragma unroll
        for (int jj = 0; jj < 2; ++jj) { const int j = 2 * qq + jj; const f32x4 h = LDV(xr, j) * (LDVL(sc, j) + 1.0f) + LDVL(sh, j);
            v2u w; w.x = pk2(h[0], h[1]); w.y = pk2(h[2], h[3]); *(GAS v2u*)(HB + (size_t)row * D + 4 * F.lane + 256 * j) = w; } }
#endif
}
__device__ __forceinline__ void p3_attn_naive(Frame& F) {
    const int gw = F.vcu * NWAVES + F.wave, NGW = F.G * NWAVES;
    LAS float* Pl = (LAS float*)(F.lds + F.wave * 4096);
    LAS int* Tl = (LAS int*)(F.lds + F.wave * 4096 + 2048);
    const GAS bf16* QK = ws_tile(F, T_QK); const GAS bf16* VT = ws_tile(F, T_VT); GAS bf16* AO = ws_tile(F, T_AO);
    const float scale = 0.08838834764831845f;
    for (int un = gw; un < NROWS * NH; un += NGW) {
        const int row = un >> 4, h = un & 15; const bool lat = row < NLAT;
        int b, r = 0, qc = 0, rs = 0, cst = 0;
        if (lat) { b = row >> 12; const int t = row & 4095; r = t >> 6; qc = t & 63; rs = min(max(r - 4, 0), 56); cst = min(max(qc - 8, 0), 48); } else b = (row - NLAT) >> 8;
        const int nk = lat ? 384 : 256;
        const GAS bf16* q = QK + (size_t)row * 4096 + h * HD;
        float sv[6]; float mx = -3.0e38f;
#pragma unroll
        for (int i = 0; i < 6; ++i) { const int kk = F.lane + 64 * i; float s = -3.0e38f;
            if (kk < nk) { int krow; float bias = 0.f;
                if (lat && kk < 128) { const int kr = rs + (kk >> 4), kc = cst + (kk & 15); krow = b * SEQ + kr * 64 + kc;
                    const int dc = min(max(kc - qc + 15, 0), 30); bias = fin(F, I_RPB)[(h * 15 + (kr - r + 7)) * 31 + dc]; }
                else krow = NLAT + b * CTXL + (lat ? kk - 128 : kk);
                s = dot_bf16(q, QK + (size_t)krow * 4096 + D + h * HD, HD) * scale + bias; Tl[kk] = krow; }
            sv[i] = s; mx = fmaxf(mx, s); }
        mx = wave_max(mx); float sum = 0.f;
#pragma unroll
        for (int i = 0; i < 6; ++i) { const int kk = F.lane + 64 * i; const float p = (kk < nk) ? __expf(sv[i] - mx) : 0.f; sv[i] = p; sum += p; }
        sum = wave_sum(sum); const float inv = 1.0f / sum;
#pragma unroll
        for (int i = 0; i < 6; ++i) { const int kk = F.lane + 64 * i; if (kk < nk) Pl[kk] = sv[i] * inv; }
        asm volatile("s_waitcnt lgkmcnt(0)" ::: "memory");
        float o0 = 0.f, o1 = 0.f; const GAS bf16* v0 = VT + (size_t)(h * HD + 2 * F.lane) * NROWS; const GAS bf16* v1 = v0 + NROWS;
        for (int kk = 0; kk < nk; ++kk) { const float p = Pl[kk]; const int kr = Tl[kk]; o0 += p * bf2f(v0[kr]); o1 += p * bf2f(v1[kr]); }
        *(GAS unsigned*)(AO + (size_t)row * D + h * HD + 2 * F.lane) = pk2(o0, o1);
        asm volatile("s_waitcnt lgkmcnt(0)" ::: "memory");
    }
}
__device__ __forceinline__ void ln_rows(f32x4 (&v)[8], const GAS float* g, const GAS float* bb, const Frame& F) {
    f32x4 gv[8], bv[8];
#pragma unroll
    for (int j = 0; j < 8; ++j) { gv[j] = LDV(g, j); bv[j] = LDV(bb, j); }
    __builtin_amdgcn_sched_barrier(0);
    float s = 0.f;
#pragma unroll
    for (int j = 0; j < 8; ++j) s += (v[j][0] + v[j][1]) + (v[j][2] + v[j][3]);
    const float mean = wave_sum(s) * (1.0f / D); float s2 = 0.f;
#pragma unroll
    for (int j = 0; j < 8; ++j) { v[j] = v[j] - mean; s2 += (v[j][0] * v[j][0] + v[j][1] * v[j][1]) + (v[j][2] * v[j][2] + v[j][3] * v[j][3]); }
    const float rstd = 1.0f / sqrtf(wave_sum(s2) * (1.0f / D) + LN_EPS);
#pragma unroll
    for (int j = 0; j < 8; ++j) v[j] = v[j] * rstd * gv[j] + bv[j];
}
__device__ __forceinline__ float reduce16(float (&v)[16], int lane) {
    float a[8], b[4], c[2];
    const bool h5 = lane & 32, h4 = lane & 16, h3 = lane & 8, h2 = lane & 4;
#pragma unroll
    for (int k = 0; k < 8; ++k) { const float snd = h5 ? v[k] : v[k + 8], kp = h5 ? v[k + 8] : v[k]; a[k] = kp + __shfl_xor(snd, 32); }
#pragma unroll
    for (int k = 0; k < 4; ++k) { const float snd = h4 ? a[k] : a[k + 4], kp = h4 ? a[k + 4] : a[k]; b[k] = kp + __shfl_xor(snd, 16); }
#pragma unroll
    for (int k = 0; k < 2; ++k) { const float snd = h3 ? b[k] : b[k + 2], kp = h3 ? b[k + 2] : b[k]; c[k] = kp + __shfl_xor(snd, 8); }
    float d = (h2 ? c[1] : c[0]) + __shfl_xor(h2 ? c[0] : c[1], 4);
    d += __shfl_xor(d, 2); d += __shfl_xor(d, 1);
    return d;
}
__device__ __forceinline__ void row_phase(Frame& F, int l, int dv) {
    const int gw = F.vcu * NWAVES + F.wave, NGW = F.G * NWAVES, nrows = (l || ROW_CTX_COOP) ? NLAT : NROWS;
    const GAS bf16* O = (const GAS bf16*)(F.ws + WS_O); GAS float* X1 = (GAS float*)(F.ws + WS_X1); GAS bf16* HB = ws_tile(F, T_HB); GAS float* AFFT = (GAS float*)(F.ws + WS_AFF);
    const GAS float* lng = fin(F, I_LNG) + (size_t)(l * 2 + 0) * D; const GAS float* lnb = fin(F, I_LNB) + (size_t)(l * 2 + 0) * D; const GAS float* wr = fin(F, I_ROUTER) + (size_t)l * D * NE;
    LAS float* WR = (LAS float*)F.lds;
#pragma unroll
    for (int bt = 0; bt < 2; ++bt) { f32x4 t8[8];
#pragma unroll
        for (int k = 0; k < 8; ++k) { const int pc = F.tid + NTHREADS * (8 * bt + k), ln = pc & 63, e4 = (pc >> 6) & 3, qq = (pc >> 8) & 3, jj = pc >> 10;
            t8[k] = *(const GAS f32x4*)(wr + (size_t)(4 * ln + 256 * jj + qq) * NE + 4 * e4); }
#pragma unroll
        for (int k = 0; k < 8; ++k) *(LAS f32x4*)(WR + 4 * (F.tid + NTHREADS * (8 * bt + k))) = t8[k]; }
    __syncthreads();
    f32x4 xn[8]; v2u on[8];
    if (gw < nrows) { const GAS bf16* orow = O + (size_t)gw * D;
        XN_LOAD(xn, l, gw);
#pragma unroll
        for (int j = 0; j < 8; ++j) on[j] = *(const GAS v2u*)(orow + 4 * F.lane + 256 * j); }
    for (int row = gw; row < nrows; row += NGW) {
        const int r = row_r(row);
        const GAS float* g1 = mods(F, l, r, 2); const GAS float* sh2 = mods(F, l, r, 3); const GAS float* sc2 = mods(F, l, r, 4);
        f32x4 v[8];
        { f32x4 gg[8];
#pragma unroll
          for (int j = 0; j < 8; ++j) gg[j] = LDV(g1, j);
          __builtin_amdgcn_sched_barrier(0);
#pragma unroll
          for (int j = 0; j < 8; ++j) { const f32x4 xx = (X2_FP16 && l) ? h4_to_f32((v2u){__float_as_uint(xn[j][0]), __float_as_uint(xn[j][1])}) : xn[j];
              v[j] = xx * ALPHA + gg[j] * bf4_to_f32(on[j]); } }
        if (row + NGW < nrows) { const GAS bf16* orow = O + (size_t)(row + NGW) * D;
            XN_LOAD(xn, l, row + NGW);
#pragma unroll
            for (int j = 0; j < 8; ++j) on[j] = *(const GAS v2u*)(orow + 4 * F.lane + 256 * j); }
        ln_rows(v, lng, lnb, F);
        float lg[NE];
#pragma unroll
        for (int e = 0; e < NE; ++e) lg[e] = 0.f;
        f32x4 hv[8];
        { f32x4 cv[8], sv[8];
#pragma unroll
          for (int j = 0; j < 8; ++j) { cv[j] = LDV(sc2, j); sv[j] = LDV(sh2, j); }
          __builtin_amdgcn_sched_barrier(0);
#pragma unroll
          for (int j = 0; j < 8; ++j) hv[j] = v[j] * (cv[j] + 1.0f) + sv[j]; }
#if X1_BF16
        { v2u xw[8];
#pragma unroll
          for (int j = 0; j < 8; ++j) { xw[j].x = X1PK(v[j][0], v[j][1]); xw[j].y = X1PK(v[j][2], v[j][3]); }
          __builtin_amdgcn_sched_barrier(0);
#pragma unroll
          for (int j = 0; j < 8; ++j) {
#if NT_STREAM
              __builtin_nontemporal_store(xw[j], (GAS v2u*)((GAS bf16*)X1 + (size_t)row * D + 4 * F.lane + 256 * j));
#else
              *(GAS v2u*)((GAS bf16*)X1 + (size_t)row * D + 4 * F.lane + 256 * j) = xw[j];
#endif
          } }
#pragma unroll
        for (int j = 0; j < 8; ++j) { v2u w; w.x = pk2(hv[j][0], hv[j][1]); w.y = pk2(hv[j][2], hv[j][3]); *(GAS v2u*)(HB + (size_t)row * D + 4 * F.lane + 256 * j) = w; }
#else
#pragma unroll
        for (int j = 0; j < 8; ++j) { *(GAS f32x4*)(X1 + (size_t)row * D + 4 * F.lane + 256 * j) = v[j];
            v2u w; w.x = pk2(hv[j][0], hv[j][1]); w.y = pk2(hv[j][2], hv[j][3]); *(GAS v2u*)(HB + (size_t)row * D + 4 * F.lane + 256 * j) = w; }
#endif
        {
            const LAS float* wl = WR + 4 * F.lane; f32x4 wv[2][4];
#pragma unroll
            for (int e4 = 0; e4 < 4; ++e4) wv[0][e4] = *(const LAS f32x4*)(wl + e4 * 256);
#pragma unroll
            for (int st = 0; st < 32; ++st) {
                if (st + 1 < 32) {
#pragma unroll
                    for (int e4 = 0; e4 < 4; ++e4) wv[(st + 1) & 1][e4] = *(const LAS f32x4*)(wl + ((st + 1) * 4 + e4) * 256); }
                const float hq = hv[st >> 2][st & 3];
#pragma unroll
                for (int e4 = 0; e4 < 4; ++e4)
#pragma unroll
                    for (int t = 0; t < 4; ++t) lg[4 * e4 + t] += hq * wv[st & 1][e4][t];
                __builtin_amdgcn_sched_barrier(0); }
        }
        const float lgt = reduce16(lg, F.lane);
        float mx = lgt;
#pragma unroll
        for (int o = 4; o < 64; o <<= 1) mx = fmaxf(mx, __shfl_xor(mx, o));
        const float ex = expf(lgt - mx); float sum = ex;
#pragma unroll
        for (int o = 4; o < 64; o <<= 1) sum += __shfl_xor(sum, o);
        if ((F.lane & 3) == 0) AFFT[(size_t)((F.lane >> 2) & 15) * NROWS + row] = ex / sum;
    }
#if ROW_CTX_COOP
    if (l == 0) {
        LAS float* PS = (LAS float*)(F.lds + 131072);
        LAS float* PQ = PS + 8; LAS float* PL = PQ + 8;
        const int rr = F.wave >> 2, qq = F.wave & 3;
        for (int base = 2 * F.vcu; base < NCTX; base += 2 * F.G) {
            const int row = NLAT + base + rr;
            const GAS float* xr = xin_row(F, 0, row); const GAS bf16* orow = O + (size_t)row * D;
            const GAS float* g1 = mods(F, 0, 2, 2); const GAS float* sh2 = mods(F, 0, 2, 3); const GAS float* sc2 = mods(F, 0, 2, 4);
            f32x4 v[2], gv[2], bv[2], cv[2], sv[2];
#pragma unroll
            for (int jj = 0; jj < 2; ++jj) { const int j = 2 * qq + jj; v[jj] = LDV(xr, j) * ALPHA + LDV(g1, j) * bf4_to_f32(*(const GAS v2u*)(orow + 4 * F.lane + 256 * j));
                gv[jj] = LDV(lng, j); bv[jj] = LDV(lnb, j); cv[jj] = LDV(sc2, j); sv[jj] = LDV(sh2, j); }
            float s = (v[0][0] + v[0][1]) + (v[0][2] + v[0][3]) + (v[1][0] + v[1][1]) + (v[1][2] + v[1][3]);
            s = wave_sum(s); if (F.lane == 0) PS[rr * 4 + qq] = s;
            __syncthreads();
            const float mean = ((PS[rr * 4 + 0] + PS[rr * 4 + 1]) + (PS[rr * 4 + 2] + PS[rr * 4 + 3])) * (1.0f / D);
            float s2 = 0.f;
#pragma unroll
            for (int jj = 0; jj < 2; ++jj) { v[jj] = v[jj] - mean; s2 += (v[jj][0] * v[jj][0] + v[jj][1] * v[jj][1]) + (v[jj][2] * v[jj][2] + v[jj][3] * v[jj][3]); }
            s2 = wave_sum(s2); if (F.lane == 0) PQ[rr * 4 + qq] = s2;
            __syncthreads();
            const float rstd = 1.0f / sqrtf(((PQ[rr * 4 + 0] + PQ[rr * 4 + 1]) + (PQ[rr * 4 + 2] + PQ[rr * 4 + 3])) * (1.0f / D) + LN_EPS);
            f32x4 hv[2];
#pragma unroll
            for (int jj = 0; jj < 2; ++jj) { const int j = 2 * qq + jj; v[jj] = v[jj] * rstd * gv[jj] + bv[jj]; hv[jj] = v[jj] * (cv[jj] + 1.0f) + sv[jj];
#if X1_BF16
                { v2u xw; xw.x = X1PK(v[jj][0], v[jj][1]); xw.y = X1PK(v[jj][2], v[jj][3]); *(GAS v2u*)((GAS bf16*)X1 + (size_t)row * D + 4 * F.lane + 256 * j) = xw; }
#else
                *(GAS f32x4*)(X1 + (size_t)row * D + 4 * F.lane + 256 * j) = v[jj];
#endif
                v2u w; w.x = pk2(hv[jj][0], hv[jj][1]); w.y = pk2(hv[jj][2], hv[jj][3]); *(GAS v2u*)(HB + (size_t)row * D + 4 * F.lane + 256 * j) = w; }
            float lg[NE];
#pragma unroll
            for (int e = 0; e < NE; ++e) lg[e] = 0.f;
#pragma unroll
            for (int jj = 0; jj < 2; ++jj)
#pragma unroll
                for (int q = 0; q < 4; ++q) { const LAS float* wp = WR + ((((2 * qq + jj) * 4 + q) * 4) * 64 + F.lane) * 4; const float hq = hv[jj][q];
#pragma unroll
                    for (int e4 = 0; e4 < 4; ++e4) { const f32x4 wv = *(const LAS f32x4*)(wp + e4 * 256);
#pragma unroll
                        for (int t = 0; t < 4; ++t) lg[4 * e4 + t] += hq * wv[t]; } }
            const float lgt = reduce16(lg, F.lane);
            if ((F.lane & 3) == 0) PL[(rr * 4 + qq) * 16 + ((F.lane >> 2) & 15)] = lgt;
            __syncthreads();
            if (qq == 0) { const int e = F.lane & 15;
                const float lgs = (PL[(rr * 4 + 0) * 16 + e] + PL[(rr * 4 + 1) * 16 + e]) + (PL[(rr * 4 + 2) * 16 + e] + PL[(rr * 4 + 3) * 16 + e]);
                float mx = lgs;
#pragma unroll
                for (int o = 1; o < 16; o <<= 1) mx = fmaxf(mx, __shfl_xor(mx, o));
                const float ex = expf(lgs - mx); float sum = ex;
#pragma unroll
                for (int o = 1; o < 16; o <<= 1) sum += __shfl_xor(sum, o);
                if (F.lane < 16) AFFT[(size_t)e * NROWS + row] = ex / sum; }
            __syncthreads();
        }
    }
#endif
    __syncthreads();
}
__device__ __forceinline__ void topk_phase(Frame& F, int l) {
    LAS int* CW = (LAS int*)F.lds;
    LAS int* CG = CW + 16;
    LAS int* CE = CG + 64;
    const GAS float* AFFT = (const GAS float*)(F.ws + WS_AFF); GAS int* SLOT = (GAS int*)(F.ws + WS_SLOT); GAS int* IDX = (GAS int*)(F.ws + WS_IDX); GAS float* GATE = (GAS float*)(F.ws + WS_GATE);
    const int nlat = 2 * NE * 8, ntot = nlat + (l == 0 ? 2 * NE : 0);
#if CV_TKN
    const int cv_end = CV_NIT_ALL - (1 - l) * CV_TK, cv_ngw = F.G * NWAVES; int cv_it = cv_end - CV_TK + F.vcu * NWAVES + F.wave, cv_left = CV_TKN; bool cv_pend = false;
    const GAS float* cs0 = nullptr; int cl0 = 0, cd0 = 0, ck0 = 0; GAS bf16* co0 = nullptr; f32x4 cva[8];
#endif
    for (int un = blockIdx.x; un < ntot; un += F.G) {
        const bool lat = un < nlat; int b, e, ch, n, cap, rowbase, slotbase;
        if (lat) { b = un >> 7; e = (un >> 3) & 15; ch = un & 7; n = SEQ; cap = 512; rowbase = b * SEQ; slotbase = e * RPE + b * 512; }
        else { const int q = un - nlat; b = q >> 4; e = q & 15; ch = 0; n = CTXL; cap = 32; rowbase = NLAT + b * CTXL; slotbase = e * RPE + 1024 + b * 32; }
        unsigned key[8];
#pragma unroll
        for (int i = 0; i < 8; ++i) { const int t = F.tid + 512 * i; key[i] = (t < n) ? __float_as_uint(AFFT[(size_t)e * NROWS + rowbase + t]) : 0u; }
        unsigned T = 0u;
#if TOPK_2BIT
        typedef int i32x4 __attribute__((ext_vector_type(4)));
        LAS i32x4* CW4 = (LAS i32x4*)(F.lds + 4096);
        {   const unsigned cand = 1u << 30; int cnt = 0;
#pragma unroll
            for (int i = 0; i < 8; ++i) cnt += __builtin_popcountll(__ballot(key[i] >= cand));
            if (F.lane == 0) CW[F.wave] = cnt;
            __syncthreads();
            int tot = 0;
#pragma unroll
            for (int w = 0; w < 8; ++w) tot += CW[w];
            if (tot >= cap) T = cand; }
        for (int lo = 28; lo >= 0; lo -= 2) {
            const unsigned c1 = T | (1u << lo), c2 = T | (2u << lo), c3 = T | (3u << lo); int n1 = 0, n2 = 0, n3 = 0;
#pragma unroll
            for (int i = 0; i < 8; ++i) { n1 += __builtin_popcountll(__ballot(key[i] >= c1)); n2 += __builtin_popcountll(__ballot(key[i] >= c2)); n3 += __builtin_popcountll(__ballot(key[i] >= c3)); }
            LAS i32x4* cw = CW4 + ((lo >> 1) & 1) * 8;
            if (F.lane == 0) cw[F.wave] = (i32x4){n1, n2, n3, 0};
            __syncthreads();
            i32x4 tot = {0, 0, 0, 0};
#pragma unroll
            for (int w = 0; w < 8; ++w) tot += cw[w];
            T = tot[2] >= cap ? c3 : tot[1] >= cap ? c2 : tot[0] >= cap ? c1 : T;
        }
#else
        for (int bit = 30; bit >= 0; --bit) {
#if CV_TKN
            if ((bit & 3) == 2) {
                if (cv_pend) { p0_item_store(co0, cd0, ck0, F.lane, cva); cv_pend = false; }
                if (cv_left > 0 && cv_it < cv_end) { p0_decode(F, cv_it, cs0, cl0, co0, cd0, ck0); p0_item_load(cs0, cl0, ck0, F.lane, cva); cv_pend = true; cv_it += cv_ngw; }
                --cv_left; }
#endif
            const unsigned cand = T | (1u << bit); int cnt = 0;
#pragma unroll
            for (int i = 0; i < 8; ++i) cnt += __builtin_popcountll(__ballot(key[i] >= cand));
            LAS int* cw = CW + (bit & 1) * 8;
            if (F.lane == 0) cw[F.wave] = cnt;
            __syncthreads();
            int tot = 0;
#pragma unroll
            for (int w = 0; w < 8; ++w) tot += cw[w];
            if (tot >= cap) T = cand;
        }
#endif
#pragma unroll
        for (int i = 0; i < 8; ++i) { const unsigned long long mg = __ballot(key[i] > T), me = __ballot(key[i] == T);
            if (F.lane == 0) { CG[i * 8 + F.wave] = __builtin_popcountll(mg); CE[i * 8 + F.wave] = __builtin_popcountll(me); } }
        __syncthreads();
        int gt_total = 0, g_before = 0, e_before = 0;
        { typedef int i32x4 __attribute__((ext_vector_type(4))); i32x4 cgv[16], cev[16];
#pragma unroll
          for (int k4 = 0; k4 < 16; ++k4) { cgv[k4] = *(const LAS i32x4*)(CG + 4 * k4); cev[k4] = *(const LAS i32x4*)(CE + 4 * k4); }
          const int lim = ch * 8 + F.wave;
#pragma unroll
          for (int k4 = 0; k4 < 16; ++k4)
#pragma unroll
              for (int t = 0; t < 4; ++t) { const int k = 4 * k4 + t; gt_total += cgv[k4][t]; g_before += (k < lim) ? cgv[k4][t] : 0; e_before += (k < lim) ? cev[k4][t] : 0; } }
        const int need = cap - gt_total;
        {
            unsigned kv = 0u;
#pragma unroll
            for (int i = 0; i < 8; ++i) kv = (i == ch) ? key[i] : kv;
            const int t = F.tid + 512 * ch;
            const unsigned long long mg = __ballot(kv > T), me = __ballot(kv == T);
            const unsigned long long lower = (F.lane == 0) ? 0ull : (~0ull >> (64 - F.lane));
            const int g_rank = g_before + __builtin_popcountll(mg & lower), e_rank = e_before + __builtin_popcountll(me & lower);
            const int e_taken_before = e_rank < need ? e_rank : need;
            const bool sel = (t < n) && ((kv > T) || (kv == T && e_rank < need));
            if (t < n) { int s = -1;
                if (sel) { s = slotbase + g_rank + e_taken_before; IDX[s] = rowbase + t; GATE[s] = __uint_as_float(kv); }
                SLOT[(size_t)(rowbase + t) * NE + e] = s; }
        }
        __syncthreads();
    }
#if CV_TKN
    if (cv_pend) p0_item_store(co0, cd0, ck0, F.lane, cva);
    for (; cv_left > 0 && cv_it < cv_end; --cv_left, cv_it += cv_ngw) { p0_decode(F, cv_it, cs0, cl0, co0, cd0, ck0); p0_item_load(cs0, cl0, ck0, F.lane, cva); p0_item_store(co0, cd0, ck0, F.lane, cva); }
#endif
}
__device__ __forceinline__ void gather_phase(Frame& F, int l) {
    const int gw = F.vcu * NWAVES + F.wave, NGW = F.G * NWAVES, nv = l ? 1024 : 1088;
    const GAS bf16* HB = ws_tile(F, T_HB); GAS bf16* XE = ws_tile(F, T_XE); const GAS int* IDX = (const GAS int*)(F.ws + WS_IDX);
    for (int i = gw; i < NE * nv; i += NGW) { const int e = i / nv, s = e * RPE + i % nv; const int src = IDX[s];
        const GAS v4u* sp = (const GAS v4u*)(HB + (size_t)src * D); GAS v4u* dp = (GAS v4u*)(XE + (size_t)s * D);
        v4u t4[4];
#pragma unroll
        for (int j = 0; j < 4; ++j) t4[j] = sp[F.lane + 64 * j];
#pragma unroll
        for (int j = 0; j < 4; ++j) dp[F.lane + 64 * j] = t4[j]; }
}
__device__ __forceinline__ void combine_phase(Frame& F, int l) {
    const int gw = F.vcu * NWAVES + F.wave, NGW = F.G * NWAVES, nrows = (l || CTX_COOP2) ? NLAT : NROWS;
    const GAS float* X1 = (const GAS float*)(F.ws + WS_X1); const GAS bf16* YE = (const GAS bf16*)(F.ws + WS_YE); const GAS int* SLOT = (const GAS int*)(F.ws + WS_SLOT);
    GAS float* X2 = (GAS float*)(F.ws + WS_X2); GAS bf16* HB = ws_tile(F, T_HB);
    const GAS float* lng = fin(F, I_LNG) + (size_t)(l * 2 + 1) * D; const GAS float* lnb = fin(F, I_LNB) + (size_t)(l * 2 + 1) * D;
    LAS float* VL = (LAS float*)F.lds;
    stage_vec(F, VL, lng); stage_vec(F, VL + D, lnb);
#pragma unroll
    for (int r = 0; r < 3; ++r) { stage_vec(F, VL + (2 + r) * D, mods(F, l, r, 5)); if (l == 0) { stage_vec(F, VL + (5 + r) * D, mods(F, 1, r, 0)); stage_vec(F, VL + (8 + r) * D, mods(F, 1, r, 1)); } }
    __syncthreads();
    int svn = (gw < nrows) ? SLOT[(size_t)gw * NE + (F.lane & 15)] : -1;
    for (int row = gw; row < nrows; row += NGW) {
        const int r = row_r(row); const LAS float* g2 = VL + (2 + r) * D;
#if X1_BF16
        const GAS bf16* x1 = (const GAS bf16*)X1 + (size_t)row * D;
#else
        const GAS float* x1 = X1 + (size_t)row * D;
#endif
        f32x4 f[8];
#pragma unroll
        for (int j = 0; j < 8; ++j) f[j] = (f32x4){0.f, 0.f, 0.f, 0.f};
        const int sv = svn;
        if (row + NGW < nrows) svn = SLOT[(size_t)(row + NGW) * NE + (F.lane & 15)];
        f32x4 xv[8], g2v[8];
#if X1_BF16
#pragma unroll
        for (int j = 0; j < 8; ++j) { xv[j] = X1UNPK(*(const GAS v2u*)(x1 + 4 * F.lane + 256 * j)); g2v[j] = LDVL(g2, j); }
#else
#pragma unroll
        for (int j = 0; j < 8; ++j) { xv[j] = LDV(x1, j); g2v[j] = LDVL(g2, j); }
#endif
#pragma unroll
        for (int e = 0; e < NE; ++e) { const int s = __builtin_amdgcn_readlane(sv, e);
            if (s >= 0) { const GAS bf16* yr = YE + (size_t)s * D; v2u t[8];
#pragma unroll
                for (int j = 0; j < 8; ++j) t[j] = *(const GAS v2u*)(yr + 4 * F.lane + 256 * j);
#pragma unroll
                for (int j = 0; j < 8; ++j) f[j] += bf4_to_f32(t[j]); } }
        f32x4 v[8];
#pragma unroll
        for (int j = 0; j < 8; ++j) v[j] = xv[j] * ALPHA + g2v[j] * f[j];
        ln_rows_lds(v, VL, VL + D, F);
        if (l == 0) { const LAS float* sh = VL + (5 + r) * D; const LAS float* sc = VL + (8 + r) * D; v2u hw[8];
#pragma unroll
            for (int j = 0; j < 8; ++j) { const f32x4 h = v[j] * (LDVL(sc, j) + 1.0f) + LDVL(sh, j); hw[j].x = pk2(h[0], h[1]); hw[j].y = pk2(h[2], h[3]); }
#pragma unroll
            for (int j = 0; j < 8; ++j) {
#if NT_STREAM
                __builtin_nontemporal_store(v[j], (GAS f32x4*)(X2 + (size_t)row * D + 4 * F.lane + 256 * j));
#elif X2_FP16
                { v2u xw; xw.x = pkh2(v[j][0], v[j][1]); xw.y = pkh2(v[j][2], v[j][3]); *(GAS v2u*)((GAS bf16*)X2 + (size_t)row * D + 4 * F.lane + 256 * j) = xw; }
#else
                *(GAS f32x4*)(X2 + (size_t)row * D + 4 * F.lane + 256 * j) = v[j];
#endif
                *(GAS v2u*)(HB + (size_t)row * D + 4 * F.lane + 256 * j) = hw[j]; } }
        else {
#pragma unroll
            for (int j = 0; j < 8; ++j) {
#if NT_STREAM
                __builtin_nontemporal_store(v[j], (GAS f32x4*)(F.out + (size_t)row * D + 4 * F.lane + 256 * j));
#else
                *(GAS f32x4*)(F.out + (size_t)row * D + 4 * F.lane + 256 * j) = v[j];
#endif
            } }
    }
#if CTX_COOP2
    if (l == 0) {
        LAS float* PS = (LAS float*)(F.lds + 131072); LAS float* PQ = PS + 8;
        const int rr = F.wave >> 2, qq = F.wave & 3;
        for (int base = 2 * F.vcu; base < NCTX; base += 2 * F.G) {
            const int row = NLAT + base + rr; const GAS float* x1 = X1 + (size_t)row * D; const LAS float* g2 = VL + 4 * D;
            const int sv = SLOT[(size_t)row * NE + (F.lane & 15)];
            f32x4 f[2] = {{0.f, 0.f, 0.f, 0.f}, {0.f, 0.f, 0.f, 0.f}}, xv[2];
#pragma unroll
            for (int jj = 0; jj < 2; ++jj) xv[jj] = LDV(x1, 2 * qq + jj);
#pragma unroll
            for (int e = 0; e < NE; ++e) { const int sl = __builtin_amdgcn_readlane(sv, e);
                if (sl >= 0) { const GAS bf16* yr = YE + (size_t)sl * D; v2u t[2];
#pragma unroll
                    for (int jj = 0; jj < 2; ++jj) t[jj] = *(const GAS v2u*)(yr + 4 * F.lane + 256 * (2 * qq + jj));
#pragma unroll
                    for (int jj = 0; jj < 2; ++jj) f[jj] += bf4_to_f32(t[jj]); } }
            f32x4 v[2];
#pragma unroll
            for (int jj = 0; jj < 2; ++jj) v[jj] = xv[jj] * ALPHA + LDVL(g2, 2 * qq + jj) * f[jj];
            float s1 = (v[0][0] + v[0][1]) + (v[0][2] + v[0][3]) + (v[1][0] + v[1][1]) + (v[1][2] + v[1][3]);
            s1 = wave_sum(s1); if (F.lane == 0) PS[rr * 4 + qq] = s1;
            __syncthreads();
            const float mean = ((PS[rr * 4 + 0] + PS[rr * 4 + 1]) + (PS[rr * 4 + 2] + PS[rr * 4 + 3])) * (1.0f / D);
            float s2 = 0.f;
#pragma unroll
            for (int jj = 0; jj < 2; ++jj) { v[jj] = v[jj] - mean; s2 += (v[jj][0] * v[jj][0] + v[jj][1] * v[jj][1]) + (v[jj][2] * v[jj][2] + v[jj][3] * v[jj][3]); }
            s2 = wave_sum(s2); if (F.lane == 0) PQ[rr * 4 + qq] = s2;
            __syncthreads();
            const float rstd = 1.0f / sqrtf(((PQ[rr * 4 + 0] + PQ[rr * 4 + 1]) + (PQ[rr * 4 + 2] + PQ[rr * 4 + 3])) * (1.0f / D) + LN_EPS);
            const LAS float* sh = VL + 7 * D; const LAS float* sc = VL + 10 * D;
#pragma unroll
            for (int jj = 0; jj < 2; ++jj) { const int j = 2 * qq + jj; v[jj] = v[jj] * rstd * LDVL(VL, j) + LDVL(VL + D, j);
                const f32x4 h = v[jj] * (LDVL(sc, j) + 1.0f) + LDVL(sh, j);
                *(GAS f32x4*)(X2 + (size_t)row * D + 4 * F.lane + 256 * j) = v[jj];
                v2u w; w.x = pk2(h[0], h[1]); w.y = pk2(h[2], h[3]); *(GAS v2u*)(HB + (size_t)row * D + 4 * F.lane + 256 * j) = w; }
            __syncthreads();
        }
    }
#endif
    __syncthreads();
}
__device__ __forceinline__ void s5_naive(Frame& F) {
    const int gw = F.vcu * NWAVES + F.wave, NGW = F.G * NWAVES;
    const GAS float* AR = (const GAS float*)(F.ws + WS_SPAR); const GAS float* AI = AR + 2 * NG * NP; const GAS float* BB = AI + 2 * NG * NP;
    const GAS bf16* HB = ws_tile(F, T_HB);
    for (int un = gw; un < 2 * NG * 2; un += NGW) {
        const int b = un >> 8, g = (un >> 1) & 127, dir = un & 1; const int idx = (dir * NG + g) * NP + F.lane;
        const float ar = AR[idx], ai = AI[idx]; float br[GH], bi[GH], cr[GH], ci[GH];
#pragma unroll
        for (int h = 0; h < GH; ++h) { br[h] = BB[(size_t)idx * 32 + h]; bi[h] = BB[(size_t)idx * 32 + 16 + h];
            cr[h] = fin(F, I_CRE)[((size_t)(dir * NG + g) * GH + h) * NP + F.lane]; ci[h] = fin(F, I_CIM)[((size_t)(dir * NG + g) * GH + h) * NP + F.lane]; }
        GAS float* Y = (GAS float*)(F.ws + (dir ? WS_YB : WS_YF));
        float xr = 0.f, xi = 0.f;
        for (int tau = 0; tau < CTXL + SEQ; ++tau) {
            int row; if (tau < CTXL) row = NLAT + b * CTXL + (dir ? CTXL - 1 - tau : tau); else row = b * SEQ + (dir ? SEQ - 1 - (tau - CTXL) : tau - CTXL);
            const v4u u0 = *(const GAS v4u*)(HB + (size_t)row * D + g * GH), u1 = *(const GAS v4u*)(HB + (size_t)row * D + g * GH + 8);
            float u[GH];
#pragma unroll
            for (int q = 0; q < 4; ++q) { u[2 * q] = bf2f(u0[q] & 0xffffu); u[2 * q + 1] = bf2f(u0[q] >> 16); u[8 + 2 * q] = bf2f(u1[q] & 0xffffu); u[8 + 2 * q + 1] = bf2f(u1[q] >> 16); }
            float pr = 0.f, pi = 0.f;
#pragma unroll
            for (int h = 0; h < GH; ++h) { pr += br[h] * u[h]; pi += bi[h] * u[h]; }
            const float nxr = ar * xr - ai * xi + pr, nxi = ar * xi + ai * xr + pi; xr = nxr; xi = nxi;
            if (tau >= CTXL) { float mine = 0.f;
#pragma unroll
                for (int h = 0; h < GH; ++h) { const float y = wave_sum(cr[h] * xr - ci[h] * xi); mine = (F.lane == h) ? y : mine; }
                if (F.lane < GH) Y[(size_t)row * D + g * GH + F.lane] = mine; }
        }
    }
}
__device__ __forceinline__ void zprep_phase(Frame& F) {
    const int gw = F.vcu * NWAVES + F.wave, NGW = F.G * NWAVES;
    const GAS float* X2 = (const GAS float*)(F.ws + WS_X2); const GAS bf16* YF = (const GAS bf16*)(F.ws + WS_YF); const GAS bf16* YB = (const GAS bf16*)(F.ws + WS_YB); GAS bf16* Z = ws_tile(F, T_Z);
    const GAS float* dsk = fin(F, I_SD);
    for (int row = gw; row < NLAT; row += NGW) {
        const int r = row >> 12; const GAS float* sh = mods(F, 1, r, 0); const GAS float* sc = mods(F, 1, r, 1);
        const GAS float* x2 = X2 + (size_t)row * D; const GAS bf16* yf = YF + (size_t)row * D; const GAS bf16* yb = YB + (size_t)row * D;
        f32x4 xv[8]; v2u fv[8], bv[8];
#pragma unroll
        for (int j = 0; j < 8; ++j) { xv[j] = LDV(x2, j); fv[j] = *(const GAS v2u*)(yf + 4 * F.lane + 256 * j); bv[j] = *(const GAS v2u*)(yb + 4 * F.lane + 256 * j); }
        v2u zo[8];
#pragma unroll
        for (int j = 0; j < 8; ++j) { const f32x4 u = xv[j] * (LDV(sc, j) + 1.0f) + LDV(sh, j); const f32x4 y = LDV(dsk, j) * u + bf4_to_f32(fv[j]) + bf4_to_f32(bv[j]);
            zo[j].x = pk2(gelu_tanh_f(y[0]), gelu_tanh_f(y[1])); zo[j].y = pk2(gelu_tanh_f(y[2]), gelu_tanh_f(y[3])); }
#pragma unroll
        for (int j = 0; j < 8; ++j) *(GAS v2u*)(Z + (size_t)row * D + 4 * F.lane + 256 * j) = zo[j];
    }
}

constexpr int S5_T = 34, S5_NCH = 128;
typedef float f32x4s __attribute__((ext_vector_type(4)));
struct S5Consts { bf16x8 abu[8]; float ar[4][4], ai[4][4]; };
__device__ __forceinline__ void s5_load_consts(const Frame& F, int gd, int lane, S5Consts& K) {
    const GAS float* AR = (const GAS float*)(F.ws + WS_SPAR); const GAS float* AI = AR + 2 * NG * NP; const GAS float* BB = AI + 2 * NG * NP;
    const int m = lane & 15, q = lane >> 4;
#pragma unroll
    for (int tt = 0; tt < 8; ++tt) { const int p = 16 * (tt >> 1) + m; v4u w = {0u, 0u, 0u, 0u};
        if (q < 2) { const GAS float* s = BB + (size_t)(gd * NP + p) * 32 + (tt & 1) * 16 + 8 * q; const f32x4 x0 = *(const GAS f32x4*)s, x1 = *(const GAS f32x4*)(s + 4);
            w.x = pk2(x0[0], x0[1]); w.y = pk2(x0[2], x0[3]); w.z = pk2(x1[0], x1[1]); w.w = pk2(x1[2], x1[3]); }
        K.abu[tt] = __builtin_bit_cast(bf16x8, w); }
#pragma unroll
    for (int pb = 0; pb < 4; ++pb) { const f32x4 a = *(const GAS f32x4*)(AR + gd * NP + 16 * pb + 4 * q), b = *(const GAS f32x4*)(AI + gd * NP + 16 * pb + 4 * q);
#pragma unroll
        for (int i = 0; i < 4; ++i) { K.ar[pb][i] = a[i]; K.ai[pb][i] = b[i]; } }
}
__device__ __forceinline__ int s5_row(int b, int dir, int tau) {
    const int ctxrow = NLAT + b * CTXL + (dir ? CTXL - 1 - tau : tau), latrow = b * SEQ + (dir ? (CTXL + SEQ - 1) - tau : tau - CTXL);
    return tau < CTXL ? ctxrow : latrow;
}
constexpr int S5_XP = 132;
template <bool READOUT>
__device__ __forceinline__ void s5_run(Frame& F, const S5Consts& K, const bf16x8 (&cfr)[4], int gd, int cg, LAS float* XS) {
    const int lane = F.lane, n = lane & 15, q = lane >> 4, dir = gd >> 7, g = gd & 127;
    const GAS bf16* HB = ws_tile(F, T_HB);
    GAS bf16* Y = (GAS bf16*)(F.ws + (dir ? WS_YB : WS_YF));
    const int chunk = cg * 16 + n, b = chunk >> 7, c = chunk & 127, tau0 = c * S5_T;
    LAS float* xs = XS + chunk * S5_XP + 8 * q;
    f32x4s X[8];
    if (READOUT) {
#pragma unroll
        for (int pb = 0; pb < 4; ++pb) { const f32x4 v0 = *(const LAS f32x4*)(xs + 32 * pb), v1 = *(const LAS f32x4*)(xs + 32 * pb + 4);
            X[2 * pb] = (f32x4s){v0[0], v0[2], v1[0], v1[2]}; X[2 * pb + 1] = (f32x4s){v0[1], v0[3], v1[1], v1[3]}; }
    } else {
#pragma unroll
        for (int tt = 0; tt < 8; ++tt) X[tt] = (f32x4s){0.f, 0.f, 0.f, 0.f};
    }
    constexpr int PD = 6;
    v4u ur[PD];
    const GAS bf16* ucol = HB + g * GH + 8 * q;
#pragma unroll
    for (int t = 0; t < PD; ++t) { ur[t] = (v4u){0u, 0u, 0u, 0u}; if (q < 2) ur[t] = *(const GAS v4u*)(ucol + (size_t)s5_row(b, dir, tau0 + t) * D); }
#define S5_STEP(KS, T, REFILL) do { \
        const bf16x8 ub = __builtin_bit_cast(bf16x8, ur[KS]); \
        if (REFILL) { ur[KS] = (v4u){0u, 0u, 0u, 0u}; if (q < 2) ur[KS] = *(const GAS v4u*)(ucol + (size_t)s5_row(b, dir, tau0 + (T) + PD) * D); } \
        _Pragma("unroll") for (int pb = 0; pb < 4; ++pb) _Pragma("unroll") for (int i = 0; i < 4; ++i) { const float re = X[2 * pb][i], im = X[2 * pb + 1][i]; \
            X[2 * pb][i] = K.ar[pb][i] * re - K.ai[pb][i] * im; X[2 * pb + 1][i] = K.ar[pb][i] * im + K.ai[pb][i] * re; } \
        _Pragma("unroll") for (int tt = 0; tt < 8; ++tt) X[tt] = __builtin_amdgcn_mfma_f32_16x16x32_bf16(K.abu[tt], ub, X[tt], 0, 0, 0); \
        if (READOUT) { f32x4s y0 = {0.f, 0.f, 0.f, 0.f}, y1 = y0; \
            _Pragma("unroll") for (int s = 0; s < 4; ++s) { v4u w; w.x = pk2(X[2 * s][0], X[2 * s][1]); w.y = pk2(X[2 * s][2], X[2 * s][3]); w.z = pk2(X[2 * s + 1][0], X[2 * s + 1][1]); w.w = pk2(X[2 * s + 1][2], X[2 * s + 1][3]); \
                const bf16x8 xb = __builtin_bit_cast(bf16x8, w); \
                if (s & 1) y1 = __builtin_amdgcn_mfma_f32_16x16x32_bf16(cfr[s], xb, y1, 0, 0, 0); else y0 = __builtin_amdgcn_mfma_f32_16x16x32_bf16(cfr[s], xb, y0, 0, 0, 0); } \
            const int tau = tau0 + (T); \
            if (tau >= CTXL) { const f32x4s y = y0 + y1; v2u w; w.x = pk2(y[0], y[1]); w.y = pk2(y[2], y[3]); *(GAS v2u*)(Y + (size_t)s5_row(b, dir, tau) * D + g * GH + 4 * q) = w; } } \
    } while (0)
#pragma unroll 1
    for (int t0 = 0; t0 < 24; t0 += PD) {
        S5_STEP(0, t0 + 0, true); S5_STEP(1, t0 + 1, true); S5_STEP(2, t0 + 2, true); S5_STEP(3, t0 + 3, true); S5_STEP(4, t0 + 4, true); S5_STEP(5, t0 + 5, true); }
    S5_STEP(0, 24, true); S5_STEP(1, 25, true); S5_STEP(2, 26, true); S5_STEP(3, 27, true); S5_STEP(4, 28, false); S5_STEP(5, 29, false);
    S5_STEP(0, 30, false); S5_STEP(1, 31, false); S5_STEP(2, 32, false); S5_STEP(3, 33, false);
#undef S5_STEP
    if (!READOUT) {
#pragma unroll
        for (int pb = 0; pb < 4; ++pb) { const f32x4s re = X[2 * pb], im = X[2 * pb + 1];
            *(LAS f32x4*)(xs + 32 * pb) = (f32x4){re[0], im[0], re[1], im[1]}; *(LAS f32x4*)(xs + 32 * pb + 4) = (f32x4){re[2], im[2], re[3], im[3]}; }
    }
}
__device__ __forceinline__ void s5_fused(Frame& F) {
    LAS float* XS = (LAS float*)F.lds;
    LAS f32x2* AG = (LAS f32x2*)(F.lds + 256 * S5_XP * 4);
    const GAS float* AR = (const GAS float*)(F.ws + WS_SPAR); const GAS float* AI = AR + 2 * NG * NP;
    const int lane = F.lane, n = lane & 15, q = lane >> 4, seg = F.tid >> 6, p = F.tid & 63;
    for (int gd = F.vcu; gd < 2 * NG; gd += F.G) {
        S5Consts K; s5_load_consts(F, gd, lane, K);
        bf16x8 cz[4];
#pragma unroll
        for (int s = 0; s < 4; ++s) cz[s] = (bf16x8){0, 0, 0, 0, 0, 0, 0, 0};
#pragma unroll 1
        for (int k2 = 0; k2 < 2; ++k2) s5_run<false>(F, K, cz, gd, F.wave * 2 + k2, XS);
        __syncthreads();
        {
            const double ar = AR[gd * NP + p], ai = AI[gd * NP + p];
            double sr = ar, si = ai, t; t = sr * sr - si * si; si = 2.0 * sr * si; sr = t;
            double pr = sr, pi = si;
            for (int k = 0; k < 4; ++k) { t = sr * sr - si * si; si = 2.0 * sr * si; sr = t; }
            t = pr * sr - pi * si; pi = pr * si + pi * sr; pr = t;
            const float tr = (float)pr, ti = (float)pi;
            double qr = pr, qi = pi; for (int k = 0; k < 4; ++k) { t = qr * qr - qi * qi; qi = 2.0 * qr * qi; qr = t; }
            const float t16r = (float)qr, t16i = (float)qi;
            for (int b = 0; b < 2; ++b) {
                LAS float* xs = XS + (b * S5_NCH + seg * 16) * S5_XP + 2 * p;
                f32x2 loc[16];
#pragma unroll
                for (int k = 0; k < 16; ++k) loc[k] = *(const LAS f32x2*)(xs + k * S5_XP);
                float ar_ = 0.f, ai_ = 0.f;
#pragma unroll
                for (int k = 0; k < 16; ++k) { const float nr = tr * ar_ - ti * ai_ + loc[k][0], ni = tr * ai_ + ti * ar_ + loc[k][1]; ar_ = nr; ai_ = ni; }
                AG[seg * 64 + p] = (f32x2){ar_, ai_};
                __syncthreads();
                float cr = 0.f, ci = 0.f;
                for (int s2 = 0; s2 < seg; ++s2) { const f32x2 a = AG[s2 * 64 + p]; const float nr = t16r * cr - t16i * ci + a[0], ni = t16r * ci + t16i * cr + a[1]; cr = nr; ci = ni; }
#pragma unroll
                for (int k = 0; k < 16; ++k) { *(LAS f32x2*)(xs + k * S5_XP) = (f32x2){cr, ci};
                    const float nr = tr * cr - ti * ci + loc[k][0], ni = tr * ci + ti * cr + loc[k][1]; cr = nr; ci = ni; }
                __syncthreads();
            }
        }
        bf16x8 cfr[4];
#pragma unroll
        for (int s = 0; s < 4; ++s) { const GAS float* cr = fin(F, I_CRE) + (size_t)(gd * GH + n) * NP + 16 * s + 4 * q; const GAS float* ci = fin(F, I_CIM) + (size_t)(gd * GH + n) * NP + 16 * s + 4 * q;
            const f32x4 a = *(const GAS f32x4*)cr, b = *(const GAS f32x4*)ci; v4u w; w.x = pk2(a[0], a[1]); w.y = pk2(a[2], a[3]); w.z = pk2(-b[0], -b[1]); w.w = pk2(-b[2], -b[3]);
            cfr[s] = __builtin_bit_cast(bf16x8, w); }
#pragma unroll 1
        for (int k2 = 0; k2 < 2; ++k2) s5_run<true>(F, K, cfr, gd, F.wave * 2 + k2, XS);
        __syncthreads();
    }
}

template <int MODE>
__device__ __forceinline__ void s5z_run(Frame& F, const S5Consts& K, const bf16x8 (&cfr)[4], int g, int dir, int b, int cgl, LAS float* XS) {
    constexpr bool READOUT = MODE != 0;
    const int lane = F.lane, n = lane & 15, q = lane >> 4;
    const GAS bf16* HB = ws_tile(F, T_HB);
    GAS bf16* YF = (GAS bf16*)(F.ws + WS_YF); GAS bf16* Z = ws_tile(F, T_Z);
    const int c = cgl * 16 + n, tau0 = c * S5_T;
    LAS float* xs = XS + (dir * S5_NCH + c) * S5_XP + 8 * q;
    f32x4s X[8];
    if (READOUT) {
#pragma unroll
        for (int pb = 0; pb < 4; ++pb) { const f32x4 v0 = *(const LAS f32x4*)(xs + 32 * pb), v1 = *(const LAS f32x4*)(xs + 32 * pb + 4);
            X[2 * pb] = (f32x4s){v0[0], v0[2], v1[0], v1[2]}; X[2 * pb + 1] = (f32x4s){v0[1], v0[3], v1[1], v1[3]}; }
    } else {
#pragma unroll
        for (int tt = 0; tt < 8; ++tt) X[tt] = (f32x4s){0.f, 0.f, 0.f, 0.f};
    }
    f32x4 dsk = {0.f, 0.f, 0.f, 0.f};
    if (MODE == 2) dsk = *(const GAS f32x4*)(fin(F, I_SD) + g * GH + 4 * q);
    constexpr int PD = 6;
    v4u ur[PD];
    const GAS bf16* ucol = HB + g * GH + 8 * q;
#pragma unroll
    for (int t = 0; t < PD; ++t) { ur[t] = (v4u){0u, 0u, 0u, 0u}; if (q < 2) ur[t] = *(const GAS v4u*)(ucol + (size_t)s5_row(b, dir, tau0 + t) * D); }
    unsigned long long yfn = 0ull, un = 0ull;
    if (MODE == 2) { const int tau = tau0; if (tau >= CTXL) { const size_t o = (size_t)s5_row(b, dir, tau) * D + g * GH + 4 * q;
        yfn = __hip_atomic_load((const GAS unsigned long long*)(YF + o), __ATOMIC_RELAXED, __HIP_MEMORY_SCOPE_AGENT); un = *(const GAS unsigned long long*)(HB + o); } }
#define S5Z_STEP(KS, T, REFILL) do { \
        const bf16x8 ub = __builtin_bit_cast(bf16x8, ur[KS]); \
        if (REFILL) { ur[KS] = (v4u){0u, 0u, 0u, 0u}; if (q < 2) ur[KS] = *(const GAS v4u*)(ucol + (size_t)s5_row(b, dir, tau0 + (T) + PD) * D); } \
        const unsigned long long yfc = yfn, uc = un; \
        if (MODE == 2) { const int tn_ = tau0 + (T) + 1; if ((T) + 1 < S5_T && tn_ >= CTXL) { const size_t o_ = (size_t)s5_row(b, dir, tn_) * D + g * GH + 4 * q; \
            yfn = __hip_atomic_load((const GAS unsigned long long*)(YF + o_), __ATOMIC_RELAXED, __HIP_MEMORY_SCOPE_AGENT); un = *(const GAS unsigned long long*)(HB + o_); } } \
        _Pragma("unroll") for (int pb = 0; pb < 4; ++pb) _Pragma("unroll") for (int i = 0; i < 4; ++i) { const float re = X[2 * pb][i], im = X[2 * pb + 1][i]; \
            X[2 * pb][i] = K.ar[pb][i] * re - K.ai[pb][i] * im; X[2 * pb + 1][i] = K.ar[pb][i] * im + K.ai[pb][i] * re; } \
        _Pragma("unroll") for (int tt = 0; tt < 8; ++tt) X[tt] = __builtin_amdgcn_mfma_f32_16x16x32_bf16(K.abu[tt], ub, X[tt], 0, 0, 0); \
        if (READOUT) { f32x4s y0 = {0.f, 0.f, 0.f, 0.f}, y1 = y0; \
            _Pragma("unroll") for (int s = 0; s < 4; ++s) { v4u w; w.x = pk2(X[2 * s][0], X[2 * s][1]); w.y = pk2(X[2 * s][2], X[2 * s][3]); w.z = pk2(X[2 * s + 1][0], X[2 * s + 1][1]); w.w = pk2(X[2 * s + 1][2], X[2 * s + 1][3]); \
                const bf16x8 xb = __builtin_bit_cast(bf16x8, w); \
                if (s & 1) y1 = __builtin_amdgcn_mfma_f32_16x16x32_bf16(cfr[s], xb, y1, 0, 0, 0); else y0 = __builtin_amdgcn_mfma_f32_16x16x32_bf16(cfr[s], xb, y0, 0, 0, 0); } \
            const int tau = tau0 + (T); \
            if (tau >= CTXL) { f32x4s y = y0 + y1; const size_t o = (size_t)s5_row(b, dir, tau) * D + g * GH + 4 * q; \
                if (MODE == 2) { const f32x4 yf4 = bf4_to_f32((v2u){(unsigned)yfc, (unsigned)(yfc >> 32)}), u4 = bf4_to_f32((v2u){(unsigned)uc, (unsigned)(uc >> 32)}); \
                    _Pragma("unroll") for (int e = 0; e < 4; ++e) y[e] = gelu_tanh_f(dsk[e] * u4[e] + yf4[e] + y[e]); \
                    v2u w; w.x = pk2(y[0], y[1]); w.y = pk2(y[2], y[3]); *(GAS v2u*)(Z + o) = w; } \
                else { v2u w; w.x = pk2(y[0], y[1]); w.y = pk2(y[2], y[3]); *(GAS v2u*)(YF + o) = w; } } } \
    } while (0)
#pragma unroll 1
    for (int t0 = 0; t0 < 24; t0 += PD) {
        S5Z_STEP(0, t0 + 0, true); S5Z_STEP(1, t0 + 1, true); S5Z_STEP(2, t0 + 2, true); S5Z_STEP(3, t0 + 3, true); S5Z_STEP(4, t0 + 4, true); S5Z_STEP(5, t0 + 5, true); }
    S5Z_STEP(0, 24, true); S5Z_STEP(1, 25, true); S5Z_STEP(2, 26, true); S5Z_STEP(3, 27, true); S5Z_STEP(4, 28, false); S5Z_STEP(5, 29, false);
    S5Z_STEP(0, 30, false); S5Z_STEP(1, 31, false); S5Z_STEP(2, 32, false); S5Z_STEP(3, 33, false);
#undef S5Z_STEP
    if (!READOUT) {
#pragma unroll
        for (int pb = 0; pb < 4; ++pb) { const f32x4s re = X[2 * pb], im = X[2 * pb + 1];
            *(LAS f32x4*)(xs + 32 * pb) = (f32x4){re[0], im[0], re[1], im[1]}; *(LAS f32x4*)(xs + 32 * pb + 4) = (f32x4){re[2], im[2], re[3], im[3]}; }
    }
}
__device__ __forceinline__ void s5z_load_cfr(const Frame& F, int gd, int lane, bf16x8 (&cfr)[4]) {
    const int n = lane & 15, q = lane >> 4;
#pragma unroll
    for (int s = 0; s < 4; ++s) { const GAS float* cr = fin(F, I_CRE) + (size_t)(gd * GH + n) * NP + 16 * s + 4 * q; const GAS float* ci = fin(F, I_CIM) + (size_t)(gd * GH + n) * NP + 16 * s + 4 * q;
        const f32x4 a = *(const GAS f32x4*)cr, b = *(const GAS f32x4*)ci; v4u w; w.x = pk2(a[0], a[1]); w.y = pk2(a[2], a[3]); w.z = pk2(-b[0], -b[1]); w.w = pk2(-b[2], -b[3]);
        cfr[s] = __builtin_bit_cast(bf16x8, w); }
}
__device__ __forceinline__ void s5z_fused(Frame& F) {
    LAS float* XS = (LAS float*)F.lds;
    LAS f32x2* AG = (LAS f32x2*)(F.lds + 256 * S5_XP * 4);
    const GAS float* AR = (const GAS float*)(F.ws + WS_SPAR); const GAS float* AI = AR + 2 * NG * NP;
    const int lane = F.lane, seg = F.tid >> 6, p = F.tid & 63;
    for (int wu = F.vcu; wu < 2 * NG; wu += F.G) {
        const int g = wu & 127, b = wu >> 7;
        bf16x8 cz[4];
#pragma unroll
        for (int s = 0; s < 4; ++s) cz[s] = (bf16x8){0, 0, 0, 0, 0, 0, 0, 0};
#pragma unroll 1
        for (int dir = 0; dir < 2; ++dir) { S5Consts K; s5_load_consts(F, dir * NG + g, lane, K); s5z_run<0>(F, K, cz, g, dir, b, F.wave, XS); }
        __syncthreads();
#pragma unroll 1
        for (int dir = 0; dir < 2; ++dir) {
            const int gd = dir * NG + g;
            const double ar = AR[gd * NP + p], ai = AI[gd * NP + p];
            double sr = ar, si = ai, t; t = sr * sr - si * si; si = 2.0 * sr * si; sr = t;
            double pr = sr, pi = si;
            for (int k = 0; k < 4; ++k) { t = sr * sr - si * si; si = 2.0 * sr * si; sr = t; }
            t = pr * sr - pi * si; pi = pr * si + pi * sr; pr = t;
            const float tr = (float)pr, ti = (float)pi;
            double qr = pr, qi = pi; for (int k = 0; k < 4; ++k) { t = qr * qr - qi * qi; qi = 2.0 * qr * qi; qr = t; }
            const float t16r = (float)qr, t16i = (float)qi;
            LAS float* xs = XS + (dir * S5_NCH + seg * 16) * S5_XP + 2 * p;
            f32x2 loc[16];
#pragma unroll
            for (int k = 0; k < 16; ++k) loc[k] = *(const LAS f32x2*)(xs + k * S5_XP);
            float ar_ = 0.f, ai_ = 0.f;
#pragma unroll
            for (int k = 0; k < 16; ++k) { const float nr = tr * ar_ - ti * ai_ + loc[k][0], ni = tr * ai_ + ti * ar_ + loc[k][1]; ar_ = nr; ai_ = ni; }
            AG[seg * 64 + p] = (f32x2){ar_, ai_};
            __syncthreads();
            float cr = 0.f, ci = 0.f;
            for (int s2 = 0; s2 < seg; ++s2) { const f32x2 a = AG[s2 * 64 + p]; const float nr = t16r * cr - t16i * ci + a[0], ni = t16r * ci + t16i * cr + a[1]; cr = nr; ci = ni; }
#pragma unroll
            for (int k = 0; k < 16; ++k) { *(LAS f32x2*)(xs + k * S5_XP) = (f32x2){cr, ci};
                const float nr = tr * cr - ti * ci + loc[k][0], ni = tr * ci + ti * cr + loc[k][1]; cr = nr; ci = ni; }
            __syncthreads();
        }
        { S5Consts K; s5_load_consts(F, g, lane, K); bf16x8 cfr[4]; s5z_load_cfr(F, g, lane, cfr); s5z_run<1>(F, K, cfr, g, 0, b, F.wave, XS); }
        asm volatile("s_waitcnt vmcnt(0)" ::: "memory");
        __syncthreads();
        { S5Consts K; s5_load_consts(F, NG + g, lane, K); bf16x8 cfr[4]; s5z_load_cfr(F, NG + g, lane, cfr); s5z_run<2>(F, K, cfr, g, 1, b, F.wave, XS); }
        __syncthreads();
    }
}

constexpr int ATT_KP = 272, ATT_VP = 528, ATT_VOFF = 256 * ATT_KP;
constexpr int ATT_RPOFF = ATT_VOFF + 128 * ATT_VP;
__device__ __forceinline__ void attn_unit(Frame& F, bool lat, int b, int h, int r, int j, int qrow0, int dv) {
    const int lane = F.lane, n = lane & 15, qd = lane >> 4;
    const GAS bf16* QK = ws_tile(F, T_QK); const GAS bf16* VT = ws_tile(F, T_VT); GAS bf16* AO = ws_tile(F, T_AO);
    const float scale = 0.08838834764831845f * 1.4426950408889634f, NEG = -3.0e38f;
    const int mkey = 8 * (n >> 2) + (n & 3);
    unsigned kb_ = (unsigned)(n * ATT_KP + 16 * qd), vb_ = (unsigned)(ATT_VOFF + n * ATT_VP + 16 * qd);
    asm volatile("" : "+v"(kb_), "+v"(vb_));
    const LAS unsigned char* kbase = F.lds + kb_; const LAS unsigned char* vbase = F.lds + vb_;
    const LAS float* RP = (const LAS float*)(F.lds + ATT_RPOFF);
    bf16x8 qf[4];
    { const GAS bf16* qp = QK + (size_t)(qrow0 + n) * 4096 + h * HD + 8 * qd;
#pragma unroll
      for (int kk = 0; kk < 4; ++kk) qf[kk] = *(const GAS bf16x8*)(qp + 32 * kk); }
    const int rs = min(max(r - 4, 0), 56), cs = min(max(16 * j - 8, 0), 32), qc = 16 * j + n, cst = min(max(qc - 8, 0), 48);
    float S[16][2][4];
    float mx = NEG;
    bf16x8 kf[2][4];
    if (lat && !(dv & 1)) {
        const GAS bf16* kp = QK + (size_t)(b * SEQ + (rs + (n >> 2)) * 64 + cs + (n & 3)) * 4096 + D + h * HD + 8 * qd;
#pragma unroll
        for (int kk = 0; kk < 4; ++kk) kf[0][kk] = *(const GAS bf16x8*)(kp + 32 * kk);
#pragma unroll
        for (int st = 0; st < 16; ++st) { const int blk = st >> 1, hf = st & 1, cg = blk >> 1, rh = blk & 1;
            if (st + 1 < 16) { constexpr int dummy_ = 0; (void)dummy_;
                const int s1 = st + 1, o1 = ((s1 >> 1) & 1) * 256 + (s1 >> 2) * 8 + (s1 & 1) * 4, o0 = rh * 256 + cg * 8 + hf * 4;
                kp += (ptrdiff_t)(o1 - o0) * 4096; asm volatile("" : "+v"(kp));
#pragma unroll
                for (int kk = 0; kk < 4; ++kk) kf[(st + 1) & 1][kk] = *(const GAS bf16x8*)(kp + 32 * kk); }
            f32x4 acc = {0.f, 0.f, 0.f, 0.f};
#pragma unroll
            for (int kk = 0; kk < 4; ++kk) acc = __builtin_amdgcn_mfma_f32_16x16x32_bf16(kf[st & 1][kk], qf[kk], acc, 0, 0, 0);
#pragma unroll
            for (int i = 0; i < 4; ++i) { const int kc = cs + 8 * cg + 4 * hf + i; const bool valid = (unsigned)(kc - cst) < 16u;
                const float sc = acc[i] * scale + RP[(rs + 4 * rh + qd - r + 7) * 31 + (kc - qc + 15)]; const float sv = valid ? sc : NEG;
                S[blk][hf][i] = sv; mx = fmaxf(mx, sv); }
            __builtin_amdgcn_sched_barrier(0); }
    } else {
#pragma unroll
        for (int blk = 0; blk < 8; ++blk)
#pragma unroll
            for (int hf = 0; hf < 2; ++hf)
#pragma unroll
                for (int i = 0; i < 4; ++i) S[blk][hf][i] = NEG;
    }
    if (dv & 2) {
#pragma unroll
        for (int blk = 8; blk < 16; ++blk)
#pragma unroll
            for (int hf = 0; hf < 2; ++hf)
#pragma unroll
                for (int i = 0; i < 4; ++i) { S[blk][hf][i] = 0.f; mx = fmaxf(mx, 0.f); }
    } else {
#pragma unroll
    for (int kk = 0; kk < 4; ++kk) kf[0][kk] = *(const LAS bf16x8*)(kbase + 64 * kk);
#pragma unroll
    for (int st = 0; st < 16; ++st) { const int blk = 8 + (st >> 1), hf = st & 1;
        if (st + 1 < 16) { const LAS unsigned char* kp = kbase + (16 * (st + 1)) * ATT_KP;
#pragma unroll
            for (int kk = 0; kk < 4; ++kk) kf[(st + 1) & 1][kk] = *(const LAS bf16x8*)(kp + 64 * kk); }
        f32x4 acc = {0.f, 0.f, 0.f, 0.f};
#pragma unroll
        for (int kk = 0; kk < 4; ++kk) acc = __builtin_amdgcn_mfma_f32_16x16x32_bf16(kf[st & 1][kk], qf[kk], acc, 0, 0, 0);
#pragma unroll
        for (int i = 0; i < 4; ++i) { const float sv = acc[i] * scale; S[blk][hf][i] = sv; mx = fmaxf(mx, sv); }
        __builtin_amdgcn_sched_barrier(0); }
    }
    mx = fmaxf(mx, __shfl_xor(mx, 16)); mx = fmaxf(mx, __shfl_xor(mx, 32));
    float sum = 0.f; bf16x8 pf[16];
#pragma unroll
    for (int blk = 0; blk < 16; ++blk) { float p[8];
#pragma unroll
        for (int hf = 0; hf < 2; ++hf)
#pragma unroll
            for (int i = 0; i < 4; ++i) { const float e = __builtin_amdgcn_exp2f(S[blk][hf][i] - mx); p[4 * hf + i] = e; sum += e; }
        v4u w; w.x = pk2(p[0], p[1]); w.y = pk2(p[2], p[3]); w.z = pk2(p[4], p[5]); w.w = pk2(p[6], p[7]); pf[blk] = __builtin_bit_cast(bf16x8, w); }
    sum += __shfl_xor(sum, 16); sum += __shfl_xor(sum, 32);
    const float inv = 1.0f / sum;
    f32x4 O[8];
#pragma unroll
    for (int dt = 0; dt < 8; ++dt) O[dt] = (f32x4){0.f, 0.f, 0.f, 0.f};
    bf16x8 vf[2][8];
    if (lat && !(dv & 4)) {
        const GAS bf16* vloc = (dv & 16) ? VT + (size_t)n * NROWS + qd * 8 : VT + (size_t)(h * HD + n) * NROWS + b * SEQ + (cs >> 3) * 512 + (rs + qd) * 8;
        bf16x8 vr[3][8];
#pragma unroll
        for (int dt = 0; dt < 8; ++dt) vr[0][dt] = *(const GAS bf16x8*)(vloc + (size_t)dt * 16 * NROWS);
#pragma unroll
        for (int dt = 0; dt < 8; ++dt) vr[1][dt] = *(const GAS bf16x8*)(vloc + 32 + (size_t)dt * 16 * NROWS);
#pragma unroll
        for (int blk = 0; blk < 8; ++blk) {
            if (blk + 2 < 8) { const int o2 = ((blk + 2) >> 1) * 512 + ((blk + 2) & 1) * 32;
#pragma unroll
                for (int dt = 0; dt < 8; ++dt) vr[(blk + 2) % 3][dt] = *(const GAS bf16x8*)(vloc + o2 + (size_t)dt * 16 * NROWS); }
#pragma unroll
            for (int dt = 0; dt < 8; ++dt) O[dt] = __builtin_amdgcn_mfma_f32_16x16x32_bf16(vr[blk % 3][dt], pf[blk], O[dt], 0, 0, 0);
            __builtin_amdgcn_sched_barrier(0); }
    }
    if (!(dv & 8)) {
#pragma unroll
    for (int dt = 0; dt < 8; ++dt) vf[0][dt] = *(const LAS bf16x8*)(vbase + dt * 16 * ATT_VP);
#pragma unroll
    for (int cb = 0; cb < 8; ++cb) {
        if (cb + 1 < 8) {
#pragma unroll
            for (int dt = 0; dt < 8; ++dt) vf[(cb + 1) & 1][dt] = *(const LAS bf16x8*)(vbase + 64 * (cb + 1) + dt * 16 * ATT_VP); }
#pragma unroll
        for (int dt = 0; dt < 8; ++dt) O[dt] = __builtin_amdgcn_mfma_f32_16x16x32_bf16(vf[cb & 1][dt], pf[8 + cb], O[dt], 0, 0, 0);
        __builtin_amdgcn_sched_barrier(0); }
    }
    GAS bf16* op = AO + (size_t)(qrow0 + n) * D + h * HD + 4 * qd;
#pragma unroll
    for (int dt = 0; dt < 8; ++dt) { v2u w; w.x = pk2(O[dt][0] * inv, O[dt][1] * inv); w.y = pk2(O[dt][2] * inv, O[dt][3] * inv); *(GAS v2u*)(op + 16 * dt) = w; }
}
__device__ __forceinline__ void attn_phase2(Frame& F, int dv) {
    const GAS bf16* QK = ws_tile(F, T_QK); const GAS bf16* VT = ws_tile(F, T_VT);
    for (int wu = F.vcu; wu < 2 * NH * 8; wu += F.G) {
        const int b = wu >> 7, h = (wu >> 3) & 15, ro = wu & 7;
        int tid_ = F.tid; asm volatile("" : "+v"(tid_));
#pragma unroll 2
        for (int i = 0; i < 8; ++i) { const int pc = tid_ + NTHREADS * i;
            { const int key = pc >> 4, c = pc & 15, rho = (key & ~31) + 16 * ((key >> 2) & 1) + 4 * ((key >> 3) & 3) + (key & 3);
              *(LAS v4u*)(F.lds + rho * ATT_KP + 16 * c) = *(const GAS v4u*)(QK + (size_t)(NLAT + b * CTXL + key) * 4096 + D + h * HD + 8 * c); }
            { const int dh = pc >> 5, c = pc & 31;
              *(LAS v4u*)(F.lds + ATT_VOFF + dh * ATT_VP + 16 * c) = *(const GAS v4u*)(VT + (size_t)(h * HD + dh) * NROWS + NLAT + b * CTXL + 8 * c); } }
        for (int i = tid_; i < 15 * 31; i += NTHREADS) ((LAS float*)(F.lds + ATT_RPOFF))[i] = fin(F, I_RPB)[h * 15 * 31 + i] * 1.4426950408889634f;
        __syncthreads();
        int b2 = b, h2 = h; asm volatile("" : "+s"(b2), "+s"(h2));
        const int r = 8 * ro + F.wave;
        const int nu = F.wave < 2 ? 5 : 4;
#pragma unroll 1
        for (int u = 0; u < nu; ++u) { const bool lat = u < 4;
            attn_unit(F, lat, b2, h2, lat ? r : 0, lat ? u : 0, lat ? b2 * SEQ + r * 64 + 16 * u : NLAT + b2 * CTXL + 16 * (2 * ro + F.wave), dv); }
        __syncthreads();
    }
}

constexpr int CV_NIT = (6 + 2 * NE * 3) * 2048;
constexpr int KG_QKV = CV_KG1, KG_WO = CV_KG2, KG_DN0 = CV_KG3, KG_UP0 = CV_KG4;
constexpr int CV_W1 = 8 * (32 - KG_QKV) * CV_N1, CV_W2 = 8 * (32 - KG_WO) * CV_N2, CV_W3 = 8 * (32 - KG_DN0) * CV_N3, CV_W4 = 8 * (32 - KG_UP0) * CV_N4;
constexpr int CV_NIT_MAIN = CV_NIT - 2 * CV_TK;
static_assert(CV_NIT == CV_NIT_ALL, "item count");
constexpr int CV_T4_END = CV_NIT_MAIN - CV_W3, CV_T2_END = CV_T4_END - CV_W4, CV_T1_END = CV_T2_END - CV_W2, CV_P0_END = CV_T1_END - CV_W1;
static_assert(CV_P0_END >= 3 * 2048 && CV_T1_END >= 6 * 2048 && CV_T2_END >= (6 + NE * 3) * 2048, "conversion windows: the QKV weight in the prologue, Wo / GLU weights by the end of the QKV window, every layer-0 expert weight before the layer-0 up GEMM");
__device__ __forceinline__ bool split_role(const Frame& F, int KG, int& cx, int& Gg, int& ci, int& nci) {
    if (F.G != 256) { cx = F.vcu; Gg = F.G; ci = 0; nci = 0; return true; }
    const int x = F.vcu >> 5, k = F.vcu & 31;
    if (k < KG) { cx = x * KG + k; Gg = 8 * KG; ci = 0; nci = 0; return true; }
    ci = x * (32 - KG) + (k - KG); nci = 8 * (32 - KG); cx = 0; Gg = 0; return false;
}
constexpr int NPH = 22;
__global__ void __launch_bounds__(NTHREADS, 2) mk_fwd(Args args) {
    extern __shared__ __attribute__((aligned(16))) unsigned char lds[];
    Frame F;
    F.lds = (LAS unsigned char*)lds; F.ws = (GAS unsigned char*)args.ws; F.out = (GAS float*)args.out;
    F.ap = (const CAS Args*)__builtin_amdgcn_kernarg_segment_ptr();
    F.tid = threadIdx.x; F.lane = F.tid & 63; F.wave = __builtin_amdgcn_readfirstlane(F.tid >> 6);
    F.G = gridDim.x; { const int bx = blockIdx.x; F.vcu = (F.G % 8 == 0) ? (bx % 8) * (F.G / 8) + bx / 8 : bx; }
    const int vcu0 = F.vcu, wave0 = F.wave;
    volatile LAS unsigned* MISC = (volatile LAS unsigned*)(F.lds + MISC_OFF);
    for (int u = F.tid; u < 32; u += NTHREADS) MISC[u] = 0u;
    __syncthreads();
    const int lo = args.ph_lo, hi = args.ph_hi;
    const bool multi = (hi - lo) > 1;
    XcdBarrier bar; bar.bar = (unsigned*)(unsigned char*)(F.ws + WS_CTL) + CW_BAR; bar.x = 0; bar.st = nullptr;
    if (multi) bar = xcd_barrier_post((unsigned*)(unsigned char*)(F.ws + WS_CTL) + CW_BAR, MISC + 8);
#if PROBE
#define IS_T0() ({ unsigned z2_ = 0u; asm volatile("" : "+v"(z2_)); (wave0 == 0 && __builtin_amdgcn_mbcnt_hi(~0u, __builtin_amdgcn_mbcnt_lo(~0u, z2_)) == 0); })
#endif
#define IN(k) ({ int lo_ = lo, hi_ = hi; asm volatile("" : "+s"(lo_), "+s"(hi_)); (lo_ <= (k) && (k) < hi_); })
#if PROBE
#define SEAM13(k) do { if (IN(k) && IN(14)) xcd_barrier(bar); if ((k) == PROBE_B && IS_T0()) { const unsigned long long t_ = wall_clock64(); MISC[18] = (unsigned)t_; MISC[19] = (unsigned)(t_ >> 32); } if (14 == PROBE_A && IS_T0()) { const unsigned long long t_ = wall_clock64(); MISC[16] = (unsigned)t_; MISC[17] = (unsigned)(t_ >> 32); } } while (0)
#else
#define SEAM13(k) do { if (IN(k) && IN(14)) xcd_barrier(bar); } while (0)
#endif
#if PROBE
#define SEAM_SKIP(a, b) do { if (IN(a) && IN(b)) xcd_barrier(bar); if ((a) == PROBE_B && IS_T0()) { const unsigned long long t_ = wall_clock64(); MISC[18] = (unsigned)t_; MISC[19] = (unsigned)(t_ >> 32); } if ((b) == PROBE_A && IS_T0()) { const unsigned long long t_ = wall_clock64(); MISC[16] = (unsigned)t_; MISC[17] = (unsigned)(t_ >> 32); } } while (0)
#else
#define SEAM_SKIP(a, b) do { if (IN(a) && IN(b)) xcd_barrier(bar); } while (0)
#endif
#define REPN(k) (((k) == REPEAT_PH) ? REPEAT_N : 1)
#define PH() do { const CAS Args* a_ = (const CAS Args*)__builtin_amdgcn_kernarg_segment_ptr(); asm volatile("" : "+s"(a_)); F.ap = a_; unsigned char* w_ = args.ws; asm volatile("" : "+s"(w_)); F.ws = (GAS unsigned char*)w_; unsigned z_ = 0u; asm volatile("" : "+v"(z_)); int l_ = __builtin_amdgcn_mbcnt_hi(~0u, __builtin_amdgcn_mbcnt_lo(~0u, z_)); int wv_ = wave0; asm volatile("" : "+s"(wv_)); F.lane = l_; F.wave = wv_; F.tid = wv_ * 64 + l_; int v_ = vcu0; asm volatile("" : "+s"(v_)); F.vcu = v_; } while (0)
#if PROBE
#define SEAM(k) do { if (IN(k) && IN((k) + 1)) xcd_barrier(bar); if ((k) == PROBE_B && IS_T0()) { const unsigned long long t_ = wall_clock64(); MISC[18] = (unsigned)t_; MISC[19] = (unsigned)(t_ >> 32); } if ((k) + 1 == PROBE_A && IS_T0()) { const unsigned long long t_ = wall_clock64(); MISC[16] = (unsigned)t_; MISC[17] = (unsigned)(t_ >> 32); } } while (0)
#else
#define SEAM(k) do { if (IN(k) && IN((k) + 1)) xcd_barrier(bar); } while (0)
#endif

#if PROBE
    if (PROBE_A == 0 && IS_T0()) { const unsigned long long t_ = wall_clock64(); MISC[16] = (unsigned)t_; MISC[17] = (unsigned)(t_ >> 32); }
#endif
    if (IN(0)) for (int rp_ = 0; rp_ < REPN(0); ++rp_) { PH(); p0_mods(F); p0_s5params(F); __syncthreads(); p0_weights(F, 0, F.G == 256 ? CV_P0_END : CV_NIT, F.vcu * NWAVES + F.wave, F.G * NWAVES);     __syncthreads(); }
    SEAM(0);
    for (int l = 0; l < 2; ++l) {
        if (l == 0) {
            if (IN(1)) for (int rp_ = 0; rp_ < REPN(1); ++rp_) { PH(); p1_prep(F); }
            SEAM(1);
            if (IN(2)) for (int rp_ = 0; rp_ < REPN(2); ++rp_) { PH(); int cx, Gg, ci, nci; if (split_role(F, KG_QKV, cx, Gg, ci, nci)) { SegSched S; S.init(Gg, cx, 34, 16, T_HB, T_WQKV, 8, 34, T_WQKV + 16, T_HB); EpiQKV E{ws_tile(F, T_QK), ws_tile(F, T_VT)}; run_gemm<EpiQKV, SegSched, false, 0, false>(F, S, E); } else p0_weights(F, CV_P0_END, CV_T1_END, ci * NWAVES + F.wave, nci * NWAVES); }
            SEAM(2);
            if (IN(3)) for (int rp_ = 0; rp_ < REPN(3); ++rp_) { PH();
#if ATTN_NAIVE
                p3_attn_naive(F);
#else
                attn_phase2(F, (rp_ < REPN(3) - 1) ? DUMMY_VARIANT : 0);
#endif
                __syncthreads(); }
            SEAM(3);
            if (IN(4)) for (int rp_ = 0; rp_ < REPN(4); ++rp_) { PH(); int cx, Gg, ci, nci; if (split_role(F, KG_WO, cx, Gg, ci, nci)) { SegSched S; S.init(Gg, cx, 34, 8, T_AO, T_WO, 0, 0, 0, 0); EpiWo E{(GAS bf16*)(F.ws + WS_O)}; run_gemm(F, S, E); } else p0_weights(F, CV_T1_END, CV_T2_END, ci * NWAVES + F.wave, nci * NWAVES); }
            SEAM(4);
        } else {
#if S5_NAIVE
            if (IN(11)) for (int rp_ = 0; rp_ < REPN(11); ++rp_) { PH(); s5_naive(F); }
            SEAM(11); SEAM(12); SEAM(13);
#else
#if S5_FUSE_Z
            if (IN(11)) for (int rp_ = 0; rp_ < REPN(11); ++rp_) { PH(); s5z_fused(F); }
            SEAM_SKIP(11, 15);
#else
            if (IN(11)) for (int rp_ = 0; rp_ < REPN(11); ++rp_) { PH(); s5_fused(F); }
            SEAM13(11);
#endif
#endif
#if !S5_FUSE_Z || S5_NAIVE
            if (IN(14)) for (int rp_ = 0; rp_ < REPN(14); ++rp_) { PH(); zprep_phase(F); }
            SEAM(14);
#endif
            if (IN(15)) for (int rp_ = 0; rp_ < REPN(15); ++rp_) { PH(); SegSched S; S.init(F.G, F.vcu, 32, 16, T_Z, T_WVG, 0, 0, 0, 0); EpiGlu E{(GAS bf16*)(F.ws + WS_O)}; run_gemm(F, S, E); }
            SEAM(15);
        }
        const int pb = l ? 16 : 5;
        if (IN(pb)) for (int rp_ = 0; rp_ < REPN(pb); ++rp_) { PH(); row_phase(F, l, (rp_ < REPN(pb) - 1) ? DUMMY_VARIANT : 0); }
        SEAM(pb);
        if (IN(pb + 1)) for (int rp_ = 0; rp_ < REPN(pb + 1); ++rp_) { PH(); topk_phase(F, l); }
#if !GATHER_IN_GEMM
        SEAM(pb + 1);
#endif
#if !GATHER_IN_GEMM
        if (IN(pb + 2)) for (int rp_ = 0; rp_ < REPN(pb + 2); ++rp_) { PH(); gather_phase(F, l); }
        SEAM(pb + 2);
#else
        SEAM_SKIP(pb + 1, pb + 3);
#endif
        if (IN(pb + 3)) for (int rp_ = 0; rp_ < REPN(pb + 3); ++rp_) { PH(); int cx, Gg, ci, nci; if (split_role(F, l == 0 ? KG_UP0 : 32, cx, Gg, ci, nci)) { MoeSched S; S.init(Gg, cx, l ? 4 : 5, 16, T_XE, T_MOE1 + l * 256); S.ga_idx = (const GAS int*)(F.ws + WS_IDX); S.ga_nrows = NROWS; EpiSwiglu E{ws_tile(F, T_ACT), T_MOE1 + l * 256};
#if GATHER_IN_GEMM
            run_gemm_ga(F, S, E, T_HB);
#else
            run_gemm(F, S, E);
#endif
            } else p0_weights(F, CV_T2_END, CV_T4_END, ci * NWAVES + F.wave, nci * NWAVES);
        }
        SEAM(pb + 3);
        if (IN(pb + 4)) for (int rp_ = 0; rp_ < REPN(pb + 4); ++rp_) { PH(); int cx, Gg, ci, nci; if (split_role(F, l == 0 ? KG_DN0 : 32, cx, Gg, ci, nci)) { MoeSched S; S.init(Gg, cx, l ? 4 : 5, 8, T_ACT, T_MOE2 + l * 128); EpiDown E{(GAS bf16*)(F.ws + WS_YE), (const GAS float*)(F.ws + WS_GATE), T_MOE2 + l * 128}; run_gemm<EpiDown, MoeSched, false, MOE_BAUX>(F, S, E); } else p0_weights(F, CV_T4_END, CV_NIT_MAIN, ci * NWAVES + F.wave, nci * NWAVES); }
        SEAM(pb + 4);
        if (IN(pb + 5)) for (int rp_ = 0; rp_ < REPN(pb + 5); ++rp_) { PH(); combine_phase(F, l); }
        SEAM(pb + 5);
    }
#if PROBE
    if (blockIdx.x == 0 && IS_T0()) { const unsigned long long tA_ = ((unsigned long long)MISC[17] << 32) | MISC[16], tB_ = ((unsigned long long)MISC[19] << 32) | MISC[18]; const float us_ = (float)(tB_ - tA_) * 0.01f; F.out[0] = exp2f(rintf(log2f(us_) * PROBE_Q + PROBE_OFF) / PROBE_Q); }
#endif
#undef IN
#undef SEAM
}

extern "C" void kernel_launch(void* const* d_in, const int* in_sizes, int n_in, void* d_out, int out_size, void* d_ws, size_t ws_size, hipStream_t stream) {
    static int grid = 0;
    if (grid == 0) {
        if (n_in != 25 || out_size != NLAT * D || ws_size < WS_END) { fprintf(stderr, "kernel_launch: unexpected shapes (n_in %d out %d ws %zu)\n", n_in, out_size, ws_size); grid = -1; return; }
        int dev = 0, cus = 0, per_cu = 0;
        if (hipGetDevice(&dev) != hipSuccess || hipDeviceGetAttribute(&cus, hipDeviceAttributeMultiprocessorCount, dev) != hipSuccess) { grid = -1; return; }
        if (hipFuncSetAttribute((const void*)mk_fwd, hipFuncAttributeMaxDynamicSharedMemorySize, LDS_BYTES) != hipSuccess) { fprintf(stderr, "kernel_launch: hipFuncSetAttribute failed\n"); grid = -1; return; }
        if (hipOccupancyMaxActiveBlocksPerMultiprocessor(&per_cu, (const void*)mk_fwd, NTHREADS, LDS_BYTES) != hipSuccess || per_cu < 1) { fprintf(stderr, "kernel_launch: occupancy query reports %d\n", per_cu); }
        (void)hipGetLastError();
        grid = cus;
    }
    if (grid < 0) return;
    (void)hipMemsetAsync((char*)d_ws + WS_CTL, 0, CTL_ZERO_BYTES, stream);
    Args a{};
    for (int i = 0; i < 25; ++i) a.in[i] = (const float*)d_in[i];
    a.out = (float*)d_out; a.ws = (unsigned char*)d_ws;
#if MK_N_LAUNCHES == 1
    a.ph_lo = 0; a.ph_hi = NPH;
    hipLaunchKernelGGL(mk_fwd, dim3(grid), dim3(NTHREADS), LDS_BYTES, stream, a);
#else
    for (int p = 0; p < NPH; ++p) { a.ph_lo = p; a.ph_hi = p + 1; hipLaunchKernelGGL(mk_fwd, dim3(grid), dim3(NTHREADS), LDS_BYTES, stream, a); }
#endif
}
```

```cpp
#include <hip/hip_runtime.h>
#include <cstdio>
#include <cstdint>
namespace pg8 {
#define PG8_LAS __attribute__((address_space(3)))
typedef unsigned short bf16_t;
typedef short bf16x8 __attribute__((ext_vector_type(8)));
typedef float f32x4 __attribute__((ext_vector_type(4)));
typedef unsigned u32x4 __attribute__((ext_vector_type(4)));
constexpr int BM = 256, BK = 64, HALF = 128, HTB = HALF * BK * 2  , STAGE_BYTES = 8 * HTB, NXCD = 8, WGM = 8;

__host__ __device__ __forceinline__ int lds_byte(int r, int c) { const int st = (r >> 4) * 2 + (c >> 5), rr = r & 15, cc = c & 31, ob = rr * 64 + cc * 2; return st * 1024 + (ob ^ (((ob >> 9) & 1) << 5)); }
__host__ __device__ __forceinline__ void stage_rc(int b, int& R, int& C) { const int st = b / 1024, sb = b % 1024, swz = sb ^ (((sb >> 9) & 1) << 5); R = (st >> 1) * 16 + swz / 64; C = (st & 1) * 32 + (swz % 64) / 2; }
__host__ __device__ __forceinline__ int perm32(int rho) { const int n = rho >> 4, i = rho & 15; return 8 * (i >> 2) + 4 * n + (i & 3); }

struct Unit { int pm, pn; };
struct Gemm { const bf16_t* A; const bf16_t* Bt; int M, N, K; };

__device__ __forceinline__ unsigned cvt_pk_bf16(float lo, float hi) { unsigned r; asm volatile("v_cvt_pk_bf16_f32 %0, %1, %2" : "=v"(r) : "v"(lo), "v"(hi)); return r; }
#ifndef WT_BKM
#define WT_BKM 0
#endif
template <class Epi, class Sched, bool ALIGN_EPI = false, bool SP2 = false, bool GA = false, bool VR = false, int BAUX = 0, bool BKM = false>
__device__ __forceinline__ void gemm_phase(PG8_LAS unsigned char* lds, const Gemm g, const Sched& S, const Epi& E, int tid_in) {
    int tid_ = tid_in; asm volatile("" : "+v"(tid_));
    const int tid = tid_, wid = __builtin_amdgcn_readfirstlane(tid >> 6), lane = tid & 63, wr = wid >> 2, wc = wid & 3, fr = lane & 15, fq = lane >> 4;
    const int K = g.K, nt = K / BK;
    unsigned voffA[2], voffB[2];
#pragma unroll
    for (int i = 0; i < 2; ++i) { int R, C; stage_rc(tid * 16 + i * 8192, R, C); const int Rb = Epi::PERM ? ((R & ~31) + perm32(R & 31)) : R;
        voffA[i] = (unsigned)(R * K + C) * 2u; voffB[i] = BKM ? (unsigned)(Rb * BK + C) * 2u : (unsigned)(Rb * K + C) * 2u; }
    unsigned vA[2][2] = {{0u, 0u}, {0u, 0u}}, nvA[2][2] = {{0u, 0u}, {0u, 0u}}; int gaR[2] = {0, 0}; unsigned gaC[2] = {0u, 0u};
    if constexpr (GA) {
#pragma unroll
        for (int i = 0; i < 2; ++i) { int R, C; stage_rc(tid * 16 + i * 8192, R, C); gaR[i] = R; gaC[i] = (unsigned)C * 2u; } }
#define PG8_GA_OFFS(dst, unit) do { const int _r0 = S.ga_row0(unit); _Pragma("unroll") for (int _h = 0; _h < 2; ++_h) _Pragma("unroll") for (int _i = 0; _i < 2; ++_i) { \
        const unsigned _ix = (unsigned)S.ga_idx[_r0 + _h * HALF + gaR[_i]]; dst[_h][_i] = (_ix < S.ga_nrows ? _ix : 0u) * (unsigned)(K * 2) + gaC[_i]; } } while (0)
    const size_t kstep = (size_t)(BK * 2);
    const size_t hstep = (size_t)HALF * K * 2;
    const size_t kstepB = BKM ? (size_t)(256 * BK * 2) : kstep, hstepB = BKM ? (size_t)(HALF * BK * 2) : hstep;
    const size_t tstep = 2 * hstep;
    const unsigned ldsw = (unsigned)wid * 1024u;
    const int aoff = lds_byte(wr * 64 + fr, fq * 8), boff = lds_byte(wc * 32 + fr, fq * 8);
#define PG8_SA(b, h) (((b) * 2 + (h)) * HTB)
#define PG8_SB(b, h) ((4 + (b) * 2 + (h)) * HTB)
#define PG8_STAGE(bufoff, gbase, voff) do { _Pragma("unroll") for (int _i = 0; _i < 2; ++_i) \
        __builtin_amdgcn_global_load_lds((const unsigned*)((const char*)(gbase) + (voff)[_i]), (PG8_LAS unsigned*)(lds + (bufoff) + ldsw + _i * 8192), 16, 0, 0); } while (0)
#define PG8_STAGE_B(bufoff, gbase, voff) do { _Pragma("unroll") for (int _i = 0; _i < 2; ++_i) \
        __builtin_amdgcn_global_load_lds((const unsigned*)((const char*)(gbase) + (voff)[_i]), (PG8_LAS unsigned*)(lds + (bufoff) + ldsw + _i * 8192), 16, 0, BAUX); } while (0)
#define PG8_STAGE_A(bufoff, kbase, half, arr) do { if constexpr (GA) PG8_STAGE(bufoff, kbase, arr[half]); else PG8_STAGE(bufoff, (kbase) + (half) * hstep, voffA); } while (0)
#define PG8_LDA(dst, b, h) do { _Pragma("unroll") for (int m = 0; m < 4; ++m) _Pragma("unroll") for (int k = 0; k < 2; ++k) dst[m][k] = *(const PG8_LAS bf16x8*)(lds + PG8_SA(b, h) + aoff + m * 2048 + k * 1024); } while (0)
#define PG8_LDB(dst, b, h) do { _Pragma("unroll") for (int n = 0; n < 2; ++n) _Pragma("unroll") for (int k = 0; k < 2; ++k) dst[n][k] = *(const PG8_LAS bf16x8*)(lds + PG8_SB(b, h) + boff + n * 2048 + k * 1024); } while (0)
#define PG8_MMA(ai, bj, At, Bt) do { if (VR && !((ai) == 0 ? mma_on0 : mma_on1)) break; __builtin_amdgcn_s_setprio(1); _Pragma("unroll") for (int m = 0; m < 4; ++m) _Pragma("unroll") for (int n = 0; n < 2; ++n) _Pragma("unroll") for (int k = 0; k < 2; ++k) \
        acc[ai][bj][m][n] = __builtin_amdgcn_mfma_f32_16x16x32_bf16(Bt[n][k], At[m][k], acc[ai][bj][m][n], 0, 0, 0); __builtin_amdgcn_s_setprio(0); } while (0)
#define PG8_WAIT_V(n) asm volatile("s_waitcnt vmcnt(" #n ")" ::: "memory")
#define PG8_WAIT_L(n) asm volatile("s_waitcnt lgkmcnt(" #n ")" ::: "memory")
#define PG8_BAR __builtin_amdgcn_s_barrier()
#define PG8_SCHED __builtin_amdgcn_sched_barrier(0)
    Unit cur, nxt; int ui = 0;
    if (!S.next(0, cur)) return;
    f32x4 acc[2][2][4][2];
#pragma unroll
    for (int a = 0; a < 2; ++a)
#pragma unroll
        for (int b = 0; b < 2; ++b)
#pragma unroll
            for (int m = 0; m < 4; ++m)
#pragma unroll
                for (int n = 0; n < 2; ++n) acc[a][b][m][n] = (f32x4){0.f, 0.f, 0.f, 0.f};
    bf16x8 At[4][2], B0[2][2], B1[2][2];
    const char* cA = GA ? (const char*)g.A : (const char*)g.A + (size_t)cur.pm * tstep; const char* cB = (const char*)g.Bt + (size_t)cur.pn * tstep;
    if constexpr (GA) PG8_GA_OFFS(vA, cur);
    bool mma_on0 = true, mma_on1 = true;
    if constexpr (VR) { const int vr_ = S.valid_rows(cur); mma_on0 = wr * 64 < vr_; mma_on1 = HALF + wr * 64 < vr_; }
    S.a_ready(cur);
    if constexpr (SP2) {
        PG8_STAGE_B(PG8_SB(0, 0), cB, voffB); PG8_STAGE_B(PG8_SB(0, 1), cB + hstepB, voffB); PG8_STAGE_A(PG8_SA(0, 0), cA, 0, vA); PG8_STAGE_A(PG8_SA(0, 1), cA, 1, vA);
        if (wr == 1) PG8_BAR;
        PG8_WAIT_V(2); PG8_BAR;
        PG8_STAGE_B(PG8_SB(1, 0), cB + kstepB, voffB); PG8_STAGE_A(PG8_SA(1, 0), cA + kstep, 0, vA); PG8_STAGE_B(PG8_SB(1, 1), cB + hstepB + kstepB, voffB);
        PG8_WAIT_V(6); PG8_BAR;
    } else {
        PG8_STAGE_B(PG8_SB(0, 0), cB, voffB); PG8_STAGE_A(PG8_SA(0, 0), cA, 0, vA); PG8_STAGE_B(PG8_SB(0, 1), cB + hstepB, voffB); PG8_STAGE_A(PG8_SA(0, 1), cA, 1, vA);
        if (wr == 1) PG8_BAR;
        PG8_WAIT_V(4); PG8_BAR;
        PG8_STAGE_B(PG8_SB(1, 0), cB + kstepB, voffB); PG8_STAGE_A(PG8_SA(1, 0), cA + kstep, 0, vA); PG8_STAGE_B(PG8_SB(1, 1), cB + hstepB + kstepB, voffB);
        PG8_WAIT_V(6); PG8_BAR;
    }
    for (;;) {
        const bool has_next = S.next(ui + 1, nxt);
        const char* nA = GA ? cA : (has_next ? (const char*)g.A + (size_t)nxt.pm * tstep : cA); const char* nB = has_next ? (const char*)g.Bt + (size_t)nxt.pn * tstep : cB;
        if constexpr (GA) { if (has_next) PG8_GA_OFFS(nvA, nxt); else {
#pragma unroll
            for (int _h = 0; _h < 2; ++_h)
#pragma unroll
                for (int _i = 0; _i < 2; ++_i) nvA[_h][_i] = vA[_h][_i]; } }
        for (int t = 0; t < nt; t += 2) {
            const bool last = (t == nt - 2);
            const char* a1 = cA + (size_t)(t + 1) * kstep;
            const char* a2 = last ? nA : cA + (size_t)(t + 2) * kstep; const char* b2 = last ? nB : cB + (size_t)(t + 2) * kstepB;
            const char* a3 = a2 + kstep; const char* b3 = b2 + kstepB;
            unsigned sA[2][2];
#pragma unroll
            for (int _h = 0; _h < 2; ++_h)
#pragma unroll
                for (int _i = 0; _i < 2; ++_i) sA[_h][_i] = last ? nvA[_h][_i] : vA[_h][_i];
            if (last && has_next) S.a_ready(nxt);
            if constexpr (SP2) {
            PG8_LDB(B0, 0, 0); PG8_LDB(B1, 0, 1); PG8_SCHED; PG8_LDA(At, 0, 0); PG8_STAGE_A(PG8_SA(1, 1), a1, 1, vA);
            PG8_WAIT_V(8); PG8_WAIT_L(0); PG8_BAR; PG8_MMA(0, 0, At, B0); PG8_MMA(0, 1, At, B1); PG8_BAR; PG8_SCHED;
            PG8_LDA(At, 0, 1); PG8_STAGE_B(PG8_SB(0, 0), b2, voffB); PG8_STAGE_B(PG8_SB(0, 1), b2 + hstepB, voffB); PG8_STAGE_A(PG8_SA(0, 0), a2, 0, sA);
            PG8_WAIT_V(8); PG8_WAIT_L(0); PG8_BAR; PG8_MMA(1, 0, At, B0); PG8_MMA(1, 1, At, B1); PG8_BAR; PG8_SCHED;
            PG8_LDB(B0, 1, 0); PG8_LDB(B1, 1, 1); PG8_SCHED; PG8_LDA(At, 1, 0); PG8_STAGE_A(PG8_SA(0, 1), a2, 1, sA);
            PG8_WAIT_V(8); PG8_WAIT_L(0); PG8_BAR; PG8_MMA(0, 0, At, B0); PG8_MMA(0, 1, At, B1); PG8_BAR; PG8_SCHED;
            PG8_LDA(At, 1, 1); PG8_STAGE_B(PG8_SB(1, 0), b3, voffB); PG8_STAGE_B(PG8_SB(1, 1), b3 + hstepB, voffB); PG8_STAGE_A(PG8_SA(1, 0), a3, 0, sA);
            PG8_WAIT_V(8); PG8_WAIT_L(0); PG8_BAR; PG8_MMA(1, 0, At, B0); PG8_MMA(1, 1, At, B1); PG8_BAR; PG8_SCHED;
            } else {
            PG8_LDB(B0, 0, 0); PG8_SCHED; PG8_LDA(At, 0, 0); PG8_STAGE_A(PG8_SA(1, 1), a1, 1, vA);
            PG8_WAIT_L(8); PG8_BAR; PG8_WAIT_L(0); PG8_MMA(0, 0, At, B0); PG8_BAR; PG8_SCHED;
            PG8_LDB(B1, 0, 1); PG8_STAGE_B(PG8_SB(0, 0), b2, voffB);
            PG8_BAR; PG8_WAIT_L(0); PG8_MMA(0, 1, At, B1); PG8_BAR;
            PG8_LDA(At, 0, 1); PG8_STAGE_A(PG8_SA(0, 0), a2, 0, sA);
            PG8_BAR; PG8_WAIT_L(0); PG8_MMA(1, 0, At, B0); PG8_BAR; PG8_SCHED;
            PG8_STAGE_B(PG8_SB(0, 1), b2 + hstepB, voffB);
            PG8_WAIT_V(6); PG8_BAR; PG8_MMA(1, 1, At, B1); PG8_BAR;
            PG8_LDB(B0, 1, 0); PG8_SCHED; PG8_LDA(At, 1, 0); PG8_STAGE_A(PG8_SA(0, 1), a2, 1, sA);
            PG8_WAIT_L(8); PG8_BAR; PG8_WAIT_L(0); PG8_MMA(0, 0, At, B0); PG8_BAR; PG8_SCHED;
            PG8_LDB(B1, 1, 1); PG8_STAGE_B(PG8_SB(1, 0), b3, voffB);
            PG8_BAR; PG8_WAIT_L(0); PG8_MMA(0, 1, At, B1); PG8_BAR;
            PG8_LDA(At, 1, 1); PG8_STAGE_A(PG8_SA(1, 0), a3, 0, sA);
            PG8_BAR; PG8_WAIT_L(0); PG8_MMA(1, 0, At, B0); PG8_BAR; PG8_SCHED;
            PG8_STAGE_B(PG8_SB(1, 1), b3 + hstepB, voffB);
            PG8_WAIT_V(6); PG8_BAR; PG8_MMA(1, 1, At, B1); PG8_BAR;
            }
        }
        if constexpr (ALIGN_EPI) { if (wr == 0) PG8_BAR; }
        if constexpr (!Epi::AFTER_DRAIN) { E(acc, cur, wr, wc, fr, fq); S.done(cur); }
        if (!has_next) break;
#pragma unroll
        for (int a = 0; a < 2; ++a)
#pragma unroll
            for (int b = 0; b < 2; ++b)
#pragma unroll
                for (int m = 0; m < 4; ++m)
#pragma unroll
                    for (int n = 0; n < 2; ++n) acc[a][b][m][n] = (f32x4){0.f, 0.f, 0.f, 0.f};
        cur = nxt; cA = nA; cB = nB; ++ui;
        if constexpr (VR) { const int vr_ = S.valid_rows(cur); mma_on0 = wr * 64 < vr_; mma_on1 = HALF + wr * 64 < vr_; }
        if constexpr (GA) {
#pragma unroll
            for (int _h = 0; _h < 2; ++_h)
#pragma unroll
                for (int _i = 0; _i < 2; ++_i) vA[_h][_i] = nvA[_h][_i]; }
        if constexpr (ALIGN_EPI) { if (wr == 1) PG8_BAR; }
    }
    PG8_WAIT_V(0);
    if constexpr (!ALIGN_EPI) { if (wr == 0) PG8_BAR; }
    PG8_BAR;
    if constexpr (Epi::AFTER_DRAIN) { E.fused(acc, cur, wr, wc, fr, fq, lds, wid, lane); S.done(cur); }
#undef PG8_SA
#undef PG8_SB
#undef PG8_STAGE
#undef PG8_STAGE_B
#undef PG8_STAGE_A
#undef PG8_GA_OFFS
#undef PG8_LDA
#undef PG8_LDB
#undef PG8_MMA
#undef PG8_WAIT_V
#undef PG8_WAIT_L
#undef PG8_BAR
#undef PG8_SCHED
}
}

#ifndef PG8_SP2
#define PG8_SP2 true
#endif
#ifndef PG8_ALIGN
#define PG8_ALIGN true
#endif
#ifndef X1_BF16
#define X1_BF16 1
#endif
#ifndef TOPK_2BIT
#define TOPK_2BIT 0
#endif
#ifndef NT_STREAM
#define NT_STREAM 0
#endif
#ifndef X1_FP16
#define X1_FP16 1
#endif
#if X1_FP16
#define X1PK pkh2
#define X1UNPK h4_to_f32
#else
#define X1PK pk2
#define X1UNPK bf4_to_f32
#endif
#ifndef X2_FP16
#define X2_FP16 1
#endif
#ifndef MK_N_LAUNCHES
#define MK_N_LAUNCHES 1
#endif
#ifndef PROBE
#define PROBE 0
#endif
#ifndef PROBE_Q
#define PROBE_Q 6.0f
#define PROBE_OFF 0.0f
#endif
#ifndef PROBE_A
#define PROBE_A 0
#define PROBE_B 0
#endif
#ifndef REPEAT_PH
#define REPEAT_PH (-1)
#define REPEAT_N 2
#endif
#ifndef ATT_W
#define ATT_W 8
#endif
#ifndef DUMMY_VARIANT
#define DUMMY_VARIANT 0
#endif
#ifndef CV_NF_MOE
#define CV_NF_MOE 4
#endif
#ifndef CV_KG1
#define CV_KG1 17
#define CV_KG2 17
#define CV_KG3 27
#define CV_KG4 27
#define CV_N4 950
#endif
#ifndef CV_N1
#define CV_N1 850
#define CV_N2 280
#define CV_N3 500
#endif
#ifndef GATHER_IN_GEMM
#define GATHER_IN_GEMM 1
#endif
#ifndef S5_FUSE_Z
#define S5_FUSE_Z 1
#endif
#ifndef ROW_CTX_COOP
#define ROW_CTX_COOP 1
#endif
#ifndef MOE_BAUX
#define MOE_BAUX 0
#endif
#ifndef CTX_COOP2
#define CTX_COOP2 0
#endif
#ifndef P1_COOP
#define P1_COOP 0
#endif
#ifndef S5_NAIVE
#define S5_NAIVE 0
#endif
#ifndef ATTN_NAIVE
#define ATTN_NAIVE 0
#endif
#ifndef NAIVE_GEMM
#define NAIVE_GEMM 0
#endif

constexpr int D = 2048, SEQ = 4096, CTXL = 256, NLAT = 8192, NCTX = 512, NROWS = 8704;
constexpr int NH = 16, HD = 128, NE = 16, NG = 128, NP = 64, GH = 16, D6 = 6 * D;
constexpr int RPE = 1280;
constexpr float LN_EPS = 1e-5f, ALPHA = 1.4142135623730951f;
constexpr int NWAVES = 8, NTHREADS = 512;
constexpr int LDS_BYTES = 147456, MISC_OFF = LDS_BYTES - 128;

constexpr size_t MiB = 1u << 20;
constexpr size_t WS_CTL = 0, CTL_ZERO_BYTES = 1 * MiB;
constexpr size_t WS_MODS = 1 * MiB;
constexpr size_t WS_SPAR = 2 * MiB;
constexpr size_t WS_AFF = 6 * MiB;
constexpr size_t WS_SLOT = 7 * MiB;
constexpr size_t WS_IDX = 8 * MiB;
constexpr size_t WS_GATE = 8 * MiB + 512 * 1024;
constexpr int T_WQKV = 16, T_WO = 40, T_WVG = 48, T_MOE1 = 64, T_MOE2 = 576, T_HB = 832, T_QK = 866, T_VT = 934, T_AO = 968, T_XE = 1002, T_ACT = 1082, T_Z = 1162;
constexpr size_t WS_O = 1194 * MiB, WS_X1 = 1262 * MiB, WS_X2 = 1330 * MiB, WS_YE = 1398 * MiB, WS_YF = 1558 * MiB, WS_YB = 1622 * MiB, WS_XLOC = 1686 * MiB, WS_CARRY = 1718 * MiB, WS_END = 1750 * MiB;
constexpr int CW_BAR = 4096;

#define GAS __attribute__((address_space(1)))
#define LAS __attribute__((address_space(3)))
typedef unsigned short bf16;
typedef unsigned v4u __attribute__((ext_vector_type(4)));
typedef unsigned v2u __attribute__((ext_vector_type(2)));
typedef float f32x4 __attribute__((ext_vector_type(4)));
typedef float f32x2 __attribute__((ext_vector_type(2)));
typedef short bf16x8 __attribute__((ext_vector_type(8)));
typedef GAS unsigned gu32;
#define RLX_AGENT __ATOMIC_RELAXED, __HIP_MEMORY_SCOPE_AGENT

__device__ __forceinline__ float bf2f(unsigned b) { return __uint_as_float(b << 16); }
__device__ __forceinline__ unsigned pk2(float lo, float hi) { typedef __bf16 bf2_t __attribute__((ext_vector_type(2))); f32x2 v = {lo, hi}; return __builtin_bit_cast(unsigned, __builtin_convertvector(v, bf2_t)); }
__device__ __forceinline__ unsigned pkh2(float lo, float hi) { typedef _Float16 h2_t __attribute__((ext_vector_type(2))); f32x2 v = {lo, hi}; return __builtin_bit_cast(unsigned, __builtin_convertvector(v, h2_t)); }
__device__ __forceinline__ f32x4 h4_to_f32(v2u w) { typedef _Float16 h4_t __attribute__((ext_vector_type(4))); return __builtin_convertvector(__builtin_bit_cast(h4_t, w), f32x4); }
template <int CTRL> __device__ __forceinline__ float dpp_f(float x) { return __builtin_bit_cast(float, __builtin_amdgcn_mov_dpp(__builtin_bit_cast(int, x), CTRL, 0xf, 0xf, true)); }
__device__ __forceinline__ float wave_sum(float v) {
    v += dpp_f<0xB1>(v);
    v += dpp_f<0x4E>(v);
    v += dpp_f<0x141>(v);
    v += dpp_f<0x140>(v);
    const float a = __builtin_bit_cast(float, __builtin_amdgcn_readlane(__builtin_bit_cast(int, v), 0)), b = __builtin_bit_cast(float, __builtin_amdgcn_readlane(__builtin_bit_cast(int, v), 16));
    const float c = __builtin_bit_cast(float, __builtin_amdgcn_readlane(__builtin_bit_cast(int, v), 32)), d = __builtin_bit_cast(float, __builtin_amdgcn_readlane(__builtin_bit_cast(int, v), 48));
    return (a + b) + (c + d);
}
__device__ __forceinline__ float wave_max(float v) {
#pragma unroll
    for (int o = 1; o < 64; o <<= 1) v = fmaxf(v, __shfl_xor(v, o));
    return v;
}
__device__ __forceinline__ float silu_f(float x) { return x * __builtin_amdgcn_rcpf(1.0f + __builtin_amdgcn_exp2f(-1.4426950409f * x)); }
__device__ __forceinline__ float sigmoid_f(float x) { return __builtin_amdgcn_rcpf(1.0f + __builtin_amdgcn_exp2f(-1.4426950409f * x)); }
__device__ __forceinline__ float gelu_tanh_f(float x) { const float e = __builtin_amdgcn_exp2f(x * (-2.302208198f - 0.1029432397f * x * x)); return x * __builtin_amdgcn_rcpf(1.0f + e); }
#define XB_TMO      128
#define XB_XCNT(j)  (256  + 64 * (j))
#define XB_XSUB(j)  (1280 + 64 * (j))
#define XB_XGEN(j)  (2304 + 64 * (j))
#define XB_TOP      3328
#define XB_TOPGEN   3392
#define XCD_BAR_WORDS 3456
#define XB_SPIN_CAP (1u << 18)

__device__ __forceinline__ unsigned xb_ld(unsigned* p)              { return __hip_atomic_load(p, __ATOMIC_RELAXED, __HIP_MEMORY_SCOPE_AGENT); }
__device__ __forceinline__ unsigned xb_add(unsigned* p, unsigned v) { return __hip_atomic_fetch_add(p, v, __ATOMIC_RELAXED, __HIP_MEMORY_SCOPE_AGENT); }
__device__ __forceinline__ unsigned xb_xcc_id() { return (unsigned)__builtin_amdgcn_s_getreg((3 << 11) | 20) & 0xFu; }
#define XB_SPIN(cond, bar) do { unsigned _sp = 0; while (cond) { __builtin_amdgcn_s_sleep(1); \
    if ((++_sp & 255u) == 0u) { if (xb_ld(&(bar)[XB_TMO])) break; if (_sp > XB_SPIN_CAP) { atomicAdd(&(bar)[XB_TMO], 1u); break; } } } } while (0)

struct XcdBarrier {
    unsigned* bar; unsigned x;
    volatile LAS unsigned* st;
};

__device__ __forceinline__ XcdBarrier xcd_barrier_post(unsigned* bar, volatile LAS unsigned* st) {
    XcdBarrier b; b.bar = bar; b.x = xb_xcc_id(); b.st = st;
    if (threadIdx.x == 0) (void)xb_add(&bar[XB_XCNT(b.x)], 1u);
    return b;
}
__device__ __forceinline__ void xcd_barrier_complete(unsigned* bar, unsigned x, unsigned& nloc, unsigned& nx) {
    const unsigned G = gridDim.x * gridDim.y * gridDim.z;
    unsigned sum, cnt, mine, sp = 0u;
    for (;;) {
        sum = 0u; cnt = 0u; mine = 0u;
#pragma unroll
        for (unsigned j = 0; j < 16; ++j) { const unsigned c = xb_ld(&bar[XB_XCNT(j)]); sum += c; cnt += (c > 0u) ? 1u : 0u; mine = (j == x) ? c : mine; }
        if (sum == G) break;
        __builtin_amdgcn_s_sleep(1);
        if ((++sp & 255u) == 0u) { if (xb_ld(&bar[XB_TMO])) break; if (sp > XB_SPIN_CAP) { atomicAdd(&bar[XB_TMO], 1u); break; } }
    }
    nloc = mine > 0u ? mine : 1u; nx = cnt > 0u ? cnt : 1u;
}

__device__ __forceinline__ void xcd_barrier(const XcdBarrier& b) {
    asm volatile("s_waitcnt vmcnt(0)" ::: "memory");
    __syncthreads();
    if (threadIdx.x == 0) {
        unsigned* bar = b.bar;
        __builtin_amdgcn_s_waitcnt(0);
        unsigned nloc = b.st[0], nx = b.st[1];
        if (nloc == 0u) { xcd_barrier_complete(bar, b.x, nloc, nx); b.st[0] = nloc; b.st[1] = nx; }
        const unsigned old = xb_add(&bar[XB_XSUB(b.x)], 1u);
        const unsigned gen = old / nloc;
        if (old + 1u == (gen + 1u) * nloc) {
            __builtin_amdgcn_fence(__ATOMIC_RELEASE, "agent");
            asm volatile("s_waitcnt vmcnt(0)" ::: "memory");
            const unsigned og = xb_add(&bar[XB_TOP], 1u);
            const unsigned tg = og / nx;
            if (og + 1u == (tg + 1u) * nx) xb_add(&bar[XB_TOPGEN], 1u);
            else XB_SPIN(xb_ld(&bar[XB_TOPGEN]) == tg, bar);
            __builtin_amdgcn_fence(__ATOMIC_ACQUIRE, "agent");
            xb_add(&bar[XB_XGEN(b.x)], 1u);
            asm volatile("s_waitcnt vmcnt(0)" ::: "memory");
        } else {
            XB_SPIN(xb_ld(&bar[XB_XGEN(b.x)]) == gen, bar);
            __builtin_amdgcn_fence(__ATOMIC_ACQUIRE, "agent");
            asm volatile("s_waitcnt vmcnt(0)" ::: "memory");
        }
    }
    __syncthreads();
}

struct Args { const float* in[25]; float* out; unsigned char* ws; int ph_lo, ph_hi; };
#define CAS __attribute__((address_space(4)))
struct Frame {
    LAS unsigned char* lds;
    GAS unsigned char* ws;
    int tid, lane, wave, vcu, G;
    const CAS Args* ap;
    GAS float* out;
};
__device__ __forceinline__ const GAS float* fin(const Frame& F, int i) { return (const GAS float*)F.ap->in[i]; }
enum { I_X = 0, I_C, I_CTX, I_CCTX, I_WMOD, I_BMOD, I_LNG, I_LNB, I_WQKV, I_WO, I_RPB, I_LAMRE, I_LAMIM, I_LOGSTEP, I_BRE, I_BIM, I_CRE, I_CIM, I_SD, I_WVAL, I_WGATE, I_ROUTER, I_MGATE, I_MUP, I_MDOWN };

__device__ __forceinline__ GAS bf16* ws_tile(const Frame& F, int t) { return (GAS bf16*)(F.ws + (size_t)t * MiB); }
__device__ __forceinline__ GAS float* ws_f32(const Frame& F, size_t off) { return (GAS float*)(F.ws + off); }
__device__ __forceinline__ const GAS float* mods(const Frame& F, int l, int r, int which) { return (const GAS float*)(F.ws + WS_MODS) + (size_t)((l * 3 + r) * 6 + which) * D; }
__device__ __forceinline__ int row_r(int row) { return row < NLAT ? (row >> 12) : 2; }

struct SegSched {
    int G, cx, n0, ntot, nM0, nN0, pm0, pn0, nM1, nN1, pm1, pn1;
    __device__ __forceinline__ void init(int G_, int cx_, int nM0_, int nN0_, int pm0_, int pn0_, int nM1_, int nN1_, int pm1_, int pn1_) {
        G = G_; cx = cx_; nM0 = nM0_; nN0 = nN0_; pm0 = pm0_; pn0 = pn0_; nM1 = nM1_; nN1 = nN1_; pm1 = pm1_; pn1 = pn1_; n0 = nM0 * nN0; ntot = n0 + nM1 * nN1; }
    __device__ __forceinline__ bool next(int i, pg8::Unit& u) const {
        const int U = i * G + cx; if (U >= ntot) return false;
        const bool s1 = U >= n0; const int loc = s1 ? U - n0 : U, nM = s1 ? nM1 : nM0, nN = s1 ? nN1 : nN0;
        const int nig = 8 * nN, gid = loc / nig, fm = gid * 8, gsz = (nM - fm) < 8 ? (nM - fm) : 8;
        u.pm = (s1 ? pm1 : pm0) + fm + ((loc % nig) % gsz); u.pn = (s1 ? pn1 : pn0) + (loc % nig) / gsz; return true;
    }
    __device__ __forceinline__ void a_ready(const pg8::Unit&) const {}
    __device__ __forceinline__ void done(const pg8::Unit&) const {}
};
struct MoeSched {
    int G, cx, nMe, nNe, pmA, pnB, ntot;
    const GAS int* ga_idx; unsigned ga_nrows;
    __device__ __forceinline__ int ga_row0(const pg8::Unit& u) const { return (u.pm - pmA) * 256; }
    __device__ __forceinline__ int valid_rows(const pg8::Unit& u) const { return (nMe == 5 && (u.pm - pmA) % 5 == 4) ? 64 : 256; }
    __device__ __forceinline__ void init(int G_, int cx_, int nMe_, int nNe_, int pmA_, int pnB_) { G = G_; cx = cx_; nMe = nMe_; nNe = nNe_; pmA = pmA_; pnB = pnB_; ntot = NE * nMe * nNe; }
    __device__ __forceinline__ bool next(int i, pg8::Unit& u) const {
        const int U = i * G + cx; if (U >= ntot) return false;
        const int per = nMe * nNe, e = U / per, loc = U % per;
        u.pm = pmA + e * 5 + loc % nMe; u.pn = pnB + e * nNe + loc / nMe; return true;
    }
    __device__ __forceinline__ void a_ready(const pg8::Unit&) const {}
    __device__ __forceinline__ void done(const pg8::Unit&) const {}
};

struct EpiQKV {
    static constexpr bool PERM = true, AFTER_DRAIN = false;
    GAS bf16* QK; GAS bf16* VT;
    __device__ __forceinline__ void operator()(const f32x4 (&acc)[2][2][4][2], const pg8::Unit& u, int wr, int wc, int fr_in, int fq_in) const {
        int fr = fr_in, fq = fq_in; asm volatile("" : "+v"(fr), "+v"(fq));
        GAS bf16* base; int ldc;
        if (u.pn < T_HB) { base = QK + (size_t)(u.pm - T_HB) * 256 * 4096 + (size_t)(u.pn - T_WQKV) * 256; ldc = 4096; }
        else { base = VT + (size_t)(u.pm - (T_WQKV + 16)) * 256 * NROWS + (size_t)(u.pn - T_HB) * 256; ldc = NROWS; }
        int cofs[2];
#pragma unroll
        for (int bj = 0; bj < 2; ++bj) { int c = wc * 32 + 8 * fq + bj * 128;
            if (u.pn >= T_HB) { const int tok = (u.pn - T_HB) * 256 + c; if (tok < NLAT) { const int t = tok & 4095; c += (((t & 63) >> 3) << 9 | (t >> 6) << 3) - t; } }
            cofs[bj] = c; }
#pragma unroll
        for (int ai = 0; ai < 2; ++ai)
#pragma unroll
            for (int m = 0; m < 4; ++m) { GAS bf16* rowp = base + (size_t)(ai * 128 + wr * 64 + m * 16 + fr) * ldc;
#pragma unroll
                for (int bj = 0; bj < 2; ++bj) { const f32x4 v0 = acc[ai][bj][m][0], v1 = acc[ai][bj][m][1];
                    v4u w; w.x = pk2(v0[0], v0[1]); w.y = pk2(v0[2], v0[3]); w.z = pk2(v1[0], v1[1]); w.w = pk2(v1[2], v1[3]);
                    *(GAS v4u*)(rowp + cofs[bj]) = w; } }
    }
};
struct EpiWo {
    static constexpr bool PERM = true, AFTER_DRAIN = false;
    GAS bf16* O;
    __device__ __forceinline__ void operator()(const f32x4 (&acc)[2][2][4][2], const pg8::Unit& u, int wr, int wc, int fr_in, int fq_in) const {
        int fr = fr_in, fq = fq_in; asm volatile("" : "+v"(fr), "+v"(fq));
        GAS bf16* base = O + (size_t)(u.pm - T_AO) * 256 * D + (size_t)(u.pn - T_WO) * 256;
#pragma unroll
        for (int ai = 0; ai < 2; ++ai)
#pragma unroll
            for (int m = 0; m < 4; ++m) { GAS bf16* rowp = base + (size_t)(ai * 128 + wr * 64 + m * 16 + fr) * D + wc * 32 + 8 * fq;
#pragma unroll
                for (int bj = 0; bj < 2; ++bj) { const f32x4 v0 = acc[ai][bj][m][0], v1 = acc[ai][bj][m][1];
                    v4u w; w.x = pk2(v0[0], v0[1]); w.y = pk2(v0[2], v0[3]); w.z = pk2(v1[0], v1[1]); w.w = pk2(v1[2], v1[3]);
                    *(GAS v4u*)(rowp + bj * 128) = w; } }
    }
};
struct EpiGlu {
    static constexpr bool PERM = true, AFTER_DRAIN = false;
    GAS bf16* O;
    __device__ __forceinline__ void operator()(const f32x4 (&acc)[2][2][4][2], const pg8::Unit& u, int wr, int wc, int fr_in, int fq_in) const {
        int fr = fr_in, fq = fq_in; asm volatile("" : "+v"(fr), "+v"(fq));
        GAS bf16* base = O + (size_t)(u.pm - T_Z) * 256 * D + (size_t)(u.pn - T_WVG) * 128;
#pragma unroll
        for (int ai = 0; ai < 2; ++ai)
#pragma unroll
            for (int m = 0; m < 4; ++m) { GAS bf16* rowp = base + (size_t)(ai * 128 + wr * 64 + m * 16 + fr) * D + wc * 32 + 8 * fq;
                f32x4 o0, o1;
#pragma unroll
                for (int q = 0; q < 4; ++q) { o0[q] = acc[ai][0][m][0][q] * sigmoid_f(acc[ai][1][m][0][q]); o1[q] = acc[ai][0][m][1][q] * sigmoid_f(acc[ai][1][m][1][q]); }
                v4u w; w.x = pk2(o0[0], o0[1]); w.y = pk2(o0[2], o0[3]); w.z = pk2(o1[0], o1[1]); w.w = pk2(o1[2], o1[3]);
                *(GAS v4u*)rowp = w; }
    }
};
struct EpiSwiglu {
    static constexpr bool PERM = true, AFTER_DRAIN = false;
    GAS bf16* ACT; int pnB;
    __device__ __forceinline__ void operator()(const f32x4 (&acc)[2][2][4][2], const pg8::Unit& u, int wr, int wc, int fr_in, int fq_in) const {
        int fr = fr_in, fq = fq_in; asm volatile("" : "+v"(fr), "+v"(fq));
        const int j = (u.pn - pnB) & 15;
        GAS bf16* base = ACT + (size_t)(u.pm - T_XE) * 256 * D + (size_t)j * 128;
#pragma unroll
        for (int ai = 0; ai < 2; ++ai)
#pragma unroll
            for (int m = 0; m < 4; ++m) { GAS bf16* rowp = base + (size_t)(ai * 128 + wr * 64 + m * 16 + fr) * D + wc * 32 + 8 * fq;
                f32x4 o0, o1;
#pragma unroll
                for (int q = 0; q < 4; ++q) { o0[q] = silu_f(acc[ai][0][m][0][q]) * acc[ai][1][m][0][q]; o1[q] = silu_f(acc[ai][0][m][1][q]) * acc[ai][1][m][1][q]; }
                v4u w; w.x = pk2(o0[0], o0[1]); w.y = pk2(o0[2], o0[3]); w.z = pk2(o1[0], o1[1]); w.w = pk2(o1[2], o1[3]);
                *(GAS v4u*)rowp = w; }
    }
};
struct EpiDown {
    static constexpr bool PERM = true, AFTER_DRAIN = false;
    GAS bf16* YE; const GAS float* GATE; int pnB;
    __device__ __forceinline__ void operator()(const f32x4 (&acc)[2][2][4][2], const pg8::Unit& u, int wr, int wc, int fr_in, int fq_in) const {
        int fr = fr_in, fq = fq_in; asm volatile("" : "+v"(fr), "+v"(fq));
        const int j = (u.pn - pnB) & 7; const int rt = (u.pm - T_ACT) * 256;
        GAS bf16* base = YE + (size_t)rt * D + (size_t)j * 256;
#pragma unroll
        for (int ai = 0; ai < 2; ++ai)
#pragma unroll
            for (int m = 0; m < 4; ++m) { const int r = ai * 128 + wr * 64 + m * 16 + fr; const float gt = GATE[rt + r]; GAS bf16* rowp = base + (size_t)r * D + wc * 32 + 8 * fq;
#pragma unroll
                for (int bj = 0; bj < 2; ++bj) { const f32x4 v0 = acc[ai][bj][m][0] * gt, v1 = acc[ai][bj][m][1] * gt;
                    v4u w; w.x = pk2(v0[0], v0[1]); w.y = pk2(v0[2], v0[3]); w.z = pk2(v1[0], v1[1]); w.w = pk2(v1[2], v1[3]);
                    *(GAS v4u*)(rowp + bj * 128) = w; } }
    }
};

__device__ __forceinline__ float dot_bf16(const GAS bf16* a, const GAS bf16* b, int K) {
    float s = 0.f;
    for (int k = 0; k < K; k += 8) { const v4u x = *(const GAS v4u*)(a + k), y = *(const GAS v4u*)(b + k);
#pragma unroll
        for (int q = 0; q < 4; ++q) { s += bf2f(x[q] & 0xffffu) * bf2f(y[q] & 0xffffu); s += bf2f(x[q] >> 16) * bf2f(y[q] >> 16); } }
    return s;
}
template <class Epi, class Sched>
__device__ __forceinline__ void naive_gemm_phase(const pg8::Gemm g, const Sched& S, const Epi& E, int tid_in) {
    const int tid = tid_in, wid = __builtin_amdgcn_readfirstlane(tid >> 6), lane = tid & 63, wr = wid >> 2, wc = wid & 3, fr = lane & 15, fq = lane >> 4;
    pg8::Unit u;
    for (int i = 0; S.next(i, u); ++i) {
        f32x4 acc[2][2][4][2];
        const GAS bf16* A = (const GAS bf16*)g.A + (size_t)u.pm * 256 * g.K; const GAS bf16* B = (const GAS bf16*)g.Bt + (size_t)u.pn * 256 * g.K;
#pragma unroll
        for (int ai = 0; ai < 2; ++ai)
#pragma unroll
            for (int m = 0; m < 4; ++m) { const GAS bf16* ar = A + (size_t)(ai * 128 + wr * 64 + m * 16 + fr) * g.K;
#pragma unroll
                for (int bj = 0; bj < 2; ++bj)
#pragma unroll
                    for (int n = 0; n < 2; ++n)
#pragma unroll
                        for (int j = 0; j < 4; ++j) { const int c = Epi::PERM ? (bj * 128 + wc * 32 + 8 * fq + 4 * n + j) : (bj * 128 + wc * 32 + 16 * n + 4 * fq + j);
                            acc[ai][bj][m][n][j] = dot_bf16(ar, B + (size_t)c * g.K, g.K); } }
        E(acc, u, wr, wc, fr, fq);
    }
}
template <class Epi, class Sched>
__device__ __forceinline__ void run_gemm_ga(Frame& F, const Sched& S, const Epi& E, int tA) {
    const pg8::Gemm g{(const pg8::bf16_t*)(const unsigned char*)(F.ws + (size_t)tA * MiB), (const pg8::bf16_t*)(const unsigned char*)F.ws, 0, 0, D};
    pg8::gemm_phase<Epi, Sched, PG8_ALIGN, PG8_SP2, true, false, MOE_BAUX, WT_BKM != 0>((PG8_LAS unsigned char*)F.lds, g, S, E, F.tid);
}
template <class Epi, class Sched, bool VR = false, int BAUX = 0, bool BKM = (WT_BKM != 0)>
__device__ __forceinline__ void run_gemm(Frame& F, const Sched& S, const Epi& E) {
    const pg8::Gemm g{(const pg8::bf16_t*)(const unsigned char*)F.ws, (const pg8::bf16_t*)(const unsigned char*)F.ws, 0, 0, D};
#if NAIVE_GEMM
    naive_gemm_phase<Epi, Sched>(g, S, E, F.tid);
#else
    pg8::gemm_phase<Epi, Sched, PG8_ALIGN, PG8_SP2, false, VR, BAUX, BKM>((PG8_LAS unsigned char*)F.lds, g, S, E, F.tid);
#endif
}

#define LDV(p, j) (*(const GAS f32x4*)((p) + 4 * F.lane + 256 * (j)))
__device__ __forceinline__ f32x4 bf4_to_f32(v2u w) { return (f32x4){bf2f(w.x & 0xffffu), bf2f(w.x >> 16), bf2f(w.y & 0xffffu), bf2f(w.y >> 16)}; }
#define LDVB(p, j) bf4_to_f32(*(const GAS v2u*)((p) + 4 * F.lane + 256 * (j)))
#define LDVL(p, j) (*(const LAS f32x4*)((p) + 4 * F.lane + 256 * (j)))
__device__ __forceinline__ void stage_vec(const Frame& F, LAS float* dst, const GAS float* src) {
    *(LAS f32x4*)(dst + 4 * F.tid) = *(const GAS f32x4*)(src + 4 * F.tid);
}
__device__ __forceinline__ void ln_rows_lds(f32x4 (&v)[8], const LAS float* g, const LAS float* bb, const Frame& F) {
    float s = 0.f;
#pragma unroll
    for (int j = 0; j < 8; ++j) s += (v[j][0] + v[j][1]) + (v[j][2] + v[j][3]);
    const float mean = wave_sum(s) * (1.0f / D); float s2 = 0.f;
#pragma unroll
    for (int j = 0; j < 8; ++j) { v[j] = v[j] - mean; s2 += (v[j][0] * v[j][0] + v[j][1] * v[j][1]) + (v[j][2] * v[j][2] + v[j][3] * v[j][3]); }
    const float rstd = 1.0f / sqrtf(wave_sum(s2) * (1.0f / D) + LN_EPS);
#pragma unroll
    for (int j = 0; j < 8; ++j) v[j] = v[j] * rstd * LDVL(g, j) + LDVL(bb, j);
}

__device__ __forceinline__ void p0_mods(Frame& F) {
    LAS float* S = (LAS float*)F.lds;
    LAS float* P = S + 3 * D;
    const GAS float* c = fin(F, I_C); const GAS float* cctx = fin(F, I_CCTX);
    for (int i = F.tid; i < 3 * D; i += NTHREADS) { const int r = i / D, k = i % D; const float cv = (r < 2) ? c[r * D + k] : cctx[k]; S[i] = cv / (1.0f + expf(-cv)); }
    __syncthreads();
    const int tl = F.tid & 7, kg = F.tid >> 3;
    GAS float* M = (GAS float*)(F.ws + WS_MODS);
    for (int it = blockIdx.x; it < 2 * 384; it += F.G) {
        const int l = it / 384, cc = it % 384;
        const GAS float* w = fin(F, I_WMOD) + (size_t)l * D * D6 + cc * 32 + tl * 4;
        f32x4 a0 = {0.f, 0.f, 0.f, 0.f}, a1 = a0, a2 = a0;
#pragma unroll 8
        for (int kk = 0; kk < 32; ++kk) { const int k = kg * 32 + kk; const f32x4 wv = *(const GAS f32x4*)(w + (size_t)k * D6); a0 += wv * S[k]; a1 += wv * S[D + k]; a2 += wv * S[2 * D + k]; }
#pragma unroll
        for (int j = 0; j < 4; ++j) { P[(kg * 3 + 0) * 32 + tl * 4 + j] = a0[j]; P[(kg * 3 + 1) * 32 + tl * 4 + j] = a1[j]; P[(kg * 3 + 2) * 32 + tl * 4 + j] = a2[j]; }
        __syncthreads();
        if (F.tid < 96) { const int r = F.tid >> 5, col = F.tid & 31; float s = 0.f;
            for (int q = 0; q < 64; ++q) s += P[(q * 3 + r) * 32 + col];
            M[(size_t)(l * 3 + r) * D6 + cc * 32 + col] = s + fin(F, I_BMOD)[l * D6 + cc * 32 + col]; }
        __syncthreads();
    }
}
__device__ __forceinline__ void p0_s5params(Frame& F) {
    GAS float* AR = (GAS float*)(F.ws + WS_SPAR); GAS float* AI = AR + 2 * NG * NP; GAS float* BB = AI + 2 * NG * NP;
    for (int idx = blockIdx.x * NTHREADS + F.tid; idx < 2 * NG * NP; idx += F.G * NTHREADS) {
        const int dg = idx / NP;
        const double lr = (double)fminf(fin(F, I_LAMRE)[idx], -1e-4f), li = (double)fin(F, I_LAMIM)[idx], dt = exp((double)fin(F, I_LOGSTEP)[dg]);
        const double mag = exp(lr * dt); double sn, cs; sincos(li * dt, &sn, &cs);
        const double ar = mag * cs, ai = mag * sn, nr = ar - 1.0, den = lr * lr + li * li, cr = (nr * lr + ai * li) / den, ci = (ai * lr - nr * li) / den;
        AR[idx] = (float)ar; AI[idx] = (float)ai;
        for (int h = 0; h < GH; ++h) { const double bre = fin(F, I_BRE)[(size_t)idx * GH + h], bim = fin(F, I_BIM)[(size_t)idx * GH + h];
            BB[(size_t)idx * 32 + h] = (float)(cr * bre - ci * bim); BB[(size_t)idx * 32 + 16 + h] = (float)(cr * bim + ci * bre); }
    }
}
__device__ __forceinline__ void p0_item_load(const GAS float* W, int ldw, int k0, int lane, f32x4 (&v)[8]) {
    const GAS float* p = W + (size_t)((k0 & ~1) + 8 * (lane >> 3)) * ldw + 4 * (lane & 7);
#pragma unroll
    for (int i = 0; i < 8; ++i) v[i] = __builtin_nontemporal_load((const GAS f32x4*)(p + (size_t)i * ldw));
}
__device__ __forceinline__ void p0_item_store(GAS bf16* WT, int dst_row0, int k0, int lane, const f32x4 (&v)[8]) {
    const int g0 = dst_row0 + 4 * (lane & 7), kq = k0 & ~1; const bool bkm = (k0 & 1) != 0;
    GAS bf16* o = bkm ? WT + (size_t)(g0 >> 8) * (256 * D) + (size_t)(kq >> 6) * (256 * 64) + (g0 & 255) * 64 + 8 * (lane >> 3) : WT + (size_t)g0 * D + kq + 8 * (lane >> 3);
    const int RS = bkm ? 64 : D;
#pragma unroll
    for (int j = 0; j < 4; ++j) { v4u w; w.x = pk2(v[0][j], v[1][j]); w.y = pk2(v[2][j], v[3][j]); w.z = pk2(v[4][j], v[5][j]); w.w = pk2(v[6][j], v[7][j]);
        __builtin_nontemporal_store(w, (GAS v4u*)(o + (size_t)j * RS)); }
}
__device__ __forceinline__ void p0_decode(const Frame& F, int it, const GAS float*& src, int& ldw, GAS bf16*& dst, int& dr0, int& k0) {
    const int sq = it >> 11, r = it & 2047, kb = r >> 6, nb = r & 63, n0 = nb * 32;
    int mode = 0, off = 0; ldw = D;
    if (sq < 3) { src = fin(F, I_WQKV) + sq * D; ldw = 3 * D; dst = ws_tile(F, T_WQKV) + (size_t)sq * D * D; }
    else if (sq == 3) { src = fin(F, I_WO); dst = ws_tile(F, T_WO); }
    else if (sq == 4) { src = fin(F, I_WVAL); dst = ws_tile(F, T_WVG); mode = 1; }
    else if (sq == 5) { src = fin(F, I_WGATE); dst = ws_tile(F, T_WVG); mode = 1; off = 128; }
    else { const int mm = sq - 6, l = mm / 48, e = (mm % 48) / 3, t = mm % 3; const size_t wofs = (size_t)(l * NE + e) * D * D;
        if (t == 0) { src = fin(F, I_MGATE) + wofs; dst = ws_tile(F, T_MOE1 + l * 256) + (size_t)e * 4096 * D; mode = 1; }
        else if (t == 1) { src = fin(F, I_MUP) + wofs; dst = ws_tile(F, T_MOE1 + l * 256) + (size_t)e * 4096 * D; mode = 1; off = 128; }
        else { src = fin(F, I_MDOWN) + wofs; dst = ws_tile(F, T_MOE2 + l * 128) + (size_t)e * 2048 * D; } }
    src += n0; dr0 = mode ? ((n0 >> 7) * 256 + (n0 & 127) + off) : n0; k0 = kb * 64 + ((WT_BKM && sq >= 3) ? 1 : 0);
}
template <int NF>
__device__ __forceinline__ void p0_weights_n(Frame& F, int it0, int NIT, int gw, int NGW) {
    for (int it = it0 + gw; it < NIT; it += NF * NGW) {
        const GAS float* sp[NF]; int lw[NF], dr[NF], kk[NF]; GAS bf16* op[NF]; f32x4 v[NF][8]; bool ok[NF];
#pragma unroll
        for (int q = 0; q < NF; ++q) { ok[q] = it + q * NGW < NIT; if (ok[q]) { p0_decode(F, it + q * NGW, sp[q], lw[q], op[q], dr[q], kk[q]); p0_item_load(sp[q], lw[q], kk[q], F.lane, v[q]); } }
#pragma unroll
        for (int q = 0; q < NF; ++q) if (ok[q]) p0_item_store(op[q], dr[q], kk[q], F.lane, v[q]);
    }
}
__device__ __forceinline__ void p0_weights(Frame& F, int it0, int NIT, int gw, int NGW) {
    for (int it = it0 + gw; it < NIT; it += 2 * NGW) {
        const GAS float* s0; const GAS float* s1; int l0, l1, d0, d1, k0, k1; GAS bf16* o0; GAS bf16* o1; f32x4 va[8], vb[8];
        const bool two = it + NGW < NIT;
        p0_decode(F, it, s0, l0, o0, d0, k0); p0_item_load(s0, l0, k0, F.lane, va);
        if (two) { p0_decode(F, it + NGW, s1, l1, o1, d1, k1); p0_item_load(s1, l1, k1, F.lane, vb); }
        p0_item_store(o0, d0, k0, F.lane, va);
        if (two) p0_item_store(o1, d1, k1, F.lane, vb);
    }
}
__device__ __forceinline__ const GAS float* xin_row(Frame& F, int l, int row) {
    if (l == 0) return row < NLAT ? fin(F, I_X) + (size_t)row * D : fin(F, I_CTX) + (size_t)(row - NLAT) * D;
    return (const GAS float*)(F.ws + WS_X2) + (size_t)row * D;
}
#define XN_LOAD(dst, l_, row_) do { if (X2_FP16 && (l_)) { const GAS bf16* xh_ = (const GAS bf16*)(F.ws + WS_X2) + (size_t)(row_) * D; \
        _Pragma("unroll") for (int j = 0; j < 8; ++j) { const f32x2 t_ = *(const GAS f32x2*)(xh_ + 4 * F.lane + 256 * j); dst[j][0] = t_[0]; dst[j][1] = t_[1]; } } \
    else { const GAS float* xr_ = xin_row(F, l_, row_); _Pragma("unroll") for (int j = 0; j < 8; ++j) dst[j] = LDV(xr_, j); } } while (0)
__device__ __forceinline__ void p1_prep(Frame& F) {
    const int gw = F.vcu * NWAVES + F.wave, NGW = F.G * NWAVES;
    GAS bf16* HB = ws_tile(F, T_HB);
    LAS float* VL = (LAS float*)F.lds;
#pragma unroll
    for (int r = 0; r < 3; ++r) { stage_vec(F, VL + r * D, mods(F, 0, r, 0)); stage_vec(F, VL + (3 + r) * D, mods(F, 0, r, 1)); }
    f32x4 xn[8];
    if (gw < NROWS) { const GAS float* xr = xin_row(F, 0, gw);
#pragma unroll
        for (int j = 0; j < 8; ++j) xn[j] = LDV(xr, j); }
    __syncthreads();
    const int p1rows = P1_COOP ? NLAT : NROWS;
    for (int row = gw; row < p1rows; row += NGW) {
        const int r = row_r(row); const LAS float* sh = VL + r * D; const LAS float* sc = VL + (3 + r) * D;
        f32x4 h[8];
#pragma unroll
        for (int j = 0; j < 8; ++j) h[j] = xn[j] * (LDVL(sc, j) + 1.0f) + LDVL(sh, j);
        if (row + NGW < p1rows) { const GAS float* xr = xin_row(F, 0, row + NGW);
#pragma unroll
            for (int j = 0; j < 8; ++j) xn[j] = LDV(xr, j); }
#pragma unroll
        for (int j = 0; j < 8; ++j) { v2u w; w.x = pk2(h[j][0], h[j][1]); w.y = pk2(h[j][2], h[j][3]); *(GAS v2u*)(HB + (size_t)row * D + 4 * F.lane + 256 * j) = w; }
    }
#if P1_COOP
    for (int task = gw; task < 4 * NCTX; task += NGW) { const int row = NLAT + (task >> 2), qq = task & 3; const GAS float* xr = xin_row(F, 0, row);
        const LAS float* sh = VL + 2 * D; const LAS float* sc = VL + 5 * D;
#pragma unroll
        for (int jj = 0; jj < 2; ++jj) { const int j = 2 * qq + jj; const f32x4 h = LDV(xr, j) * (LDVL(sc, j) + 1.0f) + LDVL(sh, j);
            v2u w; w.x = pk2(h[0], h[1]); w.y = pk2(h[2], h[3]); *(GAS v2u*)(HB + (size_t)row * D + 4 * F.lane + 256 * j) = w; } }
#endif
}
__device__ __forceinline__ void p3_attn_naive(Frame& F) {
    const int gw = F.vcu * NWAVES + F.wave, NGW = F.G * NWAVES;
    LAS float* Pl = (LAS float*)(F.lds + F.wave * 4096);
    LAS int* Tl = (LAS int*)(F.lds + F.wave * 4096 + 2048);
    const GAS bf16* QK = ws_tile(F, T_QK); const GAS bf16* VT = ws_tile(F, T_VT); GAS bf16* AO = ws_tile(F, T_AO);
    const float scale = 0.08838834764831845f;
    for (int un = gw; un < NROWS * NH; un += NGW) {
        const int row = un >> 4, h = un & 15; const bool lat = row < NLAT;
        int b, r = 0, qc = 0, rs = 0, cst = 0;
        if (lat) { b = row >> 12; const int t = row & 4095; r = t >> 6; qc = t & 63; rs = min(max(r - 4, 0), 56); cst = min(max(qc - 8, 0), 48); } else b = (row - NLAT) >> 8;
        const int nk = lat ? 384 : 256;
        const GAS bf16* q = QK + (size_t)row * 4096 + h * HD;
        float sv[6]; float mx = -3.0e38f;
#pragma unroll
        for (int i = 0; i < 6; ++i) { const int kk = F.lane + 64 * i; float s = -3.0e38f;
            if (kk < nk) { int krow; float bias = 0.f;
                if (lat && kk < 128) { const int kr = rs + (kk >> 4), kc = cst + (kk & 15); krow = b * SEQ + kr * 64 + kc;
                    const int dc = min(max(kc - qc + 15, 0), 30); bias = fin(F, I_RPB)[(h * 15 + (kr - r + 7)) * 31 + dc]; }
                else krow = NLAT + b * CTXL + (lat ? kk - 128 : kk);
                s = dot_bf16(q, QK + (size_t)krow * 4096 + D + h * HD, HD) * scale + bias; Tl[kk] = krow; }
            sv[i] = s; mx = fmaxf(mx, s); }
        mx = wave_max(mx); float sum = 0.f;
#pragma unroll
        for (int i = 0; i < 6; ++i) { const int kk = F.lane + 64 * i; const float p = (kk < nk) ? __expf(sv[i] - mx) : 0.f; sv[i] = p; sum += p; }
        sum = wave_sum(sum); const float inv = 1.0f / sum;
#pragma unroll
        for (int i = 0; i < 6; ++i) { const int kk = F.lane + 64 * i; if (kk < nk) Pl[kk] = sv[i] * inv; }
        asm volatile("s_waitcnt lgkmcnt(0)" ::: "memory");
        float o0 = 0.f, o1 = 0.f; const GAS bf16* v0 = VT + (size_t)(h * HD + 2 * F.lane) * NROWS; const GAS bf16* v1 = v0 + NROWS;
        for (int kk = 0; kk < nk; ++kk) { const float p = Pl[kk]; const int kr = Tl[kk]; o0 += p * bf2f(v0[kr]); o1 += p * bf2f(v1[kr]); }
        *(GAS unsigned*)(AO + (size_t)row * D + h * HD + 2 * F.lane) = pk2(o0, o1);
        asm volatile("s_waitcnt lgkmcnt(0)" ::: "memory");
    }
}
__device__ __forceinline__ void ln_rows(f32x4 (&v)[8], const GAS float* g, const GAS float* bb, const Frame& F) {
    f32x4 gv[8], bv[8];
#pragma unroll
    for (int j = 0; j < 8; ++j) { gv[j] = LDV(g, j); bv[j] = LDV(bb, j); }
    __builtin_amdgcn_sched_barrier(0);
    float s = 0.f;
#pragma unroll
    for (int j = 0; j < 8; ++j) s += (v[j][0] + v[j][1]) + (v[j][2] + v[j][3]);
    const float mean = wave_sum(s) * (1.0f / D); float s2 = 0.f;
#pragma unroll
    for (int j = 0; j < 8; ++j) { v[j] = v[j] - mean; s2 += (v[j][0] * v[j][0] + v[j][1] * v[j][1]) + (v[j][2] * v[j][2] + v[j][3] * v[j][3]); }
    const float rstd = 1.0f / sqrtf(wave_sum(s2) * (1.0f / D) + LN_EPS);
#pragma unroll
    for (int j = 0; j < 8; ++j) v[j] = v[j] * rstd * gv[j] + bv[j];
}
__device__ __forceinline__ float reduce16(float (&v)[16], int lane) {
    float a[8], b[4], c[2];
    const bool h5 = lane & 32, h4 = lane & 16, h3 = lane & 8, h2 = lane & 4;
#pragma unroll
    for (int k = 0; k < 8; ++k) { const float snd = h5 ? v[k] : v[k + 8], kp = h5 ? v[k + 8] : v[k]; a[k] = kp + __shfl_xor(snd, 32); }
#pragma unroll
    for (int k = 0; k < 4; ++k) { const float snd = h4 ? a[k] : a[k + 4], kp = h4 ? a[k + 4] : a[k]; b[k] = kp + __shfl_xor(snd, 16); }
#pragma unroll
    for (int k = 0; k < 2; ++k) { const float snd = h3 ? b[k] : b[k + 2], kp = h3 ? b[k + 2] : b[k]; c[k] = kp + __shfl_xor(snd, 8); }
    float d = (h2 ? c[1] : c[0]) + __shfl_xor(h2 ? c[0] : c[1], 4);
    d += __shfl_xor(d, 2); d += __shfl_xor(d, 1);
    return d;
}
__device__ __forceinline__ void row_phase(Frame& F, int l, int dv) {
    const int gw = F.vcu * NWAVES + F.wave, NGW = F.G * NWAVES, nrows = (l || ROW_CTX_COOP) ? NLAT : NROWS;
    const GAS bf16* O = (const GAS bf16*)(F.ws + WS_O); GAS float* X1 = (GAS float*)(F.ws + WS_X1); GAS bf16* HB = ws_tile(F, T_HB); GAS float* AFFT = (GAS float*)(F.ws + WS_AFF);
    const GAS float* lng = fin(F, I_LNG) + (size_t)(l * 2 + 0) * D; const GAS float* lnb = fin(F, I_LNB) + (size_t)(l * 2 + 0) * D; const GAS float* wr = fin(F, I_ROUTER) + (size_t)l * D * NE;
    LAS float* WR = (LAS float*)F.lds;
#pragma unroll
    for (int bt = 0; bt < 2; ++bt) { f32x4 t8[8];
#pragma unroll
        for (int k = 0; k < 8; ++k) { const int pc = F.tid + NTHREADS * (8 * bt + k), ln = pc & 63, e4 = (pc >> 6) & 3, qq = (pc >> 8) & 3, jj = pc >> 10;
            t8[k] = *(const GAS f32x4*)(wr + (size_t)(4 * ln + 256 * jj + qq) * NE + 4 * e4); }
#pragma unroll
        for (int k = 0; k < 8; ++k) *(LAS f32x4*)(WR + 4 * (F.tid + NTHREADS * (8 * bt + k))) = t8[k]; }
    __syncthreads();
    f32x4 xn[8]; v2u on[8];
    if (gw < nrows) { const GAS bf16* orow = O + (size_t)gw * D;
        XN_LOAD(xn, l, gw);
#pragma unroll
        for (int j = 0; j < 8; ++j) on[j] = *(const GAS v2u*)(orow + 4 * F.lane + 256 * j); }
    for (int row = gw; row < nrows; row += NGW) {
        const int r = row_r(row);
        const GAS float* g1 = mods(F, l, r, 2); const GAS float* sh2 = mods(F, l, r, 3); const GAS float* sc2 = mods(F, l, r, 4);
        f32x4 v[8];
        { f32x4 gg[8];
#pragma unroll
          for (int j = 0; j < 8; ++j) gg[j] = LDV(g1, j);
          __builtin_amdgcn_sched_barrier(0);
#pragma unroll
          for (int j = 0; j < 8; ++j) { const f32x4 xx = (X2_FP16 && l) ? h4_to_f32((v2u){__float_as_uint(xn[j][0]), __float_as_uint(xn[j][1])}) : xn[j];
              v[j] = xx * ALPHA + gg[j] * bf4_to_f32(on[j]); } }
        if (row + NGW < nrows) { const GAS bf16* orow = O + (size_t)(row + NGW) * D;
            XN_LOAD(xn, l, row + NGW);
#pragma unroll
            for (int j = 0; j < 8; ++j) on[j] = *(const GAS v2u*)(orow + 4 * F.lane + 256 * j); }
        ln_rows(v, lng, lnb, F);
        float lg[NE];
#pragma unroll
        for (int e = 0; e < NE; ++e) lg[e] = 0.f;
        f32x4 hv[8];
        { f32x4 cv[8], sv[8];
#pragma unroll
          for (int j = 0; j < 8; ++j) { cv[j] = LDV(sc2, j); sv[j] = LDV(sh2, j); }
          __builtin_amdgcn_sched_barrier(0);
#pragma unroll
          for (int j = 0; j < 8; ++j) hv[j] = v[j] * (cv[j] + 1.0f) + sv[j]; }
#if X1_BF16
        { v2u xw[8];
#pragma unroll
          for (int j = 0; j < 8; ++j) { xw[j].x = X1PK(v[j][0], v[j][1]); xw[j].y = X1PK(v[j][2], v[j][3]); }
          __builtin_amdgcn_sched_barrier(0);
#pragma unroll
          for (int j = 0; j < 8; ++j) {
#if NT_STREAM
              __builtin_nontemporal_store(xw[j], (GAS v2u*)((GAS bf16*)X1 + (size_t)row * D + 4 * F.lane + 256 * j));
#else
              *(GAS v2u*)((GAS bf16*)X1 + (size_t)row * D + 4 * F.lane + 256 * j) = xw[j];
#endif
          } }
#pragma unroll
        for (int j = 0; j < 8; ++j) { v2u w; w.x = pk2(hv[j][0], hv[j][1]); w.y = pk2(hv[j][2], hv[j][3]); *(GAS v2u*)(HB + (size_t)row * D + 4 * F.lane + 256 * j) = w; }
#else
#pragma unroll
        for (int j = 0; j < 8; ++j) { *(GAS f32x4*)(X1 + (size_t)row * D + 4 * F.lane + 256 * j) = v[j];
            v2u w; w.x = pk2(hv[j][0], hv[j][1]); w.y = pk2(hv[j][2], hv[j][3]); *(GAS v2u*)(HB + (size_t)row * D + 4 * F.lane + 256 * j) = w; }
#endif
        {
            const LAS float* wl = WR + 4 * F.lane; f32x4 wv[2][4];
#pragma unroll
            for (int e4 = 0; e4 < 4; ++e4) wv[0][e4] = *(const LAS f32x4*)(wl + e4 * 256);
#pragma unroll
            for (int st = 0; st < 32; ++st) {
                if (st + 1 < 32) {
#pragma unroll
                    for (int e4 = 0; e4 < 4; ++e4) wv[(st + 1) & 1][e4] = *(const LAS f32x4*)(wl + ((st + 1) * 4 + e4) * 256); }
                const float hq = hv[st >> 2][st & 3];
#pragma unroll
                for (int e4 = 0; e4 < 4; ++e4)
#pragma unroll
                    for (int t = 0; t < 4; ++t) lg[4 * e4 + t] += hq * wv[st & 1][e4][t];
                __builtin_amdgcn_sched_barrier(0); }
        }
        const float lgt = reduce16(lg, F.lane);
        float mx = lgt;
#pragma unroll
        for (int o = 4; o < 64; o <<= 1) mx = fmaxf(mx, __shfl_xor(mx, o));
        const float ex = expf(lgt - mx); float sum = ex;
#pragma unroll
        for (int o = 4; o < 64; o <<= 1) sum += __shfl_xor(sum, o);
        if ((F.lane & 3) == 0) AFFT[(size_t)((F.lane >> 2) & 15) * NROWS + row] = ex / sum;
    }
#if ROW_CTX_COOP
    if (l == 0) {
        LAS float* PS = (LAS float*)(F.lds + 131072);
        LAS float* PQ = PS + 8; LAS float* PL = PQ + 8;
        const int rr = F.wave >> 2, qq = F.wave & 3;
        for (int base = 2 * F.vcu; base < NCTX; base += 2 * F.G) {
            const int row = NLAT + base + rr;
            const GAS float* xr = xin_row(F, 0, row); const GAS bf16* orow = O + (size_t)row * D;
            const GAS float* g1 = mods(F, 0, 2, 2); const GAS float* sh2 = mods(F, 0, 2, 3); const GAS float* sc2 = mods(F, 0, 2, 4);
            f32x4 v[2], gv[2], bv[2], cv[2], sv[2];
#pragma unroll
            for (int jj = 0; jj < 2; ++jj) { const int j = 2 * qq + jj; v[jj] = LDV(xr, j) * ALPHA + LDV(g1, j) * bf4_to_f32(*(const GAS v2u*)(orow + 4 * F.lane + 256 * j));
                gv[jj] = LDV(lng, j); bv[jj] = LDV(lnb, j); cv[jj] = LDV(sc2, j); sv[jj] = LDV(sh2, j); }
            float s = (v[0][0] + v[0][1]) + (v[0][2] + v[0][3]) + (v[1][0] + v[1][1]) + (v[1][2] + v[1][3]);
            s = wave_sum(s); if (F.lane == 0) PS[rr * 4 + qq] = s;
            __syncthreads();
            const float mean = ((PS[rr * 4 + 0] + PS[rr * 4 + 1]) + (PS[rr * 4 + 2] + PS[rr * 4 + 3])) * (1.0f / D);
            float s2 = 0.f;
#pragma unroll
            for (int jj = 0; jj < 2; ++jj) { v[jj] = v[jj] - mean; s2 += (v[jj][0] * v[jj][0] + v[jj][1] * v[jj][1]) + (v[jj][2] * v[jj][2] + v[jj][3] * v[jj][3]); }
            s2 = wave_sum(s2); if (F.lane == 0) PQ[rr * 4 + qq] = s2;
            __syncthreads();
            const float rstd = 1.0f / sqrtf(((PQ[rr * 4 + 0] + PQ[rr * 4 + 1]) + (PQ[rr * 4 + 2] + PQ[rr * 4 + 3])) * (1.0f / D) + LN_EPS);
            f32x4 hv[2];
#pragma unroll
            for (int jj = 0; jj < 2; ++jj) { const int j = 2 * qq + jj; v[jj] = v[jj] * rstd * gv[jj] + bv[jj]; hv[jj] = v[jj] * (cv[jj] + 1.0f) + sv[jj];
#if X1_BF16
                { v2u xw; xw.x = X1PK(v[jj][0], v[jj][1]); xw.y = X1PK(v[jj][2], v[jj][3]); *(GAS v2u*)((GAS bf16*)X1 + (size_t)row * D + 4 * F.lane + 256 * j) = xw; }
#else
                *(GAS f32x4*)(X1 + (size_t)row * D + 4 * F.lane + 256 * j) = v[jj];
#endif
                v2u w; w.x = pk2(hv[jj][0], hv[jj][1]); w.y = pk2(hv[jj][2], hv[jj][3]); *(GAS v2u*)(HB + (size_t)row * D + 4 * F.lane + 256 * j) = w; }
            float lg[NE];
#pragma unroll
            for (int e = 0; e < NE; ++e) lg[e] = 0.f;
#pragma unroll
            for (int jj = 0; jj < 2; ++jj)
#pragma unroll
                for (int q = 0; q < 4; ++q) { const LAS float* wp = WR + ((((2 * qq + jj) * 4 + q) * 4) * 64 + F.lane) * 4; const float hq = hv[jj][q];
#pragma unroll
                    for (int e4 = 0; e4 < 4; ++e4) { const f32x4 wv = *(const LAS f32x4*)(wp + e4 * 256);
#pragma unroll
                        for (int t = 0; t < 4; ++t) lg[4 * e4 + t] += hq * wv[t]; } }
            const float lgt = reduce16(lg, F.lane);
            if ((F.lane & 3) == 0) PL[(rr * 4 + qq) * 16 + ((F.lane >> 2) & 15)] = lgt;
            __syncthreads();
            if (qq == 0) { const int e = F.lane & 15;
                const float lgs = (PL[(rr * 4 + 0) * 16 + e] + PL[(rr * 4 + 1) * 16 + e]) + (PL[(rr * 4 + 2) * 16 + e] + PL[(rr * 4 + 3) * 16 + e]);
                float mx = lgs;
#pragma unroll
                for (int o = 1; o < 16; o <<= 1) mx = fmaxf(mx, __shfl_xor(mx, o));
                const float ex = expf(lgs - mx); float sum = ex;
#pragma unroll
                for (int o = 1; o < 16; o <<= 1) sum += __shfl_xor(sum, o);
                if (F.lane < 16) AFFT[(size_t)e * NROWS + row] = ex / sum; }
            __syncthreads();
        }
    }
#endif
    __syncthreads();
}
__device__ __forceinline__ void topk_phase(Frame& F, int l) {
    LAS int* CW = (LAS int*)F.lds;
    LAS int* CG = CW + 16;
    LAS int* CE = CG + 64;
    const GAS float* AFFT = (const GAS float*)(F.ws + WS_AFF); GAS int* SLOT = (GAS int*)(F.ws + WS_SLOT); GAS int* IDX = (GAS int*)(F.ws + WS_IDX); GAS float* GATE = (GAS float*)(F.ws + WS_GATE);
    const int nlat = 2 * NE * 8, ntot = nlat + (l == 0 ? 2 * NE : 0);
    for (int un = blockIdx.x; un < ntot; un += F.G) {
        const bool lat = un < nlat; int b, e, ch, n, cap, rowbase, slotbase;
        if (lat) { b = un >> 7; e = (un >> 3) & 15; ch = un & 7; n = SEQ; cap = 512; rowbase = b * SEQ; slotbase = e * RPE + b * 512; }
        else { const int q = un - nlat; b = q >> 4; e = q & 15; ch = 0; n = CTXL; cap = 32; rowbase = NLAT + b * CTXL; slotbase = e * RPE + 1024 + b * 32; }
        unsigned key[8];
#pragma unroll
        for (int i = 0; i < 8; ++i) { const int t = F.tid + 512 * i; key[i] = (t < n) ? __float_as_uint(AFFT[(size_t)e * NROWS + rowbase + t]) : 0u; }
        unsigned T = 0u;
#if TOPK_2BIT
        typedef int i32x4 __attribute__((ext_vector_type(4)));
        LAS i32x4* CW4 = (LAS i32x4*)(F.lds + 4096);
        {   const unsigned cand = 1u << 30; int cnt = 0;
#pragma unroll
            for (int i = 0; i < 8; ++i) cnt += __builtin_popcountll(__ballot(key[i] >= cand));
            if (F.lane == 0) CW[F.wave] = cnt;
            __syncthreads();
            int tot = 0;
#pragma unroll
            for (int w = 0; w < 8; ++w) tot += CW[w];
            if (tot >= cap) T = cand; }
        for (int lo = 28; lo >= 0; lo -= 2) {
            const unsigned c1 = T | (1u << lo), c2 = T | (2u << lo), c3 = T | (3u << lo); int n1 = 0, n2 = 0, n3 = 0;
#pragma unroll
            for (int i = 0; i < 8; ++i) { n1 += __builtin_popcountll(__ballot(key[i] >= c1)); n2 += __builtin_popcountll(__ballot(key[i] >= c2)); n3 += __builtin_popcountll(__ballot(key[i] >= c3)); }
            LAS i32x4* cw = CW4 + ((lo >> 1) & 1) * 8;
            if (F.lane == 0) cw[F.wave] = (i32x4){n1, n2, n3, 0};
            __syncthreads();
            i32x4 tot = {0, 0, 0, 0};
#pragma unroll
            for (int w = 0; w < 8; ++w) tot += cw[w];
            T = tot[2] >= cap ? c3 : tot[1] >= cap ? c2 : tot[0] >= cap ? c1 : T;
        }
#else
        for (int bit = 30; bit >= 0; --bit) {
            const unsigned cand = T | (1u << bit); int cnt = 0;
#pragma unroll
            for (int i = 0; i < 8; ++i) cnt += __builtin_popcountll(__ballot(key[i] >= cand));
            LAS int* cw = CW + (bit & 1) * 8;
            if (F.lane == 0) cw[F.wave] = cnt;
            __syncthreads();
            int tot = 0;
#pragma unroll
            for (int w = 0; w < 8; ++w) tot += cw[w];
            if (tot >= cap) T = cand;
        }
#endif
#pragma unroll
        for (int i = 0; i < 8; ++i) { const unsigned long long mg = __ballot(key[i] > T), me = __ballot(key[i] == T);
            if (F.lane == 0) { CG[i * 8 + F.wave] = __builtin_popcountll(mg); CE[i * 8 + F.wave] = __builtin_popcountll(me); } }
        __syncthreads();
        int gt_total = 0, g_before = 0, e_before = 0;
        { typedef int i32x4 __attribute__((ext_vector_type(4))); i32x4 cgv[16], cev[16];
#pragma unroll
          for (int k4 = 0; k4 < 16; ++k4) { cgv[k4] = *(const LAS i32x4*)(CG + 4 * k4); cev[k4] = *(const LAS i32x4*)(CE + 4 * k4); }
          const int lim = ch * 8 + F.wave;
#pragma unroll
          for (int k4 = 0; k4 < 16; ++k4)
#pragma unroll
              for (int t = 0; t < 4; ++t) { const int k = 4 * k4 + t; gt_total += cgv[k4][t]; g_before += (k < lim) ? cgv[k4][t] : 0; e_before += (k < lim) ? cev[k4][t] : 0; } }
        const int need = cap - gt_total;
        {
            unsigned kv = 0u;
#pragma unroll
            for (int i = 0; i < 8; ++i) kv = (i == ch) ? key[i] : kv;
            const int t = F.tid + 512 * ch;
            const unsigned long long mg = __ballot(kv > T), me = __ballot(kv == T);
            const unsigned long long lower = (F.lane == 0) ? 0ull : (~0ull >> (64 - F.lane));
            const int g_rank = g_before + __builtin_popcountll(mg & lower), e_rank = e_before + __builtin_popcountll(me & lower);
            const int e_taken_before = e_rank < need ? e_rank : need;
            const bool sel = (t < n) && ((kv > T) || (kv == T && e_rank < need));
            if (t < n) { int s = -1;
                if (sel) { s = slotbase + g_rank + e_taken_before; IDX[s] = rowbase + t; GATE[s] = __uint_as_float(kv); }
                SLOT[(size_t)(rowbase + t) * NE + e] = s; }
        }
        __syncthreads();
    }
}
__device__ __forceinline__ void gather_phase(Frame& F, int l) {
    const int gw = F.vcu * NWAVES + F.wave, NGW = F.G * NWAVES, nv = l ? 1024 : 1088;
    const GAS bf16* HB = ws_tile(F, T_HB); GAS bf16* XE = ws_tile(F, T_XE); const GAS int* IDX = (const GAS int*)(F.ws + WS_IDX);
    for (int i = gw; i < NE * nv; i += NGW) { const int e = i / nv, s = e * RPE + i % nv; const int src = IDX[s];
        const GAS v4u* sp = (const GAS v4u*)(HB + (size_t)src * D); GAS v4u* dp = (GAS v4u*)(XE + (size_t)s * D);
        v4u t4[4];
#pragma unroll
        for (int j = 0; j < 4; ++j) t4[j] = sp[F.lane + 64 * j];
#pragma unroll
        for (int j = 0; j < 4; ++j) dp[F.lane + 64 * j] = t4[j]; }
}
__device__ __forceinline__ void combine_phase(Frame& F, int l) {
    const int gw = F.vcu * NWAVES + F.wave, NGW = F.G * NWAVES, nrows = (l || CTX_COOP2) ? NLAT : NROWS;
    const GAS float* X1 = (const GAS float*)(F.ws + WS_X1); const GAS bf16* YE = (const GAS bf16*)(F.ws + WS_YE); const GAS int* SLOT = (const GAS int*)(F.ws + WS_SLOT);
    GAS float* X2 = (GAS float*)(F.ws + WS_X2); GAS bf16* HB = ws_tile(F, T_HB);
    const GAS float* lng = fin(F, I_LNG) + (size_t)(l * 2 + 1) * D; const GAS float* lnb = fin(F, I_LNB) + (size_t)(l * 2 + 1) * D;
    LAS float* VL = (LAS float*)F.lds;
    stage_vec(F, VL, lng); stage_vec(F, VL + D, lnb);
#pragma unroll
    for (int r = 0; r < 3; ++r) { stage_vec(F, VL + (2 + r) * D, mods(F, l, r, 5)); if (l == 0) { stage_vec(F, VL + (5 + r) * D, mods(F, 1, r, 0)); stage_vec(F, VL + (8 + r) * D, mods(F, 1, r, 1)); } }
    __syncthreads();
    int svn = (gw < nrows) ? SLOT[(size_t)gw * NE + (F.lane & 15)] : -1;
    for (int row = gw; row < nrows; row += NGW) {
        const int r = row_r(row); const LAS float* g2 = VL + (2 + r) * D;
#if X1_BF16
        const GAS bf16* x1 = (const GAS bf16*)X1 + (size_t)row * D;
#else
        const GAS float* x1 = X1 + (size_t)row * D;
#endif
        f32x4 f[8];
#pragma unroll
        for (int j = 0; j < 8; ++j) f[j] = (f32x4){0.f, 0.f, 0.f, 0.f};
        const int sv = svn;
        if (row + NGW < nrows) svn = SLOT[(size_t)(row + NGW) * NE + (F.lane & 15)];
        f32x4 xv[8], g2v[8];
#if X1_BF16
#pragma unroll
        for (int j = 0; j < 8; ++j) { xv[j] = X1UNPK(*(const GAS v2u*)(x1 + 4 * F.lane + 256 * j)); g2v[j] = LDVL(g2, j); }
#else
#pragma unroll
        for (int j = 0; j < 8; ++j) { xv[j] = LDV(x1, j); g2v[j] = LDVL(g2, j); }
#endif
#pragma unroll
        for (int e = 0; e < NE; ++e) { const int s = __builtin_amdgcn_readlane(sv, e);
            if (s >= 0) { const GAS bf16* yr = YE + (size_t)s * D; v2u t[8];
#pragma unroll
                for (int j = 0; j < 8; ++j) t[j] = *(const GAS v2u*)(yr + 4 * F.lane + 256 * j);
#pragma unroll
                for (int j = 0; j < 8; ++j) f[j] += bf4_to_f32(t[j]); } }
        f32x4 v[8];
#pragma unroll
        for (int j = 0; j < 8; ++j) v[j] = xv[j] * ALPHA + g2v[j] * f[j];
        ln_rows_lds(v, VL, VL + D, F);
        if (l == 0) { const LAS float* sh = VL + (5 + r) * D; const LAS float* sc = VL + (8 + r) * D; v2u hw[8];
#pragma unroll
            for (int j = 0; j < 8; ++j) { const f32x4 h = v[j] * (LDVL(sc, j) + 1.0f) + LDVL(sh, j); hw[j].x = pk2(h[0], h[1]); hw[j].y = pk2(h[2], h[3]); }
#pragma unroll
            for (int j = 0; j < 8; ++j) {
#if NT_STREAM
                __builtin_nontemporal_store(v[j], (GAS f32x4*)(X2 + (size_t)row * D + 4 * F.lane + 256 * j));
#elif X2_FP16
                { v2u xw; xw.x = pkh2(v[j][0], v[j][1]); xw.y = pkh2(v[j][2], v[j][3]); *(GAS v2u*)((GAS bf16*)X2 + (size_t)row * D + 4 * F.lane + 256 * j) = xw; }
#else
                *(GAS f32x4*)(X2 + (size_t)row * D + 4 * F.lane + 256 * j) = v[j];
#endif
                *(GAS v2u*)(HB + (size_t)row * D + 4 * F.lane + 256 * j) = hw[j]; } }
        else {
#pragma unroll
            for (int j = 0; j < 8; ++j) {
#if NT_STREAM
                __builtin_nontemporal_store(v[j], (GAS f32x4*)(F.out + (size_t)row * D + 4 * F.lane + 256 * j));
#else
                *(GAS f32x4*)(F.out + (size_t)row * D + 4 * F.lane + 256 * j) = v[j];
#endif
            } }
    }
#if CTX_COOP2
    if (l == 0) {
        LAS float* PS = (LAS float*)(F.lds + 131072); LAS float* PQ = PS + 8;
        const int rr = F.wave >> 2, qq = F.wave & 3;
        for (int base = 2 * F.vcu; base < NCTX; base += 2 * F.G) {
            const int row = NLAT + base + rr; const GAS float* x1 = X1 + (size_t)row * D; const LAS float* g2 = VL + 4 * D;
            const int sv = SLOT[(size_t)row * NE + (F.lane & 15)];
            f32x4 f[2] = {{0.f, 0.f, 0.f, 0.f}, {0.f, 0.f, 0.f, 0.f}}, xv[2];
#pragma unroll
            for (int jj = 0; jj < 2; ++jj) xv[jj] = LDV(x1, 2 * qq + jj);
#pragma unroll
            for (int e = 0; e < NE; ++e) { const int sl = __builtin_amdgcn_readlane(sv, e);
                if (sl >= 0) { const GAS bf16* yr = YE + (size_t)sl * D; v2u t[2];
#pragma unroll
                    for (int jj = 0; jj < 2; ++jj) t[jj] = *(const GAS v2u*)(yr + 4 * F.lane + 256 * (2 * qq + jj));
#pragma unroll
                    for (int jj = 0; jj < 2; ++jj) f[jj] += bf4_to_f32(t[jj]); } }
            f32x4 v[2];
#pragma unroll
            for (int jj = 0; jj < 2; ++jj) v[jj] = xv[jj] * ALPHA + LDVL(g2, 2 * qq + jj) * f[jj];
            float s1 = (v[0][0] + v[0][1]) + (v[0][2] + v[0][3]) + (v[1][0] + v[1][1]) + (v[1][2] + v[1][3]);
            s1 = wave_sum(s1); if (F.lane == 0) PS[rr * 4 + qq] = s1;
            __syncthreads();
            const float mean = ((PS[rr * 4 + 0] + PS[rr * 4 + 1]) + (PS[rr * 4 + 2] + PS[rr * 4 + 3])) * (1.0f / D);
            float s2 = 0.f;
#pragma unroll
            for (int jj = 0; jj < 2; ++jj) { v[jj] = v[jj] - mean; s2 += (v[jj][0] * v[jj][0] + v[jj][1] * v[jj][1]) + (v[jj][2] * v[jj][2] + v[jj][3] * v[jj][3]); }
            s2 = wave_sum(s2); if (F.lane == 0) PQ[rr * 4 + qq] = s2;
            __syncthreads();
            const float rstd = 1.0f / sqrtf(((PQ[rr * 4 + 0] + PQ[rr * 4 + 1]) + (PQ[rr * 4 + 2] + PQ[rr * 4 + 3])) * (1.0f / D) + LN_EPS);
            const LAS float* sh = VL + 7 * D; const LAS float* sc = VL + 10 * D;
#pragma unroll
            for (int jj = 0; jj < 2; ++jj) { const int j = 2 * qq + jj; v[jj] = v[jj] * rstd * LDVL(VL, j) + LDVL(VL + D, j);
                const f32x4 h = v[jj] * (LDVL(sc, j) + 1.0f) + LDVL(sh, j);
                *(GAS f32x4*)(X2 + (size_t)row * D + 4 * F.lane + 256 * j) = v[jj];
                v2u w; w.x = pk2(h[0], h[1]); w.y = pk2(h[2], h[3]); *(GAS v2u*)(HB + (size_t)row * D + 4 * F.lane + 256 * j) = w; }
            __syncthreads();
        }
    }
#endif
    __syncthreads();
}
__device__ __forceinline__ void s5_naive(Frame& F) {
    const int gw = F.vcu * NWAVES + F.wave, NGW = F.G * NWAVES;
    const GAS float* AR = (const GAS float*)(F.ws + WS_SPAR); const GAS float* AI = AR + 2 * NG * NP; const GAS float* BB = AI + 2 * NG * NP;
    const GAS bf16* HB = ws_tile(F, T_HB);
    for (int un = gw; un < 2 * NG * 2; un += NGW) {
        const int b = un >> 8, g = (un >> 1) & 127, dir = un & 1; const int idx = (dir * NG + g) * NP + F.lane;
        const float ar = AR[idx], ai = AI[idx]; float br[GH], bi[GH], cr[GH], ci[GH];
#pragma unroll
        for (int h = 0; h < GH; ++h) { br[h] = BB[(size_t)idx * 32 + h]; bi[h] = BB[(size_t)idx * 32 + 16 + h];
            cr[h] = fin(F, I_CRE)[((size_t)(dir * NG + g) * GH + h) * NP + F.lane]; ci[h] = fin(F, I_CIM)[((size_t)(dir * NG + g) * GH + h) * NP + F.lane]; }
        GAS float* Y = (GAS float*)(F.ws + (dir ? WS_YB : WS_YF));
        float xr = 0.f, xi = 0.f;
        for (int tau = 0; tau < CTXL + SEQ; ++tau) {
            int row; if (tau < CTXL) row = NLAT + b * CTXL + (dir ? CTXL - 1 - tau : tau); else row = b * SEQ + (dir ? SEQ - 1 - (tau - CTXL) : tau - CTXL);
            const v4u u0 = *(const GAS v4u*)(HB + (size_t)row * D + g * GH), u1 = *(const GAS v4u*)(HB + (size_t)row * D + g * GH + 8);
            float u[GH];
#pragma unroll
            for (int q = 0; q < 4; ++q) { u[2 * q] = bf2f(u0[q] & 0xffffu); u[2 * q + 1] = bf2f(u0[q] >> 16); u[8 + 2 * q] = bf2f(u1[q] & 0xffffu); u[8 + 2 * q + 1] = bf2f(u1[q] >> 16); }
            float pr = 0.f, pi = 0.f;
#pragma unroll
            for (int h = 0; h < GH; ++h) { pr += br[h] * u[h]; pi += bi[h] * u[h]; }
            const float nxr = ar * xr - ai * xi + pr, nxi = ar * xi + ai * xr + pi; xr = nxr; xi = nxi;
            if (tau >= CTXL) { float mine = 0.f;
#pragma unroll
                for (int h = 0; h < GH; ++h) { const float y = wave_sum(cr[h] * xr - ci[h] * xi); mine = (F.lane == h) ? y : mine; }
                if (F.lane < GH) Y[(size_t)row * D + g * GH + F.lane] = mine; }
        }
    }
}
__device__ __forceinline__ void zprep_phase(Frame& F) {
    const int gw = F.vcu * NWAVES + F.wave, NGW = F.G * NWAVES;
    const GAS float* X2 = (const GAS float*)(F.ws + WS_X2); const GAS bf16* YF = (const GAS bf16*)(F.ws + WS_YF); const GAS bf16* YB = (const GAS bf16*)(F.ws + WS_YB); GAS bf16* Z = ws_tile(F, T_Z);
    const GAS float* dsk = fin(F, I_SD);
    for (int row = gw; row < NLAT; row += NGW) {
        const int r = row >> 12; const GAS float* sh = mods(F, 1, r, 0); const GAS float* sc = mods(F, 1, r, 1);
        const GAS float* x2 = X2 + (size_t)row * D; const GAS bf16* yf = YF + (size_t)row * D; const GAS bf16* yb = YB + (size_t)row * D;
        f32x4 xv[8]; v2u fv[8], bv[8];
#pragma unroll
        for (int j = 0; j < 8; ++j) { xv[j] = LDV(x2, j); fv[j] = *(const GAS v2u*)(yf + 4 * F.lane + 256 * j); bv[j] = *(const GAS v2u*)(yb + 4 * F.lane + 256 * j); }
        v2u zo[8];
#pragma unroll
        for (int j = 0; j < 8; ++j) { const f32x4 u = xv[j] * (LDV(sc, j) + 1.0f) + LDV(sh, j); const f32x4 y = LDV(dsk, j) * u + bf4_to_f32(fv[j]) + bf4_to_f32(bv[j]);
            zo[j].x = pk2(gelu_tanh_f(y[0]), gelu_tanh_f(y[1])); zo[j].y = pk2(gelu_tanh_f(y[2]), gelu_tanh_f(y[3])); }
#pragma unroll
        for (int j = 0; j < 8; ++j) *(GAS v2u*)(Z + (size_t)row * D + 4 * F.lane + 256 * j) = zo[j];
    }
}

constexpr int S5_T = 34, S5_NCH = 128;
typedef float f32x4s __attribute__((ext_vector_type(4)));
struct S5Consts { bf16x8 abu[8]; float ar[4][4], ai[4][4]; };
__device__ __forceinline__ void s5_load_consts(const Frame& F, int gd, int lane, S5Consts& K) {
    const GAS float* AR = (const GAS float*)(F.ws + WS_SPAR); const GAS float* AI = AR + 2 * NG * NP; const GAS float* BB = AI + 2 * NG * NP;
    const int m = lane & 15, q = lane >> 4;
#pragma unroll
    for (int tt = 0; tt < 8; ++tt) { const int p = 16 * (tt >> 1) + m; v4u w = {0u, 0u, 0u, 0u};
        if (q < 2) { const GAS float* s = BB + (size_t)(gd * NP + p) * 32 + (tt & 1) * 16 + 8 * q; const f32x4 x0 = *(const GAS f32x4*)s, x1 = *(const GAS f32x4*)(s + 4);
            w.x = pk2(x0[0], x0[1]); w.y = pk2(x0[2], x0[3]); w.z = pk2(x1[0], x1[1]); w.w = pk2(x1[2], x1[3]); }
        K.abu[tt] = __builtin_bit_cast(bf16x8, w); }
#pragma unroll
    for (int pb = 0; pb < 4; ++pb) { const f32x4 a = *(const GAS f32x4*)(AR + gd * NP + 16 * pb + 4 * q), b = *(const GAS f32x4*)(AI + gd * NP + 16 * pb + 4 * q);
#pragma unroll
        for (int i = 0; i < 4; ++i) { K.ar[pb][i] = a[i]; K.ai[pb][i] = b[i]; } }
}
__device__ __forceinline__ int s5_row(int b, int dir, int tau) {
    const int ctxrow = NLAT + b * CTXL + (dir ? CTXL - 1 - tau : tau), latrow = b * SEQ + (dir ? (CTXL + SEQ - 1) - tau : tau - CTXL);
    return tau < CTXL ? ctxrow : latrow;
}
constexpr int S5_XP = 132;
template <bool READOUT>
__device__ __forceinline__ void s5_run(Frame& F, const S5Consts& K, const bf16x8 (&cfr)[4], int gd, int cg, LAS float* XS) {
    const int lane = F.lane, n = lane & 15, q = lane >> 4, dir = gd >> 7, g = gd & 127;
    const GAS bf16* HB = ws_tile(F, T_HB);
    GAS bf16* Y = (GAS bf16*)(F.ws + (dir ? WS_YB : WS_YF));
    const int chunk = cg * 16 + n, b = chunk >> 7, c = chunk & 127, tau0 = c * S5_T;
    LAS float* xs = XS + chunk * S5_XP + 8 * q;
    f32x4s X[8];
    if (READOUT) {
#pragma unroll
        for (int pb = 0; pb < 4; ++pb) { const f32x4 v0 = *(const LAS f32x4*)(xs + 32 * pb), v1 = *(const LAS f32x4*)(xs + 32 * pb + 4);
            X[2 * pb] = (f32x4s){v0[0], v0[2], v1[0], v1[2]}; X[2 * pb + 1] = (f32x4s){v0[1], v0[3], v1[1], v1[3]}; }
    } else {
#pragma unroll
        for (int tt = 0; tt < 8; ++tt) X[tt] = (f32x4s){0.f, 0.f, 0.f, 0.f};
    }
    constexpr int PD = 6;
    v4u ur[PD];
    const GAS bf16* ucol = HB + g * GH + 8 * q;
#pragma unroll
    for (int t = 0; t < PD; ++t) { ur[t] = (v4u){0u, 0u, 0u, 0u}; if (q < 2) ur[t] = *(const GAS v4u*)(ucol + (size_t)s5_row(b, dir, tau0 + t) * D); }
#define S5_STEP(KS, T, REFILL) do { \
        const bf16x8 ub = __builtin_bit_cast(bf16x8, ur[KS]); \
        if (REFILL) { ur[KS] = (v4u){0u, 0u, 0u, 0u}; if (q < 2) ur[KS] = *(const GAS v4u*)(ucol + (size_t)s5_row(b, dir, tau0 + (T) + PD) * D); } \
        _Pragma("unroll") for (int pb = 0; pb < 4; ++pb) _Pragma("unroll") for (int i = 0; i < 4; ++i) { const float re = X[2 * pb][i], im = X[2 * pb + 1][i]; \
            X[2 * pb][i] = K.ar[pb][i] * re - K.ai[pb][i] * im; X[2 * pb + 1][i] = K.ar[pb][i] * im + K.ai[pb][i] * re; } \
        _Pragma("unroll") for (int tt = 0; tt < 8; ++tt) X[tt] = __builtin_amdgcn_mfma_f32_16x16x32_bf16(K.abu[tt], ub, X[tt], 0, 0, 0); \
        if (READOUT) { f32x4s y0 = {0.f, 0.f, 0.f, 0.f}, y1 = y0; \
            _Pragma("unroll") for (int s = 0; s < 4; ++s) { v4u w; w.x = pk2(X[2 * s][0], X[2 * s][1]); w.y = pk2(X[2 * s][2], X[2 * s][3]); w.z = pk2(X[2 * s + 1][0], X[2 * s + 1][1]); w.w = pk2(X[2 * s + 1][2], X[2 * s + 1][3]); \
                const bf16x8 xb = __builtin_bit_cast(bf16x8, w); \
                if (s & 1) y1 = __builtin_amdgcn_mfma_f32_16x16x32_bf16(cfr[s], xb, y1, 0, 0, 0); else y0 = __builtin_amdgcn_mfma_f32_16x16x32_bf16(cfr[s], xb, y0, 0, 0, 0); } \
            const int tau = tau0 + (T); \
            if (tau >= CTXL) { const f32x4s y = y0 + y1; v2u w; w.x = pk2(y[0], y[1]); w.y = pk2(y[2], y[3]); *(GAS v2u*)(Y + (size_t)s5_row(b, dir, tau) * D + g * GH + 4 * q) = w; } } \
    } while (0)
#pragma unroll 1
    for (int t0 = 0; t0 < 24; t0 += PD) {
        S5_STEP(0, t0 + 0, true); S5_STEP(1, t0 + 1, true); S5_STEP(2, t0 + 2, true); S5_STEP(3, t0 + 3, true); S5_STEP(4, t0 + 4, true); S5_STEP(5, t0 + 5, true); }
    S5_STEP(0, 24, true); S5_STEP(1, 25, true); S5_STEP(2, 26, true); S5_STEP(3, 27, true); S5_STEP(4, 28, false); S5_STEP(5, 29, false);
    S5_STEP(0, 30, false); S5_STEP(1, 31, false); S5_STEP(2, 32, false); S5_STEP(3, 33, false);
#undef S5_STEP
    if (!READOUT) {
#pragma unroll
        for (int pb = 0; pb < 4; ++pb) { const f32x4s re = X[2 * pb], im = X[2 * pb + 1];
            *(LAS f32x4*)(xs + 32 * pb) = (f32x4){re[0], im[0], re[1], im[1]}; *(LAS f32x4*)(xs + 32 * pb + 4) = (f32x4){re[2], im[2], re[3], im[3]}; }
    }
}
__device__ __forceinline__ void s5_fused(Frame& F) {
    LAS float* XS = (LAS float*)F.lds;
    LAS f32x2* AG = (LAS f32x2*)(F.lds + 256 * S5_XP * 4);
    const GAS float* AR = (const GAS float*)(F.ws + WS_SPAR); const GAS float* AI = AR + 2 * NG * NP;
    const int lane = F.lane, n = lane & 15, q = lane >> 4, seg = F.tid >> 6, p = F.tid & 63;
    for (int gd = F.vcu; gd < 2 * NG; gd += F.G) {
        S5Consts K; s5_load_consts(F, gd, lane, K);
        bf16x8 cz[4];
#pragma unroll
        for (int s = 0; s < 4; ++s) cz[s] = (bf16x8){0, 0, 0, 0, 0, 0, 0, 0};
#pragma unroll 1
        for (int k2 = 0; k2 < 2; ++k2) s5_run<false>(F, K, cz, gd, F.wave * 2 + k2, XS);
        __syncthreads();
        {
            const double ar = AR[gd * NP + p], ai = AI[gd * NP + p];
            double sr = ar, si = ai, t; t = sr * sr - si * si; si = 2.0 * sr * si; sr = t;
            double pr = sr, pi = si;
            for (int k = 0; k < 4; ++k) { t = sr * sr - si * si; si = 2.0 * sr * si; sr = t; }
            t = pr * sr - pi * si; pi = pr * si + pi * sr; pr = t;
            const float tr = (float)pr, ti = (float)pi;
            double qr = pr, qi = pi; for (int k = 0; k < 4; ++k) { t = qr * qr - qi * qi; qi = 2.0 * qr * qi; qr = t; }
            const float t16r = (float)qr, t16i = (float)qi;
            for (int b = 0; b < 2; ++b) {
                LAS float* xs = XS + (b * S5_NCH + seg * 16) * S5_XP + 2 * p;
                f32x2 loc[16];
#pragma unroll
                for (int k = 0; k < 16; ++k) loc[k] = *(const LAS f32x2*)(xs + k * S5_XP);
                float ar_ = 0.f, ai_ = 0.f;
#pragma unroll
                for (int k = 0; k < 16; ++k) { const float nr = tr * ar_ - ti * ai_ + loc[k][0], ni = tr * ai_ + ti * ar_ + loc[k][1]; ar_ = nr; ai_ = ni; }
                AG[seg * 64 + p] = (f32x2){ar_, ai_};
                __syncthreads();
                float cr = 0.f, ci = 0.f;
                for (int s2 = 0; s2 < seg; ++s2) { const f32x2 a = AG[s2 * 64 + p]; const float nr = t16r * cr - t16i * ci + a[0], ni = t16r * ci + t16i * cr + a[1]; cr = nr; ci = ni; }
#pragma unroll
                for (int k = 0; k < 16; ++k) { *(LAS f32x2*)(xs + k * S5_XP) = (f32x2){cr, ci};
                    const float nr = tr * cr - ti * ci + loc[k][0], ni = tr * ci + ti * cr + loc[k][1]; cr = nr; ci = ni; }
                __syncthreads();
            }
        }
        bf16x8 cfr[4];
#pragma unroll
        for (int s = 0; s < 4; ++s) { const GAS float* cr = fin(F, I_CRE) + (size_t)(gd * GH + n) * NP + 16 * s + 4 * q; const GAS float* ci = fin(F, I_CIM) + (size_t)(gd * GH + n) * NP + 16 * s + 4 * q;
            const f32x4 a = *(const GAS f32x4*)cr, b = *(const GAS f32x4*)ci; v4u w; w.x = pk2(a[0], a[1]); w.y = pk2(a[2], a[3]); w.z = pk2(-b[0], -b[1]); w.w = pk2(-b[2], -b[3]);
            cfr[s] = __builtin_bit_cast(bf16x8, w); }
#pragma unroll 1
        for (int k2 = 0; k2 < 2; ++k2) s5_run<true>(F, K, cfr, gd, F.wave * 2 + k2, XS);
        __syncthreads();
    }
}

template <int MODE>
__device__ __forceinline__ void s5z_run(Frame& F, const S5Consts& K, const bf16x8 (&cfr)[4], int g, int dir, int b, int cgl, LAS float* XS) {
    constexpr bool READOUT = MODE != 0;
    const int lane = F.lane, n = lane & 15, q = lane >> 4;
    const GAS bf16* HB = ws_tile(F, T_HB);
    GAS bf16* YF = (GAS bf16*)(F.ws + WS_YF); GAS bf16* Z = ws_tile(F, T_Z);
    const int c = cgl * 16 + n, tau0 = c * S5_T;
    LAS float* xs = XS + (dir * S5_NCH + c) * S5_XP + 8 * q;
    f32x4s X[8];
    if (READOUT) {
#pragma unroll
        for (int pb = 0; pb < 4; ++pb) { const f32x4 v0 = *(const LAS f32x4*)(xs + 32 * pb), v1 = *(const LAS f32x4*)(xs + 32 * pb + 4);
            X[2 * pb] = (f32x4s){v0[0], v0[2], v1[0], v1[2]}; X[2 * pb + 1] = (f32x4s){v0[1], v0[3], v1[1], v1[3]}; }
    } else {
#pragma unroll
        for (int tt = 0; tt < 8; ++tt) X[tt] = (f32x4s){0.f, 0.f, 0.f, 0.f};
    }
    f32x4 dsk = {0.f, 0.f, 0.f, 0.f};
    if (MODE == 2) dsk = *(const GAS f32x4*)(fin(F, I_SD) + g * GH + 4 * q);
    constexpr int PD = 6;
    v4u ur[PD];
    const GAS bf16* ucol = HB + g * GH + 8 * q;
#pragma unroll
    for (int t = 0; t < PD; ++t) { ur[t] = (v4u){0u, 0u, 0u, 0u}; if (q < 2) ur[t] = *(const GAS v4u*)(ucol + (size_t)s5_row(b, dir, tau0 + t) * D); }
    unsigned long long yfn = 0ull, un = 0ull;
    if (MODE == 2) { const int tau = tau0; if (tau >= CTXL) { const size_t o = (size_t)s5_row(b, dir, tau) * D + g * GH + 4 * q;
        yfn = __hip_atomic_load((const GAS unsigned long long*)(YF + o), __ATOMIC_RELAXED, __HIP_MEMORY_SCOPE_AGENT); un = *(const GAS unsigned long long*)(HB + o); } }
#define S5Z_STEP(KS, T, REFILL) do { \
        const bf16x8 ub = __builtin_bit_cast(bf16x8, ur[KS]); \
        if (REFILL) { ur[KS] = (v4u){0u, 0u, 0u, 0u}; if (q < 2) ur[KS] = *(const GAS v4u*)(ucol + (size_t)s5_row(b, dir, tau0 + (T) + PD) * D); } \
        const unsigned long long yfc = yfn, uc = un; \
        if (MODE == 2) { const int tn_ = tau0 + (T) + 1; if ((T) + 1 < S5_T && tn_ >= CTXL) { const size_t o_ = (size_t)s5_row(b, dir, tn_) * D + g * GH + 4 * q; \
            yfn = __hip_atomic_load((const GAS unsigned long long*)(YF + o_), __ATOMIC_RELAXED, __HIP_MEMORY_SCOPE_AGENT); un = *(const GAS unsigned long long*)(HB + o_); } } \
        _Pragma("unroll") for (int pb = 0; pb < 4; ++pb) _Pragma("unroll") for (int i = 0; i < 4; ++i) { const float re = X[2 * pb][i], im = X[2 * pb + 1][i]; \
            X[2 * pb][i] = K.ar[pb][i] * re - K.ai[pb][i] * im; X[2 * pb + 1][i] = K.ar[pb][i] * im + K.ai[pb][i] * re; } \
        _Pragma("unroll") for (int tt = 0; tt < 8; ++tt) X[tt] = __builtin_amdgcn_mfma_f32_16x16x32_bf16(K.abu[tt], ub, X[tt], 0, 0, 0); \
        if (READOUT) { f32x4s y0 = {0.f, 0.f, 0.f, 0.f}, y1 = y0; \
            _Pragma("unroll") for (int s = 0; s < 4; ++s) { v4u w; w.x = pk2(X[2 * s][0], X[2 * s][1]); w.y = pk2(X[2 * s][2], X[2 * s][3]); w.z = pk2(X[2 * s + 1][0], X[2 * s + 1][1]); w.w = pk2(X[2 * s + 1][2], X[2 * s + 1][3]); \
                const bf16x8 xb = __builtin_bit_cast(bf16x8, w); \
                if (s & 1) y1 = __builtin_amdgcn_mfma_f32_16x16x32_bf16(cfr[s], xb, y1, 0, 0, 0); else y0 = __builtin_amdgcn_mfma_f32_16x16x32_bf16(cfr[s], xb, y0, 0, 0, 0); } \
            const int tau = tau0 + (T); \
            if (tau >= CTXL) { f32x4s y = y0 + y1; const size_t o = (size_t)s5_row(b, dir, tau) * D + g * GH + 4 * q; \
                if (MODE == 2) { const f32x4 yf4 = bf4_to_f32((v2u){(unsigned)yfc, (unsigned)(yfc >> 32)}), u4 = bf4_to_f32((v2u){(unsigned)uc, (unsigned)(uc >> 32)}); \
                    _Pragma("unroll") for (int e = 0; e < 4; ++e) y[e] = gelu_tanh_f(dsk[e] * u4[e] + yf4[e] + y[e]); \
                    v2u w; w.x = pk2(y[0], y[1]); w.y = pk2(y[2], y[3]); *(GAS v2u*)(Z + o) = w; } \
                else { v2u w; w.x = pk2(y[0], y[1]); w.y = pk2(y[2], y[3]); *(GAS v2u*)(YF + o) = w; } } } \
    } while (0)
#pragma unroll 1
    for (int t0 = 0; t0 < 24; t0 += PD) {
        S5Z_STEP(0, t0 + 0, true); S5Z_STEP(1, t0 + 1, true); S5Z_STEP(2, t0 + 2, true); S5Z_STEP(3, t0 + 3, true); S5Z_STEP(4, t0 + 4, true); S5Z_STEP(5, t0 + 5, true); }
    S5Z_STEP(0, 24, true); S5Z_STEP(1, 25, true); S5Z_STEP(2, 26, true); S5Z_STEP(3, 27, true); S5Z_STEP(4, 28, false); S5Z_STEP(5, 29, false);
    S5Z_STEP(0, 30, false); S5Z_STEP(1, 31, false); S5Z_STEP(2, 32, false); S5Z_STEP(3, 33, false);
#undef S5Z_STEP
    if (!READOUT) {
#pragma unroll
        for (int pb = 0; pb < 4; ++pb) { const f32x4s re = X[2 * pb], im = X[2 * pb + 1];
            *(LAS f32x4*)(xs + 32 * pb) = (f32x4){re[0], im[0], re[1], im[1]}; *(LAS f32x4*)(xs + 32 * pb + 4) = (f32x4){re[2], im[2], re[3], im[3]}; }
    }
}
__device__ __forceinline__ void s5z_load_cfr(const Frame& F, int gd, int lane, bf16x8 (&cfr)[4]) {
    const int n = lane & 15, q = lane >> 4;
#pragma unroll
    for (int s = 0; s < 4; ++s) { const GAS float* cr = fin(F, I_CRE) + (size_t)(gd * GH + n) * NP + 16 * s + 4 * q; const GAS float* ci = fin(F, I_CIM) + (size_t)(gd * GH + n) * NP + 16 * s + 4 * q;
        const f32x4 a = *(const GAS f32x4*)cr, b = *(const GAS f32x4*)ci; v4u w; w.x = pk2(a[0], a[1]); w.y = pk2(a[2], a[3]); w.z = pk2(-b[0], -b[1]); w.w = pk2(-b[2], -b[3]);
        cfr[s] = __builtin_bit_cast(bf16x8, w); }
}
__device__ __forceinline__ void s5z_fused(Frame& F) {
    LAS float* XS = (LAS float*)F.lds;
    LAS f32x2* AG = (LAS f32x2*)(F.lds + 256 * S5_XP * 4);
    const GAS float* AR = (const GAS float*)(F.ws + WS_SPAR); const GAS float* AI = AR + 2 * NG * NP;
    const int lane = F.lane, seg = F.tid >> 6, p = F.tid & 63;
    for (int wu = F.vcu; wu < 2 * NG; wu += F.G) {
        const int g = wu & 127, b = wu >> 7;
        bf16x8 cz[4];
#pragma unroll
        for (int s = 0; s < 4; ++s) cz[s] = (bf16x8){0, 0, 0, 0, 0, 0, 0, 0};
#pragma unroll 1
        for (int dir = 0; dir < 2; ++dir) { S5Consts K; s5_load_consts(F, dir * NG + g, lane, K); s5z_run<0>(F, K, cz, g, dir, b, F.wave, XS); }
        __syncthreads();
#pragma unroll 1
        for (int dir = 0; dir < 2; ++dir) {
            const int gd = dir * NG + g;
            const double ar = AR[gd * NP + p], ai = AI[gd * NP + p];
            double sr = ar, si = ai, t; t = sr * sr - si * si; si = 2.0 * sr * si; sr = t;
            double pr = sr, pi = si;
            for (int k = 0; k < 4; ++k) { t = sr * sr - si * si; si = 2.0 * sr * si; sr = t; }
            t = pr * sr - pi * si; pi = pr * si + pi * sr; pr = t;
            const float tr = (float)pr, ti = (float)pi;
            double qr = pr, qi = pi; for (int k = 0; k < 4; ++k) { t = qr * qr - qi * qi; qi = 2.0 * qr * qi; qr = t; }
            const float t16r = (float)qr, t16i = (float)qi;
            LAS float* xs = XS + (dir * S5_NCH + seg * 16) * S5_XP + 2 * p;
            f32x2 loc[16];
#pragma unroll
            for (int k = 0; k < 16; ++k) loc[k] = *(const LAS f32x2*)(xs + k * S5_XP);
            float ar_ = 0.f, ai_ = 0.f;
#pragma unroll
            for (int k = 0; k < 16; ++k) { const float nr = tr * ar_ - ti * ai_ + loc[k][0], ni = tr * ai_ + ti * ar_ + loc[k][1]; ar_ = nr; ai_ = ni; }
            AG[seg * 64 + p] = (f32x2){ar_, ai_};
            __syncthreads();
            float cr = 0.f, ci = 0.f;
            for (int s2 = 0; s2 < seg; ++s2) { const f32x2 a = AG[s2 * 64 + p]; const float nr = t16r * cr - t16i * ci + a[0], ni = t16r * ci + t16i * cr + a[1]; cr = nr; ci = ni; }
#pragma unroll
            for (int k = 0; k < 16; ++k) { *(LAS f32x2*)(xs + k * S5_XP) = (f32x2){cr, ci};
                const float nr = tr * cr - ti * ci + loc[k][0], ni = tr * ci + ti * cr + loc[k][1]; cr = nr; ci = ni; }
            __syncthreads();
        }
        { S5Consts K; s5_load_consts(F, g, lane, K); bf16x8 cfr[4]; s5z_load_cfr(F, g, lane, cfr); s5z_run<1>(F, K, cfr, g, 0, b, F.wave, XS); }
        asm volatile("s_waitcnt vmcnt(0)" ::: "memory");
        __syncthreads();
        { S5Consts K; s5_load_consts(F, NG + g, lane, K); bf16x8 cfr[4]; s5z_load_cfr(F, NG + g, lane, cfr); s5z_run<2>(F, K, cfr, g, 1, b, F.wave, XS); }
        __syncthreads();
    }
}

constexpr int ATT_KP = 272, ATT_VP = 528, ATT_VOFF = 256 * ATT_KP;
constexpr int ATT_RPOFF = ATT_VOFF + 128 * ATT_VP;
__device__ __forceinline__ void attn_unit(Frame& F, bool lat, int b, int h, int r, int j, int qrow0, int dv) {
    const int lane = F.lane, n = lane & 15, qd = lane >> 4;
    const GAS bf16* QK = ws_tile(F, T_QK); const GAS bf16* VT = ws_tile(F, T_VT); GAS bf16* AO = ws_tile(F, T_AO);
    const float scale = 0.08838834764831845f * 1.4426950408889634f, NEG = -3.0e38f;
    const int mkey = 8 * (n >> 2) + (n & 3);
    unsigned kb_ = (unsigned)(n * ATT_KP + 16 * qd), vb_ = (unsigned)(ATT_VOFF + n * ATT_VP + 16 * qd);
    asm volatile("" : "+v"(kb_), "+v"(vb_));
    const LAS unsigned char* kbase = F.lds + kb_; const LAS unsigned char* vbase = F.lds + vb_;
    const LAS float* RP = (const LAS float*)(F.lds + ATT_RPOFF);
    bf16x8 qf[4];
    { const GAS bf16* qp = QK + (size_t)(qrow0 + n) * 4096 + h * HD + 8 * qd;
#pragma unroll
      for (int kk = 0; kk < 4; ++kk) qf[kk] = *(const GAS bf16x8*)(qp + 32 * kk); }
    const int rs = min(max(r - 4, 0), 56), cs = min(max(16 * j - 8, 0), 32), qc = 16 * j + n, cst = min(max(qc - 8, 0), 48);
    float S[16][2][4];
    float mx = NEG;
    bf16x8 kf[2][4];
    if (lat && !(dv & 1)) {
        const GAS bf16* kp = QK + (size_t)(b * SEQ + (rs + (n >> 2)) * 64 + cs + (n & 3)) * 4096 + D + h * HD + 8 * qd;
#pragma unroll
        for (int kk = 0; kk < 4; ++kk) kf[0][kk] = *(const GAS bf16x8*)(kp + 32 * kk);
#pragma unroll
        for (int st = 0; st < 16; ++st) { const int blk = st >> 1, hf = st & 1, cg = blk >> 1, rh = blk & 1;
            if (st + 1 < 16) { constexpr int dummy_ = 0; (void)dummy_;
                const int s1 = st + 1, o1 = ((s1 >> 1) & 1) * 256 + (s1 >> 2) * 8 + (s1 & 1) * 4, o0 = rh * 256 + cg * 8 + hf * 4;
                kp += (ptrdiff_t)(o1 - o0) * 4096; asm volatile("" : "+v"(kp));
#pragma unroll
                for (int kk = 0; kk < 4; ++kk) kf[(st + 1) & 1][kk] = *(const GAS bf16x8*)(kp + 32 * kk); }
            f32x4 acc = {0.f, 0.f, 0.f, 0.f};
#pragma unroll
            for (int kk = 0; kk < 4; ++kk) acc = __builtin_amdgcn_mfma_f32_16x16x32_bf16(kf[st & 1][kk], qf[kk], acc, 0, 0, 0);
#pragma unroll
            for (int i = 0; i < 4; ++i) { const int kc = cs + 8 * cg + 4 * hf + i; const bool valid = (unsigned)(kc - cst) < 16u;
                const float sc = acc[i] * scale + RP[(rs + 4 * rh + qd - r + 7) * 31 + (kc - qc + 15)]; const float sv = valid ? sc : NEG;
                S[blk][hf][i] = sv; mx = fmaxf(mx, sv); }
            __builtin_amdgcn_sched_barrier(0); }
    } else {
#pragma unroll
        for (int blk = 0; blk < 8; ++blk)
#pragma unroll
            for (int hf = 0; hf < 2; ++hf)
#pragma unroll
                for (int i = 0; i < 4; ++i) S[blk][hf][i] = NEG;
    }
    if (dv & 2) {
#pragma unroll
        for (int blk = 8; blk < 16; ++blk)
#pragma unroll
            for (int hf = 0; hf < 2; ++hf)
#pragma unroll
                for (int i = 0; i < 4; ++i) { S[blk][hf][i] = 0.f; mx = fmaxf(mx, 0.f); }
    } else {
#pragma unroll
    for (int kk = 0; kk < 4; ++kk) kf[0][kk] = *(const LAS bf16x8*)(kbase + 64 * kk);
#pragma unroll
    for (int st = 0; st < 16; ++st) { const int blk = 8 + (st >> 1), hf = st & 1;
        if (st + 1 < 16) { const LAS unsigned char* kp = kbase + (16 * (st + 1)) * ATT_KP;
#pragma unroll
            for (int kk = 0; kk < 4; ++kk) kf[(st + 1) & 1][kk] = *(const LAS bf16x8*)(kp + 64 * kk); }
        f32x4 acc = {0.f, 0.f, 0.f, 0.f};
#pragma unroll
        for (int kk = 0; kk < 4; ++kk) acc = __builtin_amdgcn_mfma_f32_16x16x32_bf16(kf[st & 1][kk], qf[kk], acc, 0, 0, 0);
#pragma unroll
        for (int i = 0; i < 4; ++i) { const float sv = acc[i] * scale; S[blk][hf][i] = sv; mx = fmaxf(mx, sv); }
        __builtin_amdgcn_sched_barrier(0); }
    }
    mx = fmaxf(mx, __shfl_xor(mx, 16)); mx = fmaxf(mx, __shfl_xor(mx, 32));
    float sum = 0.f; bf16x8 pf[16];
#pragma unroll
    for (int blk = 0; blk < 16; ++blk) { float p[8];
#pragma unroll
        for (int hf = 0; hf < 2; ++hf)
#pragma unroll
            for (int i = 0; i < 4; ++i) { const float e = __builtin_amdgcn_exp2f(S[blk][hf][i] - mx); p[4 * hf + i] = e; sum += e; }
        v4u w; w.x = pk2(p[0], p[1]); w.y = pk2(p[2], p[3]); w.z = pk2(p[4], p[5]); w.w = pk2(p[6], p[7]); pf[blk] = __builtin_bit_cast(bf16x8, w); }
    sum += __shfl_xor(sum, 16); sum += __shfl_xor(sum, 32);
    const float inv = 1.0f / sum;
    f32x4 O[8];
#pragma unroll
    for (int dt = 0; dt < 8; ++dt) O[dt] = (f32x4){0.f, 0.f, 0.f, 0.f};
    bf16x8 vf[2][8];
    if (lat && !(dv & 4)) {
        const GAS bf16* vloc = (dv & 16) ? VT + (size_t)n * NROWS + qd * 8 : VT + (size_t)(h * HD + n) * NROWS + b * SEQ + (cs >> 3) * 512 + (rs + qd) * 8;
        bf16x8 vr[3][8];
#pragma unroll
        for (int dt = 0; dt < 8; ++dt) vr[0][dt] = *(const GAS bf16x8*)(vloc + (size_t)dt * 16 * NROWS);
#pragma unroll
        for (int dt = 0; dt < 8; ++dt) vr[1][dt] = *(const GAS bf16x8*)(vloc + 32 + (size_t)dt * 16 * NROWS);
#pragma unroll
        for (int blk = 0; blk < 8; ++blk) {
            if (blk + 2 < 8) { const int o2 = ((blk + 2) >> 1) * 512 + ((blk + 2) & 1) * 32;
#pragma unroll
                for (int dt = 0; dt < 8; ++dt) vr[(blk + 2) % 3][dt] = *(const GAS bf16x8*)(vloc + o2 + (size_t)dt * 16 * NROWS); }
#pragma unroll
            for (int dt = 0; dt < 8; ++dt) O[dt] = __builtin_amdgcn_mfma_f32_16x16x32_bf16(vr[blk % 3][dt], pf[blk], O[dt], 0, 0, 0);
            __builtin_amdgcn_sched_barrier(0); }
    }
    if (!(dv & 8)) {
#pragma unroll
    for (int dt = 0; dt < 8; ++dt) vf[0][dt] = *(const LAS bf16x8*)(vbase + dt * 16 * ATT_VP);
#pragma unroll
    for (int cb = 0; cb < 8; ++cb) {
        if (cb + 1 < 8) {
#pragma unroll
            for (int dt = 0; dt < 8; ++dt) vf[(cb + 1) & 1][dt] = *(const LAS bf16x8*)(vbase + 64 * (cb + 1) + dt * 16 * ATT_VP); }
#pragma unroll
        for (int dt = 0; dt < 8; ++dt) O[dt] = __builtin_amdgcn_mfma_f32_16x16x32_bf16(vf[cb & 1][dt], pf[8 + cb], O[dt], 0, 0, 0);
        __builtin_amdgcn_sched_barrier(0); }
    }
    GAS bf16* op = AO + (size_t)(qrow0 + n) * D + h * HD + 4 * qd;
#pragma unroll
    for (int dt = 0; dt < 8; ++dt) { v2u w; w.x = pk2(O[dt][0] * inv, O[dt][1] * inv); w.y = pk2(O[dt][2] * inv, O[dt][3] * inv); *(GAS v2u*)(op + 16 * dt) = w; }
}
__device__ __forceinline__ void attn_phase2(Frame& F, int dv) {
    const GAS bf16* QK = ws_tile(F, T_QK); const GAS bf16* VT = ws_tile(F, T_VT);
    for (int wu = F.vcu; wu < 2 * NH * 8; wu += F.G) {
        const int b = wu >> 7, h = (wu >> 3) & 15, ro = wu & 7;
        int tid_ = F.tid; asm volatile("" : "+v"(tid_));
#pragma unroll 2
        for (int i = 0; i < 8; ++i) { const int pc = tid_ + NTHREADS * i;
            { const int key = pc >> 4, c = pc & 15, rho = (key & ~31) + 16 * ((key >> 2) & 1) + 4 * ((key >> 3) & 3) + (key & 3);
              *(LAS v4u*)(F.lds + rho * ATT_KP + 16 * c) = *(const GAS v4u*)(QK + (size_t)(NLAT + b * CTXL + key) * 4096 + D + h * HD + 8 * c); }
            { const int dh = pc >> 5, c = pc & 31;
              *(LAS v4u*)(F.lds + ATT_VOFF + dh * ATT_VP + 16 * c) = *(const GAS v4u*)(VT + (size_t)(h * HD + dh) * NROWS + NLAT + b * CTXL + 8 * c); } }
        for (int i = tid_; i < 15 * 31; i += NTHREADS) ((LAS float*)(F.lds + ATT_RPOFF))[i] = fin(F, I_RPB)[h * 15 * 31 + i] * 1.4426950408889634f;
        __syncthreads();
        int b2 = b, h2 = h; asm volatile("" : "+s"(b2), "+s"(h2));
        const int r = 8 * ro + F.wave;
        const int nu = F.wave < 2 ? 5 : 4;
#pragma unroll 1
        for (int u = 0; u < nu; ++u) { const bool lat = u < 4;
            attn_unit(F, lat, b2, h2, lat ? r : 0, lat ? u : 0, lat ? b2 * SEQ + r * 64 + 16 * u : NLAT + b2 * CTXL + 16 * (2 * ro + F.wave), dv); }
        __syncthreads();
    }
}

constexpr int CV_NIT = (6 + 2 * NE * 3) * 2048;
constexpr int KG_QKV = CV_KG1, KG_WO = CV_KG2, KG_DN0 = CV_KG3, KG_UP0 = CV_KG4;
constexpr int CV_W1 = 8 * (32 - KG_QKV) * CV_N1, CV_W2 = 8 * (32 - KG_WO) * CV_N2, CV_W3 = 8 * (32 - KG_DN0) * CV_N3, CV_W4 = 8 * (32 - KG_UP0) * CV_N4;
constexpr int CV_T4_END = CV_NIT - CV_W3, CV_T2_END = CV_T4_END - CV_W4, CV_T1_END = CV_T2_END - CV_W2, CV_P0_END = CV_T1_END - CV_W1;
static_assert(CV_P0_END >= 3 * 2048 && CV_T1_END >= 6 * 2048 && CV_T2_END >= (6 + NE * 3) * 2048, "conversion windows: the QKV weight in the prologue, Wo / GLU weights by the end of the QKV window, every layer-0 expert weight before the layer-0 up GEMM");
__device__ __forceinline__ bool split_role(const Frame& F, int KG, int& cx, int& Gg, int& ci, int& nci) {
    if (F.G != 256) { cx = F.vcu; Gg = F.G; ci = 0; nci = 0; return true; }
    const int x = F.vcu >> 5, k = F.vcu & 31;
    if (k < KG) { cx = x * KG + k; Gg = 8 * KG; ci = 0; nci = 0; return true; }
    ci = x * (32 - KG) + (k - KG); nci = 8 * (32 - KG); cx = 0; Gg = 0; return false;
}
constexpr int NPH = 22;
__global__ void __launch_bounds__(NTHREADS, 2) mk_fwd(Args args) {
    extern __shared__ __attribute__((aligned(16))) unsigned char lds[];
    Frame F;
    F.lds = (LAS unsigned char*)lds; F.ws = (GAS unsigned char*)args.ws; F.out = (GAS float*)args.out;
    F.ap = (const CAS Args*)__builtin_amdgcn_kernarg_segment_ptr();
    F.tid = threadIdx.x; F.lane = F.tid & 63; F.wave = __builtin_amdgcn_readfirstlane(F.tid >> 6);
    F.G = gridDim.x; { const int bx = blockIdx.x; F.vcu = (F.G % 8 == 0) ? (bx % 8) * (F.G / 8) + bx / 8 : bx; }
    const int vcu0 = F.vcu, wave0 = F.wave;
    volatile LAS unsigned* MISC = (volatile LAS unsigned*)(F.lds + MISC_OFF);
    for (int u = F.tid; u < 32; u += NTHREADS) MISC[u] = 0u;
    __syncthreads();
    const int lo = args.ph_lo, hi = args.ph_hi;
    const bool multi = (hi - lo) > 1;
    XcdBarrier bar; bar.bar = (unsigned*)(unsigned char*)(F.ws + WS_CTL) + CW_BAR; bar.x = 0; bar.st = nullptr;
    if (multi) bar = xcd_barrier_post((unsigned*)(unsigned char*)(F.ws + WS_CTL) + CW_BAR, MISC + 8);
#if PROBE
#define IS_T0() ({ unsigned z2_ = 0u; asm volatile("" : "+v"(z2_)); (wave0 == 0 && __builtin_amdgcn_mbcnt_hi(~0u, __builtin_amdgcn_mbcnt_lo(~0u, z2_)) == 0); })
#endif
#define IN(k) ({ int lo_ = lo, hi_ = hi; asm volatile("" : "+s"(lo_), "+s"(hi_)); (lo_ <= (k) && (k) < hi_); })
#if PROBE
#define SEAM13(k) do { if (IN(k) && IN(14)) xcd_barrier(bar); if ((k) == PROBE_B && IS_T0()) { const unsigned long long t_ = wall_clock64(); MISC[18] = (unsigned)t_; MISC[19] = (unsigned)(t_ >> 32); } if (14 == PROBE_A && IS_T0()) { const unsigned long long t_ = wall_clock64(); MISC[16] = (unsigned)t_; MISC[17] = (unsigned)(t_ >> 32); } } while (0)
#else
#define SEAM13(k) do { if (IN(k) && IN(14)) xcd_barrier(bar); } while (0)
#endif
#if PROBE
#define SEAM_SKIP(a, b) do { if (IN(a) && IN(b)) xcd_barrier(bar); if ((a) == PROBE_B && IS_T0()) { const unsigned long long t_ = wall_clock64(); MISC[18] = (unsigned)t_; MISC[19] = (unsigned)(t_ >> 32); } if ((b) == PROBE_A && IS_T0()) { const unsigned long long t_ = wall_clock64(); MISC[16] = (unsigned)t_; MISC[17] = (unsigned)(t_ >> 32); } } while (0)
#else
#define SEAM_SKIP(a, b) do { if (IN(a) && IN(b)) xcd_barrier(bar); } while (0)
#endif
#define REPN(k) (((k) == REPEAT_PH) ? REPEAT_N : 1)
#define PH() do { const CAS Args* a_ = (const CAS Args*)__builtin_amdgcn_kernarg_segment_ptr(); asm volatile("" : "+s"(a_)); F.ap = a_; unsigned char* w_ = args.ws; asm volatile("" : "+s"(w_)); F.ws = (GAS unsigned char*)w_; unsigned z_ = 0u; asm volatile("" : "+v"(z_)); int l_ = __builtin_amdgcn_mbcnt_hi(~0u, __builtin_amdgcn_mbcnt_lo(~0u, z_)); int wv_ = wave0; asm volatile("" : "+s"(wv_)); F.lane = l_; F.wave = wv_; F.tid = wv_ * 64 + l_; int v_ = vcu0; asm volatile("" : "+s"(v_)); F.vcu = v_; } while (0)
#if PROBE
#define SEAM(k) do { if (IN(k) && IN((k) + 1)) xcd_barrier(bar); if ((k) == PROBE_B && IS_T0()) { const unsigned long long t_ = wall_clock64(); MISC[18] = (unsigned)t_; MISC[19] = (unsigned)(t_ >> 32); } if ((k) + 1 == PROBE_A && IS_T0()) { const unsigned long long t_ = wall_clock64(); MISC[16] = (unsigned)t_; MISC[17] = (unsigned)(t_ >> 32); } } while (0)
#else
#define SEAM(k) do { if (IN(k) && IN((k) + 1)) xcd_barrier(bar); } while (0)
#endif

#if PROBE
    if (PROBE_A == 0 && IS_T0()) { const unsigned long long t_ = wall_clock64(); MISC[16] = (unsigned)t_; MISC[17] = (unsigned)(t_ >> 32); }
#endif
    if (IN(0)) for (int rp_ = 0; rp_ < REPN(0); ++rp_) { PH(); p0_mods(F); p0_s5params(F); __syncthreads(); p0_weights(F, 0, F.G == 256 ? CV_P0_END : CV_NIT, F.vcu * NWAVES + F.wave, F.G * NWAVES);     __syncthreads(); }
    SEAM(0);
    for (int l = 0; l < 2; ++l) {
        if (l == 0) {
            if (IN(1)) for (int rp_ = 0; rp_ < REPN(1); ++rp_) { PH(); p1_prep(F); }
            SEAM(1);
            if (IN(2)) for (int rp_ = 0; rp_ < REPN(2); ++rp_) { PH(); int cx, Gg, ci, nci; if (split_role(F, KG_QKV, cx, Gg, ci, nci)) { SegSched S; S.init(Gg, cx, 34, 16, T_HB, T_WQKV, 8, 34, T_WQKV + 16, T_HB); EpiQKV E{ws_tile(F, T_QK), ws_tile(F, T_VT)}; run_gemm<EpiQKV, SegSched, false, 0, false>(F, S, E); } else p0_weights(F, CV_P0_END, CV_T1_END, ci * NWAVES + F.wave, nci * NWAVES); }
            SEAM(2);
            if (IN(3)) for (int rp_ = 0; rp_ < REPN(3); ++rp_) { PH();
#if ATTN_NAIVE
                p3_attn_naive(F);
#else
                attn_phase2(F, (rp_ < REPN(3) - 1) ? DUMMY_VARIANT : 0);
#endif
                __syncthreads(); }
            SEAM(3);
            if (IN(4)) for (int rp_ = 0; rp_ < REPN(4); ++rp_) { PH(); int cx, Gg, ci, nci; if (split_role(F, KG_WO, cx, Gg, ci, nci)) { SegSched S; S.init(Gg, cx, 34, 8, T_AO, T_WO, 0, 0, 0, 0); EpiWo E{(GAS bf16*)(F.ws + WS_O)}; run_gemm(F, S, E); } else p0_weights(F, CV_T1_END, CV_T2_END, ci * NWAVES + F.wave, nci * NWAVES); }
            SEAM(4);
        } else {
#if S5_NAIVE
            if (IN(11)) for (int rp_ = 0; rp_ < REPN(11); ++rp_) { PH(); s5_naive(F); }
            SEAM(11); SEAM(12); SEAM(13);
#else
#if S5_FUSE_Z
            if (IN(11)) for (int rp_ = 0; rp_ < REPN(11); ++rp_) { PH(); s5z_fused(F); }
            SEAM_SKIP(11, 15);
#else
            if (IN(11)) for (int rp_ = 0; rp_ < REPN(11); ++rp_) { PH(); s5_fused(F); }
            SEAM13(11);
#endif
#endif
#if !S5_FUSE_Z || S5_NAIVE
            if (IN(14)) for (int rp_ = 0; rp_ < REPN(14); ++rp_) { PH(); zprep_phase(F); }
            SEAM(14);
#endif
            if (IN(15)) for (int rp_ = 0; rp_ < REPN(15); ++rp_) { PH(); SegSched S; S.init(F.G, F.vcu, 32, 16, T_Z, T_WVG, 0, 0, 0, 0); EpiGlu E{(GAS bf16*)(F.ws + WS_O)}; run_gemm(F, S, E); }
            SEAM(15);
        }
        const int pb = l ? 16 : 5;
        if (IN(pb)) for (int rp_ = 0; rp_ < REPN(pb); ++rp_) { PH(); row_phase(F, l, (rp_ < REPN(pb) - 1) ? DUMMY_VARIANT : 0); }
        SEAM(pb);
        if (IN(pb + 1)) for (int rp_ = 0; rp_ < REPN(pb + 1); ++rp_) { PH(); topk_phase(F, l); }
#if !GATHER_IN_GEMM
        SEAM(pb + 1);
#endif
#if !GATHER_IN_GEMM
        if (IN(pb + 2)) for (int rp_ = 0; rp_ < REPN(pb + 2); ++rp_) { PH(); gather_phase(F, l); }
        SEAM(pb + 2);
#else
        SEAM_SKIP(pb + 1, pb + 3);
#endif
        if (IN(pb + 3)) for (int rp_ = 0; rp_ < REPN(pb + 3); ++rp_) { PH(); int cx, Gg, ci, nci; if (split_role(F, l == 0 ? KG_UP0 : 32, cx, Gg, ci, nci)) { MoeSched S; S.init(Gg, cx, l ? 4 : 5, 16, T_XE, T_MOE1 + l * 256); S.ga_idx = (const GAS int*)(F.ws + WS_IDX); S.ga_nrows = NROWS; EpiSwiglu E{ws_tile(F, T_ACT), T_MOE1 + l * 256};
#if GATHER_IN_GEMM
            run_gemm_ga(F, S, E, T_HB);
#else
            run_gemm(F, S, E);
#endif
            } else p0_weights(F, CV_T2_END, CV_T4_END, ci * NWAVES + F.wave, nci * NWAVES);
        }
        SEAM(pb + 3);
        if (IN(pb + 4)) for (int rp_ = 0; rp_ < REPN(pb + 4); ++rp_) { PH(); int cx, Gg, ci, nci; if (split_role(F, l == 0 ? KG_DN0 : 32, cx, Gg, ci, nci)) { MoeSched S; S.init(Gg, cx, l ? 4 : 5, 8, T_ACT, T_MOE2 + l * 128); EpiDown E{(GAS bf16*)(F.ws + WS_YE), (const GAS float*)(F.ws + WS_GATE), T_MOE2 + l * 128}; run_gemm<EpiDown, MoeSched, false, MOE_BAUX>(F, S, E); } else p0_weights(F, CV_T4_END, CV_NIT, ci * NWAVES + F.wave, nci * NWAVES); }
        SEAM(pb + 4);
        if (IN(pb + 5)) for (int rp_ = 0; rp_ < REPN(pb + 5); ++rp_) { PH(); combine_phase(F, l); }
        SEAM(pb + 5);
    }
#if PROBE
    if (blockIdx.x == 0 && IS_T0()) { const unsigned long long tA_ = ((unsigned long long)MISC[17] << 32) | MISC[16], tB_ = ((unsigned long long)MISC[19] << 32) | MISC[18]; const float us_ = (float)(tB_ - tA_) * 0.01f; F.out[0] = exp2f(rintf(log2f(us_) * PROBE_Q + PROBE_OFF) / PROBE_Q); }
#endif
#undef IN
#undef SEAM
}

extern "C" void kernel_launch(void* const* d_in, const int* in_sizes, int n_in, void* d_out, int out_size, void* d_ws, size_t ws_size, hipStream_t stream) {
    static int grid = 0;
    if (grid == 0) {
        if (n_in != 25 || out_size != NLAT * D || ws_size < WS_END) { fprintf(stderr, "kernel_launch: unexpected shapes (n_in %d out %d ws %zu)\n", n_in, out_size, ws_size); grid = -1; return; }
        int dev = 0, cus = 0, per_cu = 0;
        if (hipGetDevice(&dev) != hipSuccess || hipDeviceGetAttribute(&cus, hipDeviceAttributeMultiprocessorCount, dev) != hipSuccess) { grid = -1; return; }
        if (hipFuncSetAttribute((const void*)mk_fwd, hipFuncAttributeMaxDynamicSharedMemorySize, LDS_BYTES) != hipSuccess) { fprintf(stderr, "kernel_launch: hipFuncSetAttribute failed\n"); grid = -1; return; }
        if (hipOccupancyMaxActiveBlocksPerMultiprocessor(&per_cu, (const void*)mk_fwd, NTHREADS, LDS_BYTES) != hipSuccess || per_cu < 1) { fprintf(stderr, "kernel_launch: occupancy query reports %d\n", per_cu); }
        (void)hipGetLastError();
        grid = cus;
    }
    if (grid < 0) return;
    (void)hipMemsetAsync((char*)d_ws + WS_CTL, 0, CTL_ZERO_BYTES, stream);
    Args a{};
    for (int i = 0; i < 25; ++i) a.in[i] = (const float*)d_in[i];
    a.out = (float*)d_out; a.ws = (unsigned char*)d_ws;
#if MK_N_LAUNCHES == 1
    a.ph_lo = 0; a.ph_hi = NPH;
    hipLaunchKernelGGL(mk_fwd, dim3(grid), dim3(NTHREADS), LDS_BYTES, stream, a);
#else
    for (int p = 0; p < NPH; ++p) { a.ph_lo = p; a.ph_hi = p + 1; hipLaunchKernelGGL(mk_fwd, dim3(grid), dim3(NTHREADS), LDS_BYTES, stream, a); }
#endif
}
```

```cpp
#include <hip/hip_runtime.h>
#include <cstdio>
#include <cstdint>
namespace pg8 {
#define PG8_LAS __attribute__((address_space(3)))
typedef unsigned short bf16_t;
typedef short bf16x8 __attribute__((ext_vector_type(8)));
typedef float f32x4 __attribute__((ext_vector_type(4)));
typedef unsigned u32x4 __attribute__((ext_vector_type(4)));
constexpr int BM = 256, BK = 64, HALF = 128, HTB = HALF * BK * 2  , STAGE_BYTES = 8 * HTB, NXCD = 8, WGM = 8;

__host__ __device__ __forceinline__ int lds_byte(int r, int c) { const int st = (r >> 4) * 2 + (c >> 5), rr = r & 15, cc = c & 31, ob = rr * 64 + cc * 2; return st * 1024 + (ob ^ (((ob >> 9) & 1) << 5)); }
__host__ __device__ __forceinline__ void stage_rc(int b, int& R, int& C) { const int st = b / 1024, sb = b % 1024, swz = sb ^ (((sb >> 9) & 1) << 5); R = (st >> 1) * 16 + swz / 64; C = (st & 1) * 32 + (swz % 64) / 2; }
__host__ __device__ __forceinline__ int perm32(int rho) { const int n = rho >> 4, i = rho & 15; return 8 * (i >> 2) + 4 * n + (i & 3); }

struct Unit { int pm, pn; };
struct Gemm { const bf16_t* A; const bf16_t* Bt; int M, N, K; };

__device__ __forceinline__ unsigned cvt_pk_bf16(float lo, float hi) { unsigned r; asm volatile("v_cvt_pk_bf16_f32 %0, %1, %2" : "=v"(r) : "v"(lo), "v"(hi)); return r; }
#ifndef WT_BKM
#define WT_BKM 1
#endif
template <class Epi, class Sched, bool ALIGN_EPI = false, bool SP2 = false, bool GA = false, bool VR = false, int BAUX = 0, bool BKM = false>
__device__ __forceinline__ void gemm_phase(PG8_LAS unsigned char* lds, const Gemm g, const Sched& S, const Epi& E, int tid_in) {
    int tid_ = tid_in; asm volatile("" : "+v"(tid_));
    const int tid = tid_, wid = __builtin_amdgcn_readfirstlane(tid >> 6), lane = tid & 63, wr = wid >> 2, wc = wid & 3, fr = lane & 15, fq = lane >> 4;
    const int K = g.K, nt = K / BK;
    unsigned voffA[2], voffB[2];
#pragma unroll
    for (int i = 0; i < 2; ++i) { int R, C; stage_rc(tid * 16 + i * 8192, R, C); const int Rb = Epi::PERM ? ((R & ~31) + perm32(R & 31)) : R;
        voffA[i] = (unsigned)(R * K + C) * 2u; voffB[i] = BKM ? (unsigned)(Rb * BK + C) * 2u : (unsigned)(Rb * K + C) * 2u; }
    unsigned vA[2][2] = {{0u, 0u}, {0u, 0u}}, nvA[2][2] = {{0u, 0u}, {0u, 0u}}; int gaR[2] = {0, 0}; unsigned gaC[2] = {0u, 0u};
    if constexpr (GA) {
#pragma unroll
        for (int i = 0; i < 2; ++i) { int R, C; stage_rc(tid * 16 + i * 8192, R, C); gaR[i] = R; gaC[i] = (unsigned)C * 2u; } }
#define PG8_GA_OFFS(dst, unit) do { const int _r0 = S.ga_row0(unit); _Pragma("unroll") for (int _h = 0; _h < 2; ++_h) _Pragma("unroll") for (int _i = 0; _i < 2; ++_i) { \
        const unsigned _ix = (unsigned)S.ga_idx[_r0 + _h * HALF + gaR[_i]]; dst[_h][_i] = (_ix < S.ga_nrows ? _ix : 0u) * (unsigned)(K * 2) + gaC[_i]; } } while (0)
    const size_t kstep = (size_t)(BK * 2);
    const size_t hstep = (size_t)HALF * K * 2;
    const size_t kstepB = BKM ? (size_t)(256 * BK * 2) : kstep, hstepB = BKM ? (size_t)(HALF * BK * 2) : hstep;
    const size_t tstep = 2 * hstep;
    const unsigned ldsw = (unsigned)wid * 1024u;
    const int aoff = lds_byte(wr * 64 + fr, fq * 8), boff = lds_byte(wc * 32 + fr, fq * 8);
#define PG8_SA(b, h) (((b) * 2 + (h)) * HTB)
#define PG8_SB(b, h) ((4 + (b) * 2 + (h)) * HTB)
#define PG8_STAGE(bufoff, gbase, voff) do { _Pragma("unroll") for (int _i = 0; _i < 2; ++_i) \
        __builtin_amdgcn_global_load_lds((const unsigned*)((const char*)(gbase) + (voff)[_i]), (PG8_LAS unsigned*)(lds + (bufoff) + ldsw + _i * 8192), 16, 0, 0); } while (0)
#define PG8_STAGE_B(bufoff, gbase, voff) do { _Pragma("unroll") for (int _i = 0; _i < 2; ++_i) \
        __builtin_amdgcn_global_load_lds((const unsigned*)((const char*)(gbase) + (voff)[_i]), (PG8_LAS unsigned*)(lds + (bufoff) + ldsw + _i * 8192), 16, 0, BAUX); } while (0)
#define PG8_STAGE_A(bufoff, kbase, half, arr) do { if constexpr (GA) PG8_STAGE(bufoff, kbase, arr[half]); else PG8_STAGE(bufoff, (kbase) + (half) * hstep, voffA); } while (0)
#define PG8_LDA(dst, b, h) do { _Pragma("unroll") for (int m = 0; m < 4; ++m) _Pragma("unroll") for (int k = 0; k < 2; ++k) dst[m][k] = *(const PG8_LAS bf16x8*)(lds + PG8_SA(b, h) + aoff + m * 2048 + k * 1024); } while (0)
#define PG8_LDB(dst, b, h) do { _Pragma("unroll") for (int n = 0; n < 2; ++n) _Pragma("unroll") for (int k = 0; k < 2; ++k) dst[n][k] = *(const PG8_LAS bf16x8*)(lds + PG8_SB(b, h) + boff + n * 2048 + k * 1024); } while (0)
#define PG8_MMA(ai, bj, At, Bt) do { if (VR && !((ai) == 0 ? mma_on0 : mma_on1)) break; __builtin_amdgcn_s_setprio(1); _Pragma("unroll") for (int m = 0; m < 4; ++m) _Pragma("unroll") for (int n = 0; n < 2; ++n) _Pragma("unroll") for (int k = 0; k < 2; ++k) \
        acc[ai][bj][m][n] = __builtin_amdgcn_mfma_f32_16x16x32_bf16(Bt[n][k], At[m][k], acc[ai][bj][m][n], 0, 0, 0); __builtin_amdgcn_s_setprio(0); } while (0)
#define PG8_WAIT_V(n) asm volatile("s_waitcnt vmcnt(" #n ")" ::: "memory")
#define PG8_WAIT_L(n) asm volatile("s_waitcnt lgkmcnt(" #n ")" ::: "memory")
#define PG8_BAR __builtin_amdgcn_s_barrier()
#define PG8_SCHED __builtin_amdgcn_sched_barrier(0)
    Unit cur, nxt; int ui = 0;
    if (!S.next(0, cur)) return;
    f32x4 acc[2][2][4][2];
#pragma unroll
    for (int a = 0; a < 2; ++a)
#pragma unroll
        for (int b = 0; b < 2; ++b)
#pragma unroll
            for (int m = 0; m < 4; ++m)
#pragma unroll
                for (int n = 0; n < 2; ++n) acc[a][b][m][n] = (f32x4){0.f, 0.f, 0.f, 0.f};
    bf16x8 At[4][2], B0[2][2], B1[2][2];
    const char* cA = GA ? (const char*)g.A : (const char*)g.A + (size_t)cur.pm * tstep; const char* cB = (const char*)g.Bt + (size_t)cur.pn * tstep;
    if constexpr (GA) PG8_GA_OFFS(vA, cur);
    bool mma_on0 = true, mma_on1 = true;
    if constexpr (VR) { const int vr_ = S.valid_rows(cur); mma_on0 = wr * 64 < vr_; mma_on1 = HALF + wr * 64 < vr_; }
    S.a_ready(cur);
    if constexpr (SP2) {
        PG8_STAGE_B(PG8_SB(0, 0), cB, voffB); PG8_STAGE_B(PG8_SB(0, 1), cB + hstepB, voffB); PG8_STAGE_A(PG8_SA(0, 0), cA, 0, vA); PG8_STAGE_A(PG8_SA(0, 1), cA, 1, vA);
        if (wr == 1) PG8_BAR;
        PG8_WAIT_V(2); PG8_BAR;
        PG8_STAGE_B(PG8_SB(1, 0), cB + kstepB, voffB); PG8_STAGE_A(PG8_SA(1, 0), cA + kstep, 0, vA); PG8_STAGE_B(PG8_SB(1, 1), cB + hstepB + kstepB, voffB);
        PG8_WAIT_V(6); PG8_BAR;
    } else {
        PG8_STAGE_B(PG8_SB(0, 0), cB, voffB); PG8_STAGE_A(PG8_SA(0, 0), cA, 0, vA); PG8_STAGE_B(PG8_SB(0, 1), cB + hstepB, voffB); PG8_STAGE_A(PG8_SA(0, 1), cA, 1, vA);
        if (wr == 1) PG8_BAR;
        PG8_WAIT_V(4); PG8_BAR;
        PG8_STAGE_B(PG8_SB(1, 0), cB + kstepB, voffB); PG8_STAGE_A(PG8_SA(1, 0), cA + kstep, 0, vA); PG8_STAGE_B(PG8_SB(1, 1), cB + hstepB + kstepB, voffB);
        PG8_WAIT_V(6); PG8_BAR;
    }
    for (;;) {
        const bool has_next = S.next(ui + 1, nxt);
        const char* nA = GA ? cA : (has_next ? (const char*)g.A + (size_t)nxt.pm * tstep : cA); const char* nB = has_next ? (const char*)g.Bt + (size_t)nxt.pn * tstep : cB;
        if constexpr (GA) { if (has_next) PG8_GA_OFFS(nvA, nxt); else {
#pragma unroll
            for (int _h = 0; _h < 2; ++_h)
#pragma unroll
                for (int _i = 0; _i < 2; ++_i) nvA[_h][_i] = vA[_h][_i]; } }
        for (int t = 0; t < nt; t += 2) {
            const bool last = (t == nt - 2);
            const char* a1 = cA + (size_t)(t + 1) * kstep;
            const char* a2 = last ? nA : cA + (size_t)(t + 2) * kstep; const char* b2 = last ? nB : cB + (size_t)(t + 2) * kstepB;
            const char* a3 = a2 + kstep; const char* b3 = b2 + kstepB;
            unsigned sA[2][2];
#pragma unroll
            for (int _h = 0; _h < 2; ++_h)
#pragma unroll
                for (int _i = 0; _i < 2; ++_i) sA[_h][_i] = last ? nvA[_h][_i] : vA[_h][_i];
            if (last && has_next) S.a_ready(nxt);
            if constexpr (SP2) {
            PG8_LDB(B0, 0, 0); PG8_LDB(B1, 0, 1); PG8_SCHED; PG8_LDA(At, 0, 0); PG8_STAGE_A(PG8_SA(1, 1), a1, 1, vA);
            PG8_WAIT_V(8); PG8_WAIT_L(0); PG8_BAR; PG8_MMA(0, 0, At, B0); PG8_MMA(0, 1, At, B1); PG8_BAR; PG8_SCHED;
            PG8_LDA(At, 0, 1); PG8_STAGE_B(PG8_SB(0, 0), b2, voffB); PG8_STAGE_B(PG8_SB(0, 1), b2 + hstepB, voffB); PG8_STAGE_A(PG8_SA(0, 0), a2, 0, sA);
            PG8_WAIT_V(8); PG8_WAIT_L(0); PG8_BAR; PG8_MMA(1, 0, At, B0); PG8_MMA(1, 1, At, B1); PG8_BAR; PG8_SCHED;
            PG8_LDB(B0, 1, 0); PG8_LDB(B1, 1, 1); PG8_SCHED; PG8_LDA(At, 1, 0); PG8_STAGE_A(PG8_SA(0, 1), a2, 1, sA);
            PG8_WAIT_V(8); PG8_WAIT_L(0); PG8_BAR; PG8_MMA(0, 0, At, B0); PG8_MMA(0, 1, At, B1); PG8_BAR; PG8_SCHED;
            PG8_LDA(At, 1, 1); PG8_STAGE_B(PG8_SB(1, 0), b3, voffB); PG8_STAGE_B(PG8_SB(1, 1), b3 + hstepB, voffB); PG8_STAGE_A(PG8_SA(1, 0), a3, 0, sA);
            PG8_WAIT_V(8); PG8_WAIT_L(0); PG8_BAR; PG8_MMA(1, 0, At, B0); PG8_MMA(1, 1, At, B1); PG8_BAR; PG8_SCHED;
            } else {
            PG8_LDB(B0, 0, 0); PG8_SCHED; PG8_LDA(At, 0, 0); PG8_STAGE_A(PG8_SA(1, 1), a1, 1, vA);
            PG8_WAIT_L(8); PG8_BAR; PG8_WAIT_L(0); PG8_MMA(0, 0, At, B0); PG8_BAR; PG8_SCHED;
            PG8_LDB(B1, 0, 1); PG8_STAGE_B(PG8_SB(0, 0), b2, voffB);
            PG8_BAR; PG8_WAIT_L(0); PG8_MMA(0, 1, At, B1); PG8_BAR;
            PG8_LDA(At, 0, 1); PG8_STAGE_A(PG8_SA(0, 0), a2, 0, sA);
            PG8_BAR; PG8_WAIT_L(0); PG8_MMA(1, 0, At, B0); PG8_BAR; PG8_SCHED;
            PG8_STAGE_B(PG8_SB(0, 1), b2 + hstepB, voffB);
            PG8_WAIT_V(6); PG8_BAR; PG8_MMA(1, 1, At, B1); PG8_BAR;
            PG8_LDB(B0, 1, 0); PG8_SCHED; PG8_LDA(At, 1, 0); PG8_STAGE_A(PG8_SA(0, 1), a2, 1, sA);
            PG8_WAIT_L(8); PG8_BAR; PG8_WAIT_L(0); PG8_MMA(0, 0, At, B0); PG8_BAR; PG8_SCHED;
            PG8_LDB(B1, 1, 1); PG8_STAGE_B(PG8_SB(1, 0), b3, voffB);
            PG8_BAR; PG8_WAIT_L(0); PG8_MMA(0, 1, At, B1); PG8_BAR;
            PG8_LDA(At, 1, 1); PG8_STAGE_A(PG8_SA(1, 0), a3, 0, sA);
            PG8_BAR; PG8_WAIT_L(0); PG8_MMA(1, 0, At, B0); PG8_BAR; PG8_SCHED;
            PG8_STAGE_B(PG8_SB(1, 1), b3 + hstepB, voffB);
            PG8_WAIT_V(6); PG8_BAR; PG8_MMA(1, 1, At, B1); PG8_BAR;
            }
        }
        if constexpr (ALIGN_EPI) { if (wr == 0) PG8_BAR; }
        if constexpr (!Epi::AFTER_DRAIN) { E(acc, cur, wr, wc, fr, fq); S.done(cur); }
        if (!has_next) break;
#pragma unroll
        for (int a = 0; a < 2; ++a)
#pragma unroll
            for (int b = 0; b < 2; ++b)
#pragma unroll
                for (int m = 0; m < 4; ++m)
#pragma unroll
                    for (int n = 0; n < 2; ++n) acc[a][b][m][n] = (f32x4){0.f, 0.f, 0.f, 0.f};
        cur = nxt; cA = nA; cB = nB; ++ui;
        if constexpr (VR) { const int vr_ = S.valid_rows(cur); mma_on0 = wr * 64 < vr_; mma_on1 = HALF + wr * 64 < vr_; }
        if constexpr (GA) {
#pragma unroll
            for (int _h = 0; _h < 2; ++_h)
#pragma unroll
                for (int _i = 0; _i < 2; ++_i) vA[_h][_i] = nvA[_h][_i]; }
        if constexpr (ALIGN_EPI) { if (wr == 1) PG8_BAR; }
    }
    PG8_WAIT_V(0);
    if constexpr (!ALIGN_EPI) { if (wr == 0) PG8_BAR; }
    PG8_BAR;
    if constexpr (Epi::AFTER_DRAIN) { E.fused(acc, cur, wr, wc, fr, fq, lds, wid, lane); S.done(cur); }
#undef PG8_SA
#undef PG8_SB
#undef PG8_STAGE
#undef PG8_STAGE_B
#undef PG8_STAGE_A
#undef PG8_GA_OFFS
#undef PG8_LDA
#undef PG8_LDB
#undef PG8_MMA
#undef PG8_WAIT_V
#undef PG8_WAIT_L
#undef PG8_BAR
#undef PG8_SCHED
}
}

#ifndef PG8_SP2
#define PG8_SP2 true
#endif
#ifndef PG8_ALIGN
#define PG8_ALIGN true
#endif
#ifndef X1_BF16
#define X1_BF16 1
#endif
#ifndef TOPK_2BIT
#define TOPK_2BIT 1
#endif
#ifndef NT_STREAM
#define NT_STREAM 0
#endif
#ifndef X1_FP16
#define X1_FP16 1
#endif
#if X1_FP16
#define X1PK pkh2
#define X1UNPK h4_to_f32
#else
#define X1PK pk2
#define X1UNPK bf4_to_f32
#endif
#ifndef X2_FP16
#define X2_FP16 1
#endif
#ifndef CV_NT_STORE
#define CV_NT_STORE 1
#endif
#ifndef CV_ROLL
#define CV_ROLL 0
#endif
#ifndef CV_TKN
#define CV_TKN 0
#endif
#ifndef MK_N_LAUNCHES
#define MK_N_LAUNCHES 1
#endif
#ifndef PROBE
#define PROBE 0
#endif
#ifndef PROBE_Q
#define PROBE_Q 6.0f
#define PROBE_OFF 0.0f
#endif
#ifndef PROBE_A
#define PROBE_A 0
#define PROBE_B 0
#endif
#ifndef REPEAT_PH
#define REPEAT_PH (-1)
#define REPEAT_N 2
#endif
#ifndef ATT_W
#define ATT_W 8
#endif
#ifndef DUMMY_VARIANT
#define DUMMY_VARIANT 0
#endif
#ifndef CV_NF_MOE
#define CV_NF_MOE 4
#endif
#ifndef CV_KG1
#define CV_KG1 17
#define CV_KG2 17
#define CV_KG3 27
#define CV_KG4 27
#define CV_N4 950
#endif
#ifndef CV_N1
#define CV_N1 850
#define CV_N2 280
#define CV_N3 500
#endif
#ifndef GATHER_IN_GEMM
#define GATHER_IN_GEMM 1
#endif
#ifndef S5_FUSE_Z
#define S5_FUSE_Z 1
#endif
#ifndef ROW_CTX_COOP
#define ROW_CTX_COOP 1
#endif
#ifndef MOE_BAUX
#define MOE_BAUX 0
#endif
#ifndef CTX_COOP2
#define CTX_COOP2 0
#endif
#ifndef P1_COOP
#define P1_COOP 0
#endif
#ifndef S5_NAIVE
#define S5_NAIVE 0
#endif
#ifndef ATTN_NAIVE
#define ATTN_NAIVE 0
#endif
#ifndef NAIVE_GEMM
#define NAIVE_GEMM 0
#endif

constexpr int D = 2048, SEQ = 4096, CTXL = 256, NLAT = 8192, NCTX = 512, NROWS = 8704;
constexpr int NH = 16, HD = 128, NE = 16, NG = 128, NP = 64, GH = 16, D6 = 6 * D;
constexpr int RPE = 1280;
constexpr float LN_EPS = 1e-5f, ALPHA = 1.4142135623730951f;
constexpr int NWAVES = 8, NTHREADS = 512;
constexpr int LDS_BYTES = 147456, MISC_OFF = LDS_BYTES - 128;

constexpr size_t MiB = 1u << 20;
constexpr size_t WS_CTL = 0, CTL_ZERO_BYTES = 1 * MiB;
constexpr size_t WS_MODS = 1 * MiB;
constexpr size_t WS_SPAR = 2 * MiB;
constexpr size_t WS_AFF = 6 * MiB;
constexpr size_t WS_SLOT = 7 * MiB;
constexpr size_t WS_IDX = 8 * MiB;
constexpr size_t WS_GATE = 8 * MiB + 512 * 1024;
constexpr int T_WQKV = 16, T_WO = 40, T_WVG = 48, T_MOE1 = 64, T_MOE2 = 576, T_HB = 832, T_QK = 866, T_VT = 934, T_AO = 968, T_XE = 1002, T_ACT = 1082, T_Z = 1162;
constexpr size_t WS_O = 1194 * MiB, WS_X1 = 1262 * MiB, WS_X2 = 1330 * MiB, WS_YE = 1398 * MiB, WS_YF = 1558 * MiB, WS_YB = 1622 * MiB, WS_XLOC = 1686 * MiB, WS_CARRY = 1718 * MiB, WS_END = 1750 * MiB;
constexpr int CW_BAR = 4096;
constexpr int CV_NIT_ALL = (6 + 2 * NE * 3) * 2048, CV_TK = 256 * NWAVES * CV_TKN;

#define GAS __attribute__((address_space(1)))
#define LAS __attribute__((address_space(3)))
typedef unsigned short bf16;
typedef unsigned v4u __attribute__((ext_vector_type(4)));
typedef unsigned v2u __attribute__((ext_vector_type(2)));
typedef float f32x4 __attribute__((ext_vector_type(4)));
typedef float f32x2 __attribute__((ext_vector_type(2)));
typedef short bf16x8 __attribute__((ext_vector_type(8)));
typedef GAS unsigned gu32;
#define RLX_AGENT __ATOMIC_RELAXED, __HIP_MEMORY_SCOPE_AGENT

__device__ __forceinline__ float bf2f(unsigned b) { return __uint_as_float(b << 16); }
__device__ __forceinline__ unsigned pk2(float lo, float hi) { typedef __bf16 bf2_t __attribute__((ext_vector_type(2))); f32x2 v = {lo, hi}; return __builtin_bit_cast(unsigned, __builtin_convertvector(v, bf2_t)); }
__device__ __forceinline__ unsigned pkh2(float lo, float hi) { typedef _Float16 h2_t __attribute__((ext_vector_type(2))); f32x2 v = {lo, hi}; return __builtin_bit_cast(unsigned, __builtin_convertvector(v, h2_t)); }
__device__ __forceinline__ f32x4 h4_to_f32(v2u w) { typedef _Float16 h4_t __attribute__((ext_vector_type(4))); return __builtin_convertvector(__builtin_bit_cast(h4_t, w), f32x4); }
template <int CTRL> __device__ __forceinline__ float dpp_f(float x) { return __builtin_bit_cast(float, __builtin_amdgcn_mov_dpp(__builtin_bit_cast(int, x), CTRL, 0xf, 0xf, true)); }
__device__ __forceinline__ float wave_sum(float v) {
    v += dpp_f<0xB1>(v);
    v += dpp_f<0x4E>(v);
    v += dpp_f<0x141>(v);
    v += dpp_f<0x140>(v);
    const float a = __builtin_bit_cast(float, __builtin_amdgcn_readlane(__builtin_bit_cast(int, v), 0)), b = __builtin_bit_cast(float, __builtin_amdgcn_readlane(__builtin_bit_cast(int, v), 16));
    const float c = __builtin_bit_cast(float, __builtin_amdgcn_readlane(__builtin_bit_cast(int, v), 32)), d = __builtin_bit_cast(float, __builtin_amdgcn_readlane(__builtin_bit_cast(int, v), 48));
    return (a + b) + (c + d);
}
__device__ __forceinline__ float wave_max(float v) {
#pragma unroll
    for (int o = 1; o < 64; o <<= 1) v = fmaxf(v, __shfl_xor(v, o));
    return v;
}
__device__ __forceinline__ float silu_f(float x) { return x * __builtin_amdgcn_rcpf(1.0f + __builtin_amdgcn_exp2f(-1.4426950409f * x)); }
__device__ __forceinline__ float sigmoid_f(float x) { return __builtin_amdgcn_rcpf(1.0f + __builtin_amdgcn_exp2f(-1.4426950409f * x)); }
__device__ __forceinline__ float gelu_tanh_f(float x) { const float e = __builtin_amdgcn_exp2f(x * (-2.302208198f - 0.1029432397f * x * x)); return x * __builtin_amdgcn_rcpf(1.0f + e); }
#define XB_TMO      128
#define XB_XCNT(j)  (256  + 64 * (j))
#define XB_XSUB(j)  (1280 + 64 * (j))
#define XB_XGEN(j)  (2304 + 64 * (j))
#define XB_TOP      3328
#define XB_TOPGEN   3392
#define XCD_BAR_WORDS 3456
#define XB_SPIN_CAP (1u << 18)

__device__ __forceinline__ unsigned xb_ld(unsigned* p)              { return __hip_atomic_load(p, __ATOMIC_RELAXED, __HIP_MEMORY_SCOPE_AGENT); }
__device__ __forceinline__ unsigned xb_add(unsigned* p, unsigned v) { return __hip_atomic_fetch_add(p, v, __ATOMIC_RELAXED, __HIP_MEMORY_SCOPE_AGENT); }
__device__ __forceinline__ unsigned xb_xcc_id() { return (unsigned)__builtin_amdgcn_s_getreg((3 << 11) | 20) & 0xFu; }
#define XB_SPIN(cond, bar) do { unsigned _sp = 0; while (cond) { __builtin_amdgcn_s_sleep(1); \
    if ((++_sp & 255u) == 0u) { if (xb_ld(&(bar)[XB_TMO])) break; if (_sp > XB_SPIN_CAP) { atomicAdd(&(bar)[XB_TMO], 1u); break; } } } } while (0)

struct XcdBarrier {
    unsigned* bar; unsigned x;
    volatile LAS unsigned* st;
};

__device__ __forceinline__ XcdBarrier xcd_barrier_post(unsigned* bar, volatile LAS unsigned* st) {
    XcdBarrier b; b.bar = bar; b.x = xb_xcc_id(); b.st = st;
    if (threadIdx.x == 0) (void)xb_add(&bar[XB_XCNT(b.x)], 1u);
    return b;
}
__device__ __forceinline__ void xcd_barrier_complete(unsigned* bar, unsigned x, unsigned& nloc, unsigned& nx) {
    const unsigned G = gridDim.x * gridDim.y * gridDim.z;
    unsigned sum, cnt, mine, sp = 0u;
    for (;;) {
        sum = 0u; cnt = 0u; mine = 0u;
#pragma unroll
        for (unsigned j = 0; j < 16; ++j) { const unsigned c = xb_ld(&bar[XB_XCNT(j)]); sum += c; cnt += (c > 0u) ? 1u : 0u; mine = (j == x) ? c : mine; }
        if (sum == G) break;
        __builtin_amdgcn_s_sleep(1);
        if ((++sp & 255u) == 0u) { if (xb_ld(&bar[XB_TMO])) break; if (sp > XB_SPIN_CAP) { atomicAdd(&bar[XB_TMO], 1u); break; } }
    }
    nloc = mine > 0u ? mine : 1u; nx = cnt > 0u ? cnt : 1u;
}

__device__ __forceinline__ void xcd_barrier(const XcdBarrier& b) {
    asm volatile("s_waitcnt vmcnt(0)" ::: "memory");
    __syncthreads();
    if (threadIdx.x == 0) {
        unsigned* bar = b.bar;
        __builtin_amdgcn_s_waitcnt(0);
        unsigned nloc = b.st[0], nx = b.st[1];
        if (nloc == 0u) { xcd_barrier_complete(bar, b.x, nloc, nx); b.st[0] = nloc; b.st[1] = nx; }
        const unsigned old = xb_add(&bar[XB_XSUB(b.x)], 1u);
        const unsigned gen = old / nloc;
        if (old + 1u == (gen + 1u) * nloc) {
            __builtin_amdgcn_fence(__ATOMIC_RELEASE, "agent");
            asm volatile("s_waitcnt vmcnt(0)" ::: "memory");
            const unsigned og = xb_add(&bar[XB_TOP], 1u);
            const unsigned tg = og / nx;
            if (og + 1u == (tg + 1u) * nx) xb_add(&bar[XB_TOPGEN], 1u);
            else XB_SPIN(xb_ld(&bar[XB_TOPGEN]) == tg, bar);
            __builtin_amdgcn_fence(__ATOMIC_ACQUIRE, "agent");
            xb_add(&bar[XB_XGEN(b.x)], 1u);
            asm volatile("s_waitcnt vmcnt(0)" ::: "memory");
        } else {
            XB_SPIN(xb_ld(&bar[XB_XGEN(b.x)]) == gen, bar);
            __builtin_amdgcn_fence(__ATOMIC_ACQUIRE, "agent");
            asm volatile("s_waitcnt vmcnt(0)" ::: "memory");
        }
    }
    __syncthreads();
}

struct Args { const float* in[25]; float* out; unsigned char* ws; int ph_lo, ph_hi; };
#define CAS __attribute__((address_space(4)))
struct Frame {
    LAS unsigned char* lds;
    GAS unsigned char* ws;
    int tid, lane, wave, vcu, G;
    const CAS Args* ap;
    GAS float* out;
};
__device__ __forceinline__ const GAS float* fin(const Frame& F, int i) { return (const GAS float*)F.ap->in[i]; }
enum { I_X = 0, I_C, I_CTX, I_CCTX, I_WMOD, I_BMOD, I_LNG, I_LNB, I_WQKV, I_WO, I_RPB, I_LAMRE, I_LAMIM, I_LOGSTEP, I_BRE, I_BIM, I_CRE, I_CIM, I_SD, I_WVAL, I_WGATE, I_ROUTER, I_MGATE, I_MUP, I_MDOWN };

__device__ __forceinline__ GAS bf16* ws_tile(const Frame& F, int t) { return (GAS bf16*)(F.ws + (size_t)t * MiB); }
__device__ __forceinline__ GAS float* ws_f32(const Frame& F, size_t off) { return (GAS float*)(F.ws + off); }
__device__ __forceinline__ const GAS float* mods(const Frame& F, int l, int r, int which) { return (const GAS float*)(F.ws + WS_MODS) + (size_t)((l * 3 + r) * 6 + which) * D; }
__device__ __forceinline__ int row_r(int row) { return row < NLAT ? (row >> 12) : 2; }

struct SegSched {
    int G, cx, n0, ntot, nM0, nN0, pm0, pn0, nM1, nN1, pm1, pn1;
    __device__ __forceinline__ void init(int G_, int cx_, int nM0_, int nN0_, int pm0_, int pn0_, int nM1_, int nN1_, int pm1_, int pn1_) {
        G = G_; cx = cx_; nM0 = nM0_; nN0 = nN0_; pm0 = pm0_; pn0 = pn0_; nM1 = nM1_; nN1 = nN1_; pm1 = pm1_; pn1 = pn1_; n0 = nM0 * nN0; ntot = n0 + nM1 * nN1; }
    __device__ __forceinline__ bool next(int i, pg8::Unit& u) const {
        const int U = i * G + cx; if (U >= ntot) return false;
        const bool s1 = U >= n0; const int loc = s1 ? U - n0 : U, nM = s1 ? nM1 : nM0, nN = s1 ? nN1 : nN0;
        const int nig = 8 * nN, gid = loc / nig, fm = gid * 8, gsz = (nM - fm) < 8 ? (nM - fm) : 8;
        u.pm = (s1 ? pm1 : pm0) + fm + ((loc % nig) % gsz); u.pn = (s1 ? pn1 : pn0) + (loc % nig) / gsz; return true;
    }
    __device__ __forceinline__ void a_ready(const pg8::Unit&) const {}
    __device__ __forceinline__ void done(const pg8::Unit&) const {}
};
struct MoeSched {
    int G, cx, nMe, nNe, pmA, pnB, ntot;
    const GAS int* ga_idx; unsigned ga_nrows;
    __device__ __forceinline__ int ga_row0(const pg8::Unit& u) const { return (u.pm - pmA) * 256; }
    __device__ __forceinline__ int valid_rows(const pg8::Unit& u) const { return (nMe == 5 && (u.pm - pmA) % 5 == 4) ? 64 : 256; }
    __device__ __forceinline__ void init(int G_, int cx_, int nMe_, int nNe_, int pmA_, int pnB_) { G = G_; cx = cx_; nMe = nMe_; nNe = nNe_; pmA = pmA_; pnB = pnB_; ntot = NE * nMe * nNe; }
    __device__ __forceinline__ bool next(int i, pg8::Unit& u) const {
        const int U = i * G + cx; if (U >= ntot) return false;
        const int per = nMe * nNe, e = U / per, loc = U % per;
        u.pm = pmA + e * 5 + loc % nMe; u.pn = pnB + e * nNe + loc / nMe; return true;
    }
    __device__ __forceinline__ void a_ready(const pg8::Unit&) const {}
    __device__ __forceinline__ void done(const pg8::Unit&) const {}
};

struct EpiQKV {
    static constexpr bool PERM = true, AFTER_DRAIN = false;
    GAS bf16* QK; GAS bf16* VT;
    __device__ __forceinline__ void operator()(const f32x4 (&acc)[2][2][4][2], const pg8::Unit& u, int wr, int wc, int fr_in, int fq_in) const {
        int fr = fr_in, fq = fq_in; asm volatile("" : "+v"(fr), "+v"(fq));
        GAS bf16* base; int ldc;
        if (u.pn < T_HB) { base = QK + (size_t)(u.pm - T_HB) * 256 * 4096 + (size_t)(u.pn - T_WQKV) * 256; ldc = 4096; }
        else { base = VT + (size_t)(u.pm - (T_WQKV + 16)) * 256 * NROWS + (size_t)(u.pn - T_HB) * 256; ldc = NROWS; }
        int cofs[2];
#pragma unroll
        for (int bj = 0; bj < 2; ++bj) { int c = wc * 32 + 8 * fq + bj * 128;
            if (u.pn >= T_HB) { const int tok = (u.pn - T_HB) * 256 + c; if (tok < NLAT) { const int t = tok & 4095; c += (((t & 63) >> 3) << 9 | (t >> 6) << 3) - t; } }
            cofs[bj] = c; }
#pragma unroll
        for (int ai = 0; ai < 2; ++ai)
#pragma unroll
            for (int m = 0; m < 4; ++m) { GAS bf16* rowp = base + (size_t)(ai * 128 + wr * 64 + m * 16 + fr) * ldc;
#pragma unroll
                for (int bj = 0; bj < 2; ++bj) { const f32x4 v0 = acc[ai][bj][m][0], v1 = acc[ai][bj][m][1];
                    v4u w; w.x = pk2(v0[0], v0[1]); w.y = pk2(v0[2], v0[3]); w.z = pk2(v1[0], v1[1]); w.w = pk2(v1[2], v1[3]);
                    *(GAS v4u*)(rowp + cofs[bj]) = w; } }
    }
};
struct EpiWo {
    static constexpr bool PERM = true, AFTER_DRAIN = false;
    GAS bf16* O;
    __device__ __forceinline__ void operator()(const f32x4 (&acc)[2][2][4][2], const pg8::Unit& u, int wr, int wc, int fr_in, int fq_in) const {
        int fr = fr_in, fq = fq_in; asm volatile("" : "+v"(fr), "+v"(fq));
        GAS bf16* base = O + (size_t)(u.pm - T_AO) * 256 * D + (size_t)(u.pn - T_WO) * 256;
#pragma unroll
        for (int ai = 0; ai < 2; ++ai)
#pragma unroll
            for (int m = 0; m < 4; ++m) { GAS bf16* rowp = base + (size_t)(ai * 128 + wr * 64 + m * 16 + fr) * D + wc * 32 + 8 * fq;
#pragma unroll
                for (int bj = 0; bj < 2; ++bj) { const f32x4 v0 = acc[ai][bj][m][0], v1 = acc[ai][bj][m][1];
                    v4u w; w.x = pk2(v0[0], v0[1]); w.y = pk2(v0[2], v0[3]); w.z = pk2(v1[0], v1[1]); w.w = pk2(v1[2], v1[3]);
                    *(GAS v4u*)(rowp + bj * 128) = w; } }
    }
};
struct EpiGlu {
    static constexpr bool PERM = true, AFTER_DRAIN = false;
    GAS bf16* O;
    __device__ __forceinline__ void operator()(const f32x4 (&acc)[2][2][4][2], const pg8::Unit& u, int wr, int wc, int fr_in, int fq_in) const {
        int fr = fr_in, fq = fq_in; asm volatile("" : "+v"(fr), "+v"(fq));
        GAS bf16* base = O + (size_t)(u.pm - T_Z) * 256 * D + (size_t)(u.pn - T_WVG) * 128;
#pragma unroll
        for (int ai = 0; ai < 2; ++ai)
#pragma unroll
            for (int m = 0; m < 4; ++m) { GAS bf16* rowp = base + (size_t)(ai * 128 + wr * 64 + m * 16 + fr) * D + wc * 32 + 8 * fq;
                f32x4 o0, o1;
#pragma unroll
                for (int q = 0; q < 4; ++q) { o0[q] = acc[ai][0][m][0][q] * sigmoid_f(acc[ai][1][m][0][q]); o1[q] = acc[ai][0][m][1][q] * sigmoid_f(acc[ai][1][m][1][q]); }
                v4u w; w.x = pk2(o0[0], o0[1]); w.y = pk2(o0[2], o0[3]); w.z = pk2(o1[0], o1[1]); w.w = pk2(o1[2], o1[3]);
                *(GAS v4u*)rowp = w; }
    }
};
struct EpiSwiglu {
    static constexpr bool PERM = true, AFTER_DRAIN = false;
    GAS bf16* ACT; int pnB;
    __device__ __forceinline__ void operator()(const f32x4 (&acc)[2][2][4][2], const pg8::Unit& u, int wr, int wc, int fr_in, int fq_in) const {
        int fr = fr_in, fq = fq_in; asm volatile("" : "+v"(fr), "+v"(fq));
        const int j = (u.pn - pnB) & 15;
        GAS bf16* base = ACT + (size_t)(u.pm - T_XE) * 256 * D + (size_t)j * 128;
#pragma unroll
        for (int ai = 0; ai < 2; ++ai)
#pragma unroll
            for (int m = 0; m < 4; ++m) { GAS bf16* rowp = base + (size_t)(ai * 128 + wr * 64 + m * 16 + fr) * D + wc * 32 + 8 * fq;
                f32x4 o0, o1;
#pragma unroll
                for (int q = 0; q < 4; ++q) { o0[q] = silu_f(acc[ai][0][m][0][q]) * acc[ai][1][m][0][q]; o1[q] = silu_f(acc[ai][0][m][1][q]) * acc[ai][1][m][1][q]; }
                v4u w; w.x = pk2(o0[0], o0[1]); w.y = pk2(o0[2], o0[3]); w.z = pk2(o1[0], o1[1]); w.w = pk2(o1[2], o1[3]);
                *(GAS v4u*)rowp = w; }
    }
};
struct EpiDown {
    static constexpr bool PERM = true, AFTER_DRAIN = false;
    GAS bf16* YE; const GAS float* GATE; int pnB;
    __device__ __forceinline__ void operator()(const f32x4 (&acc)[2][2][4][2], const pg8::Unit& u, int wr, int wc, int fr_in, int fq_in) const {
        int fr = fr_in, fq = fq_in; asm volatile("" : "+v"(fr), "+v"(fq));
        const int j = (u.pn - pnB) & 7; const int rt = (u.pm - T_ACT) * 256;
        GAS bf16* base = YE + (size_t)rt * D + (size_t)j * 256;
#pragma unroll
        for (int ai = 0; ai < 2; ++ai)
#pragma unroll
            for (int m = 0; m < 4; ++m) { const int r = ai * 128 + wr * 64 + m * 16 + fr; const float gt = GATE[rt + r]; GAS bf16* rowp = base + (size_t)r * D + wc * 32 + 8 * fq;
#pragma unroll
                for (int bj = 0; bj < 2; ++bj) { const f32x4 v0 = acc[ai][bj][m][0] * gt, v1 = acc[ai][bj][m][1] * gt;
                    v4u w; w.x = pk2(v0[0], v0[1]); w.y = pk2(v0[2], v0[3]); w.z = pk2(v1[0], v1[1]); w.w = pk2(v1[2], v1[3]);
                    *(GAS v4u*)(rowp + bj * 128) = w; } }
    }
};

__device__ __forceinline__ float dot_bf16(const GAS bf16* a, const GAS bf16* b, int K) {
    float s = 0.f;
    for (int k = 0; k < K; k += 8) { const v4u x = *(const GAS v4u*)(a + k), y = *(const GAS v4u*)(b + k);
#pragma unroll
        for (int q = 0; q < 4; ++q) { s += bf2f(x[q] & 0xffffu) * bf2f(y[q] & 0xffffu); s += bf2f(x[q] >> 16) * bf2f(y[q] >> 16); } }
    return s;
}
template <class Epi, class Sched>
__device__ __forceinline__ void naive_gemm_phase(const pg8::Gemm g, const Sched& S, const Epi& E, int tid_in) {
    const int tid = tid_in, wid = __builtin_amdgcn_readfirstlane(tid >> 6), lane = tid & 63, wr = wid >> 2, wc = wid & 3, fr = lane & 15, fq = lane >> 4;
    pg8::Unit u;
    for (int i = 0; S.next(i, u); ++i) {
        f32x4 acc[2][2][4][2];
        const GAS bf16* A = (const GAS bf16*)g.A + (size_t)u.pm * 256 * g.K; const GAS bf16* B = (const GAS bf16*)g.Bt + (size_t)u.pn * 256 * g.K;
#pragma unroll
        for (int ai = 0; ai < 2; ++ai)
#pragma unroll
            for (int m = 0; m < 4; ++m) { const GAS bf16* ar = A + (size_t)(ai * 128 + wr * 64 + m * 16 + fr) * g.K;
#pragma unroll
                for (int bj = 0; bj < 2; ++bj)
#pragma unroll
                    for (int n = 0; n < 2; ++n)
#pragma unroll
                        for (int j = 0; j < 4; ++j) { const int c = Epi::PERM ? (bj * 128 + wc * 32 + 8 * fq + 4 * n + j) : (bj * 128 + wc * 32 + 16 * n + 4 * fq + j);
                            acc[ai][bj][m][n][j] = dot_bf16(ar, B + (size_t)c * g.K, g.K); } }
        E(acc, u, wr, wc, fr, fq);
    }
}
template <class Epi, class Sched>
__device__ __forceinline__ void run_gemm_ga(Frame& F, const Sched& S, const Epi& E, int tA) {
    const pg8::Gemm g{(const pg8::bf16_t*)(const unsigned char*)(F.ws + (size_t)tA * MiB), (const pg8::bf16_t*)(const unsigned char*)F.ws, 0, 0, D};
    pg8::gemm_phase<Epi, Sched, PG8_ALIGN, PG8_SP2, true, false, MOE_BAUX, WT_BKM != 0>((PG8_LAS unsigned char*)F.lds, g, S, E, F.tid);
}
template <class Epi, class Sched, bool VR = false, int BAUX = 0, bool BKM = (WT_BKM != 0)>
__device__ __forceinline__ void run_gemm(Frame& F, const Sched& S, const Epi& E) {
    const pg8::Gemm g{(const pg8::bf16_t*)(const unsigned char*)F.ws, (const pg8::bf16_t*)(const unsigned char*)F.ws, 0, 0, D};
#if NAIVE_GEMM
    naive_gemm_phase<Epi, Sched>(g, S, E, F.tid);
#else
    pg8::gemm_phase<Epi, Sched, PG8_ALIGN, PG8_SP2, false, VR, BAUX, BKM>((PG8_LAS unsigned char*)F.lds, g, S, E, F.tid);
#endif
}

#define LDV(p, j) (*(const GAS f32x4*)((p) + 4 * F.lane + 256 * (j)))
__device__ __forceinline__ f32x4 bf4_to_f32(v2u w) { return (f32x4){bf2f(w.x & 0xffffu), bf2f(w.x >> 16), bf2f(w.y & 0xffffu), bf2f(w.y >> 16)}; }
#define LDVB(p, j) bf4_to_f32(*(const GAS v2u*)((p) + 4 * F.lane + 256 * (j)))
#define LDVL(p, j) (*(const LAS f32x4*)((p) + 4 * F.lane + 256 * (j)))
__device__ __forceinline__ void stage_vec(const Frame& F, LAS float* dst, const GAS float* src) {
    *(LAS f32x4*)(dst + 4 * F.tid) = *(const GAS f32x4*)(src + 4 * F.tid);
}
__device__ __forceinline__ void ln_rows_lds(f32x4 (&v)[8], const LAS float* g, const LAS float* bb, const Frame& F) {
    float s = 0.f;
#pragma unroll
    for (int j = 0; j < 8; ++j) s += (v[j][0] + v[j][1]) + (v[j][2] + v[j][3]);
    const float mean = wave_sum(s) * (1.0f / D); float s2 = 0.f;
#pragma unroll
    for (int j = 0; j < 8; ++j) { v[j] = v[j] - mean; s2 += (v[j][0] * v[j][0] + v[j][1] * v[j][1]) + (v[j][2] * v[j][2] + v[j][3] * v[j][3]); }
    const float rstd = 1.0f / sqrtf(wave_sum(s2) * (1.0f / D) + LN_EPS);
#pragma unroll
    for (int j = 0; j < 8; ++j) v[j] = v[j] * rstd * LDVL(g, j) + LDVL(bb, j);
}

__device__ __forceinline__ void p0_mods(Frame& F) {
    LAS float* S = (LAS float*)F.lds;
    LAS float* P = S + 3 * D;
    const GAS float* c = fin(F, I_C); const GAS float* cctx = fin(F, I_CCTX);
    for (int i = F.tid; i < 3 * D; i += NTHREADS) { const int r = i / D, k = i % D; const float cv = (r < 2) ? c[r * D + k] : cctx[k]; S[i] = cv / (1.0f + expf(-cv)); }
    __syncthreads();
    const int tl = F.tid & 7, kg = F.tid >> 3;
    GAS float* M = (GAS float*)(F.ws + WS_MODS);
    for (int it = blockIdx.x; it < 2 * 384; it += F.G) {
        const int l = it / 384, cc = it % 384;
        const GAS float* w = fin(F, I_WMOD) + (size_t)l * D * D6 + cc * 32 + tl * 4;
        f32x4 a0 = {0.f, 0.f, 0.f, 0.f}, a1 = a0, a2 = a0;
#pragma unroll 8
        for (int kk = 0; kk < 32; ++kk) { const int k = kg * 32 + kk; const f32x4 wv = *(const GAS f32x4*)(w + (size_t)k * D6); a0 += wv * S[k]; a1 += wv * S[D + k]; a2 += wv * S[2 * D + k]; }
#pragma unroll
        for (int j = 0; j < 4; ++j) { P[(kg * 3 + 0) * 32 + tl * 4 + j] = a0[j]; P[(kg * 3 + 1) * 32 + tl * 4 + j] = a1[j]; P[(kg * 3 + 2) * 32 + tl * 4 + j] = a2[j]; }
        __syncthreads();
        if (F.tid < 96) { const int r = F.tid >> 5, col = F.tid & 31; float s = 0.f;
            for (int q = 0; q < 64; ++q) s += P[(q * 3 + r) * 32 + col];
            M[(size_t)(l * 3 + r) * D6 + cc * 32 + col] = s + fin(F, I_BMOD)[l * D6 + cc * 32 + col]; }
        __syncthreads();
    }
}
__device__ __forceinline__ void p0_s5params(Frame& F) {
    GAS float* AR = (GAS float*)(F.ws + WS_SPAR); GAS float* AI = AR + 2 * NG * NP; GAS float* BB = AI + 2 * NG * NP;
    for (int idx = blockIdx.x * NTHREADS + F.tid; idx < 2 * NG * NP; idx += F.G * NTHREADS) {
        const int dg = idx / NP;
        const double lr = (double)fminf(fin(F, I_LAMRE)[idx], -1e-4f), li = (double)fin(F, I_LAMIM)[idx], dt = exp((double)fin(F, I_LOGSTEP)[dg]);
        const double mag = exp(lr * dt); double sn, cs; sincos(li * dt, &sn, &cs);
        const double ar = mag * cs, ai = mag * sn, nr = ar - 1.0, den = lr * lr + li * li, cr = (nr * lr + ai * li) / den, ci = (ai * lr - nr * li) / den;
        AR[idx] = (float)ar; AI[idx] = (float)ai;
        for (int h = 0; h < GH; ++h) { const double bre = fin(F, I_BRE)[(size_t)idx * GH + h], bim = fin(F, I_BIM)[(size_t)idx * GH + h];
            BB[(size_t)idx * 32 + h] = (float)(cr * bre - ci * bim); BB[(size_t)idx * 32 + 16 + h] = (float)(cr * bim + ci * bre); }
    }
}
__device__ __forceinline__ void p0_item_load(const GAS float* W, int ldw, int k0, int lane, f32x4 (&v)[8]) {
    const GAS float* p = W + (size_t)((k0 & ~1) + 8 * (lane >> 3)) * ldw + 4 * (lane & 7);
#pragma unroll
    for (int i = 0; i < 8; ++i) v[i] = __builtin_nontemporal_load((const GAS f32x4*)(p + (size_t)i * ldw));
}
__device__ __forceinline__ void p0_item_store(GAS bf16* WT, int dst_row0, int k0, int lane, const f32x4 (&v)[8]) {
    const int g0 = dst_row0 + 4 * (lane & 7), kq = k0 & ~1; const bool bkm = (k0 & 1) != 0;
    GAS bf16* o = bkm ? WT + (size_t)(g0 >> 8) * (256 * D) + (size_t)(kq >> 6) * (256 * 64) + (g0 & 255) * 64 + 8 * (lane >> 3) : WT + (size_t)g0 * D + kq + 8 * (lane >> 3);
    const int RS = bkm ? 64 : D;
#pragma unroll
    for (int j = 0; j < 4; ++j) { v4u w; w.x = pk2(v[0][j], v[1][j]); w.y = pk2(v[2][j], v[3][j]); w.z = pk2(v[4][j], v[5][j]); w.w = pk2(v[6][j], v[7][j]);
#if CV_NT_STORE
        __builtin_nontemporal_store(w, (GAS v4u*)(o + (size_t)j * RS));
#else
        *(GAS v4u*)(o + (size_t)j * RS) = w;
#endif
    }
}
__device__ __forceinline__ void p0_decode(const Frame& F, int it, const GAS float*& src, int& ldw, GAS bf16*& dst, int& dr0, int& k0) {
    const int sq = it >> 11, r = it & 2047, kb = r >> 6, nb = r & 63, n0 = nb * 32;
    int mode = 0, off = 0; ldw = D;
    if (sq < 3) { src = fin(F, I_WQKV) + sq * D; ldw = 3 * D; dst = ws_tile(F, T_WQKV) + (size_t)sq * D * D; }
    else if (sq == 3) { src = fin(F, I_WO); dst = ws_tile(F, T_WO); }
    else if (sq == 4) { src = fin(F, I_WVAL); dst = ws_tile(F, T_WVG); mode = 1; }
    else if (sq == 5) { src = fin(F, I_WGATE); dst = ws_tile(F, T_WVG); mode = 1; off = 128; }
    else { const int mm = sq - 6, l = mm / 48, e = (mm % 48) / 3, t = mm % 3; const size_t wofs = (size_t)(l * NE + e) * D * D;
        if (t == 0) { src = fin(F, I_MGATE) + wofs; dst = ws_tile(F, T_MOE1 + l * 256) + (size_t)e * 4096 * D; mode = 1; }
        else if (t == 1) { src = fin(F, I_MUP) + wofs; dst = ws_tile(F, T_MOE1 + l * 256) + (size_t)e * 4096 * D; mode = 1; off = 128; }
        else { src = fin(F, I_MDOWN) + wofs; dst = ws_tile(F, T_MOE2 + l * 128) + (size_t)e * 2048 * D; } }
    src += n0; dr0 = mode ? ((n0 >> 7) * 256 + (n0 & 127) + off) : n0; k0 = kb * 64 + ((WT_BKM && sq >= 3) ? 1 : 0);
}
template <int NF>
__device__ __forceinline__ void p0_weights_n(Frame& F, int it0, int NIT, int gw, int NGW) {
    for (int it = it0 + gw; it < NIT; it += NF * NGW) {
        const GAS float* sp[NF]; int lw[NF], dr[NF], kk[NF]; GAS bf16* op[NF]; f32x4 v[NF][8]; bool ok[NF];
#pragma unroll
        for (int q = 0; q < NF; ++q) { ok[q] = it + q * NGW < NIT; if (ok[q]) { p0_decode(F, it + q * NGW, sp[q], lw[q], op[q], dr[q], kk[q]); p0_item_load(sp[q], lw[q], kk[q], F.lane, v[q]); } }
#pragma unroll
        for (int q = 0; q < NF; ++q) if (ok[q]) p0_item_store(op[q], dr[q], kk[q], F.lane, v[q]);
    }
}
__device__ __forceinline__ void p0_weights(Frame& F, int it0, int NIT, int gw, int NGW) {
#if CV_ROLL
    int it = it0 + gw; if (it >= NIT) return;
    const GAS float* s0; const GAS float* s1; int l0, l1, d0, d1, k0, k1; GAS bf16* o0; GAS bf16* o1; f32x4 va[8], vb[8];
    p0_decode(F, it, s0, l0, o0, d0, k0); p0_item_load(s0, l0, k0, F.lane, va);
    for (;;) {
        const bool hb = it + NGW < NIT;
        if (hb) { p0_decode(F, it + NGW, s1, l1, o1, d1, k1); p0_item_load(s1, l1, k1, F.lane, vb); }
        p0_item_store(o0, d0, k0, F.lane, va);
        if (!hb) break;
        const bool ha = it + 2 * NGW < NIT;
        if (ha) { p0_decode(F, it + 2 * NGW, s0, l0, o0, d0, k0); p0_item_load(s0, l0, k0, F.lane, va); }
        p0_item_store(o1, d1, k1, F.lane, vb);
        if (!ha) break;
        it += 2 * NGW;
    }
#else
    for (int it = it0 + gw; it < NIT; it += 2 * NGW) {
        const GAS float* s0; const GAS float* s1; int l0, l1, d0, d1, k0, k1; GAS bf16* o0; GAS bf16* o1; f32x4 va[8], vb[8];
        const bool two = it + NGW < NIT;
        p0_decode(F, it, s0, l0, o0, d0, k0); p0_item_load(s0, l0, k0, F.lane, va);
        if (two) { p0_decode(F, it + NGW, s1, l1, o1, d1, k1); p0_item_load(s1, l1, k1, F.lane, vb); }
        p0_item_store(o0, d0, k0, F.lane, va);
        if (two) p0_item_store(o1, d1, k1, F.lane, vb);
    }
#endif
}
__device__ __forceinline__ const GAS float* xin_row(Frame& F, int l, int row) {
    if (l == 0) return row < NLAT ? fin(F, I_X) + (size_t)row * D : fin(F, I_CTX) + (size_t)(row - NLAT) * D;
    return (const GAS float*)(F.ws + WS_X2) + (size_t)row * D;
}
#define XN_LOAD(dst, l_, row_) do { if (X2_FP16 && (l_)) { const GAS bf16* xh_ = (const GAS bf16*)(F.ws + WS_X2) + (size_t)(row_) * D; \
        _Pragma("unroll") for (int j = 0; j < 8; ++j) { const f32x2 t_ = *(const GAS f32x2*)(xh_ + 4 * F.lane + 256 * j); dst[j][0] = t_[0]; dst[j][1] = t_[1]; } } \
    else { const GAS float* xr_ = xin_row(F, l_, row_); _Pragma("unroll") for (int j = 0; j < 8; ++j) dst[j] = LDV(xr_, j); } } while (0)
__device__ __forceinline__ void p1_prep(Frame& F) {
    const int gw = F.vcu * NWAVES + F.wave, NGW = F.G * NWAVES;
    GAS bf16* HB = ws_tile(F, T_HB);
    LAS float* VL = (LAS float*)F.lds;
#pragma unroll
    for (int r = 0; r < 3; ++r) { stage_vec(F, VL + r * D, mods(F, 0, r, 0)); stage_vec(F, VL + (3 + r) * D, mods(F, 0, r, 1)); }
    f32x4 xn[8];
    if (gw < NROWS) { const GAS float* xr = xin_row(F, 0, gw);
#pragma unroll
        for (int j = 0; j < 8; ++j) xn[j] = LDV(xr, j); }
    __syncthreads();
    const int p1rows = P1_COOP ? NLAT : NROWS;
    for (int row = gw; row < p1rows; row += NGW) {
        const int r = row_r(row); const LAS float* sh = VL + r * D; const LAS float* sc = VL + (3 + r) * D;
        f32x4 h[8];
#pragma unroll
        for (int j = 0; j < 8; ++j) h[j] = xn[j] * (LDVL(sc, j) + 1.0f) + LDVL(sh, j);
        if (row + NGW < p1rows) { const GAS float* xr = xin_row(F, 0, row + NGW);
#pragma unroll
            for (int j = 0; j < 8; ++j) xn[j] = LDV(xr, j); }
#pragma unroll
        for (int j = 0; j < 8; ++j) { v2u w; w.x = pk2(h[j][0], h[j][1]); w.y = pk2(h[j][2], h[j][3]); *(GAS v2u*)(HB + (size_t)row * D + 4 * F.lane + 256 * j) = w; }
    }
#if P1_COOP
    for (int task = gw; task < 4 * NCTX; task += NGW) { const int row = NLAT + (task >> 2), qq = task & 3; const GAS float* xr = xin_row(F, 0, row);
        const LAS float* sh = VL + 2 * D; const LAS float* sc = VL + 5 * D;
#pragma unroll
        for (int jj = 0; jj < 2; ++jj) { const int j = 2 * qq + jj; const f32x4 h = LDV(xr, j) * (LDVL(sc, j) + 1.0f) + LDVL(sh, j);
            v2u w; w.x = pk2(h[0], h[1]); w.y = pk2(h[2], h[3]); *(GAS v2u*)(HB + (size_t)row * D + 4 * F.lane + 256 * j) = w; } }
#endif
}
__device__ __forceinline__ void p3_attn_naive(Frame& F) {
    const int gw = F.vcu * NWAVES + F.wave, NGW = F.G * NWAVES;
    LAS float* Pl = (LAS float*)(F.lds + F.wave * 4096);
    LAS int* Tl = (LAS int*)(F.lds + F.wave * 4096 + 2048);
    const GAS bf16* QK = ws_tile(F, T_QK); const GAS bf16* VT = ws_tile(F, T_VT); GAS bf16* AO = ws_tile(F, T_AO);
    const float scale = 0.08838834764831845f;
    for (int un = gw; un < NROWS * NH; un += NGW) {
        const int row = un >> 4, h = un & 15; const bool lat = row < NLAT;
        int b, r = 0, qc = 0, rs = 0, cst = 0;
        if (lat) { b = row >> 12; const int t = row & 4095; r = t >> 6; qc = t & 63; rs = min(max(r - 4, 0), 56); cst = min(max(qc - 8, 0), 48); } else b = (row - NLAT) >> 8;
        const int nk = lat ? 384 : 256;
        const GAS bf16* q = QK + (size_t)row * 4096 + h * HD;
        float sv[6]; float mx = -3.0e38f;
#pragma unroll
        for (int i = 0; i < 6; ++i) { const int kk = F.lane + 64 * i; float s = -3.0e38f;
            if (kk < nk) { int krow; float bias = 0.f;
                if (lat && kk < 128) { const int kr = rs + (kk >> 4), kc = cst + (kk & 15); krow = b * SEQ + kr * 64 + kc;
                    const int dc = min(max(kc - qc + 15, 0), 30); bias = fin(F, I_RPB)[(h * 15 + (kr - r + 7)) * 31 + dc]; }
                else krow = NLAT + b * CTXL + (lat ? kk - 128 : kk);
                s = dot_bf16(q, QK + (size_t)krow * 4096 + D + h * HD, HD) * scale + bias; Tl[kk] = krow; }
            sv[i] = s; mx = fmaxf(mx, s); }
        mx = wave_max(mx); float sum = 0.f;
#pragma unroll
        for (int i = 0; i < 6; ++i) { const int kk = F.lane + 64 * i; const float p = (kk < nk) ? __expf(sv[i] - mx) : 0.f; sv[i] = p; sum += p; }
        sum = wave_sum(sum); const float inv = 1.0f / sum;
#pragma unroll
        for (int i = 0; i < 6; ++i) { const int kk = F.lane + 64 * i; if (kk < nk) Pl[kk] = sv[i] * inv; }
        asm volatile("s_waitcnt lgkmcnt(0)" ::: "memory");
        float o0 = 0.f, o1 = 0.f; const GAS bf16* v0 = VT + (size_t)(h * HD + 2 * F.lane) * NROWS; const GAS bf16* v1 = v0 + NROWS;
        for (int kk = 0; kk < nk; ++kk) { const float p = Pl[kk]; const int kr = Tl[kk]; o0 += p * bf2f(v0[kr]); o1 += p * bf2f(v1[kr]); }
        *(GAS unsigned*)(AO + (size_t)row * D + h * HD + 2 * F.lane) = pk2(o0, o1);
        asm volatile("s_waitcnt lgkmcnt(0)" ::: "memory");
    }
}
__device__ __forceinline__ void ln_rows(f32x4 (&v)[8], const GAS float* g, const GAS float* bb, const Frame& F) {
    f32x4 gv[8], bv[8];
#pragma unroll
    for (int j = 0; j < 8; ++j) { gv[j] = LDV(g, j); bv[j] = LDV(bb, j); }
    __builtin_amdgcn_sched_barrier(0);
    float s = 0.f;
#pragma unroll
    for (int j = 0; j < 8; ++j) s += (v[j][0] + v[j][1]) + (v[j][2] + v[j][3]);
    const float mean = wave_sum(s) * (1.0f / D); float s2 = 0.f;
#pragma unroll
    for (int j = 0; j < 8; ++j) { v[j] = v[j] - mean; s2 += (v[j][0] * v[j][0] + v[j][1] * v[j][1]) + (v[j][2] * v[j][2] + v[j][3] * v[j][3]); }
    const float rstd = 1.0f / sqrtf(wave_sum(s2) * (1.0f / D) + LN_EPS);
#pragma unroll
    for (int j = 0; j < 8; ++j) v[j] = v[j] * rstd * gv[j] + bv[j];
}
__device__ __forceinline__ float reduce16(float (&v)[16], int lane) {
    float a[8], b[4], c[2];
    const bool h5 = lane & 32, h4 = lane & 16, h3 = lane & 8, h2 = lane & 4;
#pragma unroll
    for (int k = 0; k < 8; ++k) { const float snd = h5 ? v[k] : v[k + 8], kp = h5 ? v[k + 8] : v[k]; a[k] = kp + __shfl_xor(snd, 32); }
#pragma unroll
    for (int k = 0; k < 4; ++k) { const float snd = h4 ? a[k] : a[k + 4], kp = h4 ? a[k + 4] : a[k]; b[k] = kp + __shfl_xor(snd, 16); }
#pragma unroll
    for (int k = 0; k < 2; ++k) { const float snd = h3 ? b[k] : b[k + 2], kp = h3 ? b[k + 2] : b[k]; c[k] = kp + __shfl_xor(snd, 8); }
    float d = (h2 ? c[1] : c[0]) + __shfl_xor(h2 ? c[0] : c[1], 4);
    d += __shfl_xor(d, 2); d += __shfl_xor(d, 1);
    return d;
}
__device__ __forceinline__ void row_phase(Frame& F, int l, int dv) {
    const int gw = F.vcu * NWAVES + F.wave, NGW = F.G * NWAVES, nrows = (l || ROW_CTX_COOP) ? NLAT : NROWS;
    const GAS bf16* O = (const GAS bf16*)(F.ws + WS_O); GAS float* X1 = (GAS float*)(F.ws + WS_X1); GAS bf16* HB = ws_tile(F, T_HB); GAS float* AFFT = (GAS float*)(F.ws + WS_AFF);
    const GAS float* lng = fin(F, I_LNG) + (size_t)(l * 2 + 0) * D; const GAS float* lnb = fin(F, I_LNB) + (size_t)(l * 2 + 0) * D; const GAS float* wr = fin(F, I_ROUTER) + (size_t)l * D * NE;
    LAS float* WR = (LAS float*)F.lds;
#pragma unroll
    for (int bt = 0; bt < 2; ++bt) { f32x4 t8[8];
#pragma unroll
        for (int k = 0; k < 8; ++k) { const int pc = F.tid + NTHREADS * (8 * bt + k), ln = pc & 63, e4 = (pc >> 6) & 3, qq = (pc >> 8) & 3, jj = pc >> 10;
            t8[k] = *(const GAS f32x4*)(wr + (size_t)(4 * ln + 256 * jj + qq) * NE + 4 * e4); }
#pragma unroll
        for (int k = 0; k < 8; ++k) *(LAS f32x4*)(WR + 4 * (F.tid + NTHREADS * (8 * bt + k))) = t8[k]; }
    __syncthreads();
    f32x4 xn[8]; v2u on[8];
    if (gw < nrows) { const GAS bf16* orow = O + (size_t)gw * D;
        XN_LOAD(xn, l, gw);
#pragma unroll
        for (int j = 0; j < 8; ++j) on[j] = *(const GAS v2u*)(orow + 4 * F.lane + 256 * j); }
    for (int row = gw; row < nrows; row += NGW) {
        const int r = row_r(row);
        const GAS float* g1 = mods(F, l, r, 2); const GAS float* sh2 = mods(F, l, r, 3); const GAS float* sc2 = mods(F, l, r, 4);
        f32x4 v[8];
        { f32x4 gg[8];
#pragma unroll
          for (int j = 0; j < 8; ++j) gg[j] = LDV(g1, j);
          __builtin_amdgcn_sched_barrier(0);
#pragma unroll
          for (int j = 0; j < 8; ++j) { const f32x4 xx = (X2_FP16 && l) ? h4_to_f32((v2u){__float_as_uint(xn[j][0]), __float_as_uint(xn[j][1])}) : xn[j];
              v[j] = xx * ALPHA + gg[j] * bf4_to_f32(on[j]); } }
        if (row + NGW < nrows) { const GAS bf16* orow = O + (size_t)(row + NGW) * D;
            XN_LOAD(xn, l, row + NGW);
#pragma unroll
            for (int j = 0; j < 8; ++j) on[j] = *(const GAS v2u*)(orow + 4 * F.lane + 256 * j); }
        ln_rows(v, lng, lnb, F);
        float lg[NE];
#pragma unroll
        for (int e = 0; e < NE; ++e) lg[e] = 0.f;
        f32x4 hv[8];
        { f32x4 cv[8], sv[8];
#pragma unroll
          for (int j = 0; j < 8; ++j) { cv[j] = LDV(sc2, j); sv[j] = LDV(sh2, j); }
          __builtin_amdgcn_sched_barrier(0);
#pragma unroll
          for (int j = 0; j < 8; ++j) hv[j] = v[j] * (cv[j] + 1.0f) + sv[j]; }
#if X1_BF16
        { v2u xw[8];
#pragma unroll
          for (int j = 0; j < 8; ++j) { xw[j].x = X1PK(v[j][0], v[j][1]); xw[j].y = X1PK(v[j][2], v[j][3]); }
          __builtin_amdgcn_sched_barrier(0);
#pragma unroll
          for (int j = 0; j < 8; ++j) {
#if NT_STREAM
              __builtin_nontemporal_store(xw[j], (GAS v2u*)((GAS bf16*)X1 + (size_t)row * D + 4 * F.lane + 256 * j));
#else
              *(GAS v2u*)((GAS bf16*)X1 + (size_t)row * D + 4 * F.lane + 256 * j) = xw[j];
#endif
          } }
#pragma unroll
        for (int j = 0; j < 8; ++j) { v2u w; w.x = pk2(hv[j][0], hv[j][1]); w.y = pk2(hv[j][2], hv[j][3]); *(GAS v2u*)(HB + (size_t)row * D + 4 * F.lane + 256 * j) = w; }
#else
#pragma unroll
        for (int j = 0; j < 8; ++j) { *(GAS f32x4*)(X1 + (size_t)row * D + 4 * F.lane + 256 * j) = v[j];
            v2u w; w.x = pk2(hv[j][0], hv[j][1]); w.y = pk2(hv[j][2], hv[j][3]); *(GAS v2u*)(HB + (size_t)row * D + 4 * F.lane + 256 * j) = w; }
#endif
        {
            const LAS float* wl = WR + 4 * F.lane; f32x4 wv[2][4];
#pragma unroll
            for (int e4 = 0; e4 < 4; ++e4) wv[0][e4] = *(const LAS f32x4*)(wl + e4 * 256);
#pragma unroll
            for (int st = 0; st < 32; ++st) {
                if (st + 1 < 32) {
#pragma unroll
                    for (int e4 = 0; e4 < 4; ++e4) wv[(st + 1) & 1][e4] = *(const LAS f32x4*)(wl + ((st + 1) * 4 + e4) * 256); }
                const float hq = hv[st >> 2][st & 3];
#pragma unroll
                for (int e4 = 0; e4 < 4; ++e4)
#pragma unroll
                    for (int t = 0; t < 4; ++t) lg[4 * e4 + t] += hq * wv[st & 1][e4][t];
                __builtin_amdgcn_sched_barrier(0); }
        }
        const float lgt = reduce16(lg, F.lane);
        float mx = lgt;
#pragma unroll
        for (int o = 4; o < 64; o <<= 1) mx = fmaxf(mx, __shfl_xor(mx, o));
        const float ex = expf(lgt - mx); float sum = ex;
#pragma unroll
        for (int o = 4; o < 64; o <<= 1) sum += __shfl_xor(sum, o);
        if ((F.lane & 3) == 0) AFFT[(size_t)((F.lane >> 2) & 15) * NROWS + row] = ex / sum;
    }
#if ROW_CTX_COOP
    if (l == 0) {
        LAS float* PS = (LAS float*)(F.lds + 131072);
        LAS float* PQ = PS + 8; LAS float* PL = PQ + 8;
        const int rr = F.wave >> 2, qq = F.wave & 3;
        for (int base = 2 * F.vcu; base < NCTX; base += 2 * F.G) {
            const int row = NLAT + base + rr;
            const GAS float* xr = xin_row(F, 0, row); const GAS bf16* orow = O + (size_t)row * D;
            const GAS float* g1 = mods(F, 0, 2, 2); const GAS float* sh2 = mods(F, 0, 2, 3); const GAS float* sc2 = mods(F, 0, 2, 4);
            f32x4 v[2], gv[2], bv[2], cv[2], sv[2];
#pragma unroll
            for (int jj = 0; jj < 2; ++jj) { const int j = 2 * qq + jj; v[jj] = LDV(xr, j) * ALPHA + LDV(g1, j) * bf4_to_f32(*(const GAS v2u*)(orow + 4 * F.lane + 256 * j));
                gv[jj] = LDV(lng, j); bv[jj] = LDV(lnb, j); cv[jj] = LDV(sc2, j); sv[jj] = LDV(sh2, j); }
            float s = (v[0][0] + v[0][1]) + (v[0][2] + v[0][3]) + (v[1][0] + v[1][1]) + (v[1][2] + v[1][3]);
            s = wave_sum(s); if (F.lane == 0) PS[rr * 4 + qq] = s;
            __syncthreads();
            const float mean = ((PS[rr * 4 + 0] + PS[rr * 4 + 1]) + (PS[rr * 4 + 2] + PS[rr * 4 + 3])) * (1.0f / D);
            float s2 = 0.f;
#pragma unroll
            for (int jj = 0; jj < 2; ++jj) { v[jj] = v[jj] - mean; s2 += (v[jj][0] * v[jj][0] + v[jj][1] * v[jj][1]) + (v[jj][2] * v[jj][2] + v[jj][3] * v[jj][3]); }
            s2 = wave_sum(s2); if (F.lane == 0) PQ[rr * 4 + qq] = s2;
            __syncthreads();
            const float rstd = 1.0f / sqrtf(((PQ[rr * 4 + 0] + PQ[rr * 4 + 1]) + (PQ[rr * 4 + 2] + PQ[rr * 4 + 3])) * (1.0f / D) + LN_EPS);
            f32x4 hv[2];
#pragma unroll
            for (int jj = 0; jj < 2; ++jj) { const int j = 2 * qq + jj; v[jj] = v[jj] * rstd * gv[jj] + bv[jj]; hv[jj] = v[jj] * (cv[jj] + 1.0f) + sv[jj];
#if X1_BF16
                { v2u xw; xw.x = X1PK(v[jj][0], v[jj][1]); xw.y = X1PK(v[jj][2], v[jj][3]); *(GAS v2u*)((GAS bf16*)X1 + (size_t)row * D + 4 * F.lane + 256 * j) = xw; }
#else
                *(GAS f32x4*)(X1 + (size_t)row * D + 4 * F.lane + 256 * j) = v[jj];
#endif
                v2u w; w.x = pk2(hv[jj][0], hv[jj][1]); w.y = pk2(hv[jj][2], hv[jj][3]); *(GAS v2u*)(HB + (size_t)row * D + 4 * F.lane + 256 * j) = w; }
            float lg[NE];
#pragma unroll
            for (int e = 0; e < NE; ++e) lg[e] = 0.f;
#pragma unroll
            for (int jj = 0; jj < 2; ++jj)
#pragma unroll
                for (int q = 0; q < 4; ++q) { const LAS float* wp = WR + ((((2 * qq + jj) * 4 + q) * 4) * 64 + F.lane) * 4; const float hq = hv[jj][q];
#pragma unroll
                    for (int e4 = 0; e4 < 4; ++e4) { const f32x4 wv = *(const LAS f32x4*)(wp + e4 * 256);
#pragma unroll
                        for (int t = 0; t < 4; ++t) lg[4 * e4 + t] += hq * wv[t]; } }
            const float lgt = reduce16(lg, F.lane);
            if ((F.lane & 3) == 0) PL[(rr * 4 + qq) * 16 + ((F.lane >> 2) & 15)] = lgt;
            __syncthreads();
            if (qq == 0) { const int e = F.lane & 15;
                const float lgs = (PL[(rr * 4 + 0) * 16 + e] + PL[(rr * 4 + 1) * 16 + e]) + (PL[(rr * 4 + 2) * 16 + e] + PL[(rr * 4 + 3) * 16 + e]);
                float mx = lgs;
#pragma unroll
                for (int o = 1; o < 16; o <<= 1) mx = fmaxf(mx, __shfl_xor(mx, o));
                const float ex = expf(lgs - mx); float sum = ex;
#pragma unroll
                for (int o = 1; o < 16; o <<= 1) sum += __shfl_xor(sum, o);
                if (F.lane < 16) AFFT[(size_t)e * NROWS + row] = ex / sum; }
            __syncthreads();
        }
    }
#endif
    __syncthreads();
}
__device__ __forceinline__ void topk_phase(Frame& F, int l) {
    LAS int* CW = (LAS int*)F.lds;
    LAS int* CG = CW + 16;
    LAS int* CE = CG + 64;
    const GAS float* AFFT = (const GAS float*)(F.ws + WS_AFF); GAS int* SLOT = (GAS int*)(F.ws + WS_SLOT); GAS int* IDX = (GAS int*)(F.ws + WS_IDX); GAS float* GATE = (GAS float*)(F.ws + WS_GATE);
    const int nlat = 2 * NE * 8, ntot = nlat + (l == 0 ? 2 * NE : 0);
#if CV_TKN
    const int cv_end = CV_NIT_ALL - (1 - l) * CV_TK, cv_ngw = F.G * NWAVES; int cv_it = cv_end - CV_TK + F.vcu * NWAVES + F.wave, cv_left = CV_TKN; bool cv_pend = false;
    const GAS float* cs0 = nullptr; int cl0 = 0, cd0 = 0, ck0 = 0; GAS bf16* co0 = nullptr; f32x4 cva[8];
#endif
    for (int un = blockIdx.x; un < ntot; un += F.G) {
        const bool lat = un < nlat; int b, e, ch, n, cap, rowbase, slotbase;
        if (lat) { b = un >> 7; e = (un >> 3) & 15; ch = un & 7; n = SEQ; cap = 512; rowbase = b * SEQ; slotbase = e * RPE + b * 512; }
        else { const int q = un - nlat; b = q >> 4; e = q & 15; ch = 0; n = CTXL; cap = 32; rowbase = NLAT + b * CTXL; slotbase = e * RPE + 1024 + b * 32; }
        unsigned key[8];
#pragma unroll
        for (int i = 0; i < 8; ++i) { const int t = F.tid + 512 * i; key[i] = (t < n) ? __float_as_uint(AFFT[(size_t)e * NROWS + rowbase + t]) : 0u; }
        unsigned T = 0u;
#if TOPK_2BIT
        typedef int i32x4 __attribute__((ext_vector_type(4)));
        LAS i32x4* CW4 = (LAS i32x4*)(F.lds + 4096);
        {   const unsigned cand = 1u << 30; int cnt = 0;
#pragma unroll
            for (int i = 0; i < 8; ++i) cnt += __builtin_popcountll(__ballot(key[i] >= cand));
            if (F.lane == 0) CW[F.wave] = cnt;
            __syncthreads();
            int tot = 0;
#pragma unroll
            for (int w = 0; w < 8; ++w) tot += CW[w];
            if (tot >= cap) T = cand; }
        for (int lo = 28; lo >= 0; lo -= 2) {
            const unsigned c1 = T | (1u << lo), c2 = T | (2u << lo), c3 = T | (3u << lo); int n1 = 0, n2 = 0, n3 = 0;
#pragma unroll
            for (int i = 0; i < 8; ++i) { n1 += __builtin_popcountll(__ballot(key[i] >= c1)); n2 += __builtin_popcountll(__ballot(key[i] >= c2)); n3 += __builtin_popcountll(__ballot(key[i] >= c3)); }
            LAS i32x4* cw = CW4 + ((lo >> 1) & 1) * 8;
            if (F.lane == 0) cw[F.wave] = (i32x4){n1, n2, n3, 0};
            __syncthreads();
            i32x4 tot = {0, 0, 0, 0};
#pragma unroll
            for (int w = 0; w < 8; ++w) tot += cw[w];
            T = tot[2] >= cap ? c3 : tot[1] >= cap ? c2 : tot[0] >= cap ? c1 : T;
        }
#else
        for (int bit = 30; bit >= 0; --bit) {
#if CV_TKN
            if ((bit & 3) == 2) {
                if (cv_pend) { p0_item_store(co0, cd0, ck0, F.lane, cva); cv_pend = false; }
                if (cv_left > 0 && cv_it < cv_end) { p0_decode(F, cv_it, cs0, cl0, co0, cd0, ck0); p0_item_load(cs0, cl0, ck0, F.lane, cva); cv_pend = true; cv_it += cv_ngw; }
                --cv_left; }
#endif
            const unsigned cand = T | (1u << bit); int cnt = 0;
#pragma unroll
            for (int i = 0; i < 8; ++i) cnt += __builtin_popcountll(__ballot(key[i] >= cand));
            LAS int* cw = CW + (bit & 1) * 8;
            if (F.lane == 0) cw[F.wave] = cnt;
            __syncthreads();
            int tot = 0;
#pragma unroll
            for (int w = 0; w < 8; ++w) tot += cw[w];
            if (tot >= cap) T = cand;
        }
#endif
#pragma unroll
        for (int i = 0; i < 8; ++i) { const unsigned long long mg = __ballot(key[i] > T), me = __ballot(key[i] == T);
            if (F.lane == 0) { CG[i * 8 + F.wave] = __builtin_popcountll(mg); CE[i * 8 + F.wave] = __builtin_popcountll(me); } }
        __syncthreads();
        int gt_total = 0, g_before = 0, e_before = 0;
        { typedef int i32x4 __attribute__((ext_vector_type(4))); i32x4 cgv[16], cev[16];
#pragma unroll
          for (int k4 = 0; k4 < 16; ++k4) { cgv[k4] = *(const LAS i32x4*)(CG + 4 * k4); cev[k4] = *(const LAS i32x4*)(CE + 4 * k4); }
          const int lim = ch * 8 + F.wave;
#pragma unroll
          for (int k4 = 0; k4 < 16; ++k4)
#pragma unroll
              for (int t = 0; t < 4; ++t) { const int k = 4 * k4 + t; gt_total += cgv[k4][t]; g_before += (k < lim) ? cgv[k4][t] : 0; e_before += (k < lim) ? cev[k4][t] : 0; } }
        const int need = cap - gt_total;
        {
            unsigned kv = 0u;
#pragma unroll
            for (int i = 0; i < 8; ++i) kv = (i == ch) ? key[i] : kv;
            const int t = F.tid + 512 * ch;
            const unsigned long long mg = __ballot(kv > T), me = __ballot(kv == T);
            const unsigned long long lower = (F.lane == 0) ? 0ull : (~0ull >> (64 - F.lane));
            const int g_rank = g_before + __builtin_popcountll(mg & lower), e_rank = e_before + __builtin_popcountll(me & lower);
            const int e_taken_before = e_rank < need ? e_rank : need;
            const bool sel = (t < n) && ((kv > T) || (kv == T && e_rank < need));
            if (t < n) { int s = -1;
                if (sel) { s = slotbase + g_rank + e_taken_before; IDX[s] = rowbase + t; GATE[s] = __uint_as_float(kv); }
                SLOT[(size_t)(rowbase + t) * NE + e] = s; }
        }
        __syncthreads();
    }
#if CV_TKN
    if (cv_pend) p0_item_store(co0, cd0, ck0, F.lane, cva);
    for (; cv_left > 0 && cv_it < cv_end; --cv_left, cv_it += cv_ngw) { p0_decode(F, cv_it, cs0, cl0, co0, cd0, ck0); p0_item_load(cs0, cl0, ck0, F.lane, cva); p0_item_store(co0, cd0, ck0, F.lane, cva); }
#endif
}
__device__ __forceinline__ void gather_phase(Frame& F, int l) {
    const int gw = F.vcu * NWAVES + F.wave, NGW = F.G * NWAVES, nv = l ? 1024 : 1088;
    const GAS bf16* HB = ws_tile(F, T_HB); GAS bf16* XE = ws_tile(F, T_XE); const GAS int* IDX = (const GAS int*)(F.ws + WS_IDX);
    for (int i = gw; i < NE * nv; i += NGW) { const int e = i / nv, s = e * RPE + i % nv; const int src = IDX[s];
        const GAS v4u* sp = (const GAS v4u*)(HB + (size_t)src * D); GAS v4u* dp = (GAS v4u*)(XE + (size_t)s * D);
        v4u t4[4];
#pragma unroll
        for (int j = 0; j < 4; ++j) t4[j] = sp[F.lane + 64 * j];
#pragma unroll
        for (int j = 0; j < 4; ++j) dp[F.lane + 64 * j] = t4[j]; }
}
__device__ __forceinline__ void combine_phase(Frame& F, int l) {
    const int gw = F.vcu * NWAVES + F.wave, NGW = F.G * NWAVES, nrows = (l || CTX_COOP2) ? NLAT : NROWS;
    const GAS float* X1 = (const GAS float*)(F.ws + WS_X1); const GAS bf16* YE = (const GAS bf16*)(F.ws + WS_YE); const GAS int* SLOT = (const GAS int*)(F.ws + WS_SLOT);
    GAS float* X2 = (GAS float*)(F.ws + WS_X2); GAS bf16* HB = ws_tile(F, T_HB);
    const GAS float* lng = fin(F, I_LNG) + (size_t)(l * 2 + 1) * D; const GAS float* lnb = fin(F, I_LNB) + (size_t)(l * 2 + 1) * D;
    LAS float* VL = (LAS float*)F.lds;
    stage_vec(F, VL, lng); stage_vec(F, VL + D, lnb);
#pragma unroll
    for (int r = 0; r < 3; ++r) { stage_vec(F, VL + (2 + r) * D, mods(F, l, r, 5)); if (l == 0) { stage_vec(F, VL + (5 + r) * D, mods(F, 1, r, 0)); stage_vec(F, VL + (8 + r) * D, mods(F, 1, r, 1)); } }
    __syncthreads();
    int svn = (gw < nrows) ? SLOT[(size_t)gw * NE + (F.lane & 15)] : -1;
    for (int row = gw; row < nrows; row += NGW) {
        const int r = row_r(row); const LAS float* g2 = VL + (2 + r) * D;
#if X1_BF16
        const GAS bf16* x1 = (const GAS bf16*)X1 + (size_t)row * D;
#else
        const GAS float* x1 = X1 + (size_t)row * D;
#endif
        f32x4 f[8];
#pragma unroll
        for (int j = 0; j < 8; ++j) f[j] = (f32x4){0.f, 0.f, 0.f, 0.f};
        const int sv = svn;
        if (row + NGW < nrows) svn = SLOT[(size_t)(row + NGW) * NE + (F.lane & 15)];
        f32x4 xv[8], g2v[8];
#if X1_BF16
#pragma unroll
        for (int j = 0; j < 8; ++j) { xv[j] = X1UNPK(*(const GAS v2u*)(x1 + 4 * F.lane + 256 * j)); g2v[j] = LDVL(g2, j); }
#else
#pragma unroll
        for (int j = 0; j < 8; ++j) { xv[j] = LDV(x1, j); g2v[j] = LDVL(g2, j); }
#endif
#pragma unroll
        for (int e = 0; e < NE; ++e) { const int s = __builtin_amdgcn_readlane(sv, e);
            if (s >= 0) { const GAS bf16* yr = YE + (size_t)s * D; v2u t[8];
#pragma unroll
                for (int j = 0; j < 8; ++j) t[j] = *(const GAS v2u*)(yr + 4 * F.lane + 256 * j);
#pragma unroll
                for (int j = 0; j < 8; ++j) f[j] += bf4_to_f32(t[j]); } }
        f32x4 v[8];
#pragma unroll
        for (int j = 0; j < 8; ++j) v[j] = xv[j] * ALPHA + g2v[j] * f[j];
        ln_rows_lds(v, VL, VL + D, F);
        if (l == 0) { const LAS float* sh = VL + (5 + r) * D; const LAS float* sc = VL + (8 + r) * D; v2u hw[8];
#pragma unroll
            for (int j = 0; j < 8; ++j) { const f32x4 h = v[j] * (LDVL(sc, j) + 1.0f) + LDVL(sh, j); hw[j].x = pk2(h[0], h[1]); hw[j].y = pk2(h[2], h[3]); }
#pragma unroll
            for (int j = 0; j < 8; ++j) {
#if NT_STREAM
                __builtin_nontemporal_store(v[j], (GAS f32x4*)(X2 + (size_t)row * D + 4 * F.lane + 256 * j));
#elif X2_FP16
                { v2u xw; xw.x = pkh2(v[j][0], v[j][1]); xw.y = pkh2(v[j][2], v[j][3]); *(GAS v2u*)((GAS bf16*)X2 + (size_t)row * D + 4 * F.lane + 256 * j) = xw; }
#else
                *(GAS f32x4*)(X2 + (size_t)row * D + 4 * F.lane + 256 * j) = v[j];
#endif
                *(GAS v2u*)(HB + (size_t)row * D + 4 * F.lane + 256 * j) = hw[j]; } }
        else {
#pragma unroll
            for (int j = 0; j < 8; ++j) {
#if NT_STREAM
                __builtin_nontemporal_store(v[j], (GAS f32x4*)(F.out + (size_t)row * D + 4 * F.lane + 256 * j));
#else
                *(GAS f32x4*)(F.out + (size_t)row * D + 4 * F.lane + 256 * j) = v[j];
#endif
            } }
    }
#if CTX_COOP2
    if (l == 0) {
        LAS float* PS = (LAS float*)(F.lds + 131072); LAS float* PQ = PS + 8;
        const int rr = F.wave >> 2, qq = F.wave & 3;
        for (int base = 2 * F.vcu; base < NCTX; base += 2 * F.G) {
            const int row = NLAT + base + rr; const GAS float* x1 = X1 + (size_t)row * D; const LAS float* g2 = VL + 4 * D;
            const int sv = SLOT[(size_t)row * NE + (F.lane & 15)];
            f32x4 f[2] = {{0.f, 0.f, 0.f, 0.f}, {0.f, 0.f, 0.f, 0.f}}, xv[2];
#pragma unroll
            for (int jj = 0; jj < 2; ++jj) xv[jj] = LDV(x1, 2 * qq + jj);
#pragma unroll
            for (int e = 0; e < NE; ++e) { const int sl = __builtin_amdgcn_readlane(sv, e);
                if (sl >= 0) { const GAS bf16* yr = YE + (size_t)sl * D; v2u t[2];
#pragma unroll
                    for (int jj = 0; jj < 2; ++jj) t[jj] = *(const GAS v2u*)(yr + 4 * F.lane + 256 * (2 * qq + jj));
#pragma unroll
                    for (int jj = 0; jj < 2; ++jj) f[jj] += bf4_to_f32(t[jj]); } }
            f32x4 v[2];
#pragma unroll
            for (int jj = 0; jj < 2; ++jj) v[jj] = xv[jj] * ALPHA + LDVL(g2, 2 * qq + jj) * f[jj];
            float s1 = (v[0][0] + v[0][1]) + (v[0][2] + v[0][3]) + (v[1][0] + v[1][1]) + (v[1][2] + v[1][3]);
            s1 = wave_sum(s1); if (F.lane == 0) PS[rr * 4 + qq] = s1;
            __syncthreads();
            const float mean = ((PS[rr * 4 + 0] + PS[rr * 4 + 1]) + (PS[rr * 4 + 2] + PS[rr * 4 + 3])) * (1.0f / D);
            float s2 = 0.f;
#pragma unroll
            for (int jj = 0; jj < 2; ++jj) { v[jj] = v[jj] - mean; s2 += (v[jj][0] * v[jj][0] + v[jj][1] * v[jj][1]) + (v[jj][2] * v[jj][2] + v[jj][3] * v[jj][3]); }
            s2 = wave_sum(s2); if (F.lane == 0) PQ[rr * 4 + qq] = s2;
            __syncthreads();
            const float rstd = 1.0f / sqrtf(((PQ[rr * 4 + 0] + PQ[rr * 4 + 1]) + (PQ[rr * 4 + 2] + PQ[rr * 4 + 3])) * (1.0f / D) + LN_EPS);
            const LAS float* sh = VL + 7 * D; const LAS float* sc = VL + 10 * D;
#pragma unroll
            for (int jj = 0; jj < 2; ++jj) { const int j = 2 * qq + jj; v[jj] = v[jj] * rstd * LDVL(VL, j) + LDVL(VL + D, j);
                const f32x4 h = v[jj] * (LDVL(sc, j) + 1.0f) + LDVL(sh, j);
                *(GAS f32x4*)(X2 + (size_t)row * D + 4 * F.lane + 256 * j) = v[jj];
                v2u w; w.x = pk2(h[0], h[1]); w.y = pk2(h[2], h[3]); *(GAS v2u*)(HB + (size_t)row * D + 4 * F.lane + 256 * j) = w; }
            __syncthreads();
        }
    }
#endif
    __syncthreads();
}
__device__ __forceinline__ void s5_naive(Frame& F) {
    const int gw = F.vcu * NWAVES + F.wave, NGW = F.G * NWAVES;
    const GAS float* AR = (const GAS float*)(F.ws + WS_SPAR); const GAS float* AI = AR + 2 * NG * NP; const GAS float* BB = AI + 2 * NG * NP;
    const GAS bf16* HB = ws_tile(F, T_HB);
    for (int un = gw; un < 2 * NG * 2; un += NGW) {
        const int b = un >> 8, g = (un >> 1) & 127, dir = un & 1; const int idx = (dir * NG + g) * NP + F.lane;
        const float ar = AR[idx], ai = AI[idx]; float br[GH], bi[GH], cr[GH], ci[GH];
#pragma unroll
        for (int h = 0; h < GH; ++h) { br[h] = BB[(size_t)idx * 32 + h]; bi[h] = BB[(size_t)idx * 32 + 16 + h];
            cr[h] = fin(F, I_CRE)[((size_t)(dir * NG + g) * GH + h) * NP + F.lane]; ci[h] = fin(F, I_CIM)[((size_t)(dir * NG + g) * GH + h) * NP + F.lane]; }
        GAS float* Y = (GAS float*)(F.ws + (dir ? WS_YB : WS_YF));
        float xr = 0.f, xi = 0.f;
        for (int tau = 0; tau < CTXL + SEQ; ++tau) {
            int row; if (tau < CTXL) row = NLAT + b * CTXL + (dir ? CTXL - 1 - tau : tau); else row = b * SEQ + (dir ? SEQ - 1 - (tau - CTXL) : tau - CTXL);
            const v4u u0 = *(const GAS v4u*)(HB + (size_t)row * D + g * GH), u1 = *(const GAS v4u*)(HB + (size_t)row * D + g * GH + 8);
            float u[GH];
#pragma unroll
            for (int q = 0; q < 4; ++q) { u[2 * q] = bf2f(u0[q] & 0xffffu); u[2 * q + 1] = bf2f(u0[q] >> 16); u[8 + 2 * q] = bf2f(u1[q] & 0xffffu); u[8 + 2 * q + 1] = bf2f(u1[q] >> 16); }
            float pr = 0.f, pi = 0.f;
#pragma unroll
            for (int h = 0; h < GH; ++h) { pr += br[h] * u[h]; pi += bi[h] * u[h]; }
            const float nxr = ar * xr - ai * xi + pr, nxi = ar * xi + ai * xr + pi; xr = nxr; xi = nxi;
            if (tau >= CTXL) { float mine = 0.f;
#pragma unroll
                for (int h = 0; h < GH; ++h) { const float y = wave_sum(cr[h] * xr - ci[h] * xi); mine = (F.lane == h) ? y : mine; }
                if (F.lane < GH) Y[(size_t)row * D + g * GH + F.lane] = mine; }
        }
    }
}
__device__ __forceinline__ void zprep_phase(Frame& F) {
    const int gw = F.vcu * NWAVES + F.wave, NGW = F.G * NWAVES;
    const GAS float* X2 = (const GAS float*)(F.ws + WS_X2); const GAS bf16* YF = (const GAS bf16*)(F.ws + WS_YF); const GAS bf16* YB = (const GAS bf16*)(F.ws + WS_YB); GAS bf16* Z = ws_tile(F, T_Z);
    const GAS float* dsk = fin(F, I_SD);
    for (int row = gw; row < NLAT; row += NGW) {
        const int r = row >> 12; const GAS float* sh = mods(F, 1, r, 0); const GAS float* sc = mods(F, 1, r, 1);
        const GAS float* x2 = X2 + (size_t)row * D; const GAS bf16* yf = YF + (size_t)row * D; const GAS bf16* yb = YB + (size_t)row * D;
        f32x4 xv[8]; v2u fv[8], bv[8];
#pragma unroll
        for (int j = 0; j < 8; ++j) { xv[j] = LDV(x2, j); fv[j] = *(const GAS v2u*)(yf + 4 * F.lane + 256 * j); bv[j] = *(const GAS v2u*)(yb + 4 * F.lane + 256 * j); }
        v2u zo[8];
#pragma unroll
        for (int j = 0; j < 8; ++j) { const f32x4 u = xv[j] * (LDV(sc, j) + 1.0f) + LDV(sh, j); const f32x4 y = LDV(dsk, j) * u + bf4_to_f32(fv[j]) + bf4_to_f32(bv[j]);
            zo[j].x = pk2(gelu_tanh_f(y[0]), gelu_tanh_f(y[1])); zo[j].y = pk2(gelu_tanh_f(y[2]), gelu_tanh_f(y[3])); }
#pragma unroll
        for (int j = 0; j < 8; ++j) *(GAS v2u*)(Z + (size_t)row * D + 4 * F.lane + 256 * j) = zo[j];
    }
}

constexpr int S5_T = 34, S5_NCH = 128;
typedef float f32x4s __attribute__((ext_vector_type(4)));
struct S5Consts { bf16x8 abu[8]; float ar[4][4], ai[4][4]; };
__device__ __forceinline__ void s5_load_consts(const Frame& F, int gd, int lane, S5Consts& K) {
    const GAS float* AR = (const GAS float*)(F.ws + WS_SPAR); const GAS float* AI = AR + 2 * NG * NP; const GAS float* BB = AI + 2 * NG * NP;
    const int m = lane & 15, q = lane >> 4;
#pragma unroll
    for (int tt = 0; tt < 8; ++tt) { const int p = 16 * (tt >> 1) + m; v4u w = {0u, 0u, 0u, 0u};
        if (q < 2) { const GAS float* s = BB + (size_t)(gd * NP + p) * 32 + (tt & 1) * 16 + 8 * q; const f32x4 x0 = *(const GAS f32x4*)s, x1 = *(const GAS f32x4*)(s + 4);
            w.x = pk2(x0[0], x0[1]); w.y = pk2(x0[2], x0[3]); w.z = pk2(x1[0], x1[1]); w.w = pk2(x1[2], x1[3]); }
        K.abu[tt] = __builtin_bit_cast(bf16x8, w); }
#pragma unroll
    for (int pb = 0; pb < 4; ++pb) { const f32x4 a = *(const GAS f32x4*)(AR + gd * NP + 16 * pb + 4 * q), b = *(const GAS f32x4*)(AI + gd * NP + 16 * pb + 4 * q);
#pragma unroll
        for (int i = 0; i < 4; ++i) { K.ar[pb][i] = a[i]; K.ai[pb][i] = b[i]; } }
}
__device__ __forceinline__ int s5_row(int b, int dir, int tau) {
    const int ctxrow = NLAT + b * CTXL + (dir ? CTXL - 1 - tau : tau), latrow = b * SEQ + (dir ? (CTXL + SEQ - 1) - tau : tau - CTXL);
    return tau < CTXL ? ctxrow : latrow;
}
constexpr int S5_XP = 132;
template <bool READOUT>
__device__ __forceinline__ void s5_run(Frame& F, const S5Consts& K, const bf16x8 (&cfr)[4], int gd, int cg, LAS float* XS) {
    const int lane = F.lane, n = lane & 15, q = lane >> 4, dir = gd >> 7, g = gd & 127;
    const GAS bf16* HB = ws_tile(F, T_HB);
    GAS bf16* Y = (GAS bf16*)(F.ws + (dir ? WS_YB : WS_YF));
    const int chunk = cg * 16 + n, b = chunk >> 7, c = chunk & 127, tau0 = c * S5_T;
    LAS float* xs = XS + chunk * S5_XP + 8 * q;
    f32x4s X[8];
    if (READOUT) {
#pragma unroll
        for (int pb = 0; pb < 4; ++pb) { const f32x4 v0 = *(const LAS f32x4*)(xs + 32 * pb), v1 = *(const LAS f32x4*)(xs + 32 * pb + 4);
            X[2 * pb] = (f32x4s){v0[0], v0[2], v1[0], v1[2]}; X[2 * pb + 1] = (f32x4s){v0[1], v0[3], v1[1], v1[3]}; }
    } else {
#pragma unroll
        for (int tt = 0; tt < 8; ++tt) X[tt] = (f32x4s){0.f, 0.f, 0.f, 0.f};
    }
    constexpr int PD = 6;
    v4u ur[PD];
    const GAS bf16* ucol = HB + g * GH + 8 * q;
#pragma unroll
    for (int t = 0; t < PD; ++t) { ur[t] = (v4u){0u, 0u, 0u, 0u}; if (q < 2) ur[t] = *(const GAS v4u*)(ucol + (size_t)s5_row(b, dir, tau0 + t) * D); }
#define S5_STEP(KS, T, REFILL) do { \
        const bf16x8 ub = __builtin_bit_cast(bf16x8, ur[KS]); \
        if (REFILL) { ur[KS] = (v4u){0u, 0u, 0u, 0u}; if (q < 2) ur[KS] = *(const GAS v4u*)(ucol + (size_t)s5_row(b, dir, tau0 + (T) + PD) * D); } \
        _Pragma("unroll") for (int pb = 0; pb < 4; ++pb) _Pragma("unroll") for (int i = 0; i < 4; ++i) { const float re = X[2 * pb][i], im = X[2 * pb + 1][i]; \
            X[2 * pb][i] = K.ar[pb][i] * re - K.ai[pb][i] * im; X[2 * pb + 1][i] = K.ar[pb][i] * im + K.ai[pb][i] * re; } \
        _Pragma("unroll") for (int tt = 0; tt < 8; ++tt) X[tt] = __builtin_amdgcn_mfma_f32_16x16x32_bf16(K.abu[tt], ub, X[tt], 0, 0, 0); \
        if (READOUT) { f32x4s y0 = {0.f, 0.f, 0.f, 0.f}, y1 = y0; \
            _Pragma("unroll") for (int s = 0; s < 4; ++s) { v4u w; w.x = pk2(X[2 * s][0], X[2 * s][1]); w.y = pk2(X[2 * s][2], X[2 * s][3]); w.z = pk2(X[2 * s + 1][0], X[2 * s + 1][1]); w.w = pk2(X[2 * s + 1][2], X[2 * s + 1][3]); \
                const bf16x8 xb = __builtin_bit_cast(bf16x8, w); \
                if (s & 1) y1 = __builtin_amdgcn_mfma_f32_16x16x32_bf16(cfr[s], xb, y1, 0, 0, 0); else y0 = __builtin_amdgcn_mfma_f32_16x16x32_bf16(cfr[s], xb, y0, 0, 0, 0); } \
            const int tau = tau0 + (T); \
            if (tau >= CTXL) { const f32x4s y = y0 + y1; v2u w; w.x = pk2(y[0], y[1]); w.y = pk2(y[2], y[3]); *(GAS v2u*)(Y + (size_t)s5_row(b, dir, tau) * D + g * GH + 4 * q) = w; } } \
    } while (0)
#pragma unroll 1
    for (int t0 = 0; t0 < 24; t0 += PD) {
        S5_STEP(0, t0 + 0, true); S5_STEP(1, t0 + 1, true); S5_STEP(2, t0 + 2, true); S5_STEP(3, t0 + 3, true); S5_STEP(4, t0 + 4, true); S5_STEP(5, t0 + 5, true); }
    S5_STEP(0, 24, true); S5_STEP(1, 25, true); S5_STEP(2, 26, true); S5_STEP(3, 27, true); S5_STEP(4, 28, false); S5_STEP(5, 29, false);
    S5_STEP(0, 30, false); S5_STEP(1, 31, false); S5_STEP(2, 32, false); S5_STEP(3, 33, false);
#undef S5_STEP
    if (!READOUT) {
#pragma unroll
        for (int pb = 0; pb < 4; ++pb) { const f32x4s re = X[2 * pb], im = X[2 * pb + 1];
            *(LAS f32x4*)(xs + 32 * pb) = (f32x4){re[0], im[0], re[1], im[1]}; *(LAS f32x4*)(xs + 32 * pb + 4) = (f32x4){re[2], im[2], re[3], im[3]}; }
    }
}
__device__ __forceinline__ void s5_fused(Frame& F) {
    LAS float* XS = (LAS float*)F.lds;
    LAS f32x2* AG = (LAS f32x2*)(F.lds + 256 * S5_XP * 4);
    const GAS float* AR = (const GAS float*)(F.ws + WS_SPAR); const GAS float* AI = AR + 2 * NG * NP;
    const int lane = F.lane, n = lane & 15, q = lane >> 4, seg = F.tid >> 6, p = F.tid & 63;
    for (int gd = F.vcu; gd < 2 * NG; gd += F.G) {
        S5Consts K; s5_load_consts(F, gd, lane, K);
        bf16x8 cz[4];
#pragma unroll
        for (int s = 0; s < 4; ++s) cz[s] = (bf16x8){0, 0, 0, 0, 0, 0, 0, 0};
#pragma unroll 1
        for (int k2 = 0; k2 < 2; ++k2) s5_run<false>(F, K, cz, gd, F.wave * 2 + k2, XS);
        __syncthreads();
        {
            const double ar = AR[gd * NP + p], ai = AI[gd * NP + p];
            double sr = ar, si = ai, t; t = sr * sr - si * si; si = 2.0 * sr * si; sr = t;
            double pr = sr, pi = si;
            for (int k = 0; k < 4; ++k) { t = sr * sr - si * si; si = 2.0 * sr * si; sr = t; }
            t = pr * sr - pi * si; pi = pr * si + pi * sr; pr = t;
            const float tr = (float)pr, ti = (float)pi;
            double qr = pr, qi = pi; for (int k = 0; k < 4; ++k) { t = qr * qr - qi * qi; qi = 2.0 * qr * qi; qr = t; }
            const float t16r = (float)qr, t16i = (float)qi;
            for (int b = 0; b < 2; ++b) {
                LAS float* xs = XS + (b * S5_NCH + seg * 16) * S5_XP + 2 * p;
                f32x2 loc[16];
#pragma unroll
                for (int k = 0; k < 16; ++k) loc[k] = *(const LAS f32x2*)(xs + k * S5_XP);
                float ar_ = 0.f, ai_ = 0.f;
#pragma unroll
                for (int k = 0; k < 16; ++k) { const float nr = tr * ar_ - ti * ai_ + loc[k][0], ni = tr * ai_ + ti * ar_ + loc[k][1]; ar_ = nr; ai_ = ni; }
                AG[seg * 64 + p] = (f32x2){ar_, ai_};
                __syncthreads();
                float cr = 0.f, ci = 0.f;
                for (int s2 = 0; s2 < seg; ++s2) { const f32x2 a = AG[s2 * 64 + p]; const float nr = t16r * cr - t16i * ci + a[0], ni = t16r * ci + t16i * cr + a[1]; cr = nr; ci = ni; }
#pragma unroll
                for (int k = 0; k < 16; ++k) { *(LAS f32x2*)(xs + k * S5_XP) = (f32x2){cr, ci};
                    const float nr = tr * cr - ti * ci + loc[k][0], ni = tr * ci + ti * cr + loc[k][1]; cr = nr; ci = ni; }
                __syncthreads();
            }
        }
        bf16x8 cfr[4];
#pragma unroll
        for (int s = 0; s < 4; ++s) { const GAS float* cr = fin(F, I_CRE) + (size_t)(gd * GH + n) * NP + 16 * s + 4 * q; const GAS float* ci = fin(F, I_CIM) + (size_t)(gd * GH + n) * NP + 16 * s + 4 * q;
            const f32x4 a = *(const GAS f32x4*)cr, b = *(const GAS f32x4*)ci; v4u w; w.x = pk2(a[0], a[1]); w.y = pk2(a[2], a[3]); w.z = pk2(-b[0], -b[1]); w.w = pk2(-b[2], -b[3]);
            cfr[s] = __builtin_bit_cast(bf16x8, w); }
#pragma unroll 1
        for (int k2 = 0; k2 < 2; ++k2) s5_run<true>(F, K, cfr, gd, F.wave * 2 + k2, XS);
        __syncthreads();
    }
}

template <int MODE>
__device__ __forceinline__ void s5z_run(Frame& F, const S5Consts& K, const bf16x8 (&cfr)[4], int g, int dir, int b, int cgl, LAS float* XS) {
    constexpr bool READOUT = MODE != 0;
    const int lane = F.lane, n = lane & 15, q = lane >> 4;
    const GAS bf16* HB = ws_tile(F, T_HB);
    GAS bf16* YF = (GAS bf16*)(F.ws + WS_YF); GAS bf16* Z = ws_tile(F, T_Z);
    const int c = cgl * 16 + n, tau0 = c * S5_T;
    LAS float* xs = XS + (dir * S5_NCH + c) * S5_XP + 8 * q;
    f32x4s X[8];
    if (READOUT) {
#pragma unroll
        for (int pb = 0; pb < 4; ++pb) { const f32x4 v0 = *(const LAS f32x4*)(xs + 32 * pb), v1 = *(const LAS f32x4*)(xs + 32 * pb + 4);
            X[2 * pb] = (f32x4s){v0[0], v0[2], v1[0], v1[2]}; X[2 * pb + 1] = (f32x4s){v0[1], v0[3], v1[1], v1[3]}; }
    } else {
#pragma unroll
        for (int tt = 0; tt < 8; ++tt) X[tt] = (f32x4s){0.f, 0.f, 0.f, 0.f};
    }
    f32x4 dsk = {0.f, 0.f, 0.f, 0.f};
    if (MODE == 2) dsk = *(const GAS f32x4*)(fin(F, I_SD) + g * GH + 4 * q);
    constexpr int PD = 6;
    v4u ur[PD];
    const GAS bf16* ucol = HB + g * GH + 8 * q;
#pragma unroll
    for (int t = 0; t < PD; ++t) { ur[t] = (v4u){0u, 0u, 0u, 0u}; if (q < 2) ur[t] = *(const GAS v4u*)(ucol + (size_t)s5_row(b, dir, tau0 + t) * D); }
    unsigned long long yfn = 0ull, un = 0ull;
    if (MODE == 2) { const int tau = tau0; if (tau >= CTXL) { const size_t o = (size_t)s5_row(b, dir, tau) * D + g * GH + 4 * q;
        yfn = __hip_atomic_load((const GAS unsigned long long*)(YF + o), __ATOMIC_RELAXED, __HIP_MEMORY_SCOPE_AGENT); un = *(const GAS unsigned long long*)(HB + o); } }
#define S5Z_STEP(KS, T, REFILL) do { \
        const bf16x8 ub = __builtin_bit_cast(bf16x8, ur[KS]); \
        if (REFILL) { ur[KS] = (v4u){0u, 0u, 0u, 0u}; if (q < 2) ur[KS] = *(const GAS v4u*)(ucol + (size_t)s5_row(b, dir, tau0 + (T) + PD) * D); } \
        const unsigned long long yfc = yfn, uc = un; \
        if (MODE == 2) { const int tn_ = tau0 + (T) + 1; if ((T) + 1 < S5_T && tn_ >= CTXL) { const size_t o_ = (size_t)s5_row(b, dir, tn_) * D + g * GH + 4 * q; \
            yfn = __hip_atomic_load((const GAS unsigned long long*)(YF + o_), __ATOMIC_RELAXED, __HIP_MEMORY_SCOPE_AGENT); un = *(const GAS unsigned long long*)(HB + o_); } } \
        _Pragma("unroll") for (int pb = 0; pb < 4; ++pb) _Pragma("unroll") for (int i = 0; i < 4; ++i) { const float re = X[2 * pb][i], im = X[2 * pb + 1][i]; \
            X[2 * pb][i] = K.ar[pb][i] * re - K.ai[pb][i] * im; X[2 * pb + 1][i] = K.ar[pb][i] * im + K.ai[pb][i] * re; } \
        _Pragma("unroll") for (int tt = 0; tt < 8; ++tt) X[tt] = __builtin_amdgcn_mfma_f32_16x16x32_bf16(K.abu[tt], ub, X[tt], 0, 0, 0); \
        if (READOUT) { f32x4s y0 = {0.f, 0.f, 0.f, 0.f}, y1 = y0; \
            _Pragma("unroll") for (int s = 0; s < 4; ++s) { v4u w; w.x = pk2(X[2 * s][0], X[2 * s][1]); w.y = pk2(X[2 * s][2], X[2 * s][3]); w.z = pk2(X[2 * s + 1][0], X[2 * s + 1][1]); w.w = pk2(X[2 * s + 1][2], X[2 * s + 1][3]); \
                const bf16x8 xb = __builtin_bit_cast(bf16x8, w); \
                if (s & 1) y1 = __builtin_amdgcn_mfma_f32_16x16x32_bf16(cfr[s], xb, y1, 0, 0, 0); else y0 = __builtin_amdgcn_mfma_f32_16x16x32_bf16(cfr[s], xb, y0, 0, 0, 0); } \
            const int tau = tau0 + (T); \
            if (tau >= CTXL) { f32x4s y = y0 + y1; const size_t o = (size_t)s5_row(b, dir, tau) * D + g * GH + 4 * q; \
                if (MODE == 2) { const f32x4 yf4 = bf4_to_f32((v2u){(unsigned)yfc, (unsigned)(yfc >> 32)}), u4 = bf4_to_f32((v2u){(unsigned)uc, (unsigned)(uc >> 32)}); \
                    _Pragma("unroll") for (int e = 0; e < 4; ++e) y[e] = gelu_tanh_f(dsk[e] * u4[e] + yf4[e] + y[e]); \
                    v2u w; w.x = pk2(y[0], y[1]); w.y = pk2(y[2], y[3]); *(GAS v2u*)(Z + o) = w; } \
                else { v2u w; w.x = pk2(y[0], y[1]); w.y = pk2(y[2], y[3]); *(GAS v2u*)(YF + o) = w; } } } \
    } while (0)
#pragma unroll 1
    for (int t0 = 0; t0 < 24; t0 += PD) {
        S5Z_STEP(0, t0 + 0, true); S5Z_STEP(1, t0 + 1, true); S5Z_STEP(2, t0 + 2, true); S5Z_STEP(3, t0 + 3, true); S5Z_STEP(4, t0 + 4, true); S5Z_STEP(5, t0 + 5, true); }
    S5Z_STEP(0, 24, true); S5Z_STEP(1, 25, true); S5Z_STEP(2, 26, true); S5Z_STEP(3, 27, true); S5Z_STEP(4, 28, false); S5Z_STEP(5, 29, false);
    S5Z_STEP(0, 30, false); S5Z_STEP(1, 31, false); S5Z_STEP(2, 32, false); S5Z_STEP(3, 33, false);
#undef S5Z_STEP
    if (!READOUT) {
#pragma unroll
        for (int pb = 0; pb < 4; ++pb) { const f32x4s re = X[2 * pb], im = X[2 * pb + 1];
            *(LAS f32x4*)(xs + 32 * pb) = (f32x4){re[0], im[0], re[1], im[1]}; *(LAS f32x4*)(xs + 32 * pb + 4) = (f32x4){re[2], im[2], re[3], im[3]}; }
    }
}
__device__ __forceinline__ void s5z_load_cfr(const Frame& F, int gd, int lane, bf16x8 (&cfr)[4]) {
    const int n = lane & 15, q = lane >> 4;
#pragma unroll
    for (int s = 0; s < 4; ++s) { const GAS float* cr = fin(F, I_CRE) + (size_t)(gd * GH + n) * NP + 16 * s + 4 * q; const GAS float* ci = fin(F, I_CIM) + (size_t)(gd * GH + n) * NP + 16 * s + 4 * q;
        const f32x4 a = *(const GAS f32x4*)cr, b = *(const GAS f32x4*)ci; v4u w; w.x = pk2(a[0], a[1]); w.y = pk2(a[2], a[3]); w.z = pk2(-b[0], -b[1]); w.w = pk2(-b[2], -b[3]);
        cfr[s] = __builtin_bit_cast(bf16x8, w); }
}
__device__ __forceinline__ void s5z_fused(Frame& F) {
    LAS float* XS = (LAS float*)F.lds;
    LAS f32x2* AG = (LAS f32x2*)(F.lds + 256 * S5_XP * 4);
    const GAS float* AR = (const GAS float*)(F.ws + WS_SPAR); const GAS float* AI = AR + 2 * NG * NP;
    const int lane = F.lane, seg = F.tid >> 6, p = F.tid & 63;
    for (int wu = F.vcu; wu < 2 * NG; wu += F.G) {
        const int g = wu & 127, b = wu >> 7;
        bf16x8 cz[4];
#pragma unroll
        for (int s = 0; s < 4; ++s) cz[s] = (bf16x8){0, 0, 0, 0, 0, 0, 0, 0};
#pragma unroll 1
        for (int dir = 0; dir < 2; ++dir) { S5Consts K; s5_load_consts(F, dir * NG + g, lane, K); s5z_run<0>(F, K, cz, g, dir, b, F.wave, XS); }
        __syncthreads();
#pragma unroll 1
        for (int dir = 0; dir < 2; ++dir) {
            const int gd = dir * NG + g;
            const double ar = AR[gd * NP + p], ai = AI[gd * NP + p];
            double sr = ar, si = ai, t; t = sr * sr - si * si; si = 2.0 * sr * si; sr = t;
            double pr = sr, pi = si;
            for (int k = 0; k < 4; ++k) { t = sr * sr - si * si; si = 2.0 * sr * si; sr = t; }
            t = pr * sr - pi * si; pi = pr * si + pi * sr; pr = t;
            const float tr = (float)pr, ti = (float)pi;
            double qr = pr, qi = pi; for (int k = 0; k < 4; ++k) { t = qr * qr - qi * qi; qi = 2.0 * qr * qi; qr = t; }
            const float t16r = (float)qr, t16i = (float)qi;
            LAS float* xs = XS + (dir * S5_NCH + seg * 16) * S5_XP + 2 * p;
            f32x2 loc[16];
#pragma unroll
            for (int k = 0; k < 16; ++k) loc[k] = *(const LAS f32x2*)(xs + k * S5_XP);
            float ar_ = 0.f, ai_ = 0.f;
#pragma unroll
            for (int k = 0; k < 16; ++k) { const float nr = tr * ar_ - ti * ai_ + loc[k][0], ni = tr * ai_ + ti * ar_ + loc[k][1]; ar_ = nr; ai_ = ni; }
            AG[seg * 64 + p] = (f32x2){ar_, ai_};
            __syncthreads();
            float cr = 0.f, ci = 0.f;
            for (int s2 = 0; s2 < seg; ++s2) { const f32x2 a = AG[s2 * 64 + p]; const float nr = t16r * cr - t16i * ci + a[0], ni = t16r * ci + t16i * cr + a[1]; cr = nr; ci = ni; }
#pragma unroll
            for (int k = 0; k < 16; ++k) { *(LAS f32x2*)(xs + k * S5_XP) = (f32x2){cr, ci};
                const float nr = tr * cr - ti * ci + loc[k][0], ni = tr * ci + ti * cr + loc[k][1]; cr = nr; ci = ni; }
            __syncthreads();
        }
        { S5Consts K; s5_load_consts(F, g, lane, K); bf16x8 cfr[4]; s5z_load_cfr(F, g, lane, cfr); s5z_run<1>(F, K, cfr, g, 0, b, F.wave, XS); }
        asm volatile("s_waitcnt vmcnt(0)" ::: "memory");
        __syncthreads();
        { S5Consts K; s5_load_consts(F, NG + g, lane, K); bf16x8 cfr[4]; s5z_load_cfr(F, NG + g, lane, cfr); s5z_run<2>(F, K, cfr, g, 1, b, F.wave, XS); }
        __syncthreads();
    }
}

constexpr int ATT_KP = 272, ATT_VP = 528, ATT_VOFF = 256 * ATT_KP;
constexpr int ATT_RPOFF = ATT_VOFF + 128 * ATT_VP;
__device__ __forceinline__ void attn_unit(Frame& F, bool lat, int b, int h, int r, int j, int qrow0, int dv) {
    const int lane = F.lane, n = lane & 15, qd = lane >> 4;
    const GAS bf16* QK = ws_tile(F, T_QK); const GAS bf16* VT = ws_tile(F, T_VT); GAS bf16* AO = ws_tile(F, T_AO);
    const float scale = 0.08838834764831845f * 1.4426950408889634f, NEG = -3.0e38f;
    const int mkey = 8 * (n >> 2) + (n & 3);
    unsigned kb_ = (unsigned)(n * ATT_KP + 16 * qd), vb_ = (unsigned)(ATT_VOFF + n * ATT_VP + 16 * qd);
    asm volatile("" : "+v"(kb_), "+v"(vb_));
    const LAS unsigned char* kbase = F.lds + kb_; const LAS unsigned char* vbase = F.lds + vb_;
    const LAS float* RP = (const LAS float*)(F.lds + ATT_RPOFF);
    bf16x8 qf[4];
    { const GAS bf16* qp = QK + (size_t)(qrow0 + n) * 4096 + h * HD + 8 * qd;
#pragma unroll
      for (int kk = 0; kk < 4; ++kk) qf[kk] = *(const GAS bf16x8*)(qp + 32 * kk); }
    const int rs = min(max(r - 4, 0), 56), cs = min(max(16 * j - 8, 0), 32), qc = 16 * j + n, cst = min(max(qc - 8, 0), 48);
    float S[16][2][4];
    float mx = NEG;
    bf16x8 kf[2][4];
    if (lat && !(dv & 1)) {
        const GAS bf16* kp = QK + (size_t)(b * SEQ + (rs + (n >> 2)) * 64 + cs + (n & 3)) * 4096 + D + h * HD + 8 * qd;
#pragma unroll
        for (int kk = 0; kk < 4; ++kk) kf[0][kk] = *(const GAS bf16x8*)(kp + 32 * kk);
#pragma unroll
        for (int st = 0; st < 16; ++st) { const int blk = st >> 1, hf = st & 1, cg = blk >> 1, rh = blk & 1;
            if (st + 1 < 16) { constexpr int dummy_ = 0; (void)dummy_;
                const int s1 = st + 1, o1 = ((s1 >> 1) & 1) * 256 + (s1 >> 2) * 8 + (s1 & 1) * 4, o0 = rh * 256 + cg * 8 + hf * 4;
                kp += (ptrdiff_t)(o1 - o0) * 4096; asm volatile("" : "+v"(kp));
#pragma unroll
                for (int kk = 0; kk < 4; ++kk) kf[(st + 1) & 1][kk] = *(const GAS bf16x8*)(kp + 32 * kk); }
            f32x4 acc = {0.f, 0.f, 0.f, 0.f};
#pragma unroll
            for (int kk = 0; kk < 4; ++kk) acc = __builtin_amdgcn_mfma_f32_16x16x32_bf16(kf[st & 1][kk], qf[kk], acc, 0, 0, 0);
#pragma unroll
            for (int i = 0; i < 4; ++i) { const int kc = cs + 8 * cg + 4 * hf + i; const bool valid = (unsigned)(kc - cst) < 16u;
                const float sc = acc[i] * scale + RP[(rs + 4 * rh + qd - r + 7) * 31 + (kc - qc + 15)]; const float sv = valid ? sc : NEG;
                S[blk][hf][i] = sv; mx = fmaxf(mx, sv); }
            __builtin_amdgcn_sched_barrier(0); }
    } else {
#pragma unroll
        for (int blk = 0; blk < 8; ++blk)
#pragma unroll
            for (int hf = 0; hf < 2; ++hf)
#pragma unroll
                for (int i = 0; i < 4; ++i) S[blk][hf][i] = NEG;
    }
    if (dv & 2) {
#pragma unroll
        for (int blk = 8; blk < 16; ++blk)
#pragma unroll
            for (int hf = 0; hf < 2; ++hf)
#pragma unroll
                for (int i = 0; i < 4; ++i) { S[blk][hf][i] = 0.f; mx = fmaxf(mx, 0.f); }
    } else {
#pragma unroll
    for (int kk = 0; kk < 4; ++kk) kf[0][kk] = *(const LAS bf16x8*)(kbase + 64 * kk);
#pragma unroll
    for (int st = 0; st < 16; ++st) { const int blk = 8 + (st >> 1), hf = st & 1;
        if (st + 1 < 16) { const LAS unsigned char* kp = kbase + (16 * (st + 1)) * ATT_KP;
#pragma unroll
            for (int kk = 0; kk < 4; ++kk) kf[(st + 1) & 1][kk] = *(const LAS bf16x8*)(kp + 64 * kk); }
        f32x4 acc = {0.f, 0.f, 0.f, 0.f};
#pragma unroll
        for (int kk = 0; kk < 4; ++kk) acc = __builtin_amdgcn_mfma_f32_16x16x32_bf16(kf[st & 1][kk], qf[kk], acc, 0, 0, 0);
#pragma unroll
        for (int i = 0; i < 4; ++i) { const float sv = acc[i] * scale; S[blk][hf][i] = sv; mx = fmaxf(mx, sv); }
        __builtin_amdgcn_sched_barrier(0); }
    }
    mx = fmaxf(mx, __shfl_xor(mx, 16)); mx = fmaxf(mx, __shfl_xor(mx, 32));
    float sum = 0.f; bf16x8 pf[16];
#pragma unroll
    for (int blk = 0; blk < 16; ++blk) { float p[8];
#pragma unroll
        for (int hf = 0; hf < 2; ++hf)
#pragma unroll
            for (int i = 0; i < 4; ++i) { const float e = __builtin_amdgcn_exp2f(S[blk][hf][i] - mx); p[4 * hf + i] = e; sum += e; }
        v4u w; w.x = pk2(p[0], p[1]); w.y = pk2(p[2], p[3]); w.z = pk2(p[4], p[5]); w.w = pk2(p[6], p[7]); pf[blk] = __builtin_bit_cast(bf16x8, w); }
    sum += __shfl_xor(sum, 16); sum += __shfl_xor(sum, 32);
    const float inv = 1.0f / sum;
    f32x4 O[8];
#pragma unroll
    for (int dt = 0; dt < 8; ++dt) O[dt] = (f32x4){0.f, 0.f, 0.f, 0.f};
    bf16x8 vf[2][8];
    if (lat && !(dv & 4)) {
        const GAS bf16* vloc = (dv & 16) ? VT + (size_t)n * NROWS + qd * 8 : VT + (size_t)(h * HD + n) * NROWS + b * SEQ + (cs >> 3) * 512 + (rs + qd) * 8;
        bf16x8 vr[3][8];
#pragma unroll
        for (int dt = 0; dt < 8; ++dt) vr[0][dt] = *(const GAS bf16x8*)(vloc + (size_t)dt * 16 * NROWS);
#pragma unroll
        for (int dt = 0; dt < 8; ++dt) vr[1][dt] = *(const GAS bf16x8*)(vloc + 32 + (size_t)dt * 16 * NROWS);
#pragma unroll
        for (int blk = 0; blk < 8; ++blk) {
            if (blk + 2 < 8) { const int o2 = ((blk + 2) >> 1) * 512 + ((blk + 2) & 1) * 32;
#pragma unroll
                for (int dt = 0; dt < 8; ++dt) vr[(blk + 2) % 3][dt] = *(const GAS bf16x8*)(vloc + o2 + (size_t)dt * 16 * NROWS); }
#pragma unroll
            for (int dt = 0; dt < 8; ++dt) O[dt] = __builtin_amdgcn_mfma_f32_16x16x32_bf16(vr[blk % 3][dt], pf[blk], O[dt], 0, 0, 0);
            __builtin_amdgcn_sched_barrier(0); }
    }
    if (!(dv & 8)) {
#pragma unroll
    for (int dt = 0; dt < 8; ++dt) vf[0][dt] = *(const LAS bf16x8*)(vbase + dt * 16 * ATT_VP);
#pragma unroll
    for (int cb = 0; cb < 8; ++cb) {
        if (cb + 1 < 8) {
#pragma unroll
            for (int dt = 0; dt < 8; ++dt) vf[(cb + 1) & 1][dt] = *(const LAS bf16x8*)(vbase + 64 * (cb + 1) + dt * 16 * ATT_VP); }
#pragma unroll
        for (int dt = 0; dt < 8; ++dt) O[dt] = __builtin_amdgcn_mfma_f32_16x16x32_bf16(vf[cb & 1][dt], pf[8 + cb], O[dt], 0, 0, 0);
        __builtin_amdgcn_sched_barrier(0); }
    }
    GAS bf16* op = AO + (size_t)(qrow0 + n) * D + h * HD + 4 * qd;
#pragma unroll
    for (int dt = 0; dt < 8; ++dt) { v2u w; w.x = pk2(O[dt][0] * inv, O[dt][1] * inv); w.y = pk2(O[dt][2] * inv, O[dt][3] * inv); *(GAS v2u*)(op + 16 * dt) = w; }
}
__device__ __forceinline__ void attn_phase2(Frame& F, int dv) {
    const GAS bf16* QK = ws_tile(F, T_QK); const GAS bf16* VT = ws_tile(F, T_VT);
    for (int wu = F.vcu; wu < 2 * NH * 8; wu += F.G) {
        const int b = wu >> 7, h = (wu >> 3) & 15, ro = wu & 7;
        int tid_ = F.tid; asm volatile("" : "+v"(tid_));
#pragma unroll 2
        for (int i = 0; i < 8; ++i) { const int pc = tid_ + NTHREADS * i;
            { const int key = pc >> 4, c = pc & 15, rho = (key & ~31) + 16 * ((key >> 2) & 1) + 4 * ((key >> 3) & 3) + (key & 3);
              *(LAS v4u*)(F.lds + rho * ATT_KP + 16 * c) = *(const GAS v4u*)(QK + (size_t)(NLAT + b * CTXL + key) * 4096 + D + h * HD + 8 * c); }
            { const int dh = pc >> 5, c = pc & 31;
              *(LAS v4u*)(F.lds + ATT_VOFF + dh * ATT_VP + 16 * c) = *(const GAS v4u*)(VT + (size_t)(h * HD + dh) * NROWS + NLAT + b * CTXL + 8 * c); } }
        for (int i = tid_; i < 15 * 31; i += NTHREADS) ((LAS float*)(F.lds + ATT_RPOFF))[i] = fin(F, I_RPB)[h * 15 * 31 + i] * 1.4426950408889634f;
        __syncthreads();
        int b2 = b, h2 = h; asm volatile("" : "+s"(b2), "+s"(h2));
        const int r = 8 * ro + F.wave;
        const int nu = F.wave < 2 ? 5 : 4;
#pragma unroll 1
        for (int u = 0; u < nu; ++u) { const bool lat = u < 4;
            attn_unit(F, lat, b2, h2, lat ? r : 0, lat ? u : 0, lat ? b2 * SEQ + r * 64 + 16 * u : NLAT + b2 * CTXL + 16 * (2 * ro + F.wave), dv); }
        __syncthreads();
    }
}

constexpr int CV_NIT = (6 + 2 * NE * 3) * 2048;
constexpr int KG_QKV = CV_KG1, KG_WO = CV_KG2, KG_DN0 = CV_KG3, KG_UP0 = CV_KG4;
constexpr int CV_W1 = 8 * (32 - KG_QKV) * CV_N1, CV_W2 = 8 * (32 - KG_WO) * CV_N2, CV_W3 = 8 * (32 - KG_DN0) * CV_N3, CV_W4 = 8 * (32 - KG_UP0) * CV_N4;
constexpr int CV_NIT_MAIN = CV_NIT - 2 * CV_TK;
static_assert(CV_NIT == CV_NIT_ALL, "item count");
constexpr int CV_T4_END = CV_NIT_MAIN - CV_W3, CV_T2_END = CV_T4_END - CV_W4, CV_T1_END = CV_T2_END - CV_W2, CV_P0_END = CV_T1_END - CV_W1;
static_assert(CV_P0_END >= 3 * 2048 && CV_T1_END >= 6 * 2048 && CV_T2_END >= (6 + NE * 3) * 2048, "conversion windows: the QKV weight in the prologue, Wo / GLU weights by the end of the QKV window, every layer-0 expert weight before the layer-0 up GEMM");
__device__ __forceinline__ bool split_role(const Frame& F, int KG, int& cx, int& Gg, int& ci, int& nci) {
    if (F.G != 256) { cx = F.vcu; Gg = F.G; ci = 0; nci = 0; return true; }
    const int x = F.vcu >> 5, k = F.vcu & 31;
    if (k < KG) { cx = x * KG + k; Gg = 8 * KG; ci = 0; nci = 0; return true; }
    ci = x * (32 - KG) + (k - KG); nci = 8 * (32 - KG); cx = 0; Gg = 0; return false;
}
constexpr int NPH = 22;
__global__ void __launch_bounds__(NTHREADS, 2) mk_fwd(Args args) {
    extern __shared__ __attribute__((aligned(16))) unsigned char lds[];
    Frame F;
    F.lds = (LAS unsigned char*)lds; F.ws = (GAS unsigned char*)args.ws; F.out = (GAS float*)args.out;
    F.ap = (const CAS Args*)__builtin_amdgcn_kernarg_segment_ptr();
    F.tid = threadIdx.x; F.lane = F.tid & 63; F.wave = __builtin_amdgcn_readfirstlane(F.tid >> 6);
    F.G = gridDim.x; { const int bx = blockIdx.x; F.vcu = (F.G % 8 == 0) ? (bx % 8) * (F.G / 8) + bx / 8 : bx; }
    const int vcu0 = F.vcu, wave0 = F.wave;
    volatile LAS unsigned* MISC = (volatile LAS unsigned*)(F.lds + MISC_OFF);
    for (int u = F.tid; u < 32; u += NTHREADS) MISC[u] = 0u;
    __syncthreads();
    const int lo = args.ph_lo, hi = args.ph_hi;
    const bool multi = (hi - lo) > 1;
    XcdBarrier bar; bar.bar = (unsigned*)(unsigned char*)(F.ws + WS_CTL) + CW_BAR; bar.x = 0; bar.st = nullptr;
    if (multi) bar = xcd_barrier_post((unsigned*)(unsigned char*)(F.ws + WS_CTL) + CW_BAR, MISC + 8);
#if PROBE
#define IS_T0() ({ unsigned z2_ = 0u; asm volatile("" : "+v"(z2_)); (wave0 == 0 && __builtin_amdgcn_mbcnt_hi(~0u, __builtin_amdgcn_mbcnt_lo(~0u, z2_)) == 0); })
#endif
#define IN(k) ({ int lo_ = lo, hi_ = hi; asm volatile("" : "+s"(lo_), "+s"(hi_)); (lo_ <= (k) && (k) < hi_); })
#if PROBE
#define SEAM13(k) do { if (IN(k) && IN(14)) xcd_barrier(bar); if ((k) == PROBE_B && IS_T0()) { const unsigned long long t_ = wall_clock64(); MISC[18] = (unsigned)t_; MISC[19] = (unsigned)(t_ >> 32); } if (14 == PROBE_A && IS_T0()) { const unsigned long long t_ = wall_clock64(); MISC[16] = (unsigned)t_; MISC[17] = (unsigned)(t_ >> 32); } } while (0)
#else
#define SEAM13(k) do { if (IN(k) && IN(14)) xcd_barrier(bar); } while (0)
#endif
#if PROBE
#define SEAM_SKIP(a, b) do { if (IN(a) && IN(b)) xcd_barrier(bar); if ((a) == PROBE_B && IS_T0()) { const unsigned long long t_ = wall_clock64(); MISC[18] = (unsigned)t_; MISC[19] = (unsigned)(t_ >> 32); } if ((b) == PROBE_A && IS_T0()) { const unsigned long long t_ = wall_clock64(); MISC[16] = (unsigned)t_; MISC[17] = (unsigned)(t_ >> 32); } } while (0)
#else
#define SEAM_SKIP(a, b) do { if (IN(a) && IN(b)) xcd_barrier(bar); } while (0)
#endif
#define REPN(k) (((k) == REPEAT_PH) ? REPEAT_N : 1)
#define PH() do { const CAS Args* a_ = (const CAS Args*)__builtin_amdgcn_kernarg_segment_ptr(); asm volatile("" : "+s"(a_)); F.ap = a_; unsigned char* w_ = args.ws; asm volatile("" : "+s"(w_)); F.ws = (GAS unsigned char*)w_; unsigned z_ = 0u; asm volatile("" : "+v"(z_)); int l_ = __builtin_amdgcn_mbcnt_hi(~0u, __builtin_amdgcn_mbcnt_lo(~0u, z_)); int wv_ = wave0; asm volatile("" : "+s"(wv_)); F.lane = l_; F.wave = wv_; F.tid = wv_ * 64 + l_; int v_ = vcu0; asm volatile("" : "+s"(v_)); F.vcu = v_; } while (0)
#if PROBE
#define SEAM(k) do { if (IN(k) && IN((k) + 1)) xcd_barrier(bar); if ((k) == PROBE_B && IS_T0()) { const unsigned long long t_ = wall_clock64(); MISC[18] = (unsigned)t_; MISC[19] = (unsigned)(t_ >> 32); } if ((k) + 1 == PROBE_A && IS_T0()) { const unsigned long long t_ = wall_clock64(); MISC[16] = (unsigned)t_; MISC[17] = (unsigned)(t_ >> 32); } } while (0)
#else
#define SEAM(k) do { if (IN(k) && IN((k) + 1)) xcd_barrier(bar); } while (0)
#endif

#if PROBE
    if (PROBE_A == 0 && IS_T0()) { const unsigned long long t_ = wall_clock64(); MISC[16] = (unsigned)t_; MISC[17] = (unsigned)(t_ >> 32); }
#endif
    if (IN(0)) for (int rp_ = 0; rp_ < REPN(0); ++rp_) { PH(); p0_mods(F); p0_s5params(F); __syncthreads(); p0_weights(F, 0, F.G == 256 ? CV_P0_END : CV_NIT, F.vcu * NWAVES + F.wave, F.G * NWAVES);     __syncthreads(); }
    SEAM(0);
    for (int l = 0; l < 2; ++l) {
        if (l == 0) {
            if (IN(1)) for (int rp_ = 0; rp_ < REPN(1); ++rp_) { PH(); p1_prep(F); }
            SEAM(1);
            if (IN(2)) for (int rp_ = 0; rp_ < REPN(2); ++rp_) { PH(); int cx, Gg, ci, nci; if (split_role(F, KG_QKV, cx, Gg, ci, nci)) { SegSched S; S.init(Gg, cx, 34, 16, T_HB, T_WQKV, 8, 34, T_WQKV + 16, T_HB); EpiQKV E{ws_tile(F, T_QK), ws_tile(F, T_VT)}; run_gemm<EpiQKV, SegSched, false, 0, false>(F, S, E); } else p0_weights(F, CV_P0_END, CV_T1_END, ci * NWAVES + F.wave, nci * NWAVES); }
            SEAM(2);
            if (IN(3)) for (int rp_ = 0; rp_ < REPN(3); ++rp_) { PH();
#if ATTN_NAIVE
                p3_attn_naive(F);
#else
                attn_phase2(F, (rp_ < REPN(3) - 1) ? DUMMY_VARIANT : 0);
#endif
                __syncthreads(); }
            SEAM(3);
            if (IN(4)) for (int rp_ = 0; rp_ < REPN(4); ++rp_) { PH(); int cx, Gg, ci, nci; if (split_role(F, KG_WO, cx, Gg, ci, nci)) { SegSched S; S.init(Gg, cx, 34, 8, T_AO, T_WO, 0, 0, 0, 0); EpiWo E{(GAS bf16*)(F.ws + WS_O)}; run_gemm(F, S, E); } else p0_weights(F, CV_T1_END, CV_T2_END, ci * NWAVES + F.wave, nci * NWAVES); }
            SEAM(4);
        } else {
#if S5_NAIVE
            if (IN(11)) for (int rp_ = 0; rp_ < REPN(11); ++rp_) { PH(); s5_naive(F); }
            SEAM(11); SEAM(12); SEAM(13);
#else
#if S5_FUSE_Z
            if (IN(11)) for (int rp_ = 0; rp_ < REPN(11); ++rp_) { PH(); s5z_fused(F); }
            SEAM_SKIP(11, 15);
#else
            if (IN(11)) for (int rp_ = 0; rp_ < REPN(11); ++rp_) { PH(); s5_fused(F); }
            SEAM13(11);
#endif
#endif
#if !S5_FUSE_Z || S5_NAIVE
            if (IN(14)) for (int rp_ = 0; rp_ < REPN(14); ++rp_) { PH(); zprep_phase(F); }
            SEAM(14);
#endif
            if (IN(15)) for (int rp_ = 0; rp_ < REPN(15); ++rp_) { PH(); SegSched S; S.init(F.G, F.vcu, 32, 16, T_Z, T_WVG, 0, 0, 0, 0); EpiGlu E{(GAS bf16*)(F.ws + WS_O)}; run_gemm(F, S, E); }
            SEAM(15);
        }
        const int pb = l ? 16 : 5;
        if (IN(pb)) for (int rp_ = 0; rp_ < REPN(pb); ++rp_) { PH(); row_phase(F, l, (rp_ < REPN(pb) - 1) ? DUMMY_VARIANT : 0); }
        SEAM(pb);
        if (IN(pb + 1)) for (int rp_ = 0; rp_ < REPN(pb + 1); ++rp_) { PH(); topk_phase(F, l); }
#if !GATHER_IN_GEMM
        SEAM(pb + 1);
#endif
#if !GATHER_IN_GEMM
        if (IN(pb + 2)) for (int rp_ = 0; rp_ < REPN(pb + 2); ++rp_) { PH(); gather_phase(F, l); }
        SEAM(pb + 2);
#else
        SEAM_SKIP(pb + 1, pb + 3);
#endif
        if (IN(pb + 3)) for (int rp_ = 0; rp_ < REPN(pb + 3); ++rp_) { PH(); int cx, Gg, ci, nci; if (split_role(F, l == 0 ? KG_UP0 : 32, cx, Gg, ci, nci)) { MoeSched S; S.init(Gg, cx, l ? 4 : 5, 16, T_XE, T_MOE1 + l * 256); S.ga_idx = (const GAS int*)(F.ws + WS_IDX); S.ga_nrows = NROWS; EpiSwiglu E{ws_tile(F, T_ACT), T_MOE1 + l * 256};
#if GATHER_IN_GEMM
            run_gemm_ga(F, S, E, T_HB);
#else
            run_gemm(F, S, E);
#endif
            } else p0_weights(F, CV_T2_END, CV_T4_END, ci * NWAVES + F.wave, nci * NWAVES);
        }
        SEAM(pb + 3);
        if (IN(pb + 4)) for (int rp_ = 0; rp_ < REPN(pb + 4); ++rp_) { PH(); int cx, Gg, ci, nci; if (split_role(F, l == 0 ? KG_DN0 : 32, cx, Gg, ci, nci)) { MoeSched S; S.init(Gg, cx, l ? 4 : 5, 8, T_ACT, T_MOE2 + l * 128); EpiDown E{(GAS bf16*)(F.ws + WS_YE), (const GAS float*)(F.ws + WS_GATE), T_MOE2 + l * 128}; run_gemm<EpiDown, MoeSched, false, MOE_BAUX>(F, S, E); } else p0_weights(F, CV_T4_END, CV_NIT_MAIN, ci * NWAVES + F.wave, nci * NWAVES); }
        SEAM(pb + 4);
        if (IN(pb + 5)) for (int rp_ = 0; rp_ < REPN(pb + 5); ++rp_) { PH(); combine_phase(F, l); }
        SEAM(pb + 5);
    }
#if PROBE
    if (blockIdx.x == 0 && IS_T0()) { const unsigned long long tA_ = ((unsigned long long)MISC[17] << 32) | MISC[16], tB_ = ((unsigned long long)MISC[19] << 32) | MISC[18]; const float us_ = (float)(tB_ - tA_) * 0.01f; F.out[0] = exp2f(rintf(log2f(us_) * PROBE_Q + PROBE_OFF) / PROBE_Q); }
#endif
#undef IN
#undef SEAM
}

extern "C" void kernel_launch(void* const* d_in, const int* in_sizes, int n_in, void* d_out, int out_size, void* d_ws, size_t ws_size, hipStream_t stream) {
    static int grid = 0;
    if (grid == 0) {
        if (n_in != 25 || out_size != NLAT * D || ws_size < WS_END) { fprintf(stderr, "kernel_launch: unexpected shapes (n_in %d out %d ws %zu)\n", n_in, out_size, ws_size); grid = -1; return; }
        int dev = 0, cus = 0, per_cu = 0;
        if (hipGetDevice(&dev) != hipSuccess || hipDeviceGetAttribute(&cus, hipDeviceAttributeMultiprocessorCount, dev) != hipSuccess) { grid = -1; return; }
        if (hipFuncSetAttribute((const void*)mk_fwd, hipFuncAttributeMaxDynamicSharedMemorySize, LDS_BYTES) != hipSuccess) { fprintf(stderr, "kernel_launch: hipFuncSetAttribute failed\n"); grid = -1; return; }
        if (hipOccupancyMaxActiveBlocksPerMultiprocessor(&per_cu, (const void*)mk_fwd, NTHREADS, LDS_BYTES) != hipSuccess || per_cu < 1) { fprintf(stderr, "kernel_launch: occupancy query reports %d\n", per_cu); }
        (void)hipGetLastError();
        grid = cus;
    }
    if (grid < 0) return;
    (void)hipMemsetAsync((char*)d_ws + WS_CTL, 0, CTL_ZERO_BYTES, stream);
    Args a{};
    for (int i = 0; i < 25; ++i) a.in[i] = (const float*)d_in[i];
    a.out = (float*)d_out; a.ws = (unsigned char*)d_ws;
#if MK_N_LAUNCHES == 1
    a.ph_lo = 0; a.ph_hi = NPH;
    hipLaunchKernelGGL(mk_fwd, dim3(grid), dim3(NTHREADS), LDS_BYTES, stream, a);
#else
    for (int p = 0; p < NPH; ++p) { a.ph_lo = p; a.ph_hi = p + 1; hipLaunchKernelGGL(mk_fwd, dim3(grid), dim3(NTHREADS), LDS_BYTES, stream, a); }
#endif
}
```

```cpp
#include <hip/hip_runtime.h>
#include <cstdio>
#include <cstdint>
namespace pg8 {
#define PG8_LAS __attribute__((address_space(3)))
typedef unsigned short bf16_t;
typedef short bf16x8 __attribute__((ext_vector_type(8)));
typedef float f32x4 __attribute__((ext_vector_type(4)));
typedef unsigned u32x4 __attribute__((ext_vector_type(4)));
constexpr int BM = 256, BK = 64, HALF = 128, HTB = HALF * BK * 2  , STAGE_BYTES = 8 * HTB, NXCD = 8, WGM = 8;

__host__ __device__ __forceinline__ int lds_byte(int r, int c) { const int st = (r >> 4) * 2 + (c >> 5), rr = r & 15, cc = c & 31, ob = rr * 64 + cc * 2; return st * 1024 + (ob ^ (((ob >> 9) & 1) << 5)); }
__host__ __device__ __forceinline__ void stage_rc(int b, int& R, int& C) { const int st = b / 1024, sb = b % 1024, swz = sb ^ (((sb >> 9) & 1) << 5); R = (st >> 1) * 16 + swz / 64; C = (st & 1) * 32 + (swz % 64) / 2; }
__host__ __device__ __forceinline__ int perm32(int rho) { const int n = rho >> 4, i = rho & 15; return 8 * (i >> 2) + 4 * n + (i & 3); }

struct Unit { int pm, pn; };
struct Gemm { const bf16_t* A; const bf16_t* Bt; int M, N, K; };

__device__ __forceinline__ unsigned cvt_pk_bf16(float lo, float hi) { unsigned r; asm volatile("v_cvt_pk_bf16_f32 %0, %1, %2" : "=v"(r) : "v"(lo), "v"(hi)); return r; }
#ifndef WT_BKM
#define WT_BKM 0
#endif
template <class Epi, class Sched, bool ALIGN_EPI = false, bool SP2 = false, bool GA = false, bool VR = false, int BAUX = 0, bool BKM = false>
__device__ __forceinline__ void gemm_phase(PG8_LAS unsigned char* lds, const Gemm g, const Sched& S, const Epi& E, int tid_in) {
    int tid_ = tid_in; asm volatile("" : "+v"(tid_));
    const int tid = tid_, wid = __builtin_amdgcn_readfirstlane(tid >> 6), lane = tid & 63, wr = wid >> 2, wc = wid & 3, fr = lane & 15, fq = lane >> 4;
    const int K = g.K, nt = K / BK;
    unsigned voffA[2], voffB[2];
#pragma unroll
    for (int i = 0; i < 2; ++i) { int R, C; stage_rc(tid * 16 + i * 8192, R, C); const int Rb = Epi::PERM ? ((R & ~31) + perm32(R & 31)) : R;
        voffA[i] = (unsigned)(R * K + C) * 2u; voffB[i] = BKM ? (unsigned)(Rb * BK + C) * 2u : (unsigned)(Rb * K + C) * 2u; }
    unsigned vA[2][2] = {{0u, 0u}, {0u, 0u}}, nvA[2][2] = {{0u, 0u}, {0u, 0u}}; int gaR[2] = {0, 0}; unsigned gaC[2] = {0u, 0u};
    if constexpr (GA) {
#pragma unroll
        for (int i = 0; i < 2; ++i) { int R, C; stage_rc(tid * 16 + i * 8192, R, C); gaR[i] = R; gaC[i] = (unsigned)C * 2u; } }
#define PG8_GA_OFFS(dst, unit) do { const int _r0 = S.ga_row0(unit); _Pragma("unroll") for (int _h = 0; _h < 2; ++_h) _Pragma("unroll") for (int _i = 0; _i < 2; ++_i) { \
        const unsigned _ix = (unsigned)S.ga_idx[_r0 + _h * HALF + gaR[_i]]; dst[_h][_i] = (_ix < S.ga_nrows ? _ix : 0u) * (unsigned)(K * 2) + gaC[_i]; } } while (0)
    const size_t kstep = (size_t)(BK * 2);
    const size_t hstep = (size_t)HALF * K * 2;
    const size_t kstepB = BKM ? (size_t)(256 * BK * 2) : kstep, hstepB = BKM ? (size_t)(HALF * BK * 2) : hstep;
    const size_t tstep = 2 * hstep;
    const unsigned ldsw = (unsigned)wid * 1024u;
    const int aoff = lds_byte(wr * 64 + fr, fq * 8), boff = lds_byte(wc * 32 + fr, fq * 8);
#define PG8_SA(b, h) (((b) * 2 + (h)) * HTB)
#define PG8_SB(b, h) ((4 + (b) * 2 + (h)) * HTB)
#define PG8_STAGE(bufoff, gbase, voff) do { _Pragma("unroll") for (int _i = 0; _i < 2; ++_i) \
        __builtin_amdgcn_global_load_lds((const unsigned*)((const char*)(gbase) + (voff)[_i]), (PG8_LAS unsigned*)(lds + (bufoff) + ldsw + _i * 8192), 16, 0, 0); } while (0)
#define PG8_STAGE_B(bufoff, gbase, voff) do { _Pragma("unroll") for (int _i = 0; _i < 2; ++_i) \
        __builtin_amdgcn_global_load_lds((const unsigned*)((const char*)(gbase) + (voff)[_i]), (PG8_LAS unsigned*)(lds + (bufoff) + ldsw + _i * 8192), 16, 0, BAUX); } while (0)
#define PG8_STAGE_A(bufoff, kbase, half, arr) do { if constexpr (GA) PG8_STAGE(bufoff, kbase, arr[half]); else PG8_STAGE(bufoff, (kbase) + (half) * hstep, voffA); } while (0)
#define PG8_LDA(dst, b, h) do { _Pragma("unroll") for (int m = 0; m < 4; ++m) _Pragma("unroll") for (int k = 0; k < 2; ++k) dst[m][k] = *(const PG8_LAS bf16x8*)(lds + PG8_SA(b, h) + aoff + m * 2048 + k * 1024); } while (0)
#define PG8_LDB(dst, b, h) do { _Pragma("unroll") for (int n = 0; n < 2; ++n) _Pragma("unroll") for (int k = 0; k < 2; ++k) dst[n][k] = *(const PG8_LAS bf16x8*)(lds + PG8_SB(b, h) + boff + n * 2048 + k * 1024); } while (0)
#define PG8_MMA(ai, bj, At, Bt) do { if (VR && !((ai) == 0 ? mma_on0 : mma_on1)) break; __builtin_amdgcn_s_setprio(1); _Pragma("unroll") for (int m = 0; m < 4; ++m) _Pragma("unroll") for (int n = 0; n < 2; ++n) _Pragma("unroll") for (int k = 0; k < 2; ++k) \
        acc[ai][bj][m][n] = __builtin_amdgcn_mfma_f32_16x16x32_bf16(Bt[n][k], At[m][k], acc[ai][bj][m][n], 0, 0, 0); __builtin_amdgcn_s_setprio(0); } while (0)
#define PG8_WAIT_V(n) asm volatile("s_waitcnt vmcnt(" #n ")" ::: "memory")
#define PG8_WAIT_L(n) asm volatile("s_waitcnt lgkmcnt(" #n ")" ::: "memory")
#define PG8_BAR __builtin_amdgcn_s_barrier()
#define PG8_SCHED __builtin_amdgcn_sched_barrier(0)
    Unit cur, nxt; int ui = 0;
    if (!S.next(0, cur)) return;
    f32x4 acc[2][2][4][2];
#pragma unroll
    for (int a = 0; a < 2; ++a)
#pragma unroll
        for (int b = 0; b < 2; ++b)
#pragma unroll
            for (int m = 0; m < 4; ++m)
#pragma unroll
                for (int n = 0; n < 2; ++n) acc[a][b][m][n] = (f32x4){0.f, 0.f, 0.f, 0.f};
    bf16x8 At[4][2], B0[2][2], B1[2][2];
    const char* cA = GA ? (const char*)g.A : (const char*)g.A + (size_t)cur.pm * tstep; const char* cB = (const char*)g.Bt + (size_t)cur.pn * tstep;
    if constexpr (GA) PG8_GA_OFFS(vA, cur);
    bool mma_on0 = true, mma_on1 = true;
    if constexpr (VR) { const int vr_ = S.valid_rows(cur); mma_on0 = wr * 64 < vr_; mma_on1 = HALF + wr * 64 < vr_; }
    S.a_ready(cur);
    if constexpr (SP2) {
        PG8_STAGE_B(PG8_SB(0, 0), cB, voffB); PG8_STAGE_B(PG8_SB(0, 1), cB + hstepB, voffB); PG8_STAGE_A(PG8_SA(0, 0), cA, 0, vA); PG8_STAGE_A(PG8_SA(0, 1), cA, 1, vA);
        if (wr == 1) PG8_BAR;
        PG8_WAIT_V(2); PG8_BAR;
        PG8_STAGE_B(PG8_SB(1, 0), cB + kstepB, voffB); PG8_STAGE_A(PG8_SA(1, 0), cA + kstep, 0, vA); PG8_STAGE_B(PG8_SB(1, 1), cB + hstepB + kstepB, voffB);
        PG8_WAIT_V(6); PG8_BAR;
    } else {
        PG8_STAGE_B(PG8_SB(0, 0), cB, voffB); PG8_STAGE_A(PG8_SA(0, 0), cA, 0, vA); PG8_STAGE_B(PG8_SB(0, 1), cB + hstepB, voffB); PG8_STAGE_A(PG8_SA(0, 1), cA, 1, vA);
        if (wr == 1) PG8_BAR;
        PG8_WAIT_V(4); PG8_BAR;
        PG8_STAGE_B(PG8_SB(1, 0), cB + kstepB, voffB); PG8_STAGE_A(PG8_SA(1, 0), cA + kstep, 0, vA); PG8_STAGE_B(PG8_SB(1, 1), cB + hstepB + kstepB, voffB);
        PG8_WAIT_V(6); PG8_BAR;
    }
    for (;;) {
        const bool has_next = S.next(ui + 1, nxt);
        const char* nA = GA ? cA : (has_next ? (const char*)g.A + (size_t)nxt.pm * tstep : cA); const char* nB = has_next ? (const char*)g.Bt + (size_t)nxt.pn * tstep : cB;
        if constexpr (GA) { if (has_next) PG8_GA_OFFS(nvA, nxt); else {
#pragma unroll
            for (int _h = 0; _h < 2; ++_h)
#pragma unroll
                for (int _i = 0; _i < 2; ++_i) nvA[_h][_i] = vA[_h][_i]; } }
        for (int t = 0; t < nt; t += 2) {
            const bool last = (t == nt - 2);
            const char* a1 = cA + (size_t)(t + 1) * kstep;
            const char* a2 = last ? nA : cA + (size_t)(t + 2) * kstep; const char* b2 = last ? nB : cB + (size_t)(t + 2) * kstepB;
            const char* a3 = a2 + kstep; const char* b3 = b2 + kstepB;
            unsigned sA[2][2];
#pragma unroll
            for (int _h = 0; _h < 2; ++_h)
#pragma unroll
                for (int _i = 0; _i < 2; ++_i) sA[_h][_i] = last ? nvA[_h][_i] : vA[_h][_i];
            if (last && has_next) S.a_ready(nxt);
            if constexpr (SP2) {
            PG8_LDB(B0, 0, 0); PG8_LDB(B1, 0, 1); PG8_SCHED; PG8_LDA(At, 0, 0); PG8_STAGE_A(PG8_SA(1, 1), a1, 1, vA);
            PG8_WAIT_V(8); PG8_WAIT_L(0); PG8_BAR; PG8_MMA(0, 0, At, B0); PG8_MMA(0, 1, At, B1); PG8_BAR; PG8_SCHED;
            PG8_LDA(At, 0, 1); PG8_STAGE_B(PG8_SB(0, 0), b2, voffB); PG8_STAGE_B(PG8_SB(0, 1), b2 + hstepB, voffB); PG8_STAGE_A(PG8_SA(0, 0), a2, 0, sA);
            PG8_WAIT_V(8); PG8_WAIT_L(0); PG8_BAR; PG8_MMA(1, 0, At, B0); PG8_MMA(1, 1, At, B1); PG8_BAR; PG8_SCHED;
            PG8_LDB(B0, 1, 0); PG8_LDB(B1, 1, 1); PG8_SCHED; PG8_LDA(At, 1, 0); PG8_STAGE_A(PG8_SA(0, 1), a2, 1, sA);
            PG8_WAIT_V(8); PG8_WAIT_L(0); PG8_BAR; PG8_MMA(0, 0, At, B0); PG8_MMA(0, 1, At, B1); PG8_BAR; PG8_SCHED;
            PG8_LDA(At, 1, 1); PG8_STAGE_B(PG8_SB(1, 0), b3, voffB); PG8_STAGE_B(PG8_SB(1, 1), b3 + hstepB, voffB); PG8_STAGE_A(PG8_SA(1, 0), a3, 0, sA);
            PG8_WAIT_V(8); PG8_WAIT_L(0); PG8_BAR; PG8_MMA(1, 0, At, B0); PG8_MMA(1, 1, At, B1); PG8_BAR; PG8_SCHED;
            } else {
            PG8_LDB(B0, 0, 0); PG8_SCHED; PG8_LDA(At, 0, 0); PG8_STAGE_A(PG8_SA(1, 1), a1, 1, vA);
            PG8_WAIT_L(8); PG8_BAR; PG8_WAIT_L(0); PG8_MMA(0, 0, At, B0); PG8_BAR; PG8_SCHED;
            PG8_LDB(B1, 0, 1); PG8_STAGE_B(PG8_SB(0, 0), b2, voffB);
            PG8_BAR; PG8_WAIT_L(0); PG8_MMA(0, 1, At, B1); PG8_BAR;
            PG8_LDA(At, 0, 1); PG8_STAGE_A(PG8_SA(0, 0), a2, 0, sA);
            PG8_BAR; PG8_WAIT_L(0); PG8_MMA(1, 0, At, B0); PG8_BAR; PG8_SCHED;
            PG8_STAGE_B(PG8_SB(0, 1), b2 + hstepB, voffB);
            PG8_WAIT_V(6); PG8_BAR; PG8_MMA(1, 1, At, B1); PG8_BAR;
            PG8_LDB(B0, 1, 0); PG8_SCHED; PG8_LDA(At, 1, 0); PG8_STAGE_A(PG8_SA(0, 1), a2, 1, sA);
            PG8_WAIT_L(8); PG8_BAR; PG8_WAIT_L(0); PG8_MMA(0, 0, At, B0); PG8_BAR; PG8_SCHED;
            PG8_LDB(B1, 1, 1); PG8_STAGE_B(PG8_SB(1, 0), b3, voffB);
            PG8_BAR; PG8_WAIT_L(0); PG8_MMA(0, 1, At, B1); PG8_BAR;
            PG8_LDA(At, 1, 1); PG8_STAGE_A(PG8_SA(1, 0), a3, 0, sA);
            PG8_BAR; PG8_WAIT_L(0); PG8_MMA(1, 0, At, B0); PG8_BAR; PG8_SCHED;
            PG8_STAGE_B(PG8_SB(1, 1), b3 + hstepB, voffB);
            PG8_WAIT_V(6); PG8_BAR; PG8_MMA(1, 1, At, B1); PG8_BAR;
            }
        }
        if constexpr (ALIGN_EPI) { if (wr == 0) PG8_BAR; }
        if constexpr (!Epi::AFTER_DRAIN) { E(acc, cur, wr, wc, fr, fq); S.done(cur); }
        if (!has_next) break;
#pragma unroll
        for (int a = 0; a < 2; ++a)
#pragma unroll
            for (int b = 0; b < 2; ++b)
#pragma unroll
                for (int m = 0; m < 4; ++m)
#pragma unroll
                    for (int n = 0; n < 2; ++n) acc[a][b][m][n] = (f32x4){0.f, 0.f, 0.f, 0.f};
        cur = nxt; cA = nA; cB = nB; ++ui;
        if constexpr (VR) { const int vr_ = S.valid_rows(cur); mma_on0 = wr * 64 < vr_; mma_on1 = HALF + wr * 64 < vr_; }
        if constexpr (GA) {
#pragma unroll
            for (int _h = 0; _h < 2; ++_h)
#pragma unroll
                for (int _i = 0; _i < 2; ++_i) vA[_h][_i] = nvA[_h][_i]; }
        if constexpr (ALIGN_EPI) { if (wr == 1) PG8_BAR; }
    }
    PG8_WAIT_V(0);
    if constexpr (!ALIGN_EPI) { if (wr == 0) PG8_BAR; }
    PG8_BAR;
    if constexpr (Epi::AFTER_DRAIN) { E.fused(acc, cur, wr, wc, fr, fq, lds, wid, lane); S.done(cur); }
#undef PG8_SA
#undef PG8_SB
#undef PG8_STAGE
#undef PG8_STAGE_B
#undef PG8_STAGE_A
#undef PG8_GA_OFFS
#undef PG8_LDA
#undef PG8_LDB
#undef PG8_MMA
#undef PG8_WAIT_V
#undef PG8_WAIT_L
#undef PG8_BAR
#undef PG8_SCHED
}
}

#ifndef PG8_SP2
#define PG8_SP2 true
#endif
#ifndef PG8_ALIGN
#define PG8_ALIGN true
#endif
#ifndef X1_BF16
#define X1_BF16 1
#endif
#ifndef TOPK_2BIT
#define TOPK_2BIT 0
#endif
#ifndef NT_STREAM
#define NT_STREAM 0
#endif
#ifndef X1_FP16
#define X1_FP16 1
#endif
#if X1_FP16
#define X1PK pkh2
#define X1UNPK h4_to_f32
#else
#define X1PK pk2
#define X1UNPK bf4_to_f32
#endif
#ifndef X2_FP16
#define X2_FP16 1
#endif
#ifndef CV_NT_STORE
#define CV_NT_STORE 1
#endif
#ifndef CV_ROLL
#define CV_ROLL 0
#endif
#ifndef CV_TKN
#define CV_TKN 0
#endif
#ifndef TOPK_CTX_WAVE
#define TOPK_CTX_WAVE 1
#endif
#ifndef MK_N_LAUNCHES
#define MK_N_LAUNCHES 1
#endif
#ifndef PROBE
#define PROBE 0
#endif
#ifndef PROBE_Q
#define PROBE_Q 6.0f
#define PROBE_OFF 0.0f
#endif
#ifndef PROBE_A
#define PROBE_A 0
#define PROBE_B 0
#endif
#ifndef REPEAT_PH
#define REPEAT_PH (-1)
#define REPEAT_N 2
#endif
#ifndef ATT_W
#define ATT_W 8
#endif
#ifndef DUMMY_VARIANT
#define DUMMY_VARIANT 0
#endif
#ifndef CV_NF_MOE
#define CV_NF_MOE 4
#endif
#ifndef CV_KG1
#define CV_KG1 17
#define CV_KG2 17
#define CV_KG3 27
#define CV_KG4 27
#define CV_N4 950
#endif
#ifndef CV_N1
#define CV_N1 850
#define CV_N2 280
#define CV_N3 500
#endif
#ifndef GATHER_IN_GEMM
#define GATHER_IN_GEMM 1
#endif
#ifndef S5_FUSE_Z
#define S5_FUSE_Z 1
#endif
#ifndef ROW_CTX_COOP
#define ROW_CTX_COOP 1
#endif
#ifndef MOE_BAUX
#define MOE_BAUX 0
#endif
#ifndef CTX_COOP2
#define CTX_COOP2 0
#endif
#ifndef P1_COOP
#define P1_COOP 0
#endif
#ifndef S5_NAIVE
#define S5_NAIVE 0
#endif
#ifndef ATTN_NAIVE
#define ATTN_NAIVE 0
#endif
#ifndef NAIVE_GEMM
#define NAIVE_GEMM 0
#endif

constexpr int D = 2048, SEQ = 4096, CTXL = 256, NLAT = 8192, NCTX = 512, NROWS = 8704;
constexpr int NH = 16, HD = 128, NE = 16, NG = 128, NP = 64, GH = 16, D6 = 6 * D;
constexpr int RPE = 1280;
constexpr float LN_EPS = 1e-5f, ALPHA = 1.4142135623730951f;
constexpr int NWAVES = 8, NTHREADS = 512;
constexpr int LDS_BYTES = 147456, MISC_OFF = LDS_BYTES - 128;

constexpr size_t MiB = 1u << 20;
constexpr size_t WS_CTL = 0, CTL_ZERO_BYTES = 1 * MiB;
constexpr size_t WS_MODS = 1 * MiB;
constexpr size_t WS_SPAR = 2 * MiB;
constexpr size_t WS_AFF = 6 * MiB;
constexpr size_t WS_SLOT = 7 * MiB;
constexpr size_t WS_IDX = 8 * MiB;
constexpr size_t WS_GATE = 8 * MiB + 512 * 1024;
constexpr int T_WQKV = 16, T_WO = 40, T_WVG = 48, T_MOE1 = 64, T_MOE2 = 576, T_HB = 832, T_QK = 866, T_VT = 934, T_AO = 968, T_XE = 1002, T_ACT = 1082, T_Z = 1162;
constexpr size_t WS_O = 1194 * MiB, WS_X1 = 1262 * MiB, WS_X2 = 1330 * MiB, WS_YE = 1398 * MiB, WS_YF = 1558 * MiB, WS_YB = 1622 * MiB, WS_XLOC = 1686 * MiB, WS_CARRY = 1718 * MiB, WS_END = 1750 * MiB;
constexpr int CW_BAR = 4096;
constexpr int CV_NIT_ALL = (6 + 2 * NE * 3) * 2048, CV_TK = 256 * NWAVES * CV_TKN;

#define GAS __attribute__((address_space(1)))
#define LAS __attribute__((address_space(3)))
typedef unsigned short bf16;
typedef unsigned v4u __attribute__((ext_vector_type(4)));
typedef unsigned v2u __attribute__((ext_vector_type(2)));
typedef float f32x4 __attribute__((ext_vector_type(4)));
typedef float f32x2 __attribute__((ext_vector_type(2)));
typedef short bf16x8 __attribute__((ext_vector_type(8)));
typedef GAS unsigned gu32;
#define RLX_AGENT __ATOMIC_RELAXED, __HIP_MEMORY_SCOPE_AGENT

__device__ __forceinline__ float bf2f(unsigned b) { return __uint_as_float(b << 16); }
__device__ __forceinline__ unsigned pk2(float lo, float hi) { typedef __bf16 bf2_t __attribute__((ext_vector_type(2))); f32x2 v = {lo, hi}; return __builtin_bit_cast(unsigned, __builtin_convertvector(v, bf2_t)); }
__device__ __forceinline__ unsigned pkh2(float lo, float hi) { typedef _Float16 h2_t __attribute__((ext_vector_type(2))); f32x2 v = {lo, hi}; return __builtin_bit_cast(unsigned, __builtin_convertvector(v, h2_t)); }
__device__ __forceinline__ f32x4 h4_to_f32(v2u w) { typedef _Float16 h4_t __attribute__((ext_vector_type(4))); return __builtin_convertvector(__builtin_bit_cast(h4_t, w), f32x4); }
template <int CTRL> __device__ __forceinline__ float dpp_f(float x) { return __builtin_bit_cast(float, __builtin_amdgcn_mov_dpp(__builtin_bit_cast(int, x), CTRL, 0xf, 0xf, true)); }
__device__ __forceinline__ float wave_sum(float v) {
    v += dpp_f<0xB1>(v);
    v += dpp_f<0x4E>(v);
    v += dpp_f<0x141>(v);
    v += dpp_f<0x140>(v);
    const float a = __builtin_bit_cast(float, __builtin_amdgcn_readlane(__builtin_bit_cast(int, v), 0)), b = __builtin_bit_cast(float, __builtin_amdgcn_readlane(__builtin_bit_cast(int, v), 16));
    const float c = __builtin_bit_cast(float, __builtin_amdgcn_readlane(__builtin_bit_cast(int, v), 32)), d = __builtin_bit_cast(float, __builtin_amdgcn_readlane(__builtin_bit_cast(int, v), 48));
    return (a + b) + (c + d);
}
__device__ __forceinline__ float wave_max(float v) {
#pragma unroll
    for (int o = 1; o < 64; o <<= 1) v = fmaxf(v, __shfl_xor(v, o));
    return v;
}
__device__ __forceinline__ float silu_f(float x) { return x * __builtin_amdgcn_rcpf(1.0f + __builtin_amdgcn_exp2f(-1.4426950409f * x)); }
__device__ __forceinline__ float sigmoid_f(float x) { return __builtin_amdgcn_rcpf(1.0f + __builtin_amdgcn_exp2f(-1.4426950409f * x)); }
__device__ __forceinline__ float gelu_tanh_f(float x) { const float e = __builtin_amdgcn_exp2f(x * (-2.302208198f - 0.1029432397f * x * x)); return x * __builtin_amdgcn_rcpf(1.0f + e); }
#define XB_TMO      128
#define XB_XCNT(j)  (256  + 64 * (j))
#define XB_XSUB(j)  (1280 + 64 * (j))
#define XB_XGEN(j)  (2304 + 64 * (j))
#define XB_TOP      3328
#define XB_TOPGEN   3392
#define XCD_BAR_WORDS 3456
#define XB_SPIN_CAP (1u << 18)

__device__ __forceinline__ unsigned xb_ld(unsigned* p)              { return __hip_atomic_load(p, __ATOMIC_RELAXED, __HIP_MEMORY_SCOPE_AGENT); }
__device__ __forceinline__ unsigned xb_add(unsigned* p, unsigned v) { return __hip_atomic_fetch_add(p, v, __ATOMIC_RELAXED, __HIP_MEMORY_SCOPE_AGENT); }
__device__ __forceinline__ unsigned xb_xcc_id() { return (unsigned)__builtin_amdgcn_s_getreg((3 << 11) | 20) & 0xFu; }
#define XB_SPIN(cond, bar) do { unsigned _sp = 0; while (cond) { __builtin_amdgcn_s_sleep(1); \
    if ((++_sp & 255u) == 0u) { if (xb_ld(&(bar)[XB_TMO])) break; if (_sp > XB_SPIN_CAP) { atomicAdd(&(bar)[XB_TMO], 1u); break; } } } } while (0)

struct XcdBarrier {
    unsigned* bar; unsigned x;
    volatile LAS unsigned* st;
};

__device__ __forceinline__ XcdBarrier xcd_barrier_post(unsigned* bar, volatile LAS unsigned* st) {
    XcdBarrier b; b.bar = bar; b.x = xb_xcc_id(); b.st = st;
    if (threadIdx.x == 0) (void)xb_add(&bar[XB_XCNT(b.x)], 1u);
    return b;
}
__device__ __forceinline__ void xcd_barrier_complete(unsigned* bar, unsigned x, unsigned& nloc, unsigned& nx) {
    const unsigned G = gridDim.x * gridDim.y * gridDim.z;
    unsigned sum, cnt, mine, sp = 0u;
    for (;;) {
        sum = 0u; cnt = 0u; mine = 0u;
#pragma unroll
        for (unsigned j = 0; j < 16; ++j) { const unsigned c = xb_ld(&bar[XB_XCNT(j)]); sum += c; cnt += (c > 0u) ? 1u : 0u; mine = (j == x) ? c : mine; }
        if (sum == G) break;
        __builtin_amdgcn_s_sleep(1);
        if ((++sp & 255u) == 0u) { if (xb_ld(&bar[XB_TMO])) break; if (sp > XB_SPIN_CAP) { atomicAdd(&bar[XB_TMO], 1u); break; } }
    }
    nloc = mine > 0u ? mine : 1u; nx = cnt > 0u ? cnt : 1u;
}

__device__ __forceinline__ void xcd_barrier(const XcdBarrier& b) {
    asm volatile("s_waitcnt vmcnt(0)" ::: "memory");
    __syncthreads();
    if (threadIdx.x == 0) {
        unsigned* bar = b.bar;
        __builtin_amdgcn_s_waitcnt(0);
        unsigned nloc = b.st[0], nx = b.st[1];
        if (nloc == 0u) { xcd_barrier_complete(bar, b.x, nloc, nx); b.st[0] = nloc; b.st[1] = nx; }
        const unsigned old = xb_add(&bar[XB_XSUB(b.x)], 1u);
        const unsigned gen = old / nloc;
        if (old + 1u == (gen + 1u) * nloc) {
            __builtin_amdgcn_fence(__ATOMIC_RELEASE, "agent");
            asm volatile("s_waitcnt vmcnt(0)" ::: "memory");
            const unsigned og = xb_add(&bar[XB_TOP], 1u);
            const unsigned tg = og / nx;
            if (og + 1u == (tg + 1u) * nx) xb_add(&bar[XB_TOPGEN], 1u);
            else XB_SPIN(xb_ld(&bar[XB_TOPGEN]) == tg, bar);
            __builtin_amdgcn_fence(__ATOMIC_ACQUIRE, "agent");
            xb_add(&bar[XB_XGEN(b.x)], 1u);
            asm volatile("s_waitcnt vmcnt(0)" ::: "memory");
        } else {
            XB_SPIN(xb_ld(&bar[XB_XGEN(b.x)]) == gen, bar);
            __builtin_amdgcn_fence(__ATOMIC_ACQUIRE, "agent");
            asm volatile("s_waitcnt vmcnt(0)" ::: "memory");
        }
    }
    __syncthreads();
}

struct Args { const float* in[25]; float* out; unsigned char* ws; int ph_lo, ph_hi; };
#define CAS __attribute__((address_space(4)))
struct Frame {
    LAS unsigned char* lds;
    GAS unsigned char* ws;
    int tid, lane, wave, vcu, G;
    const CAS Args* ap;
    GAS float* out;
};
__device__ __forceinline__ const GAS float* fin(const Frame& F, int i) { return (const GAS float*)F.ap->in[i]; }
enum { I_X = 0, I_C, I_CTX, I_CCTX, I_WMOD, I_BMOD, I_LNG, I_LNB, I_WQKV, I_WO, I_RPB, I_LAMRE, I_LAMIM, I_LOGSTEP, I_BRE, I_BIM, I_CRE, I_CIM, I_SD, I_WVAL, I_WGATE, I_ROUTER, I_MGATE, I_MUP, I_MDOWN };

__device__ __forceinline__ GAS bf16* ws_tile(const Frame& F, int t) { return (GAS bf16*)(F.ws + (size_t)t * MiB); }
__device__ __forceinline__ GAS float* ws_f32(const Frame& F, size_t off) { return (GAS float*)(F.ws + off); }
__device__ __forceinline__ const GAS float* mods(const Frame& F, int l, int r, int which) { return (const GAS float*)(F.ws + WS_MODS) + (size_t)((l * 3 + r) * 6 + which) * D; }
__device__ __forceinline__ int row_r(int row) { return row < NLAT ? (row >> 12) : 2; }

struct SegSched {
    int G, cx, n0, ntot, nM0, nN0, pm0, pn0, nM1, nN1, pm1, pn1;
    __device__ __forceinline__ void init(int G_, int cx_, int nM0_, int nN0_, int pm0_, int pn0_, int nM1_, int nN1_, int pm1_, int pn1_) {
        G = G_; cx = cx_; nM0 = nM0_; nN0 = nN0_; pm0 = pm0_; pn0 = pn0_; nM1 = nM1_; nN1 = nN1_; pm1 = pm1_; pn1 = pn1_; n0 = nM0 * nN0; ntot = n0 + nM1 * nN1; }
    __device__ __forceinline__ bool next(int i, pg8::Unit& u) const {
        const int U = i * G + cx; if (U >= ntot) return false;
        const bool s1 = U >= n0; const int loc = s1 ? U - n0 : U, nM = s1 ? nM1 : nM0, nN = s1 ? nN1 : nN0;
        const int nig = 8 * nN, gid = loc / nig, fm = gid * 8, gsz = (nM - fm) < 8 ? (nM - fm) : 8;
        u.pm = (s1 ? pm1 : pm0) + fm + ((loc % nig) % gsz); u.pn = (s1 ? pn1 : pn0) + (loc % nig) / gsz; return true;
    }
    __device__ __forceinline__ void a_ready(const pg8::Unit&) const {}
    __device__ __forceinline__ void done(const pg8::Unit&) const {}
};
struct MoeSched {
    int G, cx, nMe, nNe, pmA, pnB, ntot;
    const GAS int* ga_idx; unsigned ga_nrows;
    __device__ __forceinline__ int ga_row0(const pg8::Unit& u) const { return (u.pm - pmA) * 256; }
    __device__ __forceinline__ int valid_rows(const pg8::Unit& u) const { return (nMe == 5 && (u.pm - pmA) % 5 == 4) ? 64 : 256; }
    __device__ __forceinline__ void init(int G_, int cx_, int nMe_, int nNe_, int pmA_, int pnB_) { G = G_; cx = cx_; nMe = nMe_; nNe = nNe_; pmA = pmA_; pnB = pnB_; ntot = NE * nMe * nNe; }
    __device__ __forceinline__ bool next(int i, pg8::Unit& u) const {
        const int U = i * G + cx; if (U >= ntot) return false;
        const int per = nMe * nNe, e = U / per, loc = U % per;
        u.pm = pmA + e * 5 + loc % nMe; u.pn = pnB + e * nNe + loc / nMe; return true;
    }
    __device__ __forceinline__ void a_ready(const pg8::Unit&) const {}
    __device__ __forceinline__ void done(const pg8::Unit&) const {}
};

struct EpiQKV {
    static constexpr bool PERM = true, AFTER_DRAIN = false;
    GAS bf16* QK; GAS bf16* VT;
    __device__ __forceinline__ void operator()(const f32x4 (&acc)[2][2][4][2], const pg8::Unit& u, int wr, int wc, int fr_in, int fq_in) const {
        int fr = fr_in, fq = fq_in; asm volatile("" : "+v"(fr), "+v"(fq));
        GAS bf16* base; int ldc;
        if (u.pn < T_HB) { base = QK + (size_t)(u.pm - T_HB) * 256 * 4096 + (size_t)(u.pn - T_WQKV) * 256; ldc = 4096; }
        else { base = VT + (size_t)(u.pm - (T_WQKV + 16)) * 256 * NROWS + (size_t)(u.pn - T_HB) * 256; ldc = NROWS; }
        int cofs[2];
#pragma unroll
        for (int bj = 0; bj < 2; ++bj) { int c = wc * 32 + 8 * fq + bj * 128;
            if (u.pn >= T_HB) { const int tok = (u.pn - T_HB) * 256 + c; if (tok < NLAT) { const int t = tok & 4095; c += (((t & 63) >> 3) << 9 | (t >> 6) << 3) - t; } }
            cofs[bj] = c; }
#pragma unroll
        for (int ai = 0; ai < 2; ++ai)
#pragma unroll
            for (int m = 0; m < 4; ++m) { GAS bf16* rowp = base + (size_t)(ai * 128 + wr * 64 + m * 16 + fr) * ldc;
#pragma unroll
                for (int bj = 0; bj < 2; ++bj) { const f32x4 v0 = acc[ai][bj][m][0], v1 = acc[ai][bj][m][1];
                    v4u w; w.x = pk2(v0[0], v0[1]); w.y = pk2(v0[2], v0[3]); w.z = pk2(v1[0], v1[1]); w.w = pk2(v1[2], v1[3]);
                    *(GAS v4u*)(rowp + cofs[bj]) = w; } }
    }
};
struct EpiWo {
    static constexpr bool PERM = true, AFTER_DRAIN = false;
    GAS bf16* O;
    __device__ __forceinline__ void operator()(const f32x4 (&acc)[2][2][4][2], const pg8::Unit& u, int wr, int wc, int fr_in, int fq_in) const {
        int fr = fr_in, fq = fq_in; asm volatile("" : "+v"(fr), "+v"(fq));
        GAS bf16* base = O + (size_t)(u.pm - T_AO) * 256 * D + (size_t)(u.pn - T_WO) * 256;
#pragma unroll
        for (int ai = 0; ai < 2; ++ai)
#pragma unroll
            for (int m = 0; m < 4; ++m) { GAS bf16* rowp = base + (size_t)(ai * 128 + wr * 64 + m * 16 + fr) * D + wc * 32 + 8 * fq;
#pragma unroll
                for (int bj = 0; bj < 2; ++bj) { const f32x4 v0 = acc[ai][bj][m][0], v1 = acc[ai][bj][m][1];
                    v4u w; w.x = pk2(v0[0], v0[1]); w.y = pk2(v0[2], v0[3]); w.z = pk2(v1[0], v1[1]); w.w = pk2(v1[2], v1[3]);
                    *(GAS v4u*)(rowp + bj * 128) = w; } }
    }
};
struct EpiGlu {
    static constexpr bool PERM = true, AFTER_DRAIN = false;
    GAS bf16* O;
    __device__ __forceinline__ void operator()(const f32x4 (&acc)[2][2][4][2], const pg8::Unit& u, int wr, int wc, int fr_in, int fq_in) const {
        int fr = fr_in, fq = fq_in; asm volatile("" : "+v"(fr), "+v"(fq));
        GAS bf16* base = O + (size_t)(u.pm - T_Z) * 256 * D + (size_t)(u.pn - T_WVG) * 128;
#pragma unroll
        for (int ai = 0; ai < 2; ++ai)
#pragma unroll
            for (int m = 0; m < 4; ++m) { GAS bf16* rowp = base + (size_t)(ai * 128 + wr * 64 + m * 16 + fr) * D + wc * 32 + 8 * fq;
                f32x4 o0, o1;
#pragma unroll
                for (int q = 0; q < 4; ++q) { o0[q] = acc[ai][0][m][0][q] * sigmoid_f(acc[ai][1][m][0][q]); o1[q] = acc[ai][0][m][1][q] * sigmoid_f(acc[ai][1][m][1][q]); }
                v4u w; w.x = pk2(o0[0], o0[1]); w.y = pk2(o0[2], o0[3]); w.z = pk2(o1[0], o1[1]); w.w = pk2(o1[2], o1[3]);
                *(GAS v4u*)rowp = w; }
    }
};
struct EpiSwiglu {
    static constexpr bool PERM = true, AFTER_DRAIN = false;
    GAS bf16* ACT; int pnB;
    __device__ __forceinline__ void operator()(const f32x4 (&acc)[2][2][4][2], const pg8::Unit& u, int wr, int wc, int fr_in, int fq_in) const {
        int fr = fr_in, fq = fq_in; asm volatile("" : "+v"(fr), "+v"(fq));
        const int j = (u.pn - pnB) & 15;
        GAS bf16* base = ACT + (size_t)(u.pm - T_XE) * 256 * D + (size_t)j * 128;
#pragma unroll
        for (int ai = 0; ai < 2; ++ai)
#pragma unroll
            for (int m = 0; m < 4; ++m) { GAS bf16* rowp = base + (size_t)(ai * 128 + wr * 64 + m * 16 + fr) * D + wc * 32 + 8 * fq;
                f32x4 o0, o1;
#pragma unroll
                for (int q = 0; q < 4; ++q) { o0[q] = silu_f(acc[ai][0][m][0][q]) * acc[ai][1][m][0][q]; o1[q] = silu_f(acc[ai][0][m][1][q]) * acc[ai][1][m][1][q]; }
                v4u w; w.x = pk2(o0[0], o0[1]); w.y = pk2(o0[2], o0[3]); w.z = pk2(o1[0], o1[1]); w.w = pk2(o1[2], o1[3]);
                *(GAS v4u*)rowp = w; }
    }
};
struct EpiDown {
    static constexpr bool PERM = true, AFTER_DRAIN = false;
    GAS bf16* YE; const GAS float* GATE; int pnB;
    __device__ __forceinline__ void operator()(const f32x4 (&acc)[2][2][4][2], const pg8::Unit& u, int wr, int wc, int fr_in, int fq_in) const {
        int fr = fr_in, fq = fq_in; asm volatile("" : "+v"(fr), "+v"(fq));
        const int j = (u.pn - pnB) & 7; const int rt = (u.pm - T_ACT) * 256;
        GAS bf16* base = YE + (size_t)rt * D + (size_t)j * 256;
#pragma unroll
        for (int ai = 0; ai < 2; ++ai)
#pragma unroll
            for (int m = 0; m < 4; ++m) { const int r = ai * 128 + wr * 64 + m * 16 + fr; const float gt = GATE[rt + r]; GAS bf16* rowp = base + (size_t)r * D + wc * 32 + 8 * fq;
#pragma unroll
                for (int bj = 0; bj < 2; ++bj) { const f32x4 v0 = acc[ai][bj][m][0] * gt, v1 = acc[ai][bj][m][1] * gt;
                    v4u w; w.x = pk2(v0[0], v0[1]); w.y = pk2(v0[2], v0[3]); w.z = pk2(v1[0], v1[1]); w.w = pk2(v1[2], v1[3]);
                    *(GAS v4u*)(rowp + bj * 128) = w; } }
    }
};

__device__ __forceinline__ float dot_bf16(const GAS bf16* a, const GAS bf16* b, int K) {
    float s = 0.f;
    for (int k = 0; k < K; k += 8) { const v4u x = *(const GAS v4u*)(a + k), y = *(const GAS v4u*)(b + k);
#pragma unroll
        for (int q = 0; q < 4; ++q) { s += bf2f(x[q] & 0xffffu) * bf2f(y[q] & 0xffffu); s += bf2f(x[q] >> 16) * bf2f(y[q] >> 16); } }
    return s;
}
template <class Epi, class Sched>
__device__ __forceinline__ void naive_gemm_phase(const pg8::Gemm g, const Sched& S, const Epi& E, int tid_in) {
    const int tid = tid_in, wid = __builtin_amdgcn_readfirstlane(tid >> 6), lane = tid & 63, wr = wid >> 2, wc = wid & 3, fr = lane & 15, fq = lane >> 4;
    pg8::Unit u;
    for (int i = 0; S.next(i, u); ++i) {
        f32x4 acc[2][2][4][2];
        const GAS bf16* A = (const GAS bf16*)g.A + (size_t)u.pm * 256 * g.K; const GAS bf16* B = (const GAS bf16*)g.Bt + (size_t)u.pn * 256 * g.K;
#pragma unroll
        for (int ai = 0; ai < 2; ++ai)
#pragma unroll
            for (int m = 0; m < 4; ++m) { const GAS bf16* ar = A + (size_t)(ai * 128 + wr * 64 + m * 16 + fr) * g.K;
#pragma unroll
                for (int bj = 0; bj < 2; ++bj)
#pragma unroll
                    for (int n = 0; n < 2; ++n)
#pragma unroll
                        for (int j = 0; j < 4; ++j) { const int c = Epi::PERM ? (bj * 128 + wc * 32 + 8 * fq + 4 * n + j) : (bj * 128 + wc * 32 + 16 * n + 4 * fq + j);
                            acc[ai][bj][m][n][j] = dot_bf16(ar, B + (size_t)c * g.K, g.K); } }
        E(acc, u, wr, wc, fr, fq);
    }
}
template <class Epi, class Sched>
__device__ __forceinline__ void run_gemm_ga(Frame& F, const Sched& S, const Epi& E, int tA) {
    const pg8::Gemm g{(const pg8::bf16_t*)(const unsigned char*)(F.ws + (size_t)tA * MiB), (const pg8::bf16_t*)(const unsigned char*)F.ws, 0, 0, D};
    pg8::gemm_phase<Epi, Sched, PG8_ALIGN, PG8_SP2, true, false, MOE_BAUX, WT_BKM != 0>((PG8_LAS unsigned char*)F.lds, g, S, E, F.tid);
}
template <class Epi, class Sched, bool VR = false, int BAUX = 0, bool BKM = (WT_BKM != 0)>
__device__ __forceinline__ void run_gemm(Frame& F, const Sched& S, const Epi& E) {
    const pg8::Gemm g{(const pg8::bf16_t*)(const unsigned char*)F.ws, (const pg8::bf16_t*)(const unsigned char*)F.ws, 0, 0, D};
#if NAIVE_GEMM
    naive_gemm_phase<Epi, Sched>(g, S, E, F.tid);
#else
    pg8::gemm_phase<Epi, Sched, PG8_ALIGN, PG8_SP2, false, VR, BAUX, BKM>((PG8_LAS unsigned char*)F.lds, g, S, E, F.tid);
#endif
}

#define LDV(p, j) (*(const GAS f32x4*)((p) + 4 * F.lane + 256 * (j)))
__device__ __forceinline__ f32x4 bf4_to_f32(v2u w) { return (f32x4){bf2f(w.x & 0xffffu), bf2f(w.x >> 16), bf2f(w.y & 0xffffu), bf2f(w.y >> 16)}; }
#define LDVB(p, j) bf4_to_f32(*(const GAS v2u*)((p) + 4 * F.lane + 256 * (j)))
#define LDVL(p, j) (*(const LAS f32x4*)((p) + 4 * F.lane + 256 * (j)))
__device__ __forceinline__ void stage_vec(const Frame& F, LAS float* dst, const GAS float* src) {
    *(LAS f32x4*)(dst + 4 * F.tid) = *(const GAS f32x4*)(src + 4 * F.tid);
}
__device__ __forceinline__ void ln_rows_lds(f32x4 (&v)[8], const LAS float* g, const LAS float* bb, const Frame& F) {
    float s = 0.f;
#pragma unroll
    for (int j = 0; j < 8; ++j) s += (v[j][0] + v[j][1]) + (v[j][2] + v[j][3]);
    const float mean = wave_sum(s) * (1.0f / D); float s2 = 0.f;
#pragma unroll
    for (int j = 0; j < 8; ++j) { v[j] = v[j] - mean; s2 += (v[j][0] * v[j][0] + v[j][1] * v[j][1]) + (v[j][2] * v[j][2] + v[j][3] * v[j][3]); }
    const float rstd = 1.0f / sqrtf(wave_sum(s2) * (1.0f / D) + LN_EPS);
#pragma unroll
    for (int j = 0; j < 8; ++j) v[j] = v[j] * rstd * LDVL(g, j) + LDVL(bb, j);
}

__device__ __forceinline__ void p0_mods(Frame& F) {
    LAS float* S = (LAS float*)F.lds;
    LAS float* P = S + 3 * D;
    const GAS float* c = fin(F, I_C); const GAS float* cctx = fin(F, I_CCTX);
    for (int i = F.tid; i < 3 * D; i += NTHREADS) { const int r = i / D, k = i % D; const float cv = (r < 2) ? c[r * D + k] : cctx[k]; S[i] = cv / (1.0f + expf(-cv)); }
    __syncthreads();
    const int tl = F.tid & 7, kg = F.tid >> 3;
    GAS float* M = (GAS float*)(F.ws + WS_MODS);
    for (int it = blockIdx.x; it < 2 * 384; it += F.G) {
        const int l = it / 384, cc = it % 384;
        const GAS float* w = fin(F, I_WMOD) + (size_t)l * D * D6 + cc * 32 + tl * 4;
        f32x4 a0 = {0.f, 0.f, 0.f, 0.f}, a1 = a0, a2 = a0;
#pragma unroll 8
        for (int kk = 0; kk < 32; ++kk) { const int k = kg * 32 + kk; const f32x4 wv = *(const GAS f32x4*)(w + (size_t)k * D6); a0 += wv * S[k]; a1 += wv * S[D + k]; a2 += wv * S[2 * D + k]; }
#pragma unroll
        for (int j = 0; j < 4; ++j) { P[(kg * 3 + 0) * 32 + tl * 4 + j] = a0[j]; P[(kg * 3 + 1) * 32 + tl * 4 + j] = a1[j]; P[(kg * 3 + 2) * 32 + tl * 4 + j] = a2[j]; }
        __syncthreads();
        if (F.tid < 96) { const int r = F.tid >> 5, col = F.tid & 31; float s = 0.f;
            for (int q = 0; q < 64; ++q) s += P[(q * 3 + r) * 32 + col];
            M[(size_t)(l * 3 + r) * D6 + cc * 32 + col] = s + fin(F, I_BMOD)[l * D6 + cc * 32 + col]; }
        __syncthreads();
    }
}
__device__ __forceinline__ void p0_s5params(Frame& F) {
    GAS float* AR = (GAS float*)(F.ws + WS_SPAR); GAS float* AI = AR + 2 * NG * NP; GAS float* BB = AI + 2 * NG * NP;
    for (int idx = blockIdx.x * NTHREADS + F.tid; idx < 2 * NG * NP; idx += F.G * NTHREADS) {
        const int dg = idx / NP;
        const double lr = (double)fminf(fin(F, I_LAMRE)[idx], -1e-4f), li = (double)fin(F, I_LAMIM)[idx], dt = exp((double)fin(F, I_LOGSTEP)[dg]);
        const double mag = exp(lr * dt); double sn, cs; sincos(li * dt, &sn, &cs);
        const double ar = mag * cs, ai = mag * sn, nr = ar - 1.0, den = lr * lr + li * li, cr = (nr * lr + ai * li) / den, ci = (ai * lr - nr * li) / den;
        AR[idx] = (float)ar; AI[idx] = (float)ai;
        for (int h = 0; h < GH; ++h) { const double bre = fin(F, I_BRE)[(size_t)idx * GH + h], bim = fin(F, I_BIM)[(size_t)idx * GH + h];
            BB[(size_t)idx * 32 + h] = (float)(cr * bre - ci * bim); BB[(size_t)idx * 32 + 16 + h] = (float)(cr * bim + ci * bre); }
    }
}
__device__ __forceinline__ void p0_item_load(const GAS float* W, int ldw, int k0, int lane, f32x4 (&v)[8]) {
    const GAS float* p = W + (size_t)((k0 & ~1) + 8 * (lane >> 3)) * ldw + 4 * (lane & 7);
#pragma unroll
    for (int i = 0; i < 8; ++i) v[i] = __builtin_nontemporal_load((const GAS f32x4*)(p + (size_t)i * ldw));
}
__device__ __forceinline__ void p0_item_store(GAS bf16* WT, int dst_row0, int k0, int lane, const f32x4 (&v)[8]) {
    const int g0 = dst_row0 + 4 * (lane & 7), kq = k0 & ~1; const bool bkm = (k0 & 1) != 0;
    GAS bf16* o = bkm ? WT + (size_t)(g0 >> 8) * (256 * D) + (size_t)(kq >> 6) * (256 * 64) + (g0 & 255) * 64 + 8 * (lane >> 3) : WT + (size_t)g0 * D + kq + 8 * (lane >> 3);
    const int RS = bkm ? 64 : D;
#pragma unroll
    for (int j = 0; j < 4; ++j) { v4u w; w.x = pk2(v[0][j], v[1][j]); w.y = pk2(v[2][j], v[3][j]); w.z = pk2(v[4][j], v[5][j]); w.w = pk2(v[6][j], v[7][j]);
#if CV_NT_STORE
        __builtin_nontemporal_store(w, (GAS v4u*)(o + (size_t)j * RS));
#else
        *(GAS v4u*)(o + (size_t)j * RS) = w;
#endif
    }
}
__device__ __forceinline__ void p0_decode(const Frame& F, int it, const GAS float*& src, int& ldw, GAS bf16*& dst, int& dr0, int& k0) {
    const int sq = it >> 11, r = it & 2047, kb = r >> 6, nb = r & 63, n0 = nb * 32;
    int mode = 0, off = 0; ldw = D;
    if (sq < 3) { src = fin(F, I_WQKV) + sq * D; ldw = 3 * D; dst = ws_tile(F, T_WQKV) + (size_t)sq * D * D; }
    else if (sq == 3) { src = fin(F, I_WO); dst = ws_tile(F, T_WO); }
    else if (sq == 4) { src = fin(F, I_WVAL); dst = ws_tile(F, T_WVG); mode = 1; }
    else if (sq == 5) { src = fin(F, I_WGATE); dst = ws_tile(F, T_WVG); mode = 1; off = 128; }
    else { const int mm = sq - 6, l = mm / 48, e = (mm % 48) / 3, t = mm % 3; const size_t wofs = (size_t)(l * NE + e) * D * D;
        if (t == 0) { src = fin(F, I_MGATE) + wofs; dst = ws_tile(F, T_MOE1 + l * 256) + (size_t)e * 4096 * D; mode = 1; }
        else if (t == 1) { src = fin(F, I_MUP) + wofs; dst = ws_tile(F, T_MOE1 + l * 256) + (size_t)e * 4096 * D; mode = 1; off = 128; }
        else { src = fin(F, I_MDOWN) + wofs; dst = ws_tile(F, T_MOE2 + l * 128) + (size_t)e * 2048 * D; } }
    src += n0; dr0 = mode ? ((n0 >> 7) * 256 + (n0 & 127) + off) : n0; k0 = kb * 64 + ((WT_BKM && sq >= 3) ? 1 : 0);
}
template <int NF>
__device__ __forceinline__ void p0_weights_n(Frame& F, int it0, int NIT, int gw, int NGW) {
    for (int it = it0 + gw; it < NIT; it += NF * NGW) {
        const GAS float* sp[NF]; int lw[NF], dr[NF], kk[NF]; GAS bf16* op[NF]; f32x4 v[NF][8]; bool ok[NF];
#pragma unroll
        for (int q = 0; q < NF; ++q) { ok[q] = it + q * NGW < NIT; if (ok[q]) { p0_decode(F, it + q * NGW, sp[q], lw[q], op[q], dr[q], kk[q]); p0_item_load(sp[q], lw[q], kk[q], F.lane, v[q]); } }
#pragma unroll
        for (int q = 0; q < NF; ++q) if (ok[q]) p0_item_store(op[q], dr[q], kk[q], F.lane, v[q]);
    }
}
__device__ __forceinline__ void p0_weights(Frame& F, int it0, int NIT, int gw, int NGW) {
#if CV_ROLL
    int it = it0 + gw; if (it >= NIT) return;
    const GAS float* s0; const GAS float* s1; int l0, l1, d0, d1, k0, k1; GAS bf16* o0; GAS bf16* o1; f32x4 va[8], vb[8];
    p0_decode(F, it, s0, l0, o0, d0, k0); p0_item_load(s0, l0, k0, F.lane, va);
    for (;;) {
        const bool hb = it + NGW < NIT;
        if (hb) { p0_decode(F, it + NGW, s1, l1, o1, d1, k1); p0_item_load(s1, l1, k1, F.lane, vb); }
        p0_item_store(o0, d0, k0, F.lane, va);
        if (!hb) break;
        const bool ha = it + 2 * NGW < NIT;
        if (ha) { p0_decode(F, it + 2 * NGW, s0, l0, o0, d0, k0); p0_item_load(s0, l0, k0, F.lane, va); }
        p0_item_store(o1, d1, k1, F.lane, vb);
        if (!ha) break;
        it += 2 * NGW;
    }
#else
    for (int it = it0 + gw; it < NIT; it += 2 * NGW) {
        const GAS float* s0; const GAS float* s1; int l0, l1, d0, d1, k0, k1; GAS bf16* o0; GAS bf16* o1; f32x4 va[8], vb[8];
        const bool two = it + NGW < NIT;
        p0_decode(F, it, s0, l0, o0, d0, k0); p0_item_load(s0, l0, k0, F.lane, va);
        if (two) { p0_decode(F, it + NGW, s1, l1, o1, d1, k1); p0_item_load(s1, l1, k1, F.lane, vb); }
        p0_item_store(o0, d0, k0, F.lane, va);
        if (two) p0_item_store(o1, d1, k1, F.lane, vb);
    }
#endif
}
__device__ __forceinline__ const GAS float* xin_row(Frame& F, int l, int row) {
    if (l == 0) return row < NLAT ? fin(F, I_X) + (size_t)row * D : fin(F, I_CTX) + (size_t)(row - NLAT) * D;
    return (const GAS float*)(F.ws + WS_X2) + (size_t)row * D;
}
#define XN_LOAD(dst, l_, row_) do { if (X2_FP16 && (l_)) { const GAS bf16* xh_ = (const GAS bf16*)(F.ws + WS_X2) + (size_t)(row_) * D; \
        _Pragma("unroll") for (int j = 0; j < 8; ++j) { const f32x2 t_ = *(const GAS f32x2*)(xh_ + 4 * F.lane + 256 * j); dst[j][0] = t_[0]; dst[j][1] = t_[1]; } } \
    else { const GAS float* xr_ = xin_row(F, l_, row_); _Pragma("unroll") for (int j = 0; j < 8; ++j) dst[j] = LDV(xr_, j); } } while (0)
__device__ __forceinline__ void p1_prep(Frame& F) {
    const int gw = F.vcu * NWAVES + F.wave, NGW = F.G * NWAVES;
    GAS bf16* HB = ws_tile(F, T_HB);
    LAS float* VL = (LAS float*)F.lds;
#pragma unroll
    for (int r = 0; r < 3; ++r) { stage_vec(F, VL + r * D, mods(F, 0, r, 0)); stage_vec(F, VL + (3 + r) * D, mods(F, 0, r, 1)); }
    f32x4 xn[8];
    if (gw < NROWS) { const GAS float* xr = xin_row(F, 0, gw);
#pragma unroll
        for (int j = 0; j < 8; ++j) xn[j] = LDV(xr, j); }
    __syncthreads();
    const int p1rows = P1_COOP ? NLAT : NROWS;
    for (int row = gw; row < p1rows; row += NGW) {
        const int r = row_r(row); const LAS float* sh = VL + r * D; const LAS float* sc = VL + (3 + r) * D;
        f32x4 h[8];
#pragma unroll
        for (int j = 0; j < 8; ++j) h[j] = xn[j] * (LDVL(sc, j) + 1.0f) + LDVL(sh, j);
        if (row + NGW < p1rows) { const GAS float* xr = xin_row(F, 0, row + NGW);
#pragma unroll
            for (int j = 0; j < 8; ++j) xn[j] = LDV(xr, j); }
#pragma unroll
        for (int j = 0; j < 8; ++j) { v2u w; w.x = pk2(h[j][0], h[j][1]); w.y = pk2(h[j][2], h[j][3]); *(GAS v2u*)(HB + (size_t)row * D + 4 * F.lane + 256 * j) = w; }
    }
#if P1_COOP
    for (int task = gw; task < 4 * NCTX; task += NGW) { const int row = NLAT + (task >> 2), qq = task & 3; const GAS float* xr = xin_row(F, 0, row);
        const LAS float* sh = VL + 2 * D; const LAS float* sc = VL + 5 * D;
#pragma unroll
        for (int jj = 0; jj < 2; ++jj) { const int j = 2 * qq + jj; const f32x4 h = LDV(xr, j) * (LDVL(sc, j) + 1.0f) + LDVL(sh, j);
            v2u w; w.x = pk2(h[0], h[1]); w.y = pk2(h[2], h[3]); *(GAS v2u*)(HB + (size_t)row * D + 4 * F.lane + 256 * j) = w; } }
#endif
}
__device__ __forceinline__ void p3_attn_naive(Frame& F) {
    const int gw = F.vcu * NWAVES + F.wave, NGW = F.G * NWAVES;
    LAS float* Pl = (LAS float*)(F.lds + F.wave * 4096);
    LAS int* Tl = (LAS int*)(F.lds + F.wave * 4096 + 2048);
    const GAS bf16* QK = ws_tile(F, T_QK); const GAS bf16* VT = ws_tile(F, T_VT); GAS bf16* AO = ws_tile(F, T_AO);
    const float scale = 0.08838834764831845f;
    for (int un = gw; un < NROWS * NH; un += NGW) {
        const int row = un >> 4, h = un & 15; const bool lat = row < NLAT;
        int b, r = 0, qc = 0, rs = 0, cst = 0;
        if (lat) { b = row >> 12; const int t = row & 4095; r = t >> 6; qc = t & 63; rs = min(max(r - 4, 0), 56); cst = min(max(qc - 8, 0), 48); } else b = (row - NLAT) >> 8;
        const int nk = lat ? 384 : 256;
        const GAS bf16* q = QK + (size_t)row * 4096 + h * HD;
        float sv[6]; float mx = -3.0e38f;
#pragma unroll
        for (int i = 0; i < 6; ++i) { const int kk = F.lane + 64 * i; float s = -3.0e38f;
            if (kk < nk) { int krow; float bias = 0.f;
                if (lat && kk < 128) { const int kr = rs + (kk >> 4), kc = cst + (kk & 15); krow = b * SEQ + kr * 64 + kc;
                    const int dc = min(max(kc - qc + 15, 0), 30); bias = fin(F, I_RPB)[(h * 15 + (kr - r + 7)) * 31 + dc]; }
                else krow = NLAT + b * CTXL + (lat ? kk - 128 : kk);
                s = dot_bf16(q, QK + (size_t)krow * 4096 + D + h * HD, HD) * scale + bias; Tl[kk] = krow; }
            sv[i] = s; mx = fmaxf(mx, s); }
        mx = wave_max(mx); float sum = 0.f;
#pragma unroll
        for (int i = 0; i < 6; ++i) { const int kk = F.lane + 64 * i; const float p = (kk < nk) ? __expf(sv[i] - mx) : 0.f; sv[i] = p; sum += p; }
        sum = wave_sum(sum); const float inv = 1.0f / sum;
#pragma unroll
        for (int i = 0; i < 6; ++i) { const int kk = F.lane + 64 * i; if (kk < nk) Pl[kk] = sv[i] * inv; }
        asm volatile("s_waitcnt lgkmcnt(0)" ::: "memory");
        float o0 = 0.f, o1 = 0.f; const GAS bf16* v0 = VT + (size_t)(h * HD + 2 * F.lane) * NROWS; const GAS bf16* v1 = v0 + NROWS;
        for (int kk = 0; kk < nk; ++kk) { const float p = Pl[kk]; const int kr = Tl[kk]; o0 += p * bf2f(v0[kr]); o1 += p * bf2f(v1[kr]); }
        *(GAS unsigned*)(AO + (size_t)row * D + h * HD + 2 * F.lane) = pk2(o0, o1);
        asm volatile("s_waitcnt lgkmcnt(0)" ::: "memory");
    }
}
__device__ __forceinline__ void ln_rows(f32x4 (&v)[8], const GAS float* g, const GAS float* bb, const Frame& F) {
    f32x4 gv[8], bv[8];
#pragma unroll
    for (int j = 0; j < 8; ++j) { gv[j] = LDV(g, j); bv[j] = LDV(bb, j); }
    __builtin_amdgcn_sched_barrier(0);
    float s = 0.f;
#pragma unroll
    for (int j = 0; j < 8; ++j) s += (v[j][0] + v[j][1]) + (v[j][2] + v[j][3]);
    const float mean = wave_sum(s) * (1.0f / D); float s2 = 0.f;
#pragma unroll
    for (int j = 0; j < 8; ++j) { v[j] = v[j] - mean; s2 += (v[j][0] * v[j][0] + v[j][1] * v[j][1]) + (v[j][2] * v[j][2] + v[j][3] * v[j][3]); }
    const float rstd = 1.0f / sqrtf(wave_sum(s2) * (1.0f / D) + LN_EPS);
#pragma unroll
    for (int j = 0; j < 8; ++j) v[j] = v[j] * rstd * gv[j] + bv[j];
}
__device__ __forceinline__ float reduce16(float (&v)[16], int lane) {
    float a[8], b[4], c[2];
    const bool h5 = lane & 32, h4 = lane & 16, h3 = lane & 8, h2 = lane & 4;
#pragma unroll
    for (int k = 0; k < 8; ++k) { const float snd = h5 ? v[k] : v[k + 8], kp = h5 ? v[k + 8] : v[k]; a[k] = kp + __shfl_xor(snd, 32); }
#pragma unroll
    for (int k = 0; k < 4; ++k) { const float snd = h4 ? a[k] : a[k + 4], kp = h4 ? a[k + 4] : a[k]; b[k] = kp + __shfl_xor(snd, 16); }
#pragma unroll
    for (int k = 0; k < 2; ++k) { const float snd = h3 ? b[k] : b[k + 2], kp = h3 ? b[k + 2] : b[k]; c[k] = kp + __shfl_xor(snd, 8); }
    float d = (h2 ? c[1] : c[0]) + __shfl_xor(h2 ? c[0] : c[1], 4);
    d += __shfl_xor(d, 2); d += __shfl_xor(d, 1);
    return d;
}
__device__ __forceinline__ void row_phase(Frame& F, int l, int dv) {
    const int gw = F.vcu * NWAVES + F.wave, NGW = F.G * NWAVES, nrows = (l || ROW_CTX_COOP) ? NLAT : NROWS;
    const GAS bf16* O = (const GAS bf16*)(F.ws + WS_O); GAS float* X1 = (GAS float*)(F.ws + WS_X1); GAS bf16* HB = ws_tile(F, T_HB); GAS float* AFFT = (GAS float*)(F.ws + WS_AFF);
    const GAS float* lng = fin(F, I_LNG) + (size_t)(l * 2 + 0) * D; const GAS float* lnb = fin(F, I_LNB) + (size_t)(l * 2 + 0) * D; const GAS float* wr = fin(F, I_ROUTER) + (size_t)l * D * NE;
    LAS float* WR = (LAS float*)F.lds;
#pragma unroll
    for (int bt = 0; bt < 2; ++bt) { f32x4 t8[8];
#pragma unroll
        for (int k = 0; k < 8; ++k) { const int pc = F.tid + NTHREADS * (8 * bt + k), ln = pc & 63, e4 = (pc >> 6) & 3, qq = (pc >> 8) & 3, jj = pc >> 10;
            t8[k] = *(const GAS f32x4*)(wr + (size_t)(4 * ln + 256 * jj + qq) * NE + 4 * e4); }
#pragma unroll
        for (int k = 0; k < 8; ++k) *(LAS f32x4*)(WR + 4 * (F.tid + NTHREADS * (8 * bt + k))) = t8[k]; }
    __syncthreads();
    f32x4 xn[8]; v2u on[8];
    if (gw < nrows) { const GAS bf16* orow = O + (size_t)gw * D;
        XN_LOAD(xn, l, gw);
#pragma unroll
        for (int j = 0; j < 8; ++j) on[j] = *(const GAS v2u*)(orow + 4 * F.lane + 256 * j); }
    for (int row = gw; row < nrows; row += NGW) {
        const int r = row_r(row);
        const GAS float* g1 = mods(F, l, r, 2); const GAS float* sh2 = mods(F, l, r, 3); const GAS float* sc2 = mods(F, l, r, 4);
        f32x4 v[8];
        { f32x4 gg[8];
#pragma unroll
          for (int j = 0; j < 8; ++j) gg[j] = LDV(g1, j);
          __builtin_amdgcn_sched_barrier(0);
#pragma unroll
          for (int j = 0; j < 8; ++j) { const f32x4 xx = (X2_FP16 && l) ? h4_to_f32((v2u){__float_as_uint(xn[j][0]), __float_as_uint(xn[j][1])}) : xn[j];
              v[j] = xx * ALPHA + gg[j] * bf4_to_f32(on[j]); } }
        if (row + NGW < nrows) { const GAS bf16* orow = O + (size_t)(row + NGW) * D;
            XN_LOAD(xn, l, row + NGW);
#pragma unroll
            for (int j = 0; j < 8; ++j) on[j] = *(const GAS v2u*)(orow + 4 * F.lane + 256 * j); }
        ln_rows(v, lng, lnb, F);
        float lg[NE];
#pragma unroll
        for (int e = 0; e < NE; ++e) lg[e] = 0.f;
        f32x4 hv[8];
        { f32x4 cv[8], sv[8];
#pragma unroll
          for (int j = 0; j < 8; ++j) { cv[j] = LDV(sc2, j); sv[j] = LDV(sh2, j); }
          __builtin_amdgcn_sched_barrier(0);
#pragma unroll
          for (int j = 0; j < 8; ++j) hv[j] = v[j] * (cv[j] + 1.0f) + sv[j]; }
#if X1_BF16
        { v2u xw[8];
#pragma unroll
          for (int j = 0; j < 8; ++j) { xw[j].x = X1PK(v[j][0], v[j][1]); xw[j].y = X1PK(v[j][2], v[j][3]); }
          __builtin_amdgcn_sched_barrier(0);
#pragma unroll
          for (int j = 0; j < 8; ++j) {
#if NT_STREAM
              __builtin_nontemporal_store(xw[j], (GAS v2u*)((GAS bf16*)X1 + (size_t)row * D + 4 * F.lane + 256 * j));
#else
              *(GAS v2u*)((GAS bf16*)X1 + (size_t)row * D + 4 * F.lane + 256 * j) = xw[j];
#endif
          } }
#pragma unroll
        for (int j = 0; j < 8; ++j) { v2u w; w.x = pk2(hv[j][0], hv[j][1]); w.y = pk2(hv[j][2], hv[j][3]); *(GAS v2u*)(HB + (size_t)row * D + 4 * F.lane + 256 * j) = w; }
#else
#pragma unroll
        for (int j = 0; j < 8; ++j) { *(GAS f32x4*)(X1 + (size_t)row * D + 4 * F.lane + 256 * j) = v[j];
            v2u w; w.x = pk2(hv[j][0], hv[j][1]); w.y = pk2(hv[j][2], hv[j][3]); *(GAS v2u*)(HB + (size_t)row * D + 4 * F.lane + 256 * j) = w; }
#endif
        {
            const LAS float* wl = WR + 4 * F.lane; f32x4 wv[2][4];
#pragma unroll
            for (int e4 = 0; e4 < 4; ++e4) wv[0][e4] = *(const LAS f32x4*)(wl + e4 * 256);
#pragma unroll
            for (int st = 0; st < 32; ++st) {
                if (st + 1 < 32) {
#pragma unroll
                    for (int e4 = 0; e4 < 4; ++e4) wv[(st + 1) & 1][e4] = *(const LAS f32x4*)(wl + ((st + 1) * 4 + e4) * 256); }
                const float hq = hv[st >> 2][st & 3];
#pragma unroll
                for (int e4 = 0; e4 < 4; ++e4)
#pragma unroll
                    for (int t = 0; t < 4; ++t) lg[4 * e4 + t] += hq * wv[st & 1][e4][t];
                __builtin_amdgcn_sched_barrier(0); }
        }
        const float lgt = reduce16(lg, F.lane);
        float mx = lgt;
#pragma unroll
        for (int o = 4; o < 64; o <<= 1) mx = fmaxf(mx, __shfl_xor(mx, o));
        const float ex = expf(lgt - mx); float sum = ex;
#pragma unroll
        for (int o = 4; o < 64; o <<= 1) sum += __shfl_xor(sum, o);
        if ((F.lane & 3) == 0) AFFT[(size_t)((F.lane >> 2) & 15) * NROWS + row] = ex / sum;
    }
#if ROW_CTX_COOP
    if (l == 0) {
        LAS float* PS = (LAS float*)(F.lds + 131072);
        LAS float* PQ = PS + 8; LAS float* PL = PQ + 8;
        const int rr = F.wave >> 2, qq = F.wave & 3;
        for (int base = 2 * F.vcu; base < NCTX; base += 2 * F.G) {
            const int row = NLAT + base + rr;
            const GAS float* xr = xin_row(F, 0, row); const GAS bf16* orow = O + (size_t)row * D;
            const GAS float* g1 = mods(F, 0, 2, 2); const GAS float* sh2 = mods(F, 0, 2, 3); const GAS float* sc2 = mods(F, 0, 2, 4);
            f32x4 v[2], gv[2], bv[2], cv[2], sv[2];
#pragma unroll
            for (int jj = 0; jj < 2; ++jj) { const int j = 2 * qq + jj; v[jj] = LDV(xr, j) * ALPHA + LDV(g1, j) * bf4_to_f32(*(const GAS v2u*)(orow + 4 * F.lane + 256 * j));
                gv[jj] = LDV(lng, j); bv[jj] = LDV(lnb, j); cv[jj] = LDV(sc2, j); sv[jj] = LDV(sh2, j); }
            float s = (v[0][0] + v[0][1]) + (v[0][2] + v[0][3]) + (v[1][0] + v[1][1]) + (v[1][2] + v[1][3]);
            s = wave_sum(s); if (F.lane == 0) PS[rr * 4 + qq] = s;
            __syncthreads();
            const float mean = ((PS[rr * 4 + 0] + PS[rr * 4 + 1]) + (PS[rr * 4 + 2] + PS[rr * 4 + 3])) * (1.0f / D);
            float s2 = 0.f;
#pragma unroll
            for (int jj = 0; jj < 2; ++jj) { v[jj] = v[jj] - mean; s2 += (v[jj][0] * v[jj][0] + v[jj][1] * v[jj][1]) + (v[jj][2] * v[jj][2] + v[jj][3] * v[jj][3]); }
            s2 = wave_sum(s2); if (F.lane == 0) PQ[rr * 4 + qq] = s2;
            __syncthreads();
            const float rstd = 1.0f / sqrtf(((PQ[rr * 4 + 0] + PQ[rr * 4 + 1]) + (PQ[rr * 4 + 2] + PQ[rr * 4 + 3])) * (1.0f / D) + LN_EPS);
            f32x4 hv[2];
#pragma unroll
            for (int jj = 0; jj < 2; ++jj) { const int j = 2 * qq + jj; v[jj] = v[jj] * rstd * gv[jj] + bv[jj]; hv[jj] = v[jj] * (cv[jj] + 1.0f) + sv[jj];
#if X1_BF16
                { v2u xw; xw.x = X1PK(v[jj][0], v[jj][1]); xw.y = X1PK(v[jj][2], v[jj][3]); *(GAS v2u*)((GAS bf16*)X1 + (size_t)row * D + 4 * F.lane + 256 * j) = xw; }
#else
                *(GAS f32x4*)(X1 + (size_t)row * D + 4 * F.lane + 256 * j) = v[jj];
#endif
                v2u w; w.x = pk2(hv[jj][0], hv[jj][1]); w.y = pk2(hv[jj][2], hv[jj][3]); *(GAS v2u*)(HB + (size_t)row * D + 4 * F.lane + 256 * j) = w; }
            float lg[NE];
#pragma unroll
            for (int e = 0; e < NE; ++e) lg[e] = 0.f;
#pragma unroll
            for (int jj = 0; jj < 2; ++jj)
#pragma unroll
                for (int q = 0; q < 4; ++q) { const LAS float* wp = WR + ((((2 * qq + jj) * 4 + q) * 4) * 64 + F.lane) * 4; const float hq = hv[jj][q];
#pragma unroll
                    for (int e4 = 0; e4 < 4; ++e4) { const f32x4 wv = *(const LAS f32x4*)(wp + e4 * 256);
#pragma unroll
                        for (int t = 0; t < 4; ++t) lg[4 * e4 + t] += hq * wv[t]; } }
            const float lgt = reduce16(lg, F.lane);
            if ((F.lane & 3) == 0) PL[(rr * 4 + qq) * 16 + ((F.lane >> 2) & 15)] = lgt;
            __syncthreads();
            if (qq == 0) { const int e = F.lane & 15;
                const float lgs = (PL[(rr * 4 + 0) * 16 + e] + PL[(rr * 4 + 1) * 16 + e]) + (PL[(rr * 4 + 2) * 16 + e] + PL[(rr * 4 + 3) * 16 + e]);
                float mx = lgs;
#pragma unroll
                for (int o = 1; o < 16; o <<= 1) mx = fmaxf(mx, __shfl_xor(mx, o));
                const float ex = expf(lgs - mx); float sum = ex;
#pragma unroll
                for (int o = 1; o < 16; o <<= 1) sum += __shfl_xor(sum, o);
                if (F.lane < 16) AFFT[(size_t)e * NROWS + row] = ex / sum; }
            __syncthreads();
        }
    }
#endif
    __syncthreads();
}
__device__ __forceinline__ void topk_phase(Frame& F, int l) {
    LAS int* CW = (LAS int*)F.lds;
    LAS int* CG = CW + 16;
    LAS int* CE = CG + 64;
    const GAS float* AFFT = (const GAS float*)(F.ws + WS_AFF); GAS int* SLOT = (GAS int*)(F.ws + WS_SLOT); GAS int* IDX = (GAS int*)(F.ws + WS_IDX); GAS float* GATE = (GAS float*)(F.ws + WS_GATE);
#if TOPK_CTX_WAVE
    const int nlat = 2 * NE * 8, ntot = nlat;
    if (l == 0 && F.wave == 0) {
        for (int q = blockIdx.x; q < 2 * NE; q += F.G) {
            const int b = q >> 4, e = q & 15, rowbase = NLAT + b * CTXL, slotbase = e * RPE + 1024 + b * 32, cap = 32;
            unsigned kc[4];
#pragma unroll
            for (int i = 0; i < 4; ++i) kc[i] = __float_as_uint(AFFT[(size_t)e * NROWS + rowbase + F.lane + 64 * i]);
            unsigned T = 0u;
            for (int bit = 30; bit >= 0; --bit) { const unsigned cand = T | (1u << bit); int cnt = 0;
#pragma unroll
                for (int i = 0; i < 4; ++i) cnt += __builtin_popcountll(__ballot(kc[i] >= cand));
                if (cnt >= cap) T = cand; }
            unsigned long long mg[4], me[4]; int gt_total = 0;
#pragma unroll
            for (int i = 0; i < 4; ++i) { mg[i] = __ballot(kc[i] > T); me[i] = __ballot(kc[i] == T); gt_total += __builtin_popcountll(mg[i]); }
            const int need = cap - gt_total;
            const unsigned long long lower = (F.lane == 0) ? 0ull : (~0ull >> (64 - F.lane));
            int g_before = 0, e_before = 0;
#pragma unroll
            for (int i = 0; i < 4; ++i) { const int t = F.lane + 64 * i;
                const int g_rank = g_before + __builtin_popcountll(mg[i] & lower), e_rank = e_before + __builtin_popcountll(me[i] & lower);
                const int e_taken_before = e_rank < need ? e_rank : need;
                const bool sel = (kc[i] > T) || (kc[i] == T && e_rank < need);
                int sl = -1;
                if (sel) { sl = slotbase + g_rank + e_taken_before; IDX[sl] = rowbase + t; GATE[sl] = __uint_as_float(kc[i]); }
                SLOT[(size_t)(rowbase + t) * NE + e] = sl;
                g_before += __builtin_popcountll(mg[i]); e_before += __builtin_popcountll(me[i]); }
        }
    }
#else
    const int nlat = 2 * NE * 8, ntot = nlat + (l == 0 ? 2 * NE : 0);
#endif
#if CV_TKN
    const int cv_end = CV_NIT_ALL - (1 - l) * CV_TK, cv_ngw = F.G * NWAVES; int cv_it = cv_end - CV_TK + F.vcu * NWAVES + F.wave, cv_left = CV_TKN; bool cv_pend = false;
    const GAS float* cs0 = nullptr; int cl0 = 0, cd0 = 0, ck0 = 0; GAS bf16* co0 = nullptr; f32x4 cva[8];
#endif
    for (int un = blockIdx.x; un < ntot; un += F.G) {
        const bool lat = un < nlat; int b, e, ch, n, cap, rowbase, slotbase;
        if (lat) { b = un >> 7; e = (un >> 3) & 15; ch = un & 7; n = SEQ; cap = 512; rowbase = b * SEQ; slotbase = e * RPE + b * 512; }
        else { const int q = un - nlat; b = q >> 4; e = q & 15; ch = 0; n = CTXL; cap = 32; rowbase = NLAT + b * CTXL; slotbase = e * RPE + 1024 + b * 32; }
        unsigned key[8];
#pragma unroll
        for (int i = 0; i < 8; ++i) { const int t = F.tid + 512 * i; key[i] = (t < n) ? __float_as_uint(AFFT[(size_t)e * NROWS + rowbase + t]) : 0u; }
        unsigned T = 0u;
#if TOPK_2BIT
        typedef int i32x4 __attribute__((ext_vector_type(4)));
        LAS i32x4* CW4 = (LAS i32x4*)(F.lds + 4096);
        {   const unsigned cand = 1u << 30; int cnt = 0;
#pragma unroll
            for (int i = 0; i < 8; ++i) cnt += __builtin_popcountll(__ballot(key[i] >= cand));
            if (F.lane == 0) CW[F.wave] = cnt;
            __syncthreads();
            int tot = 0;
#pragma unroll
            for (int w = 0; w < 8; ++w) tot += CW[w];
            if (tot >= cap) T = cand; }
        for (int lo = 28; lo >= 0; lo -= 2) {
            const unsigned c1 = T | (1u << lo), c2 = T | (2u << lo), c3 = T | (3u << lo); int n1 = 0, n2 = 0, n3 = 0;
#pragma unroll
            for (int i = 0; i < 8; ++i) { n1 += __builtin_popcountll(__ballot(key[i] >= c1)); n2 += __builtin_popcountll(__ballot(key[i] >= c2)); n3 += __builtin_popcountll(__ballot(key[i] >= c3)); }
            LAS i32x4* cw = CW4 + ((lo >> 1) & 1) * 8;
            if (F.lane == 0) cw[F.wave] = (i32x4){n1, n2, n3, 0};
            __syncthreads();
            i32x4 tot = {0, 0, 0, 0};
#pragma unroll
            for (int w = 0; w < 8; ++w) tot += cw[w];
            T = tot[2] >= cap ? c3 : tot[1] >= cap ? c2 : tot[0] >= cap ? c1 : T;
        }
#else
        for (int bit = 30; bit >= 0; --bit) {
#if CV_TKN
            if ((bit & 3) == 2) {
                if (cv_pend) { p0_item_store(co0, cd0, ck0, F.lane, cva); cv_pend = false; }
                if (cv_left > 0 && cv_it < cv_end) { p0_decode(F, cv_it, cs0, cl0, co0, cd0, ck0); p0_item_load(cs0, cl0, ck0, F.lane, cva); cv_pend = true; cv_it += cv_ngw; }
                --cv_left; }
#endif
            const unsigned cand = T | (1u << bit); int cnt = 0;
#pragma unroll
            for (int i = 0; i < 8; ++i) cnt += __builtin_popcountll(__ballot(key[i] >= cand));
            LAS int* cw = CW + (bit & 1) * 8;
            if (F.lane == 0) cw[F.wave] = cnt;
            __syncthreads();
            int tot = 0;
#pragma unroll
            for (int w = 0; w < 8; ++w) tot += cw[w];
            if (tot >= cap) T = cand;
        }
#endif
#pragma unroll
        for (int i = 0; i < 8; ++i) { const unsigned long long mg = __ballot(key[i] > T), me = __ballot(key[i] == T);
            if (F.lane == 0) { CG[i * 8 + F.wave] = __builtin_popcountll(mg); CE[i * 8 + F.wave] = __builtin_popcountll(me); } }
        __syncthreads();
        int gt_total = 0, g_before = 0, e_before = 0;
        { typedef int i32x4 __attribute__((ext_vector_type(4))); i32x4 cgv[16], cev[16];
#pragma unroll
          for (int k4 = 0; k4 < 16; ++k4) { cgv[k4] = *(const LAS i32x4*)(CG + 4 * k4); cev[k4] = *(const LAS i32x4*)(CE + 4 * k4); }
          const int lim = ch * 8 + F.wave;
#pragma unroll
          for (int k4 = 0; k4 < 16; ++k4)
#pragma unroll
              for (int t = 0; t < 4; ++t) { const int k = 4 * k4 + t; gt_total += cgv[k4][t]; g_before += (k < lim) ? cgv[k4][t] : 0; e_before += (k < lim) ? cev[k4][t] : 0; } }
        const int need = cap - gt_total;
        {
            unsigned kv = 0u;
#pragma unroll
            for (int i = 0; i < 8; ++i) kv = (i == ch) ? key[i] : kv;
            const int t = F.tid + 512 * ch;
            const unsigned long long mg = __ballot(kv > T), me = __ballot(kv == T);
            const unsigned long long lower = (F.lane == 0) ? 0ull : (~0ull >> (64 - F.lane));
            const int g_rank = g_before + __builtin_popcountll(mg & lower), e_rank = e_before + __builtin_popcountll(me & lower);
            const int e_taken_before = e_rank < need ? e_rank : need;
            const bool sel = (t < n) && ((kv > T) || (kv == T && e_rank < need));
            if (t < n) { int s = -1;
                if (sel) { s = slotbase + g_rank + e_taken_before; IDX[s] = rowbase + t; GATE[s] = __uint_as_float(kv); }
                SLOT[(size_t)(rowbase + t) * NE + e] = s; }
        }
        __syncthreads();
    }
#if CV_TKN
    if (cv_pend) p0_item_store(co0, cd0, ck0, F.lane, cva);
    for (; cv_left > 0 && cv_it < cv_end; --cv_left, cv_it += cv_ngw) { p0_decode(F, cv_it, cs0, cl0, co0, cd0, ck0); p0_item_load(cs0, cl0, ck0, F.lane, cva); p0_item_store(co0, cd0, ck0, F.lane, cva); }
#endif
}
__device__ __forceinline__ void gather_phase(Frame& F, int l) {
    const int gw = F.vcu * NWAVES + F.wave, NGW = F.G * NWAVES, nv = l ? 1024 : 1088;
    const GAS bf16* HB = ws_tile(F, T_HB); GAS bf16* XE = ws_tile(F, T_XE); const GAS int* IDX = (const GAS int*)(F.ws + WS_IDX);
    for (int i = gw; i < NE * nv; i += NGW) { const int e = i / nv, s = e * RPE + i % nv; const int src = IDX[s];
        const GAS v4u* sp = (const GAS v4u*)(HB + (size_t)src * D); GAS v4u* dp = (GAS v4u*)(XE + (size_t)s * D);
        v4u t4[4];
#pragma unroll
        for (int j = 0; j < 4; ++j) t4[j] = sp[F.lane + 64 * j];
#pragma unroll
        for (int j = 0; j < 4; ++j) dp[F.lane + 64 * j] = t4[j]; }
}
__device__ __forceinline__ void combine_phase(Frame& F, int l) {
    const int gw = F.vcu * NWAVES + F.wave, NGW = F.G * NWAVES, nrows = (l || CTX_COOP2) ? NLAT : NROWS;
    const GAS float* X1 = (const GAS float*)(F.ws + WS_X1); const GAS bf16* YE = (const GAS bf16*)(F.ws + WS_YE); const GAS int* SLOT = (const GAS int*)(F.ws + WS_SLOT);
    GAS float* X2 = (GAS float*)(F.ws + WS_X2); GAS bf16* HB = ws_tile(F, T_HB);
    const GAS float* lng = fin(F, I_LNG) + (size_t)(l * 2 + 1) * D; const GAS float* lnb = fin(F, I_LNB) + (size_t)(l * 2 + 1) * D;
    LAS float* VL = (LAS float*)F.lds;
    stage_vec(F, VL, lng); stage_vec(F, VL + D, lnb);
#pragma unroll
    for (int r = 0; r < 3; ++r) { stage_vec(F, VL + (2 + r) * D, mods(F, l, r, 5)); if (l == 0) { stage_vec(F, VL + (5 + r) * D, mods(F, 1, r, 0)); stage_vec(F, VL + (8 + r) * D, mods(F, 1, r, 1)); } }
    __syncthreads();
    int svn = (gw < nrows) ? SLOT[(size_t)gw * NE + (F.lane & 15)] : -1;
    for (int row = gw; row < nrows; row += NGW) {
        const int r = row_r(row); const LAS float* g2 = VL + (2 + r) * D;
#if X1_BF16
        const GAS bf16* x1 = (const GAS bf16*)X1 + (size_t)row * D;
#else
        const GAS float* x1 = X1 + (size_t)row * D;
#endif
        f32x4 f[8];
#pragma unroll
        for (int j = 0; j < 8; ++j) f[j] = (f32x4){0.f, 0.f, 0.f, 0.f};
        const int sv = svn;
        if (row + NGW < nrows) svn = SLOT[(size_t)(row + NGW) * NE + (F.lane & 15)];
        f32x4 xv[8], g2v[8];
#if X1_BF16
#pragma unroll
        for (int j = 0; j < 8; ++j) { xv[j] = X1UNPK(*(const GAS v2u*)(x1 + 4 * F.lane + 256 * j)); g2v[j] = LDVL(g2, j); }
#else
#pragma unroll
        for (int j = 0; j < 8; ++j) { xv[j] = LDV(x1, j); g2v[j] = LDVL(g2, j); }
#endif
#pragma unroll
        for (int e = 0; e < NE; ++e) { const int s = __builtin_amdgcn_readlane(sv, e);
            if (s >= 0) { const GAS bf16* yr = YE + (size_t)s * D; v2u t[8];
#pragma unroll
                for (int j = 0; j < 8; ++j) t[j] = *(const GAS v2u*)(yr + 4 * F.lane + 256 * j);
#pragma unroll
                for (int j = 0; j < 8; ++j) f[j] += bf4_to_f32(t[j]); } }
        f32x4 v[8];
#pragma unroll
        for (int j = 0; j < 8; ++j) v[j] = xv[j] * ALPHA + g2v[j] * f[j];
        ln_rows_lds(v, VL, VL + D, F);
        if (l == 0) { const LAS float* sh = VL + (5 + r) * D; const LAS float* sc = VL + (8 + r) * D; v2u hw[8];
#pragma unroll
            for (int j = 0; j < 8; ++j) { const f32x4 h = v[j] * (LDVL(sc, j) + 1.0f) + LDVL(sh, j); hw[j].x = pk2(h[0], h[1]); hw[j].y = pk2(h[2], h[3]); }
#pragma unroll
            for (int j = 0; j < 8; ++j) {
#if NT_STREAM
                __builtin_nontemporal_store(v[j], (GAS f32x4*)(X2 + (size_t)row * D + 4 * F.lane + 256 * j));
#elif X2_FP16
                { v2u xw; xw.x = pkh2(v[j][0], v[j][1]); xw.y = pkh2(v[j][2], v[j][3]); *(GAS v2u*)((GAS bf16*)X2 + (size_t)row * D + 4 * F.lane + 256 * j) = xw; }
#else
                *(GAS f32x4*)(X2 + (size_t)row * D + 4 * F.lane + 256 * j) = v[j];
#endif
                *(GAS v2u*)(HB + (size_t)row * D + 4 * F.lane + 256 * j) = hw[j]; } }
        else {
#pragma unroll
            for (int j = 0; j < 8; ++j) {
#if NT_STREAM
                __builtin_nontemporal_store(v[j], (GAS f32x4*)(F.out + (size_t)row * D + 4 * F.lane + 256 * j));
#else
                *(GAS f32x4*)(F.out + (size_t)row * D + 4 * F.lane + 256 * j) = v[j];
#endif
            } }
    }
#if CTX_COOP2
    if (l == 0) {
        LAS float* PS = (LAS float*)(F.lds + 131072); LAS float* PQ = PS + 8;
        const int rr = F.wave >> 2, qq = F.wave & 3;
        for (int base = 2 * F.vcu; base < NCTX; base += 2 * F.G) {
            const int row = NLAT + base + rr; const GAS float* x1 = X1 + (size_t)row * D; const LAS float* g2 = VL + 4 * D;
            const int sv = SLOT[(size_t)row * NE + (F.lane & 15)];
            f32x4 f[2] = {{0.f, 0.f, 0.f, 0.f}, {0.f, 0.f, 0.f, 0.f}}, xv[2];
#pragma unroll
            for (int jj = 0; jj < 2; ++jj) xv[jj] = LDV(x1, 2 * qq + jj);
#pragma unroll
            for (int e = 0; e < NE; ++e) { const int sl = __builtin_amdgcn_readlane(sv, e);
                if (sl >= 0) { const GAS bf16* yr = YE + (size_t)sl * D; v2u t[2];
#pragma unroll
                    for (int jj = 0; jj < 2; ++jj) t[jj] = *(const GAS v2u*)(yr + 4 * F.lane + 256 * (2 * qq + jj));
#pragma unroll
                    for (int jj = 0; jj < 2; ++jj) f[jj] += bf4_to_f32(t[jj]); } }
            f32x4 v[2];
#pragma unroll
            for (int jj = 0; jj < 2; ++jj) v[jj] = xv[jj] * ALPHA + LDVL(g2, 2 * qq + jj) * f[jj];
            float s1 = (v[0][0] + v[0][1]) + (v[0][2] + v[0][3]) + (v[1][0] + v[1][1]) + (v[1][2] + v[1][3]);
            s1 = wave_sum(s1); if (F.lane == 0) PS[rr * 4 + qq] = s1;
            __syncthreads();
            const float mean = ((PS[rr * 4 + 0] + PS[rr * 4 + 1]) + (PS[rr * 4 + 2] + PS[rr * 4 + 3])) * (1.0f / D);
            float s2 = 0.f;
#pragma unroll
            for (int jj = 0; jj < 2; ++jj) { v[jj] = v[jj] - mean; s2 += (v[jj][0] * v[jj][0] + v[jj][1] * v[jj][1]) + (v[jj][2] * v[jj][2] + v[jj][3] * v[jj][3]); }
            s2 = wave_sum(s2); if (F.lane == 0) PQ[rr * 4 + qq] = s2;
            __syncthreads();
            const float rstd = 1.0f / sqrtf(((PQ[rr * 4 + 0] + PQ[rr * 4 + 1]) + (PQ[rr * 4 + 2] + PQ[rr * 4 + 3])) * (1.0f / D) + LN_EPS);
            const LAS float* sh = VL + 7 * D; const LAS float* sc = VL + 10 * D;
#pragma unroll
            for (int jj = 0; jj < 2; ++jj) { const int j = 2 * qq + jj; v[jj] = v[jj] * rstd * LDVL(VL, j) + LDVL(VL + D, j);
                const f32x4 h = v[jj] * (LDVL(sc, j) + 1.0f) + LDVL(sh, j);
                *(GAS f32x4*)(X2 + (size_t)row * D + 4 * F.lane + 256 * j) = v[jj];
                v2u w; w.x = pk2(h[0], h[1]); w.y = pk2(h[2], h[3]); *(GAS v2u*)(HB + (size_t)row * D + 4 * F.lane + 256 * j) = w; }
            __syncthreads();
        }
    }
#endif
    __syncthreads();
}
__device__ __forceinline__ void s5_naive(Frame& F) {
    const int gw = F.vcu * NWAVES + F.wave, NGW = F.G * NWAVES;
    const GAS float* AR = (const GAS float*)(F.ws + WS_SPAR); const GAS float* AI = AR + 2 * NG * NP; const GAS float* BB = AI + 2 * NG * NP;
    const GAS bf16* HB = ws_tile(F, T_HB);
    for (int un = gw; un < 2 * NG * 2; un += NGW) {
        const int b = un >> 8, g = (un >> 1) & 127, dir = un & 1; const int idx = (dir * NG + g) * NP + F.lane;
        const float ar = AR[idx], ai = AI[idx]; float br[GH], bi[GH], cr[GH], ci[GH];
#pragma unroll
        for (int h = 0; h < GH; ++h) { br[h] = BB[(size_t)idx * 32 + h]; bi[h] = BB[(size_t)idx * 32 + 16 + h];
            cr[h] = fin(F, I_CRE)[((size_t)(dir * NG + g) * GH + h) * NP + F.lane]; ci[h] = fin(F, I_CIM)[((size_t)(dir * NG + g) * GH + h) * NP + F.lane]; }
        GAS float* Y = (GAS float*)(F.ws + (dir ? WS_YB : WS_YF));
        float xr = 0.f, xi = 0.f;
        for (int tau = 0; tau < CTXL + SEQ; ++tau) {
            int row; if (tau < CTXL) row = NLAT + b * CTXL + (dir ? CTXL - 1 - tau : tau); else row = b * SEQ + (dir ? SEQ - 1 - (tau - CTXL) : tau - CTXL);
            const v4u u0 = *(const GAS v4u*)(HB + (size_t)row * D + g * GH), u1 = *(const GAS v4u*)(HB + (size_t)row * D + g * GH + 8);
            float u[GH];
#pragma unroll
            for (int q = 0; q < 4; ++q) { u[2 * q] = bf2f(u0[q] & 0xffffu); u[2 * q + 1] = bf2f(u0[q] >> 16); u[8 + 2 * q] = bf2f(u1[q] & 0xffffu); u[8 + 2 * q + 1] = bf2f(u1[q] >> 16); }
            float pr = 0.f, pi = 0.f;
#pragma unroll
            for (int h = 0; h < GH; ++h) { pr += br[h] * u[h]; pi += bi[h] * u[h]; }
            const float nxr = ar * xr - ai * xi + pr, nxi = ar * xi + ai * xr + pi; xr = nxr; xi = nxi;
            if (tau >= CTXL) { float mine = 0.f;
#pragma unroll
                for (int h = 0; h < GH; ++h) { const float y = wave_sum(cr[h] * xr - ci[h] * xi); mine = (F.lane == h) ? y : mine; }
                if (F.lane < GH) Y[(size_t)row * D + g * GH + F.lane] = mine; }
        }
    }
}
__device__ __forceinline__ void zprep_phase(Frame& F) {
    const int gw = F.vcu * NWAVES + F.wave, NGW = F.G * NWAVES;
    const GAS float* X2 = (const GAS float*)(F.ws + WS_X2); const GAS bf16* YF = (const GAS bf16*)(F.ws + WS_YF); const GAS bf16* YB = (const GAS bf16*)(F.ws + WS_YB); GAS bf16* Z = ws_tile(F, T_Z);
    const GAS float* dsk = fin(F, I_SD);
    for (int row = gw; row < NLAT; row += NGW) {
        const int r = row >> 12; const GAS float* sh = mods(F, 1, r, 0); const GAS float* sc = mods(F, 1, r, 1);
        const GAS float* x2 = X2 + (size_t)row * D; const GAS bf16* yf = YF + (size_t)row * D; const GAS bf16* yb = YB + (size_t)row * D;
        f32x4 xv[8]; v2u fv[8], bv[8];
#pragma unroll
        for (int j = 0; j < 8; ++j) { xv[j] = LDV(x2, j); fv[j] = *(const GAS v2u*)(yf + 4 * F.lane + 256 * j); bv[j] = *(const GAS v2u*)(yb + 4 * F.lane + 256 * j); }
        v2u zo[8];
#pragma unroll
        for (int j = 0; j < 8; ++j) { const f32x4 u = xv[j] * (LDV(sc, j) + 1.0f) + LDV(sh, j); const f32x4 y = LDV(dsk, j) * u + bf4_to_f32(fv[j]) + bf4_to_f32(bv[j]);
            zo[j].x = pk2(gelu_tanh_f(y[0]), gelu_tanh_f(y[1])); zo[j].y = pk2(gelu_tanh_f(y[2]), gelu_tanh_f(y[3])); }
#pragma unroll
        for (int j = 0; j < 8; ++j) *(GAS v2u*)(Z + (size_t)row * D + 4 * F.lane + 256 * j) = zo[j];
    }
}

constexpr int S5_T = 34, S5_NCH = 128;
typedef float f32x4s __attribute__((ext_vector_type(4)));
struct S5Consts { bf16x8 abu[8]; float ar[4][4], ai[4][4]; };
__device__ __forceinline__ void s5_load_consts(const Frame& F, int gd, int lane, S5Consts& K) {
    const GAS float* AR = (const GAS float*)(F.ws + WS_SPAR); const GAS float* AI = AR + 2 * NG * NP; const GAS float* BB = AI + 2 * NG * NP;
    const int m = lane & 15, q = lane >> 4;
#pragma unroll
    for (int tt = 0; tt < 8; ++tt) { const int p = 16 * (tt >> 1) + m; v4u w = {0u, 0u, 0u, 0u};
        if (q < 2) { const GAS float* s = BB + (size_t)(gd * NP + p) * 32 + (tt & 1) * 16 + 8 * q; const f32x4 x0 = *(const GAS f32x4*)s, x1 = *(const GAS f32x4*)(s + 4);
            w.x = pk2(x0[0], x0[1]); w.y = pk2(x0[2], x0[3]); w.z = pk2(x1[0], x1[1]); w.w = pk2(x1[2], x1[3]); }
        K.abu[tt] = __builtin_bit_cast(bf16x8, w); }
#pragma unroll
    for (int pb = 0; pb < 4; ++pb) { const f32x4 a = *(const GAS f32x4*)(AR + gd * NP + 16 * pb + 4 * q), b = *(const GAS f32x4*)(AI + gd * NP + 16 * pb + 4 * q);
#pragma unroll
        for (int i = 0; i < 4; ++i) { K.ar[pb][i] = a[i]; K.ai[pb][i] = b[i]; } }
}
__device__ __forceinline__ int s5_row(int b, int dir, int tau) {
    const int ctxrow = NLAT + b * CTXL + (dir ? CTXL - 1 - tau : tau), latrow = b * SEQ + (dir ? (CTXL + SEQ - 1) - tau : tau - CTXL);
    return tau < CTXL ? ctxrow : latrow;
}
constexpr int S5_XP = 132;
template <bool READOUT>
__device__ __forceinline__ void s5_run(Frame& F, const S5Consts& K, const bf16x8 (&cfr)[4], int gd, int cg, LAS float* XS) {
    const int lane = F.lane, n = lane & 15, q = lane >> 4, dir = gd >> 7, g = gd & 127;
    const GAS bf16* HB = ws_tile(F, T_HB);
    GAS bf16* Y = (GAS bf16*)(F.ws + (dir ? WS_YB : WS_YF));
    const int chunk = cg * 16 + n, b = chunk >> 7, c = chunk & 127, tau0 = c * S5_T;
    LAS float* xs = XS + chunk * S5_XP + 8 * q;
    f32x4s X[8];
    if (READOUT) {
#pragma unroll
        for (int pb = 0; pb < 4; ++pb) { const f32x4 v0 = *(const LAS f32x4*)(xs + 32 * pb), v1 = *(const LAS f32x4*)(xs + 32 * pb + 4);
            X[2 * pb] = (f32x4s){v0[0], v0[2], v1[0], v1[2]}; X[2 * pb + 1] = (f32x4s){v0[1], v0[3], v1[1], v1[3]}; }
    } else {
#pragma unroll
        for (int tt = 0; tt < 8; ++tt) X[tt] = (f32x4s){0.f, 0.f, 0.f, 0.f};
    }
    constexpr int PD = 6;
    v4u ur[PD];
    const GAS bf16* ucol = HB + g * GH + 8 * q;
#pragma unroll
    for (int t = 0; t < PD; ++t) { ur[t] = (v4u){0u, 0u, 0u, 0u}; if (q < 2) ur[t] = *(const GAS v4u*)(ucol + (size_t)s5_row(b, dir, tau0 + t) * D); }
#define S5_STEP(KS, T, REFILL) do { \
        const bf16x8 ub = __builtin_bit_cast(bf16x8, ur[KS]); \
        if (REFILL) { ur[KS] = (v4u){0u, 0u, 0u, 0u}; if (q < 2) ur[KS] = *(const GAS v4u*)(ucol + (size_t)s5_row(b, dir, tau0 + (T) + PD) * D); } \
        _Pragma("unroll") for (int pb = 0; pb < 4; ++pb) _Pragma("unroll") for (int i = 0; i < 4; ++i) { const float re = X[2 * pb][i], im = X[2 * pb + 1][i]; \
            X[2 * pb][i] = K.ar[pb][i] * re - K.ai[pb][i] * im; X[2 * pb + 1][i] = K.ar[pb][i] * im + K.ai[pb][i] * re; } \
        _Pragma("unroll") for (int tt = 0; tt < 8; ++tt) X[tt] = __builtin_amdgcn_mfma_f32_16x16x32_bf16(K.abu[tt], ub, X[tt], 0, 0, 0); \
        if (READOUT) { f32x4s y0 = {0.f, 0.f, 0.f, 0.f}, y1 = y0; \
            _Pragma("unroll") for (int s = 0; s < 4; ++s) { v4u w; w.x = pk2(X[2 * s][0], X[2 * s][1]); w.y = pk2(X[2 * s][2], X[2 * s][3]); w.z = pk2(X[2 * s + 1][0], X[2 * s + 1][1]); w.w = pk2(X[2 * s + 1][2], X[2 * s + 1][3]); \
                const bf16x8 xb = __builtin_bit_cast(bf16x8, w); \
                if (s & 1) y1 = __builtin_amdgcn_mfma_f32_16x16x32_bf16(cfr[s], xb, y1, 0, 0, 0); else y0 = __builtin_amdgcn_mfma_f32_16x16x32_bf16(cfr[s], xb, y0, 0, 0, 0); } \
            const int tau = tau0 + (T); \
            if (tau >= CTXL) { const f32x4s y = y0 + y1; v2u w; w.x = pk2(y[0], y[1]); w.y = pk2(y[2], y[3]); *(GAS v2u*)(Y + (size_t)s5_row(b, dir, tau) * D + g * GH + 4 * q) = w; } } \
    } while (0)
#pragma unroll 1
    for (int t0 = 0; t0 < 24; t0 += PD) {
        S5_STEP(0, t0 + 0, true); S5_STEP(1, t0 + 1, true); S5_STEP(2, t0 + 2, true); S5_STEP(3, t0 + 3, true); S5_STEP(4, t0 + 4, true); S5_STEP(5, t0 + 5, true); }
    S5_STEP(0, 24, true); S5_STEP(1, 25, true); S5_STEP(2, 26, true); S5_STEP(3, 27, true); S5_STEP(4, 28, false); S5_STEP(5, 29, false);
    S5_STEP(0, 30, false); S5_STEP(1, 31, false); S5_STEP(2, 32, false); S5_STEP(3, 33, false);
#undef S5_STEP
    if (!READOUT) {
#pragma unroll
        for (int pb = 0; pb < 4; ++pb) { const f32x4s re = X[2 * pb], im = X[2 * pb + 1];
            *(LAS f32x4*)(xs + 32 * pb) = (f32x4){re[0], im[0], re[1], im[1]}; *(LAS f32x4*)(xs + 32 * pb + 4) = (f32x4){re[2], im[2], re[3], im[3]}; }
    }
}
__device__ __forceinline__ void s5_fused(Frame& F) {
    LAS float* XS = (LAS float*)F.lds;
    LAS f32x2* AG = (LAS f32x2*)(F.lds + 256 * S5_XP * 4);
    const GAS float* AR = (const GAS float*)(F.ws + WS_SPAR); const GAS float* AI = AR + 2 * NG * NP;
    const int lane = F.lane, n = lane & 15, q = lane >> 4, seg = F.tid >> 6, p = F.tid & 63;
    for (int gd = F.vcu; gd < 2 * NG; gd += F.G) {
        S5Consts K; s5_load_consts(F, gd, lane, K);
        bf16x8 cz[4];
#pragma unroll
        for (int s = 0; s < 4; ++s) cz[s] = (bf16x8){0, 0, 0, 0, 0, 0, 0, 0};
#pragma unroll 1
        for (int k2 = 0; k2 < 2; ++k2) s5_run<false>(F, K, cz, gd, F.wave * 2 + k2, XS);
        __syncthreads();
        {
            const double ar = AR[gd * NP + p], ai = AI[gd * NP + p];
            double sr = ar, si = ai, t; t = sr * sr - si * si; si = 2.0 * sr * si; sr = t;
            double pr = sr, pi = si;
            for (int k = 0; k < 4; ++k) { t = sr * sr - si * si; si = 2.0 * sr * si; sr = t; }
            t = pr * sr - pi * si; pi = pr * si + pi * sr; pr = t;
            const float tr = (float)pr, ti = (float)pi;
            double qr = pr, qi = pi; for (int k = 0; k < 4; ++k) { t = qr * qr - qi * qi; qi = 2.0 * qr * qi; qr = t; }
            const float t16r = (float)qr, t16i = (float)qi;
            for (int b = 0; b < 2; ++b) {
                LAS float* xs = XS + (b * S5_NCH + seg * 16) * S5_XP + 2 * p;
                f32x2 loc[16];
#pragma unroll
                for (int k = 0; k < 16; ++k) loc[k] = *(const LAS f32x2*)(xs + k * S5_XP);
                float ar_ = 0.f, ai_ = 0.f;
#pragma unroll
                for (int k = 0; k < 16; ++k) { const float nr = tr * ar_ - ti * ai_ + loc[k][0], ni = tr * ai_ + ti * ar_ + loc[k][1]; ar_ = nr; ai_ = ni; }
                AG[seg * 64 + p] = (f32x2){ar_, ai_};
                __syncthreads();
                float cr = 0.f, ci = 0.f;
                for (int s2 = 0; s2 < seg; ++s2) { const f32x2 a = AG[s2 * 64 + p]; const float nr = t16r * cr - t16i * ci + a[0], ni = t16r * ci + t16i * cr + a[1]; cr = nr; ci = ni; }
#pragma unroll
                for (int k = 0; k < 16; ++k) { *(LAS f32x2*)(xs + k * S5_XP) = (f32x2){cr, ci};
                    const float nr = tr * cr - ti * ci + loc[k][0], ni = tr * ci + ti * cr + loc[k][1]; cr = nr; ci = ni; }
                __syncthreads();
            }
        }
        bf16x8 cfr[4];
#pragma unroll
        for (int s = 0; s < 4; ++s) { const GAS float* cr = fin(F, I_CRE) + (size_t)(gd * GH + n) * NP + 16 * s + 4 * q; const GAS float* ci = fin(F, I_CIM) + (size_t)(gd * GH + n) * NP + 16 * s + 4 * q;
            const f32x4 a = *(const GAS f32x4*)cr, b = *(const GAS f32x4*)ci; v4u w; w.x = pk2(a[0], a[1]); w.y = pk2(a[2], a[3]); w.z = pk2(-b[0], -b[1]); w.w = pk2(-b[2], -b[3]);
            cfr[s] = __builtin_bit_cast(bf16x8, w); }
#pragma unroll 1
        for (int k2 = 0; k2 < 2; ++k2) s5_run<true>(F, K, cfr, gd, F.wave * 2 + k2, XS);
        __syncthreads();
    }
}

template <int MODE>
__device__ __forceinline__ void s5z_run(Frame& F, const S5Consts& K, const bf16x8 (&cfr)[4], int g, int dir, int b, int cgl, LAS float* XS) {
    constexpr bool READOUT = MODE != 0;
    const int lane = F.lane, n = lane & 15, q = lane >> 4;
    const GAS bf16* HB = ws_tile(F, T_HB);
    GAS bf16* YF = (GAS bf16*)(F.ws + WS_YF); GAS bf16* Z = ws_tile(F, T_Z);
    const int c = cgl * 16 + n, tau0 = c * S5_T;
    LAS float* xs = XS + (dir * S5_NCH + c) * S5_XP + 8 * q;
    f32x4s X[8];
    if (READOUT) {
#pragma unroll
        for (int pb = 0; pb < 4; ++pb) { const f32x4 v0 = *(const LAS f32x4*)(xs + 32 * pb), v1 = *(const LAS f32x4*)(xs + 32 * pb + 4);
            X[2 * pb] = (f32x4s){v0[0], v0[2], v1[0], v1[2]}; X[2 * pb + 1] = (f32x4s){v0[1], v0[3], v1[1], v1[3]}; }
    } else {
#pragma unroll
        for (int tt = 0; tt < 8; ++tt) X[tt] = (f32x4s){0.f, 0.f, 0.f, 0.f};
    }
    f32x4 dsk = {0.f, 0.f, 0.f, 0.f};
    if (MODE == 2) dsk = *(const GAS f32x4*)(fin(F, I_SD) + g * GH + 4 * q);
    constexpr int PD = 6;
    v4u ur[PD];
    const GAS bf16* ucol = HB + g * GH + 8 * q;
#pragma unroll
    for (int t = 0; t < PD; ++t) { ur[t] = (v4u){0u, 0u, 0u, 0u}; if (q < 2) ur[t] = *(const GAS v4u*)(ucol + (size_t)s5_row(b, dir, tau0 + t) * D); }
    unsigned long long yfn = 0ull, un = 0ull;
    if (MODE == 2) { const int tau = tau0; if (tau >= CTXL) { const size_t o = (size_t)s5_row(b, dir, tau) * D + g * GH + 4 * q;
        yfn = __hip_atomic_load((const GAS unsigned long long*)(YF + o), __ATOMIC_RELAXED, __HIP_MEMORY_SCOPE_AGENT); un = *(const GAS unsigned long long*)(HB + o); } }
#define S5Z_STEP(KS, T, REFILL) do { \
        const bf16x8 ub = __builtin_bit_cast(bf16x8, ur[KS]); \
        if (REFILL) { ur[KS] = (v4u){0u, 0u, 0u, 0u}; if (q < 2) ur[KS] = *(const GAS v4u*)(ucol + (size_t)s5_row(b, dir, tau0 + (T) + PD) * D); } \
        const unsigned long long yfc = yfn, uc = un; \
        if (MODE == 2) { const int tn_ = tau0 + (T) + 1; if ((T) + 1 < S5_T && tn_ >= CTXL) { const size_t o_ = (size_t)s5_row(b, dir, tn_) * D + g * GH + 4 * q; \
            yfn = __hip_atomic_load((const GAS unsigned long long*)(YF + o_), __ATOMIC_RELAXED, __HIP_MEMORY_SCOPE_AGENT); un = *(const GAS unsigned long long*)(HB + o_); } } \
        _Pragma("unroll") for (int pb = 0; pb < 4; ++pb) _Pragma("unroll") for (int i = 0; i < 4; ++i) { const float re = X[2 * pb][i], im = X[2 * pb + 1][i]; \
            X[2 * pb][i] = K.ar[pb][i] * re - K.ai[pb][i] * im; X[2 * pb + 1][i] = K.ar[pb][i] * im + K.ai[pb][i] * re; } \
        _Pragma("unroll") for (int tt = 0; tt < 8; ++tt) X[tt] = __builtin_amdgcn_mfma_f32_16x16x32_bf16(K.abu[tt], ub, X[tt], 0, 0, 0); \
        if (READOUT) { f32x4s y0 = {0.f, 0.f, 0.f, 0.f}, y1 = y0; \
            _Pragma("unroll") for (int s = 0; s < 4; ++s) { v4u w; w.x = pk2(X[2 * s][0], X[2 * s][1]); w.y = pk2(X[2 * s][2], X[2 * s][3]); w.z = pk2(X[2 * s + 1][0], X[2 * s + 1][1]); w.w = pk2(X[2 * s + 1][2], X[2 * s + 1][3]); \
                const bf16x8 xb = __builtin_bit_cast(bf16x8, w); \
                if (s & 1) y1 = __builtin_amdgcn_mfma_f32_16x16x32_bf16(cfr[s], xb, y1, 0, 0, 0); else y0 = __builtin_amdgcn_mfma_f32_16x16x32_bf16(cfr[s], xb, y0, 0, 0, 0); } \
            const int tau = tau0 + (T); \
            if (tau >= CTXL) { f32x4s y = y0 + y1; const size_t o = (size_t)s5_row(b, dir, tau) * D + g * GH + 4 * q; \
                if (MODE == 2) { const f32x4 yf4 = bf4_to_f32((v2u){(unsigned)yfc, (unsigned)(yfc >> 32)}), u4 = bf4_to_f32((v2u){(unsigned)uc, (unsigned)(uc >> 32)}); \
                    _Pragma("unroll") for (int e = 0; e < 4; ++e) y[e] = gelu_tanh_f(dsk[e] * u4[e] + yf4[e] + y[e]); \
                    v2u w; w.x = pk2(y[0], y[1]); w.y = pk2(y[2], y[3]); *(GAS v2u*)(Z + o) = w; } \
                else { v2u w; w.x = pk2(y[0], y[1]); w.y = pk2(y[2], y[3]); *(GAS v2u*)(YF + o) = w; } } } \
    } while (0)
#pragma unroll 1
    for (int t0 = 0; t0 < 24; t0 += PD) {
        S5Z_STEP(0, t0 + 0, true); S5Z_STEP(1, t0 + 1, true); S5Z_STEP(2, t0 + 2, true); S5Z_STEP(3, t0 + 3, true); S5Z_STEP(4, t0 + 4, true); S5Z_STEP(5, t0 + 5, true); }
    S5Z_STEP(0, 24, true); S5Z_STEP(1, 25, true); S5Z_STEP(2, 26, true); S5Z_STEP(3, 27, true); S5Z_STEP(4, 28, false); S5Z_STEP(5, 29, false);
    S5Z_STEP(0, 30, false); S5Z_STEP(1, 31, false); S5Z_STEP(2, 32, false); S5Z_STEP(3, 33, false);
#undef S5Z_STEP
    if (!READOUT) {
#pragma unroll
        for (int pb = 0; pb < 4; ++pb) { const f32x4s re = X[2 * pb], im = X[2 * pb + 1];
            *(LAS f32x4*)(xs + 32 * pb) = (f32x4){re[0], im[0], re[1], im[1]}; *(LAS f32x4*)(xs + 32 * pb + 4) = (f32x4){re[2], im[2], re[3], im[3]}; }
    }
}
__device__ __forceinline__ void s5z_load_cfr(const Frame& F, int gd, int lane, bf16x8 (&cfr)[4]) {
    const int n = lane & 15, q = lane >> 4;
#pragma unroll
    for (int s = 0; s < 4; ++s) { const GAS float* cr = fin(F, I_CRE) + (size_t)(gd * GH + n) * NP + 16 * s + 4 * q; const GAS float* ci = fin(F, I_CIM) + (size_t)(gd * GH + n) * NP + 16 * s + 4 * q;
        const f32x4 a = *(const GAS f32x4*)cr, b = *(const GAS f32x4*)ci; v4u w; w.x = pk2(a[0], a[1]); w.y = pk2(a[2], a[3]); w.z = pk2(-b[0], -b[1]); w.w = pk2(-b[2], -b[3]);
        cfr[s] = __builtin_bit_cast(bf16x8, w); }
}
__device__ __forceinline__ void s5z_fused(Frame& F) {
    LAS float* XS = (LAS float*)F.lds;
    LAS f32x2* AG = (LAS f32x2*)(F.lds + 256 * S5_XP * 4);
    const GAS float* AR = (const GAS float*)(F.ws + WS_SPAR); const GAS float* AI = AR + 2 * NG * NP;
    const int lane = F.lane, seg = F.tid >> 6, p = F.tid & 63;
    for (int wu = F.vcu; wu < 2 * NG; wu += F.G) {
        const int g = wu & 127, b = wu >> 7;
        bf16x8 cz[4];
#pragma unroll
        for (int s = 0; s < 4; ++s) cz[s] = (bf16x8){0, 0, 0, 0, 0, 0, 0, 0};
#pragma unroll 1
        for (int dir = 0; dir < 2; ++dir) { S5Consts K; s5_load_consts(F, dir * NG + g, lane, K); s5z_run<0>(F, K, cz, g, dir, b, F.wave, XS); }
        __syncthreads();
#pragma unroll 1
        for (int dir = 0; dir < 2; ++dir) {
            const int gd = dir * NG + g;
            const double ar = AR[gd * NP + p], ai = AI[gd * NP + p];
            double sr = ar, si = ai, t; t = sr * sr - si * si; si = 2.0 * sr * si; sr = t;
            double pr = sr, pi = si;
            for (int k = 0; k < 4; ++k) { t = sr * sr - si * si; si = 2.0 * sr * si; sr = t; }
            t = pr * sr - pi * si; pi = pr * si + pi * sr; pr = t;
            const float tr = (float)pr, ti = (float)pi;
            double qr = pr, qi = pi; for (int k = 0; k < 4; ++k) { t = qr * qr - qi * qi; qi = 2.0 * qr * qi; qr = t; }
            const float t16r = (float)qr, t16i = (float)qi;
            LAS float* xs = XS + (dir * S5_NCH + seg * 16) * S5_XP + 2 * p;
            f32x2 loc[16];
#pragma unroll
            for (int k = 0; k < 16; ++k) loc[k] = *(const LAS f32x2*)(xs + k * S5_XP);
            float ar_ = 0.f, ai_ = 0.f;
#pragma unroll
            for (int k = 0; k < 16; ++k) { const float nr = tr * ar_ - ti * ai_ + loc[k][0], ni = tr * ai_ + ti * ar_ + loc[k][1]; ar_ = nr; ai_ = ni; }
            AG[seg * 64 + p] = (f32x2){ar_, ai_};
            __syncthreads();
            float cr = 0.f, ci = 0.f;
            for (int s2 = 0; s2 < seg; ++s2) { const f32x2 a = AG[s2 * 64 + p]; const float nr = t16r * cr - t16i * ci + a[0], ni = t16r * ci + t16i * cr + a[1]; cr = nr; ci = ni; }
#pragma unroll
            for (int k = 0; k < 16; ++k) { *(LAS f32x2*)(xs + k * S5_XP) = (f32x2){cr, ci};
                const float nr = tr * cr - ti * ci + loc[k][0], ni = tr * ci + ti * cr + loc[k][1]; cr = nr; ci = ni; }
            __syncthreads();
        }
        { S5Consts K; s5_load_consts(F, g, lane, K); bf16x8 cfr[4]; s5z_load_cfr(F, g, lane, cfr); s5z_run<1>(F, K, cfr, g, 0, b, F.wave, XS); }
        asm volatile("s_waitcnt vmcnt(0)" ::: "memory");
        __syncthreads();
        { S5Consts K; s5_load_consts(F, NG + g, lane, K); bf16x8 cfr[4]; s5z_load_cfr(F, NG + g, lane, cfr); s5z_run<2>(F, K, cfr, g, 1, b, F.wave, XS); }
        __syncthreads();
    }
}

constexpr int ATT_KP = 272, ATT_VP = 528, ATT_VOFF = 256 * ATT_KP;
constexpr int ATT_RPOFF = ATT_VOFF + 128 * ATT_VP;
__device__ __forceinline__ void attn_unit(Frame& F, bool lat, int b, int h, int r, int j, int qrow0, int dv) {
    const int lane = F.lane, n = lane & 15, qd = lane >> 4;
    const GAS bf16* QK = ws_tile(F, T_QK); const GAS bf16* VT = ws_tile(F, T_VT); GAS bf16* AO = ws_tile(F, T_AO);
    const float scale = 0.08838834764831845f * 1.4426950408889634f, NEG = -3.0e38f;
    const int mkey = 8 * (n >> 2) + (n & 3);
    unsigned kb_ = (unsigned)(n * ATT_KP + 16 * qd), vb_ = (unsigned)(ATT_VOFF + n * ATT_VP + 16 * qd);
    asm volatile("" : "+v"(kb_), "+v"(vb_));
    const LAS unsigned char* kbase = F.lds + kb_; const LAS unsigned char* vbase = F.lds + vb_;
    const LAS float* RP = (const LAS float*)(F.lds + ATT_RPOFF);
    bf16x8 qf[4];
    { const GAS bf16* qp = QK + (size_t)(qrow0 + n) * 4096 + h * HD + 8 * qd;
#pragma unroll
      for (int kk = 0; kk < 4; ++kk) qf[kk] = *(const GAS bf16x8*)(qp + 32 * kk); }
    const int rs = min(max(r - 4, 0), 56), cs = min(max(16 * j - 8, 0), 32), qc = 16 * j + n, cst = min(max(qc - 8, 0), 48);
    float S[16][2][4];
    float mx = NEG;
    bf16x8 kf[2][4];
    if (lat && !(dv & 1)) {
        const GAS bf16* kp = QK + (size_t)(b * SEQ + (rs + (n >> 2)) * 64 + cs + (n & 3)) * 4096 + D + h * HD + 8 * qd;
#pragma unroll
        for (int kk = 0; kk < 4; ++kk) kf[0][kk] = *(const GAS bf16x8*)(kp + 32 * kk);
#pragma unroll
        for (int st = 0; st < 16; ++st) { const int blk = st >> 1, hf = st & 1, cg = blk >> 1, rh = blk & 1;
            if (st + 1 < 16) { constexpr int dummy_ = 0; (void)dummy_;
                const int s1 = st + 1, o1 = ((s1 >> 1) & 1) * 256 + (s1 >> 2) * 8 + (s1 & 1) * 4, o0 = rh * 256 + cg * 8 + hf * 4;
                kp += (ptrdiff_t)(o1 - o0) * 4096; asm volatile("" : "+v"(kp));
#pragma unroll
                for (int kk = 0; kk < 4; ++kk) kf[(st + 1) & 1][kk] = *(const GAS bf16x8*)(kp + 32 * kk); }
            f32x4 acc = {0.f, 0.f, 0.f, 0.f};
#pragma unroll
            for (int kk = 0; kk < 4; ++kk) acc = __builtin_amdgcn_mfma_f32_16x16x32_bf16(kf[st & 1][kk], qf[kk], acc, 0, 0, 0);
#pragma unroll
            for (int i = 0; i < 4; ++i) { const int kc = cs + 8 * cg + 4 * hf + i; const bool valid = (unsigned)(kc - cst) < 16u;
                const float sc = acc[i] * scale + RP[(rs + 4 * rh + qd - r + 7) * 31 + (kc - qc + 15)]; const float sv = valid ? sc : NEG;
                S[blk][hf][i] = sv; mx = fmaxf(mx, sv); }
            __builtin_amdgcn_sched_barrier(0); }
    } else {
#pragma unroll
        for (int blk = 0; blk < 8; ++blk)
#pragma unroll
            for (int hf = 0; hf < 2; ++hf)
#pragma unroll
                for (int i = 0; i < 4; ++i) S[blk][hf][i] = NEG;
    }
    if (dv & 2) {
#pragma unroll
        for (int blk = 8; blk < 16; ++blk)
#pragma unroll
            for (int hf = 0; hf < 2; ++hf)
#pragma unroll
                for (int i = 0; i < 4; ++i) { S[blk][hf][i] = 0.f; mx = fmaxf(mx, 0.f); }
    } else {
#pragma unroll
    for (int kk = 0; kk < 4; ++kk) kf[0][kk] = *(const LAS bf16x8*)(kbase + 64 * kk);
#pragma unroll
    for (int st = 0; st < 16; ++st) { const int blk = 8 + (st >> 1), hf = st & 1;
        if (st + 1 < 16) { const LAS unsigned char* kp = kbase + (16 * (st + 1)) * ATT_KP;
#pragma unroll
            for (int kk = 0; kk < 4; ++kk) kf[(st + 1) & 1][kk] = *(const LAS bf16x8*)(kp + 64 * kk); }
        f32x4 acc = {0.f, 0.f, 0.f, 0.f};
#pragma unroll
        for (int kk = 0; kk < 4; ++kk) acc = __builtin_amdgcn_mfma_f32_16x16x32_bf16(kf[st & 1][kk], qf[kk], acc, 0, 0, 0);
#pragma unroll
        for (int i = 0; i < 4; ++i) { const float sv = acc[i] * scale; S[blk][hf][i] = sv; mx = fmaxf(mx, sv); }
        __builtin_amdgcn_sched_barrier(0); }
    }
    mx = fmaxf(mx, __shfl_xor(mx, 16)); mx = fmaxf(mx, __shfl_xor(mx, 32));
    float sum = 0.f; bf16x8 pf[16];
#pragma unroll
    for (int blk = 0; blk < 16; ++blk) { float p[8];
#pragma unroll
        for (int hf = 0; hf < 2; ++hf)
#pragma unroll
            for (int i = 0; i < 4; ++i) { const float e = __builtin_amdgcn_exp2f(S[blk][hf][i] - mx); p[4 * hf + i] = e; sum += e; }
        v4u w; w.x = pk2(p[0], p[1]); w.y = pk2(p[2], p[3]); w.z = pk2(p[4], p[5]); w.w = pk2(p[6], p[7]); pf[blk] = __builtin_bit_cast(bf16x8, w); }
    sum += __shfl_xor(sum, 16); sum += __shfl_xor(sum, 32);
    const float inv = 1.0f / sum;
    f32x4 O[8];
#pragma unroll
    for (int dt = 0; dt < 8; ++dt) O[dt] = (f32x4){0.f, 0.f, 0.f, 0.f};
    bf16x8 vf[2][8];
    if (lat && !(dv & 4)) {
        const GAS bf16* vloc = (dv & 16) ? VT + (size_t)n * NROWS + qd * 8 : VT + (size_t)(h * HD + n) * NROWS + b * SEQ + (cs >> 3) * 512 + (rs + qd) * 8;
        bf16x8 vr[3][8];
#pragma unroll
        for (int dt = 0; dt < 8; ++dt) vr[0][dt] = *(const GAS bf16x8*)(vloc + (size_t)dt * 16 * NROWS);
#pragma unroll
        for (int dt = 0; dt < 8; ++dt) vr[1][dt] = *(const GAS bf16x8*)(vloc + 32 + (size_t)dt * 16 * NROWS);
#pragma unroll
        for (int blk = 0; blk < 8; ++blk) {
            if (blk + 2 < 8) { const int o2 = ((blk + 2) >> 1) * 512 + ((blk + 2) & 1) * 32;
#pragma unroll
                for (int dt = 0; dt < 8; ++dt) vr[(blk + 2) % 3][dt] = *(const GAS bf16x8*)(vloc + o2 + (size_t)dt * 16 * NROWS); }
#pragma unroll
            for (int dt = 0; dt < 8; ++dt) O[dt] = __builtin_amdgcn_mfma_f32_16x16x32_bf16(vr[blk % 3][dt], pf[blk], O[dt], 0, 0, 0);
            __builtin_amdgcn_sched_barrier(0); }
    }
    if (!(dv & 8)) {
#pragma unroll
    for (int dt = 0; dt < 8; ++dt) vf[0][dt] = *(const LAS bf16x8*)(vbase + dt * 16 * ATT_VP);
#pragma unroll
    for (int cb = 0; cb < 8; ++cb) {
        if (cb + 1 < 8) {
#pragma unroll
            for (int dt = 0; dt < 8; ++dt) vf[(cb + 1) & 1][dt] = *(const LAS bf16x8*)(vbase + 64 * (cb + 1) + dt * 16 * ATT_VP); }
#pragma unroll
        for (int dt = 0; dt < 8; ++dt) O[dt] = __builtin_amdgcn_mfma_f32_16x16x32_bf16(vf[cb & 1][dt], pf[8 + cb], O[dt], 0, 0, 0);
        __builtin_amdgcn_sched_barrier(0); }
    }
    GAS bf16* op = AO + (size_t)(qrow0 + n) * D + h * HD + 4 * qd;
#pragma unroll
    for (int dt = 0; dt < 8; ++dt) { v2u w; w.x = pk2(O[dt][0] * inv, O[dt][1] * inv); w.y = pk2(O[dt][2] * inv, O[dt][3] * inv); *(GAS v2u*)(op + 16 * dt) = w; }
}
__device__ __forceinline__ void attn_phase2(Frame& F, int dv) {
    const GAS bf16* QK = ws_tile(F, T_QK); const GAS bf16* VT = ws_tile(F, T_VT);
    for (int wu = F.vcu; wu < 2 * NH * 8; wu += F.G) {
        const int b = wu >> 7, h = (wu >> 3) & 15, ro = wu & 7;
        int tid_ = F.tid; asm volatile("" : "+v"(tid_));
#pragma unroll 2
        for (int i = 0; i < 8; ++i) { const int pc = tid_ + NTHREADS * i;
            { const int key = pc >> 4, c = pc & 15, rho = (key & ~31) + 16 * ((key >> 2) & 1) + 4 * ((key >> 3) & 3) + (key & 3);
              *(LAS v4u*)(F.lds + rho * ATT_KP + 16 * c) = *(const GAS v4u*)(QK + (size_t)(NLAT + b * CTXL + key) * 4096 + D + h * HD + 8 * c); }
            { const int dh = pc >> 5, c = pc & 31;
              *(LAS v4u*)(F.lds + ATT_VOFF + dh * ATT_VP + 16 * c) = *(const GAS v4u*)(VT + (size_t)(h * HD + dh) * NROWS + NLAT + b * CTXL + 8 * c); } }
        for (int i = tid_; i < 15 * 31; i += NTHREADS) ((LAS float*)(F.lds + ATT_RPOFF))[i] = fin(F, I_RPB)[h * 15 * 31 + i] * 1.4426950408889634f;
        __syncthreads();
        int b2 = b, h2 = h; asm volatile("" : "+s"(b2), "+s"(h2));
        const int r = 8 * ro + F.wave;
        const int nu = F.wave < 2 ? 5 : 4;
#pragma unroll 1
        for (int u = 0; u < nu; ++u) { const bool lat = u < 4;
            attn_unit(F, lat, b2, h2, lat ? r : 0, lat ? u : 0, lat ? b2 * SEQ + r * 64 + 16 * u : NLAT + b2 * CTXL + 16 * (2 * ro + F.wave), dv); }
        __syncthreads();
    }
}

constexpr int CV_NIT = (6 + 2 * NE * 3) * 2048;
constexpr int KG_QKV = CV_KG1, KG_WO = CV_KG2, KG_DN0 = CV_KG3, KG_UP0 = CV_KG4;
constexpr int CV_W1 = 8 * (32 - KG_QKV) * CV_N1, CV_W2 = 8 * (32 - KG_WO) * CV_N2, CV_W3 = 8 * (32 - KG_DN0) * CV_N3, CV_W4 = 8 * (32 - KG_UP0) * CV_N4;
constexpr int CV_NIT_MAIN = CV_NIT - 2 * CV_TK;
static_assert(CV_NIT == CV_NIT_ALL, "item count");
constexpr int CV_T4_END = CV_NIT_MAIN - CV_W3, CV_T2_END = CV_T4_END - CV_W4, CV_T1_END = CV_T2_END - CV_W2, CV_P0_END = CV_T1_END - CV_W1;
static_assert(CV_P0_END >= 3 * 2048 && CV_T1_END >= 6 * 2048 && CV_T2_END >= (6 + NE * 3) * 2048, "conversion windows: the QKV weight in the prologue, Wo / GLU weights by the end of the QKV window, every layer-0 expert weight before the layer-0 up GEMM");
__device__ __forceinline__ bool split_role(const Frame& F, int KG, int& cx, int& Gg, int& ci, int& nci) {
    if (F.G != 256) { cx = F.vcu; Gg = F.G; ci = 0; nci = 0; return true; }
    const int x = F.vcu >> 5, k = F.vcu & 31;
    if (k < KG) { cx = x * KG + k; Gg = 8 * KG; ci = 0; nci = 0; return true; }
    ci = x * (32 - KG) + (k - KG); nci = 8 * (32 - KG); cx = 0; Gg = 0; return false;
}
constexpr int NPH = 22;
__global__ void __launch_bounds__(NTHREADS, 2) mk_fwd(Args args) {
    extern __shared__ __attribute__((aligned(16))) unsigned char lds[];
    Frame F;
    F.lds = (LAS unsigned char*)lds; F.ws = (GAS unsigned char*)args.ws; F.out = (GAS float*)args.out;
    F.ap = (const CAS Args*)__builtin_amdgcn_kernarg_segment_ptr();
    F.tid = threadIdx.x; F.lane = F.tid & 63; F.wave = __builtin_amdgcn_readfirstlane(F.tid >> 6);
    F.G = gridDim.x; { const int bx = blockIdx.x; F.vcu = (F.G % 8 == 0) ? (bx % 8) * (F.G / 8) + bx / 8 : bx; }
    const int vcu0 = F.vcu, wave0 = F.wave;
    volatile LAS unsigned* MISC = (volatile LAS unsigned*)(F.lds + MISC_OFF);
    for (int u = F.tid; u < 32; u += NTHREADS) MISC[u] = 0u;
    __syncthreads();
    const int lo = args.ph_lo, hi = args.ph_hi;
    const bool multi = (hi - lo) > 1;
    XcdBarrier bar; bar.bar = (unsigned*)(unsigned char*)(F.ws + WS_CTL) + CW_BAR; bar.x = 0; bar.st = nullptr;
    if (multi) bar = xcd_barrier_post((unsigned*)(unsigned char*)(F.ws + WS_CTL) + CW_BAR, MISC + 8);
#if PROBE
#define IS_T0() ({ unsigned z2_ = 0u; asm volatile("" : "+v"(z2_)); (wave0 == 0 && __builtin_amdgcn_mbcnt_hi(~0u, __builtin_amdgcn_mbcnt_lo(~0u, z2_)) == 0); })
#endif
#define IN(k) ({ int lo_ = lo, hi_ = hi; asm volatile("" : "+s"(lo_), "+s"(hi_)); (lo_ <= (k) && (k) < hi_); })
#if PROBE
#define SEAM13(k) do { if (IN(k) && IN(14)) xcd_barrier(bar); if ((k) == PROBE_B && IS_T0()) { const unsigned long long t_ = wall_clock64(); MISC[18] = (unsigned)t_; MISC[19] = (unsigned)(t_ >> 32); } if (14 == PROBE_A && IS_T0()) { const unsigned long long t_ = wall_clock64(); MISC[16] = (unsigned)t_; MISC[17] = (unsigned)(t_ >> 32); } } while (0)
#else
#define SEAM13(k) do { if (IN(k) && IN(14)) xcd_barrier(bar); } while (0)
#endif
#if PROBE
#define SEAM_SKIP(a, b) do { if (IN(a) && IN(b)) xcd_barrier(bar); if ((a) == PROBE_B && IS_T0()) { const unsigned long long t_ = wall_clock64(); MISC[18] = (unsigned)t_; MISC[19] = (unsigned)(t_ >> 32); } if ((b) == PROBE_A && IS_T0()) { const unsigned long long t_ = wall_clock64(); MISC[16] = (unsigned)t_; MISC[17] = (unsigned)(t_ >> 32); } } while (0)
#else
#define SEAM_SKIP(a, b) do { if (IN(a) && IN(b)) xcd_barrier(bar); } while (0)
#endif
#define REPN(k) (((k) == REPEAT_PH) ? REPEAT_N : 1)
#define PH() do { const CAS Args* a_ = (const CAS Args*)__builtin_amdgcn_kernarg_segment_ptr(); asm volatile("" : "+s"(a_)); F.ap = a_; unsigned char* w_ = args.ws; asm volatile("" : "+s"(w_)); F.ws = (GAS unsigned char*)w_; unsigned z_ = 0u; asm volatile("" : "+v"(z_)); int l_ = __builtin_amdgcn_mbcnt_hi(~0u, __builtin_amdgcn_mbcnt_lo(~0u, z_)); int wv_ = wave0; asm volatile("" : "+s"(wv_)); F.lane = l_; F.wave = wv_; F.tid = wv_ * 64 + l_; int v_ = vcu0; asm volatile("" : "+s"(v_)); F.vcu = v_; } while (0)
#if PROBE
#define SEAM(k) do { if (IN(k) && IN((k) + 1)) xcd_barrier(bar); if ((k) == PROBE_B && IS_T0()) { const unsigned long long t_ = wall_clock64(); MISC[18] = (unsigned)t_; MISC[19] = (unsigned)(t_ >> 32); } if ((k) + 1 == PROBE_A && IS_T0()) { const unsigned long long t_ = wall_clock64(); MISC[16] = (unsigned)t_; MISC[17] = (unsigned)(t_ >> 32); } } while (0)
#else
#define SEAM(k) do { if (IN(k) && IN((k) + 1)) xcd_barrier(bar); } while (0)
#endif

#if PROBE
    if (PROBE_A == 0 && IS_T0()) { const unsigned long long t_ = wall_clock64(); MISC[16] = (unsigned)t_; MISC[17] = (unsigned)(t_ >> 32); }
#endif
    if (IN(0)) for (int rp_ = 0; rp_ < REPN(0); ++rp_) { PH(); p0_mods(F); p0_s5params(F); __syncthreads(); p0_weights(F, 0, F.G == 256 ? CV_P0_END : CV_NIT, F.vcu * NWAVES + F.wave, F.G * NWAVES);     __syncthreads(); }
    SEAM(0);
    for (int l = 0; l < 2; ++l) {
        if (l == 0) {
            if (IN(1)) for (int rp_ = 0; rp_ < REPN(1); ++rp_) { PH(); p1_prep(F); }
            SEAM(1);
            if (IN(2)) for (int rp_ = 0; rp_ < REPN(2); ++rp_) { PH(); int cx, Gg, ci, nci; if (split_role(F, KG_QKV, cx, Gg, ci, nci)) { SegSched S; S.init(Gg, cx, 34, 16, T_HB, T_WQKV, 8, 34, T_WQKV + 16, T_HB); EpiQKV E{ws_tile(F, T_QK), ws_tile(F, T_VT)}; run_gemm<EpiQKV, SegSched, false, 0, false>(F, S, E); } else p0_weights(F, CV_P0_END, CV_T1_END, ci * NWAVES + F.wave, nci * NWAVES); }
            SEAM(2);
            if (IN(3)) for (int rp_ = 0; rp_ < REPN(3); ++rp_) { PH();
#if ATTN_NAIVE
                p3_attn_naive(F);
#else
                attn_phase2(F, (rp_ < REPN(3) - 1) ? DUMMY_VARIANT : 0);
#endif
                __syncthreads(); }
            SEAM(3);
            if (IN(4)) for (int rp_ = 0; rp_ < REPN(4); ++rp_) { PH(); int cx, Gg, ci, nci; if (split_role(F, KG_WO, cx, Gg, ci, nci)) { SegSched S; S.init(Gg, cx, 34, 8, T_AO, T_WO, 0, 0, 0, 0); EpiWo E{(GAS bf16*)(F.ws + WS_O)}; run_gemm(F, S, E); } else p0_weights(F, CV_T1_END, CV_T2_END, ci * NWAVES + F.wave, nci * NWAVES); }
            SEAM(4);
        } else {
#if S5_NAIVE
            if (IN(11)) for (int rp_ = 0; rp_ < REPN(11); ++rp_) { PH(); s5_naive(F); }
            SEAM(11); SEAM(12); SEAM(13);
#else
#if S5_FUSE_Z
            if (IN(11)) for (int rp_ = 0; rp_ < REPN(11); ++rp_) { PH(); s5z_fused(F); }
            SEAM_SKIP(11, 15);
#else
            if (IN(11)) for (int rp_ = 0; rp_ < REPN(11); ++rp_) { PH(); s5_fused(F); }
            SEAM13(11);
#endif
#endif
#if !S5_FUSE_Z || S5_NAIVE
            if (IN(14)) for (int rp_ = 0; rp_ < REPN(14); ++rp_) { PH(); zprep_phase(F); }
            SEAM(14);
#endif
            if (IN(15)) for (int rp_ = 0; rp_ < REPN(15); ++rp_) { PH(); SegSched S; S.init(F.G, F.vcu, 32, 16, T_Z, T_WVG, 0, 0, 0, 0); EpiGlu E{(GAS bf16*)(F.ws + WS_O)}; run_gemm(F, S, E); }
            SEAM(15);
        }
        const int pb = l ? 16 : 5;
        if (IN(pb)) for (int rp_ = 0; rp_ < REPN(pb); ++rp_) { PH(); row_phase(F, l, (rp_ < REPN(pb) - 1) ? DUMMY_VARIANT : 0); }
        SEAM(pb);
        if (IN(pb + 1)) for (int rp_ = 0; rp_ < REPN(pb + 1); ++rp_) { PH(); topk_phase(F, l); }
#if !GATHER_IN_GEMM
        SEAM(pb + 1);
#endif
#if !GATHER_IN_GEMM
        if (IN(pb + 2)) for (int rp_ = 0; rp_ < REPN(pb + 2); ++rp_) { PH(); gather_phase(F, l); }
        SEAM(pb + 2);
#else
        SEAM_SKIP(pb + 1, pb + 3);
#endif
        if (IN(pb + 3)) for (int rp_ = 0; rp_ < REPN(pb + 3); ++rp_) { PH(); int cx, Gg, ci, nci; if (split_role(F, l == 0 ? KG_UP0 : 32, cx, Gg, ci, nci)) { MoeSched S; S.init(Gg, cx, l ? 4 : 5, 16, T_XE, T_MOE1 + l * 256); S.ga_idx = (const GAS int*)(F.ws + WS_IDX); S.ga_nrows = NROWS; EpiSwiglu E{ws_tile(F, T_ACT), T_MOE1 + l * 256};
#if GATHER_IN_GEMM
            run_gemm_ga(F, S, E, T_HB);
#else
            run_gemm(F, S, E);
#endif
            } else p0_weights(F, CV_T2_END, CV_T4_END, ci * NWAVES + F.wave, nci * NWAVES);
        }
        SEAM(pb + 3);
        if (IN(pb + 4)) for (int rp_ = 0; rp_ < REPN(pb + 4); ++rp_) { PH(); int cx, Gg, ci, nci; if (split_role(F, l == 0 ? KG_DN0 : 32, cx, Gg, ci, nci)) { MoeSched S; S.init(Gg, cx, l ? 4 : 5, 8, T_ACT, T_MOE2 + l * 128); EpiDown E{(GAS bf16*)(F.ws + WS_YE), (const GAS float*)(F.ws + WS_GATE), T_MOE2 + l * 128}; run_gemm<EpiDown, MoeSched, false, MOE_BAUX>(F, S, E); } else p0_weights(F, CV_T4_END, CV_NIT_MAIN, ci * NWAVES + F.wave, nci * NWAVES); }
        SEAM(pb + 4);
        if (IN(pb + 5)) for (int rp_ = 0; rp_ < REPN(pb + 5); ++rp_) { PH(); combine_phase(F, l); }
        SEAM(pb + 5);
    }
#if PROBE
    if (blockIdx.x == 0 && IS_T0()) { const unsigned long long tA_ = ((unsigned long long)MISC[17] << 32) | MISC[16], tB_ = ((unsigned long long)MISC[19] << 32) | MISC[18]; const float us_ = (float)(tB_ - tA_) * 0.01f; F.out[0] = exp2f(rintf(log2f(us_) * PROBE_Q + PROBE_OFF) / PROBE_Q); }
#endif
#undef IN
#undef SEAM
}

extern "C" void kernel_launch(void* const* d_in, const int* in_sizes, int n_in, void* d_out, int out_size, void* d_ws, size_t ws_size, hipStream_t stream) {
    static int grid = 0;
    if (grid == 0) {
        if (n_in != 25 || out_size != NLAT * D || ws_size < WS_END) { fprintf(stderr, "kernel_launch: unexpected shapes (n_in %d out %d ws %zu)\n", n_in, out_size, ws_size); grid = -1; return; }
        int dev = 0, cus = 0, per_cu = 0;
        if (hipGetDevice(&dev) != hipSuccess || hipDeviceGetAttribute(&cus, hipDeviceAttributeMultiprocessorCount, dev) != hipSuccess) { grid = -1; return; }
        if (hipFuncSetAttribute((const void*)mk_fwd, hipFuncAttributeMaxDynamicSharedMemorySize, LDS_BYTES) != hipSuccess) { fprintf(stderr, "kernel_launch: hipFuncSetAttribute failed\n"); grid = -1; return; }
        if (hipOccupancyMaxActiveBlocksPerMultiprocessor(&per_cu, (const void*)mk_fwd, NTHREADS, LDS_BYTES) != hipSuccess || per_cu < 1) { fprintf(stderr, "kernel_launch: occupancy query reports %d\n", per_cu); }
        (void)hipGetLastError();
        grid = cus;
    }
    if (grid < 0) return;
    (void)hipMemsetAsync((char*)d_ws + WS_CTL, 0, CTL_ZERO_BYTES, stream);
    Args a{};
    for (int i = 0; i < 25; ++i) a.in[i] = (const float*)d_in[i];
    a.out = (float*)d_out; a.ws = (unsigned char*)d_ws;
#if MK_N_LAUNCHES == 1
    a.ph_lo = 0; a.ph_hi = NPH;
    hipLaunchKernelGGL(mk_fwd, dim3(grid), dim3(NTHREADS), LDS_BYTES, stream, a);
#else
    for (int p = 0; p < NPH; ++p) { a.ph_lo = p; a.ph_hi = p + 1; hipLaunchKernelGGL(mk_fwd, dim3(grid), dim3(NTHREADS), LDS_BYTES, stream, a); }
#endif
}
```

```cpp
#include <hip/hip_runtime.h>
#include <cstdio>
#include <cstdint>
namespace pg8 {
#define PG8_LAS __attribute__((address_space(3)))
typedef unsigned short bf16_t;
typedef short bf16x8 __attribute__((ext_vector_type(8)));
typedef float f32x4 __attribute__((ext_vector_type(4)));
typedef unsigned u32x4 __attribute__((ext_vector_type(4)));
constexpr int BM = 256, BK = 64, HALF = 128, HTB = HALF * BK * 2  , STAGE_BYTES = 8 * HTB, NXCD = 8, WGM = 8;

__host__ __device__ __forceinline__ int lds_byte(int r, int c) { const int st = (r >> 4) * 2 + (c >> 5), rr = r & 15, cc = c & 31, ob = rr * 64 + cc * 2; return st * 1024 + (ob ^ (((ob >> 9) & 1) << 5)); }
__host__ __device__ __forceinline__ void stage_rc(int b, int& R, int& C) { const int st = b / 1024, sb = b % 1024, swz = sb ^ (((sb >> 9) & 1) << 5); R = (st >> 1) * 16 + swz / 64; C = (st & 1) * 32 + (swz % 64) / 2; }
__host__ __device__ __forceinline__ int perm32(int rho) { const int n = rho >> 4, i = rho & 15; return 8 * (i >> 2) + 4 * n + (i & 3); }

struct Unit { int pm, pn; };
struct Gemm { const bf16_t* A; const bf16_t* Bt; int M, N, K; };

__device__ __forceinline__ unsigned cvt_pk_bf16(float lo, float hi) { unsigned r; asm volatile("v_cvt_pk_bf16_f32 %0, %1, %2" : "=v"(r) : "v"(lo), "v"(hi)); return r; }
#ifndef WT_BKM
#define WT_BKM 0
#endif
template <class Epi, class Sched, bool ALIGN_EPI = false, bool SP2 = false, bool GA = false, bool VR = false, int BAUX = 0, bool BKM = false>
__device__ __forceinline__ void gemm_phase(PG8_LAS unsigned char* lds, const Gemm g, const Sched& S, const Epi& E, int tid_in) {
    int tid_ = tid_in; asm volatile("" : "+v"(tid_));
    const int tid = tid_, wid = __builtin_amdgcn_readfirstlane(tid >> 6), lane = tid & 63, wr = wid >> 2, wc = wid & 3, fr = lane & 15, fq = lane >> 4;
    const int K = g.K, nt = K / BK;
    unsigned voffA[2], voffB[2];
#pragma unroll
    for (int i = 0; i < 2; ++i) { int R, C; stage_rc(tid * 16 + i * 8192, R, C); const int Rb = Epi::PERM ? ((R & ~31) + perm32(R & 31)) : R;
        voffA[i] = (unsigned)(R * K + C) * 2u; voffB[i] = BKM ? (unsigned)(Rb * BK + C) * 2u : (unsigned)(Rb * K + C) * 2u; }
    unsigned vA[2][2] = {{0u, 0u}, {0u, 0u}}, nvA[2][2] = {{0u, 0u}, {0u, 0u}}; int gaR[2] = {0, 0}; unsigned gaC[2] = {0u, 0u};
    if constexpr (GA) {
#pragma unroll
        for (int i = 0; i < 2; ++i) { int R, C; stage_rc(tid * 16 + i * 8192, R, C); gaR[i] = R; gaC[i] = (unsigned)C * 2u; } }
#define PG8_GA_OFFS(dst, unit) do { const int _r0 = S.ga_row0(unit); _Pragma("unroll") for (int _h = 0; _h < 2; ++_h) _Pragma("unroll") for (int _i = 0; _i < 2; ++_i) { \
        const unsigned _ix = (unsigned)S.ga_idx[_r0 + _h * HALF + gaR[_i]]; dst[_h][_i] = (_ix < S.ga_nrows ? _ix : 0u) * (unsigned)(K * 2) + gaC[_i]; } } while (0)
    const size_t kstep = (size_t)(BK * 2);
    const size_t hstep = (size_t)HALF * K * 2;
    const size_t kstepB = BKM ? (size_t)(256 * BK * 2) : kstep, hstepB = BKM ? (size_t)(HALF * BK * 2) : hstep;
    const size_t tstep = 2 * hstep;
    const unsigned ldsw = (unsigned)wid * 1024u;
    const int aoff = lds_byte(wr * 64 + fr, fq * 8), boff = lds_byte(wc * 32 + fr, fq * 8);
#define PG8_SA(b, h) (((b) * 2 + (h)) * HTB)
#define PG8_SB(b, h) ((4 + (b) * 2 + (h)) * HTB)
#define PG8_STAGE(bufoff, gbase, voff) do { _Pragma("unroll") for (int _i = 0; _i < 2; ++_i) \
        __builtin_amdgcn_global_load_lds((const unsigned*)((const char*)(gbase) + (voff)[_i]), (PG8_LAS unsigned*)(lds + (bufoff) + ldsw + _i * 8192), 16, 0, 0); } while (0)
#define PG8_STAGE_B(bufoff, gbase, voff) do { _Pragma("unroll") for (int _i = 0; _i < 2; ++_i) \
        __builtin_amdgcn_global_load_lds((const unsigned*)((const char*)(gbase) + (voff)[_i]), (PG8_LAS unsigned*)(lds + (bufoff) + ldsw + _i * 8192), 16, 0, BAUX); } while (0)
#define PG8_STAGE_A(bufoff, kbase, half, arr) do { if constexpr (GA) PG8_STAGE(bufoff, kbase, arr[half]); else PG8_STAGE(bufoff, (kbase) + (half) * hstep, voffA); } while (0)
#define PG8_LDA(dst, b, h) do { _Pragma("unroll") for (int m = 0; m < 4; ++m) _Pragma("unroll") for (int k = 0; k < 2; ++k) dst[m][k] = *(const PG8_LAS bf16x8*)(lds + PG8_SA(b, h) + aoff + m * 2048 + k * 1024); } while (0)
#define PG8_LDB(dst, b, h) do { _Pragma("unroll") for (int n = 0; n < 2; ++n) _Pragma("unroll") for (int k = 0; k < 2; ++k) dst[n][k] = *(const PG8_LAS bf16x8*)(lds + PG8_SB(b, h) + boff + n * 2048 + k * 1024); } while (0)
#define PG8_MMA(ai, bj, At, Bt) do { if (VR && !((ai) == 0 ? mma_on0 : mma_on1)) break; __builtin_amdgcn_s_setprio(1); _Pragma("unroll") for (int m = 0; m < 4; ++m) _Pragma("unroll") for (int n = 0; n < 2; ++n) _Pragma("unroll") for (int k = 0; k < 2; ++k) \
        acc[ai][bj][m][n] = __builtin_amdgcn_mfma_f32_16x16x32_bf16(Bt[n][k], At[m][k], acc[ai][bj][m][n], 0, 0, 0); __builtin_amdgcn_s_setprio(0); } while (0)
#define PG8_WAIT_V(n) asm volatile("s_waitcnt vmcnt(" #n ")" ::: "memory")
#define PG8_WAIT_L(n) asm volatile("s_waitcnt lgkmcnt(" #n ")" ::: "memory")
#define PG8_BAR __builtin_amdgcn_s_barrier()
#define PG8_SCHED __builtin_amdgcn_sched_barrier(0)
    Unit cur, nxt; int ui = 0;
    if (!S.next(0, cur)) return;
    f32x4 acc[2][2][4][2];
#pragma unroll
    for (int a = 0; a < 2; ++a)
#pragma unroll
        for (int b = 0; b < 2; ++b)
#pragma unroll
            for (int m = 0; m < 4; ++m)
#pragma unroll
                for (int n = 0; n < 2; ++n) acc[a][b][m][n] = (f32x4){0.f, 0.f, 0.f, 0.f};
    bf16x8 At[4][2], B0[2][2], B1[2][2];
    const char* cA = GA ? (const char*)g.A : (const char*)g.A + (size_t)cur.pm * tstep; const char* cB = (const char*)g.Bt + (size_t)cur.pn * tstep;
    if constexpr (GA) PG8_GA_OFFS(vA, cur);
    bool mma_on0 = true, mma_on1 = true;
    if constexpr (VR) { const int vr_ = S.valid_rows(cur); mma_on0 = wr * 64 < vr_; mma_on1 = HALF + wr * 64 < vr_; }
    S.a_ready(cur);
    if constexpr (SP2) {
        PG8_STAGE_B(PG8_SB(0, 0), cB, voffB); PG8_STAGE_B(PG8_SB(0, 1), cB + hstepB, voffB); PG8_STAGE_A(PG8_SA(0, 0), cA, 0, vA); PG8_STAGE_A(PG8_SA(0, 1), cA, 1, vA);
        if (wr == 1) PG8_BAR;
        PG8_WAIT_V(2); PG8_BAR;
        PG8_STAGE_B(PG8_SB(1, 0), cB + kstepB, voffB); PG8_STAGE_A(PG8_SA(1, 0), cA + kstep, 0, vA); PG8_STAGE_B(PG8_SB(1, 1), cB + hstepB + kstepB, voffB);
        PG8_WAIT_V(6); PG8_BAR;
    } else {
        PG8_STAGE_B(PG8_SB(0, 0), cB, voffB); PG8_STAGE_A(PG8_SA(0, 0), cA, 0, vA); PG8_STAGE_B(PG8_SB(0, 1), cB + hstepB, voffB); PG8_STAGE_A(PG8_SA(0, 1), cA, 1, vA);
        if (wr == 1) PG8_BAR;
        PG8_WAIT_V(4); PG8_BAR;
        PG8_STAGE_B(PG8_SB(1, 0), cB + kstepB, voffB); PG8_STAGE_A(PG8_SA(1, 0), cA + kstep, 0, vA); PG8_STAGE_B(PG8_SB(1, 1), cB + hstepB + kstepB, voffB);
        PG8_WAIT_V(6); PG8_BAR;
    }
    for (;;) {
        const bool has_next = S.next(ui + 1, nxt);
        const char* nA = GA ? cA : (has_next ? (const char*)g.A + (size_t)nxt.pm * tstep : cA); const char* nB = has_next ? (const char*)g.Bt + (size_t)nxt.pn * tstep : cB;
        if constexpr (GA) { if (has_next) PG8_GA_OFFS(nvA, nxt); else {
#pragma unroll
            for (int _h = 0; _h < 2; ++_h)
#pragma unroll
                for (int _i = 0; _i < 2; ++_i) nvA[_h][_i] = vA[_h][_i]; } }
        for (int t = 0; t < nt; t += 2) {
            const bool last = (t == nt - 2);
            const char* a1 = cA + (size_t)(t + 1) * kstep;
            const char* a2 = last ? nA : cA + (size_t)(t + 2) * kstep; const char* b2 = last ? nB : cB + (size_t)(t + 2) * kstepB;
            const char* a3 = a2 + kstep; const char* b3 = b2 + kstepB;
            unsigned sA[2][2];
#pragma unroll
            for (int _h = 0; _h < 2; ++_h)
#pragma unroll
                for (int _i = 0; _i < 2; ++_i) sA[_h][_i] = last ? nvA[_h][_i] : vA[_h][_i];
            if (last && has_next) S.a_ready(nxt);
            if constexpr (SP2) {
            PG8_LDB(B0, 0, 0); PG8_LDB(B1, 0, 1); PG8_SCHED; PG8_LDA(At, 0, 0); PG8_STAGE_A(PG8_SA(1, 1), a1, 1, vA);
            PG8_WAIT_V(8); PG8_WAIT_L(0); PG8_BAR; PG8_MMA(0, 0, At, B0); PG8_MMA(0, 1, At, B1); PG8_BAR; PG8_SCHED;
            PG8_LDA(At, 0, 1); PG8_STAGE_B(PG8_SB(0, 0), b2, voffB); PG8_STAGE_B(PG8_SB(0, 1), b2 + hstepB, voffB); PG8_STAGE_A(PG8_SA(0, 0), a2, 0, sA);
            PG8_WAIT_V(8); PG8_WAIT_L(0); PG8_BAR; PG8_MMA(1, 0, At, B0); PG8_MMA(1, 1, At, B1); PG8_BAR; PG8_SCHED;
            PG8_LDB(B0, 1, 0); PG8_LDB(B1, 1, 1); PG8_SCHED; PG8_LDA(At, 1, 0); PG8_STAGE_A(PG8_SA(0, 1), a2, 1, sA);
            PG8_WAIT_V(8); PG8_WAIT_L(0); PG8_BAR; PG8_MMA(0, 0, At, B0); PG8_MMA(0, 1, At, B1); PG8_BAR; PG8_SCHED;
            PG8_LDA(At, 1, 1); PG8_STAGE_B(PG8_SB(1, 0), b3, voffB); PG8_STAGE_B(PG8_SB(1, 1), b3 + hstepB, voffB); PG8_STAGE_A(PG8_SA(1, 0), a3, 0, sA);
            PG8_WAIT_V(8); PG8_WAIT_L(0); PG8_BAR; PG8_MMA(1, 0, At, B0); PG8_MMA(1, 1, At, B1); PG8_BAR; PG8_SCHED;
            } else {
            PG8_LDB(B0, 0, 0); PG8_SCHED; PG8_LDA(At, 0, 0); PG8_STAGE_A(PG8_SA(1, 1), a1, 1, vA);
            PG8_WAIT_L(8); PG8_BAR; PG8_WAIT_L(0); PG8_MMA(0, 0, At, B0); PG8_BAR; PG8_SCHED;
            PG8_LDB(B1, 0, 1); PG8_STAGE_B(PG8_SB(0, 0), b2, voffB);
            PG8_BAR; PG8_WAIT_L(0); PG8_MMA(0, 1, At, B1); PG8_BAR;
            PG8_LDA(At, 0, 1); PG8_STAGE_A(PG8_SA(0, 0), a2, 0, sA);
            PG8_BAR; PG8_WAIT_L(0); PG8_MMA(1, 0, At, B0); PG8_BAR; PG8_SCHED;
            PG8_STAGE_B(PG8_SB(0, 1), b2 + hstepB, voffB);
            PG8_WAIT_V(6); PG8_BAR; PG8_MMA(1, 1, At, B1); PG8_BAR;
            PG8_LDB(B0, 1, 0); PG8_SCHED; PG8_LDA(At, 1, 0); PG8_STAGE_A(PG8_SA(0, 1), a2, 1, sA);
            PG8_WAIT_L(8); PG8_BAR; PG8_WAIT_L(0); PG8_MMA(0, 0, At, B0); PG8_BAR; PG8_SCHED;
            PG8_LDB(B1, 1, 1); PG8_STAGE_B(PG8_SB(1, 0), b3, voffB);
            PG8_BAR; PG8_WAIT_L(0); PG8_MMA(0, 1, At, B1); PG8_BAR;
            PG8_LDA(At, 1, 1); PG8_STAGE_A(PG8_SA(1, 0), a3, 0, sA);
            PG8_BAR; PG8_WAIT_L(0); PG8_MMA(1, 0, At, B0); PG8_BAR; PG8_SCHED;
            PG8_STAGE_B(PG8_SB(1, 1), b3 + hstepB, voffB);
            PG8_WAIT_V(6); PG8_BAR; PG8_MMA(1, 1, At, B1); PG8_BAR;
            }
        }
        if constexpr (ALIGN_EPI) { if (wr == 0) PG8_BAR; }
        if constexpr (!Epi::AFTER_DRAIN) { E(acc, cur, wr, wc, fr, fq); S.done(cur); }
        if (!has_next) break;
#pragma unroll
        for (int a = 0; a < 2; ++a)
#pragma unroll
            for (int b = 0; b < 2; ++b)
#pragma unroll
                for (int m = 0; m < 4; ++m)
#pragma unroll
                    for (int n = 0; n < 2; ++n) acc[a][b][m][n] = (f32x4){0.f, 0.f, 0.f, 0.f};
        cur = nxt; cA = nA; cB = nB; ++ui;
        if constexpr (VR) { const int vr_ = S.valid_rows(cur); mma_on0 = wr * 64 < vr_; mma_on1 = HALF + wr * 64 < vr_; }
        if constexpr (GA) {
#pragma unroll
            for (int _h = 0; _h < 2; ++_h)
#pragma unroll
                for (int _i = 0; _i < 2; ++_i) vA[_h][_i] = nvA[_h][_i]; }
        if constexpr (ALIGN_EPI) { if (wr == 1) PG8_BAR; }
    }
    PG8_WAIT_V(0);
    if constexpr (!ALIGN_EPI) { if (wr == 0) PG8_BAR; }
    PG8_BAR;
    if constexpr (Epi::AFTER_DRAIN) { E.fused(acc, cur, wr, wc, fr, fq, lds, wid, lane); S.done(cur); }
#undef PG8_SA
#undef PG8_SB
#undef PG8_STAGE
#undef PG8_STAGE_B
#undef PG8_STAGE_A
#undef PG8_GA_OFFS
#undef PG8_LDA
#undef PG8_LDB
#undef PG8_MMA
#undef PG8_WAIT_V
#undef PG8_WAIT_L
#undef PG8_BAR
#undef PG8_SCHED
}
}

#ifndef PG8_SP2
#define PG8_SP2 true
#endif
#ifndef PG8_ALIGN
#define PG8_ALIGN true
#endif
#ifndef X1_BF16
#define X1_BF16 1
#endif
#ifndef TOPK_2BIT
#define TOPK_2BIT 0
#endif
#ifndef NT_STREAM
#define NT_STREAM 0
#endif
#ifndef X1_FP16
#define X1_FP16 1
#endif
#if X1_FP16
#define X1PK pkh2
#define X1UNPK h4_to_f32
#else
#define X1PK pk2
#define X1UNPK bf4_to_f32
#endif
#ifndef X2_FP16
#define X2_FP16 1
#endif
#ifndef CV_NT_STORE
#define CV_NT_STORE 1
#endif
#ifndef CV_ROLL
#define CV_ROLL 0
#endif
#ifndef CV_TKN
#define CV_TKN 0
#endif
#ifndef TOPK_CTX_WAVE
#define TOPK_CTX_WAVE 1
#endif
#ifndef S5P_SPREAD
#define S5P_SPREAD 1
#endif
#ifndef MK_N_LAUNCHES
#define MK_N_LAUNCHES 1
#endif
#ifndef PROBE
#define PROBE 0
#endif
#ifndef PROBE_Q
#define PROBE_Q 6.0f
#define PROBE_OFF 0.0f
#endif
#ifndef PROBE_A
#define PROBE_A 0
#define PROBE_B 0
#endif
#ifndef REPEAT_PH
#define REPEAT_PH (-1)
#define REPEAT_N 2
#endif
#ifndef ATT_W
#define ATT_W 8
#endif
#ifndef DUMMY_VARIANT
#define DUMMY_VARIANT 0
#endif
#ifndef CV_NF_MOE
#define CV_NF_MOE 4
#endif
#ifndef CV_KG1
#define CV_KG1 17
#define CV_KG2 17
#define CV_KG3 27
#define CV_KG4 27
#define CV_N4 950
#endif
#ifndef CV_N1
#define CV_N1 850
#define CV_N2 280
#define CV_N3 500
#endif
#ifndef GATHER_IN_GEMM
#define GATHER_IN_GEMM 1
#endif
#ifndef S5_FUSE_Z
#define S5_FUSE_Z 1
#endif
#ifndef ROW_CTX_COOP
#define ROW_CTX_COOP 1
#endif
#ifndef MOE_BAUX
#define MOE_BAUX 0
#endif
#ifndef CTX_COOP2
#define CTX_COOP2 0
#endif
#ifndef P1_COOP
#define P1_COOP 0
#endif
#ifndef S5_NAIVE
#define S5_NAIVE 0
#endif
#ifndef ATTN_NAIVE
#define ATTN_NAIVE 0
#endif
#ifndef NAIVE_GEMM
#define NAIVE_GEMM 0
#endif

constexpr int D = 2048, SEQ = 4096, CTXL = 256, NLAT = 8192, NCTX = 512, NROWS = 8704;
constexpr int NH = 16, HD = 128, NE = 16, NG = 128, NP = 64, GH = 16, D6 = 6 * D;
constexpr int RPE = 1280;
constexpr float LN_EPS = 1e-5f, ALPHA = 1.4142135623730951f;
constexpr int NWAVES = 8, NTHREADS = 512;
constexpr int LDS_BYTES = 147456, MISC_OFF = LDS_BYTES - 128;

constexpr size_t MiB = 1u << 20;
constexpr size_t WS_CTL = 0, CTL_ZERO_BYTES = 1 * MiB;
constexpr size_t WS_MODS = 1 * MiB;
constexpr size_t WS_SPAR = 2 * MiB;
constexpr size_t WS_AFF = 6 * MiB;
constexpr size_t WS_SLOT = 7 * MiB;
constexpr size_t WS_IDX = 8 * MiB;
constexpr size_t WS_GATE = 8 * MiB + 512 * 1024;
constexpr int T_WQKV = 16, T_WO = 40, T_WVG = 48, T_MOE1 = 64, T_MOE2 = 576, T_HB = 832, T_QK = 866, T_VT = 934, T_AO = 968, T_XE = 1002, T_ACT = 1082, T_Z = 1162;
constexpr size_t WS_O = 1194 * MiB, WS_X1 = 1262 * MiB, WS_X2 = 1330 * MiB, WS_YE = 1398 * MiB, WS_YF = 1558 * MiB, WS_YB = 1622 * MiB, WS_XLOC = 1686 * MiB, WS_CARRY = 1718 * MiB, WS_END = 1750 * MiB;
constexpr int CW_BAR = 4096;
constexpr int CV_NIT_ALL = (6 + 2 * NE * 3) * 2048, CV_TK = 256 * NWAVES * CV_TKN;

#define GAS __attribute__((address_space(1)))
#define LAS __attribute__((address_space(3)))
typedef unsigned short bf16;
typedef unsigned v4u __attribute__((ext_vector_type(4)));
typedef unsigned v2u __attribute__((ext_vector_type(2)));
typedef float f32x4 __attribute__((ext_vector_type(4)));
typedef float f32x2 __attribute__((ext_vector_type(2)));
typedef short bf16x8 __attribute__((ext_vector_type(8)));
typedef GAS unsigned gu32;
#define RLX_AGENT __ATOMIC_RELAXED, __HIP_MEMORY_SCOPE_AGENT

__device__ __forceinline__ float bf2f(unsigned b) { return __uint_as_float(b << 16); }
__device__ __forceinline__ unsigned pk2(float lo, float hi) { typedef __bf16 bf2_t __attribute__((ext_vector_type(2))); f32x2 v = {lo, hi}; return __builtin_bit_cast(unsigned, __builtin_convertvector(v, bf2_t)); }
__device__ __forceinline__ unsigned pkh2(float lo, float hi) { typedef _Float16 h2_t __attribute__((ext_vector_type(2))); f32x2 v = {lo, hi}; return __builtin_bit_cast(unsigned, __builtin_convertvector(v, h2_t)); }
__device__ __forceinline__ f32x4 h4_to_f32(v2u w) { typedef _Float16 h4_t __attribute__((ext_vector_type(4))); return __builtin_convertvector(__builtin_bit_cast(h4_t, w), f32x4); }
template <int CTRL> __device__ __forceinline__ float dpp_f(float x) { return __builtin_bit_cast(float, __builtin_amdgcn_mov_dpp(__builtin_bit_cast(int, x), CTRL, 0xf, 0xf, true)); }
__device__ __forceinline__ float wave_sum(float v) {
    v += dpp_f<0xB1>(v);
    v += dpp_f<0x4E>(v);
    v += dpp_f<0x141>(v);
    v += dpp_f<0x140>(v);
    const float a = __builtin_bit_cast(float, __builtin_amdgcn_readlane(__builtin_bit_cast(int, v), 0)), b = __builtin_bit_cast(float, __builtin_amdgcn_readlane(__builtin_bit_cast(int, v), 16));
    const float c = __builtin_bit_cast(float, __builtin_amdgcn_readlane(__builtin_bit_cast(int, v), 32)), d = __builtin_bit_cast(float, __builtin_amdgcn_readlane(__builtin_bit_cast(int, v), 48));
    return (a + b) + (c + d);
}
__device__ __forceinline__ float wave_max(float v) {
#pragma unroll
    for (int o = 1; o < 64; o <<= 1) v = fmaxf(v, __shfl_xor(v, o));
    return v;
}
__device__ __forceinline__ float silu_f(float x) { return x * __builtin_amdgcn_rcpf(1.0f + __builtin_amdgcn_exp2f(-1.4426950409f * x)); }
__device__ __forceinline__ float sigmoid_f(float x) { return __builtin_amdgcn_rcpf(1.0f + __builtin_amdgcn_exp2f(-1.4426950409f * x)); }
__device__ __forceinline__ float gelu_tanh_f(float x) { const float e = __builtin_amdgcn_exp2f(x * (-2.302208198f - 0.1029432397f * x * x)); return x * __builtin_amdgcn_rcpf(1.0f + e); }
#define XB_TMO      128
#define XB_XCNT(j)  (256  + 64 * (j))
#define XB_XSUB(j)  (1280 + 64 * (j))
#define XB_XGEN(j)  (2304 + 64 * (j))
#define XB_TOP      3328
#define XB_TOPGEN   3392
#define XCD_BAR_WORDS 3456
#define XB_SPIN_CAP (1u << 18)

__device__ __forceinline__ unsigned xb_ld(unsigned* p)              { return __hip_atomic_load(p, __ATOMIC_RELAXED, __HIP_MEMORY_SCOPE_AGENT); }
__device__ __forceinline__ unsigned xb_add(unsigned* p, unsigned v) { return __hip_atomic_fetch_add(p, v, __ATOMIC_RELAXED, __HIP_MEMORY_SCOPE_AGENT); }
__device__ __forceinline__ unsigned xb_xcc_id() { return (unsigned)__builtin_amdgcn_s_getreg((3 << 11) | 20) & 0xFu; }
#define XB_SPIN(cond, bar) do { unsigned _sp = 0; while (cond) { __builtin_amdgcn_s_sleep(1); \
    if ((++_sp & 255u) == 0u) { if (xb_ld(&(bar)[XB_TMO])) break; if (_sp > XB_SPIN_CAP) { atomicAdd(&(bar)[XB_TMO], 1u); break; } } } } while (0)

struct XcdBarrier {
    unsigned* bar; unsigned x;
    volatile LAS unsigned* st;
};

__device__ __forceinline__ XcdBarrier xcd_barrier_post(unsigned* bar, volatile LAS unsigned* st) {
    XcdBarrier b; b.bar = bar; b.x = xb_xcc_id(); b.st = st;
    if (threadIdx.x == 0) (void)xb_add(&bar[XB_XCNT(b.x)], 1u);
    return b;
}
__device__ __forceinline__ void xcd_barrier_complete(unsigned* bar, unsigned x, unsigned& nloc, unsigned& nx) {
    const unsigned G = gridDim.x * gridDim.y * gridDim.z;
    unsigned sum, cnt, mine, sp = 0u;
    for (;;) {
        sum = 0u; cnt = 0u; mine = 0u;
#pragma unroll
        for (unsigned j = 0; j < 16; ++j) { const unsigned c = xb_ld(&bar[XB_XCNT(j)]); sum += c; cnt += (c > 0u) ? 1u : 0u; mine = (j == x) ? c : mine; }
        if (sum == G) break;
        __builtin_amdgcn_s_sleep(1);
        if ((++sp & 255u) == 0u) { if (xb_ld(&bar[XB_TMO])) break; if (sp > XB_SPIN_CAP) { atomicAdd(&bar[XB_TMO], 1u); break; } }
    }
    nloc = mine > 0u ? mine : 1u; nx = cnt > 0u ? cnt : 1u;
}

__device__ __forceinline__ void xcd_barrier(const XcdBarrier& b) {
    asm volatile("s_waitcnt vmcnt(0)" ::: "memory");
    __syncthreads();
    if (threadIdx.x == 0) {
        unsigned* bar = b.bar;
        __builtin_amdgcn_s_waitcnt(0);
        unsigned nloc = b.st[0], nx = b.st[1];
        if (nloc == 0u) { xcd_barrier_complete(bar, b.x, nloc, nx); b.st[0] = nloc; b.st[1] = nx; }
        const unsigned old = xb_add(&bar[XB_XSUB(b.x)], 1u);
        const unsigned gen = old / nloc;
        if (old + 1u == (gen + 1u) * nloc) {
            __builtin_amdgcn_fence(__ATOMIC_RELEASE, "agent");
            asm volatile("s_waitcnt vmcnt(0)" ::: "memory");
            const unsigned og = xb_add(&bar[XB_TOP], 1u);
            const unsigned tg = og / nx;
            if (og + 1u == (tg + 1u) * nx) xb_add(&bar[XB_TOPGEN], 1u);
            else XB_SPIN(xb_ld(&bar[XB_TOPGEN]) == tg, bar);
            __builtin_amdgcn_fence(__ATOMIC_ACQUIRE, "agent");
            xb_add(&bar[XB_XGEN(b.x)], 1u);
            asm volatile("s_waitcnt vmcnt(0)" ::: "memory");
        } else {
            XB_SPIN(xb_ld(&bar[XB_XGEN(b.x)]) == gen, bar);
            __builtin_amdgcn_fence(__ATOMIC_ACQUIRE, "agent");
            asm volatile("s_waitcnt vmcnt(0)" ::: "memory");
        }
    }
    __syncthreads();
}

struct Args { const float* in[25]; float* out; unsigned char* ws; int ph_lo, ph_hi; };
#define CAS __attribute__((address_space(4)))
struct Frame {
    LAS unsigned char* lds;
    GAS unsigned char* ws;
    int tid, lane, wave, vcu, G;
    const CAS Args* ap;
    GAS float* out;
};
__device__ __forceinline__ const GAS float* fin(const Frame& F, int i) { return (const GAS float*)F.ap->in[i]; }
enum { I_X = 0, I_C, I_CTX, I_CCTX, I_WMOD, I_BMOD, I_LNG, I_LNB, I_WQKV, I_WO, I_RPB, I_LAMRE, I_LAMIM, I_LOGSTEP, I_BRE, I_BIM, I_CRE, I_CIM, I_SD, I_WVAL, I_WGATE, I_ROUTER, I_MGATE, I_MUP, I_MDOWN };

__device__ __forceinline__ GAS bf16* ws_tile(const Frame& F, int t) { return (GAS bf16*)(F.ws + (size_t)t * MiB); }
__device__ __forceinline__ GAS float* ws_f32(const Frame& F, size_t off) { return (GAS float*)(F.ws + off); }
__device__ __forceinline__ const GAS float* mods(const Frame& F, int l, int r, int which) { return (const GAS float*)(F.ws + WS_MODS) + (size_t)((l * 3 + r) * 6 + which) * D; }
__device__ __forceinline__ int row_r(int row) { return row < NLAT ? (row >> 12) : 2; }

struct SegSched {
    int G, cx, n0, ntot, nM0, nN0, pm0, pn0, nM1, nN1, pm1, pn1;
    __device__ __forceinline__ void init(int G_, int cx_, int nM0_, int nN0_, int pm0_, int pn0_, int nM1_, int nN1_, int pm1_, int pn1_) {
        G = G_; cx = cx_; nM0 = nM0_; nN0 = nN0_; pm0 = pm0_; pn0 = pn0_; nM1 = nM1_; nN1 = nN1_; pm1 = pm1_; pn1 = pn1_; n0 = nM0 * nN0; ntot = n0 + nM1 * nN1; }
    __device__ __forceinline__ bool next(int i, pg8::Unit& u) const {
        const int U = i * G + cx; if (U >= ntot) return false;
        const bool s1 = U >= n0; const int loc = s1 ? U - n0 : U, nM = s1 ? nM1 : nM0, nN = s1 ? nN1 : nN0;
        const int nig = 8 * nN, gid = loc / nig, fm = gid * 8, gsz = (nM - fm) < 8 ? (nM - fm) : 8;
        u.pm = (s1 ? pm1 : pm0) + fm + ((loc % nig) % gsz); u.pn = (s1 ? pn1 : pn0) + (loc % nig) / gsz; return true;
    }
    __device__ __forceinline__ void a_ready(const pg8::Unit&) const {}
    __device__ __forceinline__ void done(const pg8::Unit&) const {}
};
struct MoeSched {
    int G, cx, nMe, nNe, pmA, pnB, ntot;
    const GAS int* ga_idx; unsigned ga_nrows;
    __device__ __forceinline__ int ga_row0(const pg8::Unit& u) const { return (u.pm - pmA) * 256; }
    __device__ __forceinline__ int valid_rows(const pg8::Unit& u) const { return (nMe == 5 && (u.pm - pmA) % 5 == 4) ? 64 : 256; }
    __device__ __forceinline__ void init(int G_, int cx_, int nMe_, int nNe_, int pmA_, int pnB_) { G = G_; cx = cx_; nMe = nMe_; nNe = nNe_; pmA = pmA_; pnB = pnB_; ntot = NE * nMe * nNe; }
    __device__ __forceinline__ bool next(int i, pg8::Unit& u) const {
        const int U = i * G + cx; if (U >= ntot) return false;
        const int per = nMe * nNe, e = U / per, loc = U % per;
        u.pm = pmA + e * 5 + loc % nMe; u.pn = pnB + e * nNe + loc / nMe; return true;
    }
    __device__ __forceinline__ void a_ready(const pg8::Unit&) const {}
    __device__ __forceinline__ void done(const pg8::Unit&) const {}
};

struct EpiQKV {
    static constexpr bool PERM = true, AFTER_DRAIN = false;
    GAS bf16* QK; GAS bf16* VT;
    __device__ __forceinline__ void operator()(const f32x4 (&acc)[2][2][4][2], const pg8::Unit& u, int wr, int wc, int fr_in, int fq_in) const {
        int fr = fr_in, fq = fq_in; asm volatile("" : "+v"(fr), "+v"(fq));
        GAS bf16* base; int ldc;
        if (u.pn < T_HB) { base = QK + (size_t)(u.pm - T_HB) * 256 * 4096 + (size_t)(u.pn - T_WQKV) * 256; ldc = 4096; }
        else { base = VT + (size_t)(u.pm - (T_WQKV + 16)) * 256 * NROWS + (size_t)(u.pn - T_HB) * 256; ldc = NROWS; }
        int cofs[2];
#pragma unroll
        for (int bj = 0; bj < 2; ++bj) { int c = wc * 32 + 8 * fq + bj * 128;
            if (u.pn >= T_HB) { const int tok = (u.pn - T_HB) * 256 + c; if (tok < NLAT) { const int t = tok & 4095; c += (((t & 63) >> 3) << 9 | (t >> 6) << 3) - t; } }
            cofs[bj] = c; }
#pragma unroll
        for (int ai = 0; ai < 2; ++ai)
#pragma unroll
            for (int m = 0; m < 4; ++m) { GAS bf16* rowp = base + (size_t)(ai * 128 + wr * 64 + m * 16 + fr) * ldc;
#pragma unroll
                for (int bj = 0; bj < 2; ++bj) { const f32x4 v0 = acc[ai][bj][m][0], v1 = acc[ai][bj][m][1];
                    v4u w; w.x = pk2(v0[0], v0[1]); w.y = pk2(v0[2], v0[3]); w.z = pk2(v1[0], v1[1]); w.w = pk2(v1[2], v1[3]);
                    *(GAS v4u*)(rowp + cofs[bj]) = w; } }
    }
};
struct EpiWo {
    static constexpr bool PERM = true, AFTER_DRAIN = false;
    GAS bf16* O;
    __device__ __forceinline__ void operator()(const f32x4 (&acc)[2][2][4][2], const pg8::Unit& u, int wr, int wc, int fr_in, int fq_in) const {
        int fr = fr_in, fq = fq_in; asm volatile("" : "+v"(fr), "+v"(fq));
        GAS bf16* base = O + (size_t)(u.pm - T_AO) * 256 * D + (size_t)(u.pn - T_WO) * 256;
#pragma unroll
        for (int ai = 0; ai < 2; ++ai)
#pragma unroll
            for (int m = 0; m < 4; ++m) { GAS bf16* rowp = base + (size_t)(ai * 128 + wr * 64 + m * 16 + fr) * D + wc * 32 + 8 * fq;
#pragma unroll
                for (int bj = 0; bj < 2; ++bj) { const f32x4 v0 = acc[ai][bj][m][0], v1 = acc[ai][bj][m][1];
                    v4u w; w.x = pk2(v0[0], v0[1]); w.y = pk2(v0[2], v0[3]); w.z = pk2(v1[0], v1[1]); w.w = pk2(v1[2], v1[3]);
                    *(GAS v4u*)(rowp + bj * 128) = w; } }
    }
};
struct EpiGlu {
    static constexpr bool PERM = true, AFTER_DRAIN = false;
    GAS bf16* O;
    __device__ __forceinline__ void operator()(const f32x4 (&acc)[2][2][4][2], const pg8::Unit& u, int wr, int wc, int fr_in, int fq_in) const {
        int fr = fr_in, fq = fq_in; asm volatile("" : "+v"(fr), "+v"(fq));
        GAS bf16* base = O + (size_t)(u.pm - T_Z) * 256 * D + (size_t)(u.pn - T_WVG) * 128;
#pragma unroll
        for (int ai = 0; ai < 2; ++ai)
#pragma unroll
            for (int m = 0; m < 4; ++m) { GAS bf16* rowp = base + (size_t)(ai * 128 + wr * 64 + m * 16 + fr) * D + wc * 32 + 8 * fq;
                f32x4 o0, o1;
#pragma unroll
                for (int q = 0; q < 4; ++q) { o0[q] = acc[ai][0][m][0][q] * sigmoid_f(acc[ai][1][m][0][q]); o1[q] = acc[ai][0][m][1][q] * sigmoid_f(acc[ai][1][m][1][q]); }
                v4u w; w.x = pk2(o0[0], o0[1]); w.y = pk2(o0[2], o0[3]); w.z = pk2(o1[0], o1[1]); w.w = pk2(o1[2], o1[3]);
                *(GAS v4u*)rowp = w; }
    }
};
struct EpiSwiglu {
    static constexpr bool PERM = true, AFTER_DRAIN = false;
    GAS bf16* ACT; int pnB;
    __device__ __forceinline__ void operator()(const f32x4 (&acc)[2][2][4][2], const pg8::Unit& u, int wr, int wc, int fr_in, int fq_in) const {
        int fr = fr_in, fq = fq_in; asm volatile("" : "+v"(fr), "+v"(fq));
        const int j = (u.pn - pnB) & 15;
        GAS bf16* base = ACT + (size_t)(u.pm - T_XE) * 256 * D + (size_t)j * 128;
#pragma unroll
        for (int ai = 0; ai < 2; ++ai)
#pragma unroll
            for (int m = 0; m < 4; ++m) { GAS bf16* rowp = base + (size_t)(ai * 128 + wr * 64 + m * 16 + fr) * D + wc * 32 + 8 * fq;
                f32x4 o0, o1;
#pragma unroll
                for (int q = 0; q < 4; ++q) { o0[q] = silu_f(acc[ai][0][m][0][q]) * acc[ai][1][m][0][q]; o1[q] = silu_f(acc[ai][0][m][1][q]) * acc[ai][1][m][1][q]; }
                v4u w; w.x = pk2(o0[0], o0[1]); w.y = pk2(o0[2], o0[3]); w.z = pk2(o1[0], o1[1]); w.w = pk2(o1[2], o1[3]);
                *(GAS v4u*)rowp = w; }
    }
};
struct EpiDown {
    static constexpr bool PERM = true, AFTER_DRAIN = false;
    GAS bf16* YE; const GAS float* GATE; int pnB;
    __device__ __forceinline__ void operator()(const f32x4 (&acc)[2][2][4][2], const pg8::Unit& u, int wr, int wc, int fr_in, int fq_in) const {
        int fr = fr_in, fq = fq_in; asm volatile("" : "+v"(fr), "+v"(fq));
        const int j = (u.pn - pnB) & 7; const int rt = (u.pm - T_ACT) * 256;
        GAS bf16* base = YE + (size_t)rt * D + (size_t)j * 256;
#pragma unroll
        for (int ai = 0; ai < 2; ++ai)
#pragma unroll
            for (int m = 0; m < 4; ++m) { const int r = ai * 128 + wr * 64 + m * 16 + fr; const float gt = GATE[rt + r]; GAS bf16* rowp = base + (size_t)r * D + wc * 32 + 8 * fq;
#pragma unroll
                for (int bj = 0; bj < 2; ++bj) { const f32x4 v0 = acc[ai][bj][m][0] * gt, v1 = acc[ai][bj][m][1] * gt;
                    v4u w; w.x = pk2(v0[0], v0[1]); w.y = pk2(v0[2], v0[3]); w.z = pk2(v1[0], v1[1]); w.w = pk2(v1[2], v1[3]);
                    *(GAS v4u*)(rowp + bj * 128) = w; } }
    }
};

__device__ __forceinline__ float dot_bf16(const GAS bf16* a, const GAS bf16* b, int K) {
    float s = 0.f;
    for (int k = 0; k < K; k += 8) { const v4u x = *(const GAS v4u*)(a + k), y = *(const GAS v4u*)(b + k);
#pragma unroll
        for (int q = 0; q < 4; ++q) { s += bf2f(x[q] & 0xffffu) * bf2f(y[q] & 0xffffu); s += bf2f(x[q] >> 16) * bf2f(y[q] >> 16); } }
    return s;
}
template <class Epi, class Sched>
__device__ __forceinline__ void naive_gemm_phase(const pg8::Gemm g, const Sched& S, const Epi& E, int tid_in) {
    const int tid = tid_in, wid = __builtin_amdgcn_readfirstlane(tid >> 6), lane = tid & 63, wr = wid >> 2, wc = wid & 3, fr = lane & 15, fq = lane >> 4;
    pg8::Unit u;
    for (int i = 0; S.next(i, u); ++i) {
        f32x4 acc[2][2][4][2];
        const GAS bf16* A = (const GAS bf16*)g.A + (size_t)u.pm * 256 * g.K; const GAS bf16* B = (const GAS bf16*)g.Bt + (size_t)u.pn * 256 * g.K;
#pragma unroll
        for (int ai = 0; ai < 2; ++ai)
#pragma unroll
            for (int m = 0; m < 4; ++m) { const GAS bf16* ar = A + (size_t)(ai * 128 + wr * 64 + m * 16 + fr) * g.K;
#pragma unroll
                for (int bj = 0; bj < 2; ++bj)
#pragma unroll
                    for (int n = 0; n < 2; ++n)
#pragma unroll
                        for (int j = 0; j < 4; ++j) { const int c = Epi::PERM ? (bj * 128 + wc * 32 + 8 * fq + 4 * n + j) : (bj * 128 + wc * 32 + 16 * n + 4 * fq + j);
                            acc[ai][bj][m][n][j] = dot_bf16(ar, B + (size_t)c * g.K, g.K); } }
        E(acc, u, wr, wc, fr, fq);
    }
}
template <class Epi, class Sched>
__device__ __forceinline__ void run_gemm_ga(Frame& F, const Sched& S, const Epi& E, int tA) {
    const pg8::Gemm g{(const pg8::bf16_t*)(const unsigned char*)(F.ws + (size_t)tA * MiB), (const pg8::bf16_t*)(const unsigned char*)F.ws, 0, 0, D};
    pg8::gemm_phase<Epi, Sched, PG8_ALIGN, PG8_SP2, true, false, MOE_BAUX, WT_BKM != 0>((PG8_LAS unsigned char*)F.lds, g, S, E, F.tid);
}
template <class Epi, class Sched, bool VR = false, int BAUX = 0, bool BKM = (WT_BKM != 0)>
__device__ __forceinline__ void run_gemm(Frame& F, const Sched& S, const Epi& E) {
    const pg8::Gemm g{(const pg8::bf16_t*)(const unsigned char*)F.ws, (const pg8::bf16_t*)(const unsigned char*)F.ws, 0, 0, D};
#if NAIVE_GEMM
    naive_gemm_phase<Epi, Sched>(g, S, E, F.tid);
#else
    pg8::gemm_phase<Epi, Sched, PG8_ALIGN, PG8_SP2, false, VR, BAUX, BKM>((PG8_LAS unsigned char*)F.lds, g, S, E, F.tid);
#endif
}

#define LDV(p, j) (*(const GAS f32x4*)((p) + 4 * F.lane + 256 * (j)))
__device__ __forceinline__ f32x4 bf4_to_f32(v2u w) { return (f32x4){bf2f(w.x & 0xffffu), bf2f(w.x >> 16), bf2f(w.y & 0xffffu), bf2f(w.y >> 16)}; }
#define LDVB(p, j) bf4_to_f32(*(const GAS v2u*)((p) + 4 * F.lane + 256 * (j)))
#define LDVL(p, j) (*(const LAS f32x4*)((p) + 4 * F.lane + 256 * (j)))
__device__ __forceinline__ void stage_vec(const Frame& F, LAS float* dst, const GAS float* src) {
    *(LAS f32x4*)(dst + 4 * F.tid) = *(const GAS f32x4*)(src + 4 * F.tid);
}
__device__ __forceinline__ void ln_rows_lds(f32x4 (&v)[8], const LAS float* g, const LAS float* bb, const Frame& F) {
    float s = 0.f;
#pragma unroll
    for (int j = 0; j < 8; ++j) s += (v[j][0] + v[j][1]) + (v[j][2] + v[j][3]);
    const float mean = wave_sum(s) * (1.0f / D); float s2 = 0.f;
#pragma unroll
    for (int j = 0; j < 8; ++j) { v[j] = v[j] - mean; s2 += (v[j][0] * v[j][0] + v[j][1] * v[j][1]) + (v[j][2] * v[j][2] + v[j][3] * v[j][3]); }
    const float rstd = 1.0f / sqrtf(wave_sum(s2) * (1.0f / D) + LN_EPS);
#pragma unroll
    for (int j = 0; j < 8; ++j) v[j] = v[j] * rstd * LDVL(g, j) + LDVL(bb, j);
}

__device__ __forceinline__ void p0_mods(Frame& F) {
    LAS float* S = (LAS float*)F.lds;
    LAS float* P = S + 3 * D;
    const GAS float* c = fin(F, I_C); const GAS float* cctx = fin(F, I_CCTX);
    for (int i = F.tid; i < 3 * D; i += NTHREADS) { const int r = i / D, k = i % D; const float cv = (r < 2) ? c[r * D + k] : cctx[k]; S[i] = cv / (1.0f + expf(-cv)); }
    __syncthreads();
    const int tl = F.tid & 7, kg = F.tid >> 3;
    GAS float* M = (GAS float*)(F.ws + WS_MODS);
    for (int it = blockIdx.x; it < 2 * 384; it += F.G) {
        const int l = it / 384, cc = it % 384;
        const GAS float* w = fin(F, I_WMOD) + (size_t)l * D * D6 + cc * 32 + tl * 4;
        f32x4 a0 = {0.f, 0.f, 0.f, 0.f}, a1 = a0, a2 = a0;
#pragma unroll 8
        for (int kk = 0; kk < 32; ++kk) { const int k = kg * 32 + kk; const f32x4 wv = *(const GAS f32x4*)(w + (size_t)k * D6); a0 += wv * S[k]; a1 += wv * S[D + k]; a2 += wv * S[2 * D + k]; }
#pragma unroll
        for (int j = 0; j < 4; ++j) { P[(kg * 3 + 0) * 32 + tl * 4 + j] = a0[j]; P[(kg * 3 + 1) * 32 + tl * 4 + j] = a1[j]; P[(kg * 3 + 2) * 32 + tl * 4 + j] = a2[j]; }
        __syncthreads();
        if (F.tid < 96) { const int r = F.tid >> 5, col = F.tid & 31; float s = 0.f;
            for (int q = 0; q < 64; ++q) s += P[(q * 3 + r) * 32 + col];
            M[(size_t)(l * 3 + r) * D6 + cc * 32 + col] = s + fin(F, I_BMOD)[l * D6 + cc * 32 + col]; }
        __syncthreads();
    }
}
__device__ __forceinline__ void p0_s5params(Frame& F) {
    GAS float* AR = (GAS float*)(F.ws + WS_SPAR); GAS float* AI = AR + 2 * NG * NP; GAS float* BB = AI + 2 * NG * NP;
#if S5P_SPREAD
    if (F.wave != 0) return;
    for (int idx = F.vcu * 64 + F.lane; idx < 2 * NG * NP; idx += F.G * 64) {
#else
    for (int idx = blockIdx.x * NTHREADS + F.tid; idx < 2 * NG * NP; idx += F.G * NTHREADS) {
#endif
        const int dg = idx / NP;
        const double lr = (double)fminf(fin(F, I_LAMRE)[idx], -1e-4f), li = (double)fin(F, I_LAMIM)[idx], dt = exp((double)fin(F, I_LOGSTEP)[dg]);
        const double mag = exp(lr * dt); double sn, cs; sincos(li * dt, &sn, &cs);
        const double ar = mag * cs, ai = mag * sn, nr = ar - 1.0, den = lr * lr + li * li, cr = (nr * lr + ai * li) / den, ci = (ai * lr - nr * li) / den;
        AR[idx] = (float)ar; AI[idx] = (float)ai;
        for (int h = 0; h < GH; ++h) { const double bre = fin(F, I_BRE)[(size_t)idx * GH + h], bim = fin(F, I_BIM)[(size_t)idx * GH + h];
            BB[(size_t)idx * 32 + h] = (float)(cr * bre - ci * bim); BB[(size_t)idx * 32 + 16 + h] = (float)(cr * bim + ci * bre); }
    }
}
__device__ __forceinline__ void p0_item_load(const GAS float* W, int ldw, int k0, int lane, f32x4 (&v)[8]) {
    const GAS float* p = W + (size_t)((k0 & ~1) + 8 * (lane >> 3)) * ldw + 4 * (lane & 7);
#pragma unroll
    for (int i = 0; i < 8; ++i) v[i] = __builtin_nontemporal_load((const GAS f32x4*)(p + (size_t)i * ldw));
}
__device__ __forceinline__ void p0_item_store(GAS bf16* WT, int dst_row0, int k0, int lane, const f32x4 (&v)[8]) {
    const int g0 = dst_row0 + 4 * (lane & 7), kq = k0 & ~1; const bool bkm = (k0 & 1) != 0;
    GAS bf16* o = bkm ? WT + (size_t)(g0 >> 8) * (256 * D) + (size_t)(kq >> 6) * (256 * 64) + (g0 & 255) * 64 + 8 * (lane >> 3) : WT + (size_t)g0 * D + kq + 8 * (lane >> 3);
    const int RS = bkm ? 64 : D;
#pragma unroll
    for (int j = 0; j < 4; ++j) { v4u w; w.x = pk2(v[0][j], v[1][j]); w.y = pk2(v[2][j], v[3][j]); w.z = pk2(v[4][j], v[5][j]); w.w = pk2(v[6][j], v[7][j]);
#if CV_NT_STORE
        __builtin_nontemporal_store(w, (GAS v4u*)(o + (size_t)j * RS));
#else
        *(GAS v4u*)(o + (size_t)j * RS) = w;
#endif
    }
}
__device__ __forceinline__ void p0_decode(const Frame& F, int it, const GAS float*& src, int& ldw, GAS bf16*& dst, int& dr0, int& k0) {
    const int sq = it >> 11, r = it & 2047, kb = r >> 6, nb = r & 63, n0 = nb * 32;
    int mode = 0, off = 0; ldw = D;
    if (sq < 3) { src = fin(F, I_WQKV) + sq * D; ldw = 3 * D; dst = ws_tile(F, T_WQKV) + (size_t)sq * D * D; }
    else if (sq == 3) { src = fin(F, I_WO); dst = ws_tile(F, T_WO); }
    else if (sq == 4) { src = fin(F, I_WVAL); dst = ws_tile(F, T_WVG); mode = 1; }
    else if (sq == 5) { src = fin(F, I_WGATE); dst = ws_tile(F, T_WVG); mode = 1; off = 128; }
    else { const int mm = sq - 6, l = mm / 48, e = (mm % 48) / 3, t = mm % 3; const size_t wofs = (size_t)(l * NE + e) * D * D;
        if (t == 0) { src = fin(F, I_MGATE) + wofs; dst = ws_tile(F, T_MOE1 + l * 256) + (size_t)e * 4096 * D; mode = 1; }
        else if (t == 1) { src = fin(F, I_MUP) + wofs; dst = ws_tile(F, T_MOE1 + l * 256) + (size_t)e * 4096 * D; mode = 1; off = 128; }
        else { src = fin(F, I_MDOWN) + wofs; dst = ws_tile(F, T_MOE2 + l * 128) + (size_t)e * 2048 * D; } }
    src += n0; dr0 = mode ? ((n0 >> 7) * 256 + (n0 & 127) + off) : n0; k0 = kb * 64 + ((WT_BKM && sq >= 3) ? 1 : 0);
}
template <int NF>
__device__ __forceinline__ void p0_weights_n(Frame& F, int it0, int NIT, int gw, int NGW) {
    for (int it = it0 + gw; it < NIT; it += NF * NGW) {
        const GAS float* sp[NF]; int lw[NF], dr[NF], kk[NF]; GAS bf16* op[NF]; f32x4 v[NF][8]; bool ok[NF];
#pragma unroll
        for (int q = 0; q < NF; ++q) { ok[q] = it + q * NGW < NIT; if (ok[q]) { p0_decode(F, it + q * NGW, sp[q], lw[q], op[q], dr[q], kk[q]); p0_item_load(sp[q], lw[q], kk[q], F.lane, v[q]); } }
#pragma unroll
        for (int q = 0; q < NF; ++q) if (ok[q]) p0_item_store(op[q], dr[q], kk[q], F.lane, v[q]);
    }
}
__device__ __forceinline__ void p0_weights(Frame& F, int it0, int NIT, int gw, int NGW) {
#if CV_ROLL
    int it = it0 + gw; if (it >= NIT) return;
    const GAS float* s0; const GAS float* s1; int l0, l1, d0, d1, k0, k1; GAS bf16* o0; GAS bf16* o1; f32x4 va[8], vb[8];
    p0_decode(F, it, s0, l0, o0, d0, k0); p0_item_load(s0, l0, k0, F.lane, va);
    for (;;) {
        const bool hb = it + NGW < NIT;
        if (hb) { p0_decode(F, it + NGW, s1, l1, o1, d1, k1); p0_item_load(s1, l1, k1, F.lane, vb); }
        p0_item_store(o0, d0, k0, F.lane, va);
        if (!hb) break;
        const bool ha = it + 2 * NGW < NIT;
        if (ha) { p0_decode(F, it + 2 * NGW, s0, l0, o0, d0, k0); p0_item_load(s0, l0, k0, F.lane, va); }
        p0_item_store(o1, d1, k1, F.lane, vb);
        if (!ha) break;
        it += 2 * NGW;
    }
#else
    for (int it = it0 + gw; it < NIT; it += 2 * NGW) {
        const GAS float* s0; const GAS float* s1; int l0, l1, d0, d1, k0, k1; GAS bf16* o0; GAS bf16* o1; f32x4 va[8], vb[8];
        const bool two = it + NGW < NIT;
        p0_decode(F, it, s0, l0, o0, d0, k0); p0_item_load(s0, l0, k0, F.lane, va);
        if (two) { p0_decode(F, it + NGW, s1, l1, o1, d1, k1); p0_item_load(s1, l1, k1, F.lane, vb); }
        p0_item_store(o0, d0, k0, F.lane, va);
        if (two) p0_item_store(o1, d1, k1, F.lane, vb);
    }
#endif
}
__device__ __forceinline__ const GAS float* xin_row(Frame& F, int l, int row) {
    if (l == 0) return row < NLAT ? fin(F, I_X) + (size_t)row * D : fin(F, I_CTX) + (size_t)(row - NLAT) * D;
    return (const GAS float*)(F.ws + WS_X2) + (size_t)row * D;
}
#define XN_LOAD(dst, l_, row_) do { if (X2_FP16 && (l_)) { const GAS bf16* xh_ = (const GAS bf16*)(F.ws + WS_X2) + (size_t)(row_) * D; \
        _Pragma("unroll") for (int j = 0; j < 8; ++j) { const f32x2 t_ = *(const GAS f32x2*)(xh_ + 4 * F.lane + 256 * j); dst[j][0] = t_[0]; dst[j][1] = t_[1]; } } \
    else { const GAS float* xr_ = xin_row(F, l_, row_); _Pragma("unroll") for (int j = 0; j < 8; ++j) dst[j] = LDV(xr_, j); } } while (0)
__device__ __forceinline__ void p1_prep(Frame& F) {
    const int gw = F.vcu * NWAVES + F.wave, NGW = F.G * NWAVES;
    GAS bf16* HB = ws_tile(F, T_HB);
    LAS float* VL = (LAS float*)F.lds;
#pragma unroll
    for (int r = 0; r < 3; ++r) { stage_vec(F, VL + r * D, mods(F, 0, r, 0)); stage_vec(F, VL + (3 + r) * D, mods(F, 0, r, 1)); }
    f32x4 xn[8];
    if (gw < NROWS) { const GAS float* xr = xin_row(F, 0, gw);
#pragma unroll
        for (int j = 0; j < 8; ++j) xn[j] = LDV(xr, j); }
    __syncthreads();
    const int p1rows = P1_COOP ? NLAT : NROWS;
    for (int row = gw; row < p1rows; row += NGW) {
        const int r = row_r(row); const LAS float* sh = VL + r * D; const LAS float* sc = VL + (3 + r) * D;
        f32x4 h[8];
#pragma unroll
        for (int j = 0; j < 8; ++j) h[j] = xn[j] * (LDVL(sc, j) + 1.0f) + LDVL(sh, j);
        if (row + NGW < p1rows) { const GAS float* xr = xin_row(F, 0, row + NGW);
#pragma unroll
            for (int j = 0; j < 8; ++j) xn[j] = LDV(xr, j); }
#pragma unroll
        for (int j = 0; j < 8; ++j) { v2u w; w.x = pk2(h[j][0], h[j][1]); w.y = pk2(h[j][2], h[j][3]); *(GAS v2u*)(HB + (size_t)row * D + 4 * F.lane + 256 * j) = w; }
    }
#if P1_COOP
    for (int task = gw; task < 4 * NCTX; task += NGW) { const int row = NLAT + (task >> 2), qq = task & 3; const GAS float* xr = xin_row(F, 0, row);
        const LAS float* sh = VL + 2 * D; const LAS float* sc = VL + 5 * D;
#pragma unroll
        for (int jj = 0; jj < 2; ++jj) { const int j = 2 * qq + jj; const f32x4 h = LDV(xr, j) * (LDVL(sc, j) + 1.0f) + LDVL(sh, j);
            v2u w; w.x = pk2(h[0], h[1]); w.y = pk2(h[2], h[3]); *(GAS v2u*)(HB + (size_t)row * D + 4 * F.lane + 256 * j) = w; } }
#endif
}
__device__ __forceinline__ void p3_attn_naive(Frame& F) {
    const int gw = F.vcu * NWAVES + F.wave, NGW = F.G * NWAVES;
    LAS float* Pl = (LAS float*)(F.lds + F.wave * 4096);
    LAS int* Tl = (LAS int*)(F.lds + F.wave * 4096 + 2048);
    const GAS bf16* QK = ws_tile(F, T_QK); const GAS bf16* VT = ws_tile(F, T_VT); GAS bf16* AO = ws_tile(F, T_AO);
    const float scale = 0.08838834764831845f;
    for (int un = gw; un < NROWS * NH; un += NGW) {
        const int row = un >> 4, h = un & 15; const bool lat = row < NLAT;
        int b, r = 0, qc = 0, rs = 0, cst = 0;
        if (lat) { b = row >> 12; const int t = row & 4095; r = t >> 6; qc = t & 63; rs = min(max(r - 4, 0), 56); cst = min(max(qc - 8, 0), 48); } else b = (row - NLAT) >> 8;
        const int nk = lat ? 384 : 256;
        const GAS bf16* q = QK + (size_t)row * 4096 + h * HD;
        float sv[6]; float mx = -3.0e38f;
#pragma unroll
        for (int i = 0; i < 6; ++i) { const int kk = F.lane + 64 * i; float s = -3.0e38f;
            if (kk < nk) { int krow; float bias = 0.f;
                if (lat && kk < 128) { const int kr = rs + (kk >> 4), kc = cst + (kk & 15); krow = b * SEQ + kr * 64 + kc;
                    const int dc = min(max(kc - qc + 15, 0), 30); bias = fin(F, I_RPB)[(h * 15 + (kr - r + 7)) * 31 + dc]; }
                else krow = NLAT + b * CTXL + (lat ? kk - 128 : kk);
                s = dot_bf16(q, QK + (size_t)krow * 4096 + D + h * HD, HD) * scale + bias; Tl[kk] = krow; }
            sv[i] = s; mx = fmaxf(mx, s); }
        mx = wave_max(mx); float sum = 0.f;
#pragma unroll
        for (int i = 0; i < 6; ++i) { const int kk = F.lane + 64 * i; const float p = (kk < nk) ? __expf(sv[i] - mx) : 0.f; sv[i] = p; sum += p; }
        sum = wave_sum(sum); const float inv = 1.0f / sum;
#pragma unroll
        for (int i = 0; i < 6; ++i) { const int kk = F.lane + 64 * i; if (kk < nk) Pl[kk] = sv[i] * inv; }
        asm volatile("s_waitcnt lgkmcnt(0)" ::: "memory");
        float o0 = 0.f, o1 = 0.f; const GAS bf16* v0 = VT + (size_t)(h * HD + 2 * F.lane) * NROWS; const GAS bf16* v1 = v0 + NROWS;
        for (int kk = 0; kk < nk; ++kk) { const float p = Pl[kk]; const int kr = Tl[kk]; o0 += p * bf2f(v0[kr]); o1 += p * bf2f(v1[kr]); }
        *(GAS unsigned*)(AO + (size_t)row * D + h * HD + 2 * F.lane) = pk2(o0, o1);
        asm volatile("s_waitcnt lgkmcnt(0)" ::: "memory");
    }
}
__device__ __forceinline__ void ln_rows(f32x4 (&v)[8], const GAS float* g, const GAS float* bb, const Frame& F) {
    f32x4 gv[8], bv[8];
#pragma unroll
    for (int j = 0; j < 8; ++j) { gv[j] = LDV(g, j); bv[j] = LDV(bb, j); }
    __builtin_amdgcn_sched_barrier(0);
    float s = 0.f;
#pragma unroll
    for (int j = 0; j < 8; ++j) s += (v[j][0] + v[j][1]) + (v[j][2] + v[j][3]);
    const float mean = wave_sum(s) * (1.0f / D); float s2 = 0.f;
#pragma unroll
    for (int j = 0; j < 8; ++j) { v[j] = v[j] - mean; s2 += (v[j][0] * v[j][0] + v[j][1] * v[j][1]) + (v[j][2] * v[j][2] + v[j][3] * v[j][3]); }
    const float rstd = 1.0f / sqrtf(wave_sum(s2) * (1.0f / D) + LN_EPS);
#pragma unroll
    for (int j = 0; j < 8; ++j) v[j] = v[j] * rstd * gv[j] + bv[j];
}
__device__ __forceinline__ float reduce16(float (&v)[16], int lane) {
    float a[8], b[4], c[2];
    const bool h5 = lane & 32, h4 = lane & 16, h3 = lane & 8, h2 = lane & 4;
#pragma unroll
    for (int k = 0; k < 8; ++k) { const float snd = h5 ? v[k] : v[k + 8], kp = h5 ? v[k + 8] : v[k]; a[k] = kp + __shfl_xor(snd, 32); }
#pragma unroll
    for (int k = 0; k < 4; ++k) { const float snd = h4 ? a[k] : a[k + 4], kp = h4 ? a[k + 4] : a[k]; b[k] = kp + __shfl_xor(snd, 16); }
#pragma unroll
    for (int k = 0; k < 2; ++k) { const float snd = h3 ? b[k] : b[k + 2], kp = h3 ? b[k + 2] : b[k]; c[k] = kp + __shfl_xor(snd, 8); }
    float d = (h2 ? c[1] : c[0]) + __shfl_xor(h2 ? c[0] : c[1], 4);
    d += __shfl_xor(d, 2); d += __shfl_xor(d, 1);
    return d;
}
__device__ __forceinline__ void row_phase(Frame& F, int l, int dv) {
    const int gw = F.vcu * NWAVES + F.wave, NGW = F.G * NWAVES, nrows = (l || ROW_CTX_COOP) ? NLAT : NROWS;
    const GAS bf16* O = (const GAS bf16*)(F.ws + WS_O); GAS float* X1 = (GAS float*)(F.ws + WS_X1); GAS bf16* HB = ws_tile(F, T_HB); GAS float* AFFT = (GAS float*)(F.ws + WS_AFF);
    const GAS float* lng = fin(F, I_LNG) + (size_t)(l * 2 + 0) * D; const GAS float* lnb = fin(F, I_LNB) + (size_t)(l * 2 + 0) * D; const GAS float* wr = fin(F, I_ROUTER) + (size_t)l * D * NE;
    LAS float* WR = (LAS float*)F.lds;
#pragma unroll
    for (int bt = 0; bt < 2; ++bt) { f32x4 t8[8];
#pragma unroll
        for (int k = 0; k < 8; ++k) { const int pc = F.tid + NTHREADS * (8 * bt + k), ln = pc & 63, e4 = (pc >> 6) & 3, qq = (pc >> 8) & 3, jj = pc >> 10;
            t8[k] = *(const GAS f32x4*)(wr + (size_t)(4 * ln + 256 * jj + qq) * NE + 4 * e4); }
#pragma unroll
        for (int k = 0; k < 8; ++k) *(LAS f32x4*)(WR + 4 * (F.tid + NTHREADS * (8 * bt + k))) = t8[k]; }
    __syncthreads();
    f32x4 xn[8]; v2u on[8];
    if (gw < nrows) { const GAS bf16* orow = O + (size_t)gw * D;
        XN_LOAD(xn, l, gw);
#pragma unroll
        for (int j = 0; j < 8; ++j) on[j] = *(const GAS v2u*)(orow + 4 * F.lane + 256 * j); }
    for (int row = gw; row < nrows; row += NGW) {
        const int r = row_r(row);
        const GAS float* g1 = mods(F, l, r, 2); const GAS float* sh2 = mods(F, l, r, 3); const GAS float* sc2 = mods(F, l, r, 4);
        f32x4 v[8];
        { f32x4 gg[8];
#pragma unroll
          for (int j = 0; j < 8; ++j) gg[j] = LDV(g1, j);
          __builtin_amdgcn_sched_barrier(0);
#pragma unroll
          for (int j = 0; j < 8; ++j) { const f32x4 xx = (X2_FP16 && l) ? h4_to_f32((v2u){__float_as_uint(xn[j][0]), __float_as_uint(xn[j][1])}) : xn[j];
              v[j] = xx * ALPHA + gg[j] * bf4_to_f32(on[j]); } }
        if (row + NGW < nrows) { const GAS bf16* orow = O + (size_t)(row + NGW) * D;
            XN_LOAD(xn, l, row + NGW);
#pragma unroll
            for (int j = 0; j < 8; ++j) on[j] = *(const GAS v2u*)(orow + 4 * F.lane + 256 * j); }
        ln_rows(v, lng, lnb, F);
        float lg[NE];
#pragma unroll
        for (int e = 0; e < NE; ++e) lg[e] = 0.f;
        f32x4 hv[8];
        { f32x4 cv[8], sv[8];
#pragma unroll
          for (int j = 0; j < 8; ++j) { cv[j] = LDV(sc2, j); sv[j] = LDV(sh2, j); }
          __builtin_amdgcn_sched_barrier(0);
#pragma unroll
          for (int j = 0; j < 8; ++j) hv[j] = v[j] * (cv[j] + 1.0f) + sv[j]; }
#if X1_BF16
        { v2u xw[8];
#pragma unroll
          for (int j = 0; j < 8; ++j) { xw[j].x = X1PK(v[j][0], v[j][1]); xw[j].y = X1PK(v[j][2], v[j][3]); }
          __builtin_amdgcn_sched_barrier(0);
#pragma unroll
          for (int j = 0; j < 8; ++j) {
#if NT_STREAM
              __builtin_nontemporal_store(xw[j], (GAS v2u*)((GAS bf16*)X1 + (size_t)row * D + 4 * F.lane + 256 * j));
#else
              *(GAS v2u*)((GAS bf16*)X1 + (size_t)row * D + 4 * F.lane + 256 * j) = xw[j];
#endif
          } }
#pragma unroll
        for (int j = 0; j < 8; ++j) { v2u w; w.x = pk2(hv[j][0], hv[j][1]); w.y = pk2(hv[j][2], hv[j][3]); *(GAS v2u*)(HB + (size_t)row * D + 4 * F.lane + 256 * j) = w; }
#else
#pragma unroll
        for (int j = 0; j < 8; ++j) { *(GAS f32x4*)(X1 + (size_t)row * D + 4 * F.lane + 256 * j) = v[j];
            v2u w; w.x = pk2(hv[j][0], hv[j][1]); w.y = pk2(hv[j][2], hv[j][3]); *(GAS v2u*)(HB + (size_t)row * D + 4 * F.lane + 256 * j) = w; }
#endif
        {
            const LAS float* wl = WR + 4 * F.lane; f32x4 wv[2][4];
#pragma unroll
            for (int e4 = 0; e4 < 4; ++e4) wv[0][e4] = *(const LAS f32x4*)(wl + e4 * 256);
#pragma unroll
            for (int st = 0; st < 32; ++st) {
                if (st + 1 < 32) {
#pragma unroll
                    for (int e4 = 0; e4 < 4; ++e4) wv[(st + 1) & 1][e4] = *(const LAS f32x4*)(wl + ((st + 1) * 4 + e4) * 256); }
                const float hq = hv[st >> 2][st & 3];
#pragma unroll
                for (int e4 = 0; e4 < 4; ++e4)
#pragma unroll
                    for (int t = 0; t < 4; ++t) lg[4 * e4 + t] += hq * wv[st & 1][e4][t];
                __builtin_amdgcn_sched_barrier(0); }
        }
        const float lgt = reduce16(lg, F.lane);
        float mx = lgt;
#pragma unroll
        for (int o = 4; o < 64; o <<= 1) mx = fmaxf(mx, __shfl_xor(mx, o));
        const float ex = expf(lgt - mx); float sum = ex;
#pragma unroll
        for (int o = 4; o < 64; o <<= 1) sum += __shfl_xor(sum, o);
        if ((F.lane & 3) == 0) AFFT[(size_t)((F.lane >> 2) & 15) * NROWS + row] = ex / sum;
    }
#if ROW_CTX_COOP
    if (l == 0) {
        LAS float* PS = (LAS float*)(F.lds + 131072);
        LAS float* PQ = PS + 8; LAS float* PL = PQ + 8;
        const int rr = F.wave >> 2, qq = F.wave & 3;
        for (int base = 2 * F.vcu; base < NCTX; base += 2 * F.G) {
            const int row = NLAT + base + rr;
            const GAS float* xr = xin_row(F, 0, row); const GAS bf16* orow = O + (size_t)row * D;
            const GAS float* g1 = mods(F, 0, 2, 2); const GAS float* sh2 = mods(F, 0, 2, 3); const GAS float* sc2 = mods(F, 0, 2, 4);
            f32x4 v[2], gv[2], bv[2], cv[2], sv[2];
#pragma unroll
            for (int jj = 0; jj < 2; ++jj) { const int j = 2 * qq + jj; v[jj] = LDV(xr, j) * ALPHA + LDV(g1, j) * bf4_to_f32(*(const GAS v2u*)(orow + 4 * F.lane + 256 * j));
                gv[jj] = LDV(lng, j); bv[jj] = LDV(lnb, j); cv[jj] = LDV(sc2, j); sv[jj] = LDV(sh2, j); }
            float s = (v[0][0] + v[0][1]) + (v[0][2] + v[0][3]) + (v[1][0] + v[1][1]) + (v[1][2] + v[1][3]);
            s = wave_sum(s); if (F.lane == 0) PS[rr * 4 + qq] = s;
            __syncthreads();
            const float mean = ((PS[rr * 4 + 0] + PS[rr * 4 + 1]) + (PS[rr * 4 + 2] + PS[rr * 4 + 3])) * (1.0f / D);
            float s2 = 0.f;
#pragma unroll
            for (int jj = 0; jj < 2; ++jj) { v[jj] = v[jj] - mean; s2 += (v[jj][0] * v[jj][0] + v[jj][1] * v[jj][1]) + (v[jj][2] * v[jj][2] + v[jj][3] * v[jj][3]); }
            s2 = wave_sum(s2); if (F.lane == 0) PQ[rr * 4 + qq] = s2;
            __syncthreads();
            const float rstd = 1.0f / sqrtf(((PQ[rr * 4 + 0] + PQ[rr * 4 + 1]) + (PQ[rr * 4 + 2] + PQ[rr * 4 + 3])) * (1.0f / D) + LN_EPS);
            f32x4 hv[2];
#pragma unroll
            for (int jj = 0; jj < 2; ++jj) { const int j = 2 * qq + jj; v[jj] = v[jj] * rstd * gv[jj] + bv[jj]; hv[jj] = v[jj] * (cv[jj] + 1.0f) + sv[jj];
#if X1_BF16
                { v2u xw; xw.x = X1PK(v[jj][0], v[jj][1]); xw.y = X1PK(v[jj][2], v[jj][3]); *(GAS v2u*)((GAS bf16*)X1 + (size_t)row * D + 4 * F.lane + 256 * j) = xw; }
#else
                *(GAS f32x4*)(X1 + (size_t)row * D + 4 * F.lane + 256 * j) = v[jj];
#endif
                v2u w; w.x = pk2(hv[jj][0], hv[jj][1]); w.y = pk2(hv[jj][2], hv[jj][3]); *(GAS v2u*)(HB + (size_t)row * D + 4 * F.lane + 256 * j) = w; }
            float lg[NE];
#pragma unroll
            for (int e = 0; e < NE; ++e) lg[e] = 0.f;
#pragma unroll
            for (int jj = 0; jj < 2; ++jj)
#pragma unroll
                for (int q = 0; q < 4; ++q) { const LAS float* wp = WR + ((((2 * qq + jj) * 4 + q) * 4) * 64 + F.lane) * 4; const float hq = hv[jj][q];
#pragma unroll
                    for (int e4 = 0; e4 < 4; ++e4) { const f32x4 wv = *(const LAS f32x4*)(wp + e4 * 256);
#pragma unroll
                        for (int t = 0; t < 4; ++t) lg[4 * e4 + t] += hq * wv[t]; } }
            const float lgt = reduce16(lg, F.lane);
            if ((F.lane & 3) == 0) PL[(rr * 4 + qq) * 16 + ((F.lane >> 2) & 15)] = lgt;
            __syncthreads();
            if (qq == 0) { const int e = F.lane & 15;
                const float lgs = (PL[(rr * 4 + 0) * 16 + e] + PL[(rr * 4 + 1) * 16 + e]) + (PL[(rr * 4 + 2) * 16 + e] + PL[(rr * 4 + 3) * 16 + e]);
                float mx = lgs;
#pragma unroll
                for (int o = 1; o < 16; o <<= 1) mx = fmaxf(mx, __shfl_xor(mx, o));
                const float ex = expf(lgs - mx); float sum = ex;
#pragma unroll
                for (int o = 1; o < 16; o <<= 1) sum += __shfl_xor(sum, o);
                if (F.lane < 16) AFFT[(size_t)e * NROWS + row] = ex / sum; }
            __syncthreads();
        }
    }
#endif
    __syncthreads();
}
__device__ __forceinline__ void topk_phase(Frame& F, int l) {
    LAS int* CW = (LAS int*)F.lds;
    LAS int* CG = CW + 16;
    LAS int* CE = CG + 64;
    const GAS float* AFFT = (const GAS float*)(F.ws + WS_AFF); GAS int* SLOT = (GAS int*)(F.ws + WS_SLOT); GAS int* IDX = (GAS int*)(F.ws + WS_IDX); GAS float* GATE = (GAS float*)(F.ws + WS_GATE);
#if TOPK_CTX_WAVE
    const int nlat = 2 * NE * 8, ntot = nlat;
    if (l == 0 && F.wave == 0) {
        for (int q = blockIdx.x; q < 2 * NE; q += F.G) {
            const int b = q >> 4, e = q & 15, rowbase = NLAT + b * CTXL, slotbase = e * RPE + 1024 + b * 32, cap = 32;
            unsigned kc[4];
#pragma unroll
            for (int i = 0; i < 4; ++i) kc[i] = __float_as_uint(AFFT[(size_t)e * NROWS + rowbase + F.lane + 64 * i]);
            unsigned T = 0u;
            for (int bit = 30; bit >= 0; --bit) { const unsigned cand = T | (1u << bit); int cnt = 0;
#pragma unroll
                for (int i = 0; i < 4; ++i) cnt += __builtin_popcountll(__ballot(kc[i] >= cand));
                if (cnt >= cap) T = cand; }
            unsigned long long mg[4], me[4]; int gt_total = 0;
#pragma unroll
            for (int i = 0; i < 4; ++i) { mg[i] = __ballot(kc[i] > T); me[i] = __ballot(kc[i] == T); gt_total += __builtin_popcountll(mg[i]); }
            const int need = cap - gt_total;
            const unsigned long long lower = (F.lane == 0) ? 0ull : (~0ull >> (64 - F.lane));
            int g_before = 0, e_before = 0;
#pragma unroll
            for (int i = 0; i < 4; ++i) { const int t = F.lane + 64 * i;
                const int g_rank = g_before + __builtin_popcountll(mg[i] & lower), e_rank = e_before + __builtin_popcountll(me[i] & lower);
                const int e_taken_before = e_rank < need ? e_rank : need;
                const bool sel = (kc[i] > T) || (kc[i] == T && e_rank < need);
                int sl = -1;
                if (sel) { sl = slotbase + g_rank + e_taken_before; IDX[sl] = rowbase + t; GATE[sl] = __uint_as_float(kc[i]); }
                SLOT[(size_t)(rowbase + t) * NE + e] = sl;
                g_before += __builtin_popcountll(mg[i]); e_before += __builtin_popcountll(me[i]); }
        }
    }
#else
    const int nlat = 2 * NE * 8, ntot = nlat + (l == 0 ? 2 * NE : 0);
#endif
#if CV_TKN
    const int cv_end = CV_NIT_ALL - (1 - l) * CV_TK, cv_ngw = F.G * NWAVES; int cv_it = cv_end - CV_TK + F.vcu * NWAVES + F.wave, cv_left = CV_TKN; bool cv_pend = false;
    const GAS float* cs0 = nullptr; int cl0 = 0, cd0 = 0, ck0 = 0; GAS bf16* co0 = nullptr; f32x4 cva[8];
#endif
    for (int un = blockIdx.x; un < ntot; un += F.G) {
        const bool lat = un < nlat; int b, e, ch, n, cap, rowbase, slotbase;
        if (lat) { b = un >> 7; e = (un >> 3) & 15; ch = un & 7; n = SEQ; cap = 512; rowbase = b * SEQ; slotbase = e * RPE + b * 512; }
        else { const int q = un - nlat; b = q >> 4; e = q & 15; ch = 0; n = CTXL; cap = 32; rowbase = NLAT + b * CTXL; slotbase = e * RPE + 1024 + b * 32; }
        unsigned key[8];
#pragma unroll
        for (int i = 0; i < 8; ++i) { const int t = F.tid + 512 * i; key[i] = (t < n) ? __float_as_uint(AFFT[(size_t)e * NROWS + rowbase + t]) : 0u; }
        unsigned T = 0u;
#if TOPK_2BIT
        typedef int i32x4 __attribute__((ext_vector_type(4)));
        LAS i32x4* CW4 = (LAS i32x4*)(F.lds + 4096);
        {   const unsigned cand = 1u << 30; int cnt = 0;
#pragma unroll
            for (int i = 0; i < 8; ++i) cnt += __builtin_popcountll(__ballot(key[i] >= cand));
            if (F.lane == 0) CW[F.wave] = cnt;
            __syncthreads();
            int tot = 0;
#pragma unroll
            for (int w = 0; w < 8; ++w) tot += CW[w];
            if (tot >= cap) T = cand; }
        for (int lo = 28; lo >= 0; lo -= 2) {
            const unsigned c1 = T | (1u << lo), c2 = T | (2u << lo), c3 = T | (3u << lo); int n1 = 0, n2 = 0, n3 = 0;
#pragma unroll
            for (int i = 0; i < 8; ++i) { n1 += __builtin_popcountll(__ballot(key[i] >= c1)); n2 += __builtin_popcountll(__ballot(key[i] >= c2)); n3 += __builtin_popcountll(__ballot(key[i] >= c3)); }
            LAS i32x4* cw = CW4 + ((lo >> 1) & 1) * 8;
            if (F.lane == 0) cw[F.wave] = (i32x4){n1, n2, n3, 0};
            __syncthreads();
            i32x4 tot = {0, 0, 0, 0};
#pragma unroll
            for (int w = 0; w < 8; ++w) tot += cw[w];
            T = tot[2] >= cap ? c3 : tot[1] >= cap ? c2 : tot[0] >= cap ? c1 : T;
        }
#else
        for (int bit = 30; bit >= 0; --bit) {
#if CV_TKN
            if ((bit & 3) == 2) {
                if (cv_pend) { p0_item_store(co0, cd0, ck0, F.lane, cva); cv_pend = false; }
                if (cv_left > 0 && cv_it < cv_end) { p0_decode(F, cv_it, cs0, cl0, co0, cd0, ck0); p0_item_load(cs0, cl0, ck0, F.lane, cva); cv_pend = true; cv_it += cv_ngw; }
                --cv_left; }
#endif
            const unsigned cand = T | (1u << bit); int cnt = 0;
#pragma unroll
            for (int i = 0; i < 8; ++i) cnt += __builtin_popcountll(__ballot(key[i] >= cand));
            LAS int* cw = CW + (bit & 1) * 8;
            if (F.lane == 0) cw[F.wave] = cnt;
            __syncthreads();
            int tot = 0;
#pragma unroll
            for (int w = 0; w < 8; ++w) tot += cw[w];
            if (tot >= cap) T = cand;
        }
#endif
#pragma unroll
        for (int i = 0; i < 8; ++i) { const unsigned long long mg = __ballot(key[i] > T), me = __ballot(key[i] == T);
            if (F.lane == 0) { CG[i * 8 + F.wave] = __builtin_popcountll(mg); CE[i * 8 + F.wave] = __builtin_popcountll(me); } }
        __syncthreads();
        int gt_total = 0, g_before = 0, e_before = 0;
        { typedef int i32x4 __attribute__((ext_vector_type(4))); i32x4 cgv[16], cev[16];
#pragma unroll
          for (int k4 = 0; k4 < 16; ++k4) { cgv[k4] = *(const LAS i32x4*)(CG + 4 * k4); cev[k4] = *(const LAS i32x4*)(CE + 4 * k4); }
          const int lim = ch * 8 + F.wave;
#pragma unroll
          for (int k4 = 0; k4 < 16; ++k4)
#pragma unroll
              for (int t = 0; t < 4; ++t) { const int k = 4 * k4 + t; gt_total += cgv[k4][t]; g_before += (k < lim) ? cgv[k4][t] : 0; e_before += (k < lim) ? cev[k4][t] : 0; } }
        const int need = cap - gt_total;
        {
            unsigned kv = 0u;
#pragma unroll
            for (int i = 0; i < 8; ++i) kv = (i == ch) ? key[i] : kv;
            const int t = F.tid + 512 * ch;
            const unsigned long long mg = __ballot(kv > T), me = __ballot(kv == T);
            const unsigned long long lower = (F.lane == 0) ? 0ull : (~0ull >> (64 - F.lane));
            const int g_rank = g_before + __builtin_popcountll(mg & lower), e_rank = e_before + __builtin_popcountll(me & lower);
            const int e_taken_before = e_rank < need ? e_rank : need;
            const bool sel = (t < n) && ((kv > T) || (kv == T && e_rank < need));
            if (t < n) { int s = -1;
                if (sel) { s = slotbase + g_rank + e_taken_before; IDX[s] = rowbase + t; GATE[s] = __uint_as_float(kv); }
                SLOT[(size_t)(rowbase + t) * NE + e] = s; }
        }
        __syncthreads();
    }
#if CV_TKN
    if (cv_pend) p0_item_store(co0, cd0, ck0, F.lane, cva);
    for (; cv_left > 0 && cv_it < cv_end; --cv_left, cv_it += cv_ngw) { p0_decode(F, cv_it, cs0, cl0, co0, cd0, ck0); p0_item_load(cs0, cl0, ck0, F.lane, cva); p0_item_store(co0, cd0, ck0, F.lane, cva); }
#endif
}
__device__ __forceinline__ void gather_phase(Frame& F, int l) {
    const int gw = F.vcu * NWAVES + F.wave, NGW = F.G * NWAVES, nv = l ? 1024 : 1088;
    const GAS bf16* HB = ws_tile(F, T_HB); GAS bf16* XE = ws_tile(F, T_XE); const GAS int* IDX = (const GAS int*)(F.ws + WS_IDX);
    for (int i = gw; i < NE * nv; i += NGW) { const int e = i / nv, s = e * RPE + i % nv; const int src = IDX[s];
        const GAS v4u* sp = (const GAS v4u*)(HB + (size_t)src * D); GAS v4u* dp = (GAS v4u*)(XE + (size_t)s * D);
        v4u t4[4];
#pragma unroll
        for (int j = 0; j < 4; ++j) t4[j] = sp[F.lane + 64 * j];
#pragma unroll
        for (int j = 0; j < 4; ++j) dp[F.lane + 64 * j] = t4[j]; }
}
__device__ __forceinline__ void combine_phase(Frame& F, int l) {
    const int gw = F.vcu * NWAVES + F.wave, NGW = F.G * NWAVES, nrows = (l || CTX_COOP2) ? NLAT : NROWS;
    const GAS float* X1 = (const GAS float*)(F.ws + WS_X1); const GAS bf16* YE = (const GAS bf16*)(F.ws + WS_YE); const GAS int* SLOT = (const GAS int*)(F.ws + WS_SLOT);
    GAS float* X2 = (GAS float*)(F.ws + WS_X2); GAS bf16* HB = ws_tile(F, T_HB);
    const GAS float* lng = fin(F, I_LNG) + (size_t)(l * 2 + 1) * D; const GAS float* lnb = fin(F, I_LNB) + (size_t)(l * 2 + 1) * D;
    LAS float* VL = (LAS float*)F.lds;
    stage_vec(F, VL, lng); stage_vec(F, VL + D, lnb);
#pragma unroll
    for (int r = 0; r < 3; ++r) { stage_vec(F, VL + (2 + r) * D, mods(F, l, r, 5)); if (l == 0) { stage_vec(F, VL + (5 + r) * D, mods(F, 1, r, 0)); stage_vec(F, VL + (8 + r) * D, mods(F, 1, r, 1)); } }
    __syncthreads();
    int svn = (gw < nrows) ? SLOT[(size_t)gw * NE + (F.lane & 15)] : -1;
    for (int row = gw; row < nrows; row += NGW) {
        const int r = row_r(row); const LAS float* g2 = VL + (2 + r) * D;
#if X1_BF16
        const GAS bf16* x1 = (const GAS bf16*)X1 + (size_t)row * D;
#else
        const GAS float* x1 = X1 + (size_t)row * D;
#endif
        f32x4 f[8];
#pragma unroll
        for (int j = 0; j < 8; ++j) f[j] = (f32x4){0.f, 0.f, 0.f, 0.f};
        const int sv = svn;
        if (row + NGW < nrows) svn = SLOT[(size_t)(row + NGW) * NE + (F.lane & 15)];
        f32x4 xv[8], g2v[8];
#if X1_BF16
#pragma unroll
        for (int j = 0; j < 8; ++j) { xv[j] = X1UNPK(*(const GAS v2u*)(x1 + 4 * F.lane + 256 * j)); g2v[j] = LDVL(g2, j); }
#else
#pragma unroll
        for (int j = 0; j < 8; ++j) { xv[j] = LDV(x1, j); g2v[j] = LDVL(g2, j); }
#endif
#pragma unroll
        for (int e = 0; e < NE; ++e) { const int s = __builtin_amdgcn_readlane(sv, e);
            if (s >= 0) { const GAS bf16* yr = YE + (size_t)s * D; v2u t[8];
#pragma unroll
                for (int j = 0; j < 8; ++j) t[j] = *(const GAS v2u*)(yr + 4 * F.lane + 256 * j);
#pragma unroll
                for (int j = 0; j < 8; ++j) f[j] += bf4_to_f32(t[j]); } }
        f32x4 v[8];
#pragma unroll
        for (int j = 0; j < 8; ++j) v[j] = xv[j] * ALPHA + g2v[j] * f[j];
        ln_rows_lds(v, VL, VL + D, F);
        if (l == 0) { const LAS float* sh = VL + (5 + r) * D; const LAS float* sc = VL + (8 + r) * D; v2u hw[8];
#pragma unroll
            for (int j = 0; j < 8; ++j) { const f32x4 h = v[j] * (LDVL(sc, j) + 1.0f) + LDVL(sh, j); hw[j].x = pk2(h[0], h[1]); hw[j].y = pk2(h[2], h[3]); }
#pragma unroll
            for (int j = 0; j < 8; ++j) {
#if NT_STREAM
                __builtin_nontemporal_store(v[j], (GAS f32x4*)(X2 + (size_t)row * D + 4 * F.lane + 256 * j));
#elif X2_FP16
                { v2u xw; xw.x = pkh2(v[j][0], v[j][1]); xw.y = pkh2(v[j][2], v[j][3]); *(GAS v2u*)((GAS bf16*)X2 + (size_t)row * D + 4 * F.lane + 256 * j) = xw; }
#else
                *(GAS f32x4*)(X2 + (size_t)row * D + 4 * F.lane + 256 * j) = v[j];
#endif
                *(GAS v2u*)(HB + (size_t)row * D + 4 * F.lane + 256 * j) = hw[j]; } }
        else {
#pragma unroll
            for (int j = 0; j < 8; ++j) {
#if NT_STREAM
                __builtin_nontemporal_store(v[j], (GAS f32x4*)(F.out + (size_t)row * D + 4 * F.lane + 256 * j));
#else
                *(GAS f32x4*)(F.out + (size_t)row * D + 4 * F.lane + 256 * j) = v[j];
#endif
            } }
    }
#if CTX_COOP2
    if (l == 0) {
        LAS float* PS = (LAS float*)(F.lds + 131072); LAS float* PQ = PS + 8;
        const int rr = F.wave >> 2, qq = F.wave & 3;
        for (int base = 2 * F.vcu; base < NCTX; base += 2 * F.G) {
            const int row = NLAT + base + rr; const GAS float* x1 = X1 + (size_t)row * D; const LAS float* g2 = VL + 4 * D;
            const int sv = SLOT[(size_t)row * NE + (F.lane & 15)];
            f32x4 f[2] = {{0.f, 0.f, 0.f, 0.f}, {0.f, 0.f, 0.f, 0.f}}, xv[2];
#pragma unroll
            for (int jj = 0; jj < 2; ++jj) xv[jj] = LDV(x1, 2 * qq + jj);
#pragma unroll
            for (int e = 0; e < NE; ++e) { const int sl = __builtin_amdgcn_readlane(sv, e);
                if (sl >= 0) { const GAS bf16* yr = YE + (size_t)sl * D; v2u t[2];
#pragma unroll
                    for (int jj = 0; jj < 2; ++jj) t[jj] = *(const GAS v2u*)(yr + 4 * F.lane + 256 * (2 * qq + jj));
#pragma unroll
                    for (int jj = 0; jj < 2; ++jj) f[jj] += bf4_to_f32(t[jj]); } }
            f32x4 v[2];
#pragma unroll
            for (int jj = 0; jj < 2; ++jj) v[jj] = xv[jj] * ALPHA + LDVL(g2, 2 * qq + jj) * f[jj];
            float s1 = (v[0][0] + v[0][1]) + (v[0][2] + v[0][3]) + (v[1][0] + v[1][1]) + (v[1][2] + v[1][3]);
            s1 = wave_sum(s1); if (F.lane == 0) PS[rr * 4 + qq] = s1;
            __syncthreads();
            const float mean = ((PS[rr * 4 + 0] + PS[rr * 4 + 1]) + (PS[rr * 4 + 2] + PS[rr * 4 + 3])) * (1.0f / D);
            float s2 = 0.f;
#pragma unroll
            for (int jj = 0; jj < 2; ++jj) { v[jj] = v[jj] - mean; s2 += (v[jj][0] * v[jj][0] + v[jj][1] * v[jj][1]) + (v[jj][2] * v[jj][2] + v[jj][3] * v[jj][3]); }
            s2 = wave_sum(s2); if (F.lane == 0) PQ[rr * 4 + qq] = s2;
            __syncthreads();
            const float rstd = 1.0f / sqrtf(((PQ[rr * 4 + 0] + PQ[rr * 4 + 1]) + (PQ[rr * 4 + 2] + PQ[rr * 4 + 3])) * (1.0f / D) + LN_EPS);
            const LAS float* sh = VL + 7 * D; const LAS float* sc = VL + 10 * D;
#pragma unroll
            for (int jj = 0; jj < 2; ++jj) { const int j = 2 * qq + jj; v[jj] = v[jj] * rstd * LDVL(VL, j) + LDVL(VL + D, j);
                const f32x4 h = v[jj] * (LDVL(sc, j) + 1.0f) + LDVL(sh, j);
                *(GAS f32x4*)(X2 + (size_t)row * D + 4 * F.lane + 256 * j) = v[jj];
                v2u w; w.x = pk2(h[0], h[1]); w.y = pk2(h[2], h[3]); *(GAS v2u*)(HB + (size_t)row * D + 4 * F.lane + 256 * j) = w; }
            __syncthreads();
        }
    }
#endif
    __syncthreads();
}
__device__ __forceinline__ void s5_naive(Frame& F) {
    const int gw = F.vcu * NWAVES + F.wave, NGW = F.G * NWAVES;
    const GAS float* AR = (const GAS float*)(F.ws + WS_SPAR); const GAS float* AI = AR + 2 * NG * NP; const GAS float* BB = AI + 2 * NG * NP;
    const GAS bf16* HB = ws_tile(F, T_HB);
    for (int un = gw; un < 2 * NG * 2; un += NGW) {
        const int b = un >> 8, g = (un >> 1) & 127, dir = un & 1; const int idx = (dir * NG + g) * NP + F.lane;
        const float ar = AR[idx], ai = AI[idx]; float br[GH], bi[GH], cr[GH], ci[GH];
#pragma unroll
        for (int h = 0; h < GH; ++h) { br[h] = BB[(size_t)idx * 32 + h]; bi[h] = BB[(size_t)idx * 32 + 16 + h];
            cr[h] = fin(F, I_CRE)[((size_t)(dir * NG + g) * GH + h) * NP + F.lane]; ci[h] = fin(F, I_CIM)[((size_t)(dir * NG + g) * GH + h) * NP + F.lane]; }
        GAS float* Y = (GAS float*)(F.ws + (dir ? WS_YB : WS_YF));
        float xr = 0.f, xi = 0.f;
        for (int tau = 0; tau < CTXL + SEQ; ++tau) {
            int row; if (tau < CTXL) row = NLAT + b * CTXL + (dir ? CTXL - 1 - tau : tau); else row = b * SEQ + (dir ? SEQ - 1 - (tau - CTXL) : tau - CTXL);
            const v4u u0 = *(const GAS v4u*)(HB + (size_t)row * D + g * GH), u1 = *(const GAS v4u*)(HB + (size_t)row * D + g * GH + 8);
            float u[GH];
#pragma unroll
            for (int q = 0; q < 4; ++q) { u[2 * q] = bf2f(u0[q] & 0xffffu); u[2 * q + 1] = bf2f(u0[q] >> 16); u[8 + 2 * q] = bf2f(u1[q] & 0xffffu); u[8 + 2 * q + 1] = bf2f(u1[q] >> 16); }
            float pr = 0.f, pi = 0.f;
#pragma unroll
            for (int h = 0; h < GH; ++h) { pr += br[h] * u[h]; pi += bi[h] * u[h]; }
            const float nxr = ar * xr - ai * xi + pr, nxi = ar * xi + ai * xr + pi; xr = nxr; xi = nxi;
            if (tau >= CTXL) { float mine = 0.f;
#pragma unroll
                for (int h = 0; h < GH; ++h) { const float y = wave_sum(cr[h] * xr - ci[h] * xi); mine = (F.lane == h) ? y : mine; }
                if (F.lane < GH) Y[(size_t)row * D + g * GH + F.lane] = mine; }
        }
    }
}
__device__ __forceinline__ void zprep_phase(Frame& F) {
    const int gw = F.vcu * NWAVES + F.wave, NGW = F.G * NWAVES;
    const GAS float* X2 = (const GAS float*)(F.ws + WS_X2); const GAS bf16* YF = (const GAS bf16*)(F.ws + WS_YF); const GAS bf16* YB = (const GAS bf16*)(F.ws + WS_YB); GAS bf16* Z = ws_tile(F, T_Z);
    const GAS float* dsk = fin(F, I_SD);
    for (int row = gw; row < NLAT; row += NGW) {
        const int r = row >> 12; const GAS float* sh = mods(F, 1, r, 0); const GAS float* sc = mods(F, 1, r, 1);
        const GAS float* x2 = X2 + (size_t)row * D; const GAS bf16* yf = YF + (size_t)row * D; const GAS bf16* yb = YB + (size_t)row * D;
        f32x4 xv[8]; v2u fv[8], bv[8];
#pragma unroll
        for (int j = 0; j < 8; ++j) { xv[j] = LDV(x2, j); fv[j] = *(const GAS v2u*)(yf + 4 * F.lane + 256 * j); bv[j] = *(const GAS v2u*)(yb + 4 * F.lane + 256 * j); }
        v2u zo[8];
#pragma unroll
        for (int j = 0; j < 8; ++j) { const f32x4 u = xv[j] * (LDV(sc, j) + 1.0f) + LDV(sh, j); const f32x4 y = LDV(dsk, j) * u + bf4_to_f32(fv[j]) + bf4_to_f32(bv[j]);
            zo[j].x = pk2(gelu_tanh_f(y[0]), gelu_tanh_f(y[1])); zo[j].y = pk2(gelu_tanh_f(y[2]), gelu_tanh_f(y[3])); }
#pragma unroll
        for (int j = 0; j < 8; ++j) *(GAS v2u*)(Z + (size_t)row * D + 4 * F.lane + 256 * j) = zo[j];
    }
}

constexpr int S5_T = 34, S5_NCH = 128;
typedef float f32x4s __attribute__((ext_vector_type(4)));
struct S5Consts { bf16x8 abu[8]; float ar[4][4], ai[4][4]; };
__device__ __forceinline__ void s5_load_consts(const Frame& F, int gd, int lane, S5Consts& K) {
    const GAS float* AR = (const GAS float*)(F.ws + WS_SPAR); const GAS float* AI = AR + 2 * NG * NP; const GAS float* BB = AI + 2 * NG * NP;
    const int m = lane & 15, q = lane >> 4;
#pragma unroll
    for (int tt = 0; tt < 8; ++tt) { const int p = 16 * (tt >> 1) + m; v4u w = {0u, 0u, 0u, 0u};
        if (q < 2) { const GAS float* s = BB + (size_t)(gd * NP + p) * 32 + (tt & 1) * 16 + 8 * q; const f32x4 x0 = *(const GAS f32x4*)s, x1 = *(const GAS f32x4*)(s + 4);
            w.x = pk2(x0[0], x0[1]); w.y = pk2(x0[2], x0[3]); w.z = pk2(x1[0], x1[1]); w.w = pk2(x1[2], x1[3]); }
        K.abu[tt] = __builtin_bit_cast(bf16x8, w); }
#pragma unroll
    for (int pb = 0; pb < 4; ++pb) { const f32x4 a = *(const GAS f32x4*)(AR + gd * NP + 16 * pb + 4 * q), b = *(const GAS f32x4*)(AI + gd * NP + 16 * pb + 4 * q);
#pragma unroll
        for (int i = 0; i < 4; ++i) { K.ar[pb][i] = a[i]; K.ai[pb][i] = b[i]; } }
}
__device__ __forceinline__ int s5_row(int b, int dir, int tau) {
    const int ctxrow = NLAT + b * CTXL + (dir ? CTXL - 1 - tau : tau), latrow = b * SEQ + (dir ? (CTXL + SEQ - 1) - tau : tau - CTXL);
    return tau < CTXL ? ctxrow : latrow;
}
constexpr int S5_XP = 132;
template <bool READOUT>
__device__ __forceinline__ void s5_run(Frame& F, const S5Consts& K, const bf16x8 (&cfr)[4], int gd, int cg, LAS float* XS) {
    const int lane = F.lane, n = lane & 15, q = lane >> 4, dir = gd >> 7, g = gd & 127;
    const GAS bf16* HB = ws_tile(F, T_HB);
    GAS bf16* Y = (GAS bf16*)(F.ws + (dir ? WS_YB : WS_YF));
    const int chunk = cg * 16 + n, b = chunk >> 7, c = chunk & 127, tau0 = c * S5_T;
    LAS float* xs = XS + chunk * S5_XP + 8 * q;
    f32x4s X[8];
    if (READOUT) {
#pragma unroll
        for (int pb = 0; pb < 4; ++pb) { const f32x4 v0 = *(const LAS f32x4*)(xs + 32 * pb), v1 = *(const LAS f32x4*)(xs + 32 * pb + 4);
            X[2 * pb] = (f32x4s){v0[0], v0[2], v1[0], v1[2]}; X[2 * pb + 1] = (f32x4s){v0[1], v0[3], v1[1], v1[3]}; }
    } else {
#pragma unroll
        for (int tt = 0; tt < 8; ++tt) X[tt] = (f32x4s){0.f, 0.f, 0.f, 0.f};
    }
    constexpr int PD = 6;
    v4u ur[PD];
    const GAS bf16* ucol = HB + g * GH + 8 * q;
#pragma unroll
    for (int t = 0; t < PD; ++t) { ur[t] = (v4u){0u, 0u, 0u, 0u}; if (q < 2) ur[t] = *(const GAS v4u*)(ucol + (size_t)s5_row(b, dir, tau0 + t) * D); }
#define S5_STEP(KS, T, REFILL) do { \
        const bf16x8 ub = __builtin_bit_cast(bf16x8, ur[KS]); \
        if (REFILL) { ur[KS] = (v4u){0u, 0u, 0u, 0u}; if (q < 2) ur[KS] = *(const GAS v4u*)(ucol + (size_t)s5_row(b, dir, tau0 + (T) + PD) * D); } \
        _Pragma("unroll") for (int pb = 0; pb < 4; ++pb) _Pragma("unroll") for (int i = 0; i < 4; ++i) { const float re = X[2 * pb][i], im = X[2 * pb + 1][i]; \
            X[2 * pb][i] = K.ar[pb][i] * re - K.ai[pb][i] * im; X[2 * pb + 1][i] = K.ar[pb][i] * im + K.ai[pb][i] * re; } \
        _Pragma("unroll") for (int tt = 0; tt < 8; ++tt) X[tt] = __builtin_amdgcn_mfma_f32_16x16x32_bf16(K.abu[tt], ub, X[tt], 0, 0, 0); \
        if (READOUT) { f32x4s y0 = {0.f, 0.f, 0.f, 0.f}, y1 = y0; \
            _Pragma("unroll") for (int s = 0; s < 4; ++s) { v4u w; w.x = pk2(X[2 * s][0], X[2 * s][1]); w.y = pk2(X[2 * s][2], X[2 * s][3]); w.z = pk2(X[2 * s + 1][0], X[2 * s + 1][1]); w.w = pk2(X[2 * s + 1][2], X[2 * s + 1][3]); \
                const bf16x8 xb = __builtin_bit_cast(bf16x8, w); \
                if (s & 1) y1 = __builtin_amdgcn_mfma_f32_16x16x32_bf16(cfr[s], xb, y1, 0, 0, 0); else y0 = __builtin_amdgcn_mfma_f32_16x16x32_bf16(cfr[s], xb, y0, 0, 0, 0); } \
            const int tau = tau0 + (T); \
            if (tau >= CTXL) { const f32x4s y = y0 + y1; v2u w; w.x = pk2(y[0], y[1]); w.y = pk2(y[2], y[3]); *(GAS v2u*)(Y + (size_t)s5_row(b, dir, tau) * D + g * GH + 4 * q) = w; } } \
    } while (0)
#pragma unroll 1
    for (int t0 = 0; t0 < 24; t0 += PD) {
        S5_STEP(0, t0 + 0, true); S5_STEP(1, t0 + 1, true); S5_STEP(2, t0 + 2, true); S5_STEP(3, t0 + 3, true); S5_STEP(4, t0 + 4, true); S5_STEP(5, t0 + 5, true); }
    S5_STEP(0, 24, true); S5_STEP(1, 25, true); S5_STEP(2, 26, true); S5_STEP(3, 27, true); S5_STEP(4, 28, false); S5_STEP(5, 29, false);
    S5_STEP(0, 30, false); S5_STEP(1, 31, false); S5_STEP(2, 32, false); S5_STEP(3, 33, false);
#undef S5_STEP
    if (!READOUT) {
#pragma unroll
        for (int pb = 0; pb < 4; ++pb) { const f32x4s re = X[2 * pb], im = X[2 * pb + 1];
            *(LAS f32x4*)(xs + 32 * pb) = (f32x4){re[0], im[0], re[1], im[1]}; *(LAS f32x4*)(xs + 32 * pb + 4) = (f32x4){re[2], im[2], re[3], im[3]}; }
    }
}
__device__ __forceinline__ void s5_fused(Frame& F) {
    LAS float* XS = (LAS float*)F.lds;
    LAS f32x2* AG = (LAS f32x2*)(F.lds + 256 * S5_XP * 4);
    const GAS float* AR = (const GAS float*)(F.ws + WS_SPAR); const GAS float* AI = AR + 2 * NG * NP;
    const int lane = F.lane, n = lane & 15, q = lane >> 4, seg = F.tid >> 6, p = F.tid & 63;
    for (int gd = F.vcu; gd < 2 * NG; gd += F.G) {
        S5Consts K; s5_load_consts(F, gd, lane, K);
        bf16x8 cz[4];
#pragma unroll
        for (int s = 0; s < 4; ++s) cz[s] = (bf16x8){0, 0, 0, 0, 0, 0, 0, 0};
#pragma unroll 1
        for (int k2 = 0; k2 < 2; ++k2) s5_run<false>(F, K, cz, gd, F.wave * 2 + k2, XS);
        __syncthreads();
        {
            const double ar = AR[gd * NP + p], ai = AI[gd * NP + p];
            double sr = ar, si = ai, t; t = sr * sr - si * si; si = 2.0 * sr * si; sr = t;
            double pr = sr, pi = si;
            for (int k = 0; k < 4; ++k) { t = sr * sr - si * si; si = 2.0 * sr * si; sr = t; }
            t = pr * sr - pi * si; pi = pr * si + pi * sr; pr = t;
            const float tr = (float)pr, ti = (float)pi;
            double qr = pr, qi = pi; for (int k = 0; k < 4; ++k) { t = qr * qr - qi * qi; qi = 2.0 * qr * qi; qr = t; }
            const float t16r = (float)qr, t16i = (float)qi;
            for (int b = 0; b < 2; ++b) {
                LAS float* xs = XS + (b * S5_NCH + seg * 16) * S5_XP + 2 * p;
                f32x2 loc[16];
#pragma unroll
                for (int k = 0; k < 16; ++k) loc[k] = *(const LAS f32x2*)(xs + k * S5_XP);
                float ar_ = 0.f, ai_ = 0.f;
#pragma unroll
                for (int k = 0; k < 16; ++k) { const float nr = tr * ar_ - ti * ai_ + loc[k][0], ni = tr * ai_ + ti * ar_ + loc[k][1]; ar_ = nr; ai_ = ni; }
                AG[seg * 64 + p] = (f32x2){ar_, ai_};
                __syncthreads();
                float cr = 0.f, ci = 0.f;
                for (int s2 = 0; s2 < seg; ++s2) { const f32x2 a = AG[s2 * 64 + p]; const float nr = t16r * cr - t16i * ci + a[0], ni = t16r * ci + t16i * cr + a[1]; cr = nr; ci = ni; }
#pragma unroll
                for (int k = 0; k < 16; ++k) { *(LAS f32x2*)(xs + k * S5_XP) = (f32x2){cr, ci};
                    const float nr = tr * cr - ti * ci + loc[k][0], ni = tr * ci + ti * cr + loc[k][1]; cr = nr; ci = ni; }
                __syncthreads();
            }
        }
        bf16x8 cfr[4];
#pragma unroll
        for (int s = 0; s < 4; ++s) { const GAS float* cr = fin(F, I_CRE) + (size_t)(gd * GH + n) * NP + 16 * s + 4 * q; const GAS float* ci = fin(F, I_CIM) + (size_t)(gd * GH + n) * NP + 16 * s + 4 * q;
            const f32x4 a = *(const GAS f32x4*)cr, b = *(const GAS f32x4*)ci; v4u w; w.x = pk2(a[0], a[1]); w.y = pk2(a[2], a[3]); w.z = pk2(-b[0], -b[1]); w.w = pk2(-b[2], -b[3]);
            cfr[s] = __builtin_bit_cast(bf16x8, w); }
#pragma unroll 1
        for (int k2 = 0; k2 < 2; ++k2) s5_run<true>(F, K, cfr, gd, F.wave * 2 + k2, XS);
        __syncthreads();
    }
}

template <int MODE>
__device__ __forceinline__ void s5z_run(Frame& F, const S5Consts& K, const bf16x8 (&cfr)[4], int g, int dir, int b, int cgl, LAS float* XS) {
    constexpr bool READOUT = MODE != 0;
    const int lane = F.lane, n = lane & 15, q = lane >> 4;
    const GAS bf16* HB = ws_tile(F, T_HB);
    GAS bf16* YF = (GAS bf16*)(F.ws + WS_YF); GAS bf16* Z = ws_tile(F, T_Z);
    const int c = cgl * 16 + n, tau0 = c * S5_T;
    LAS float* xs = XS + (dir * S5_NCH + c) * S5_XP + 8 * q;
    f32x4s X[8];
    if (READOUT) {
#pragma unroll
        for (int pb = 0; pb < 4; ++pb) { const f32x4 v0 = *(const LAS f32x4*)(xs + 32 * pb), v1 = *(const LAS f32x4*)(xs + 32 * pb + 4);
            X[2 * pb] = (f32x4s){v0[0], v0[2], v1[0], v1[2]}; X[2 * pb + 1] = (f32x4s){v0[1], v0[3], v1[1], v1[3]}; }
    } else {
#pragma unroll
        for (int tt = 0; tt < 8; ++tt) X[tt] = (f32x4s){0.f, 0.f, 0.f, 0.f};
    }
    f32x4 dsk = {0.f, 0.f, 0.f, 0.f};
    if (MODE == 2) dsk = *(const GAS f32x4*)(fin(F, I_SD) + g * GH + 4 * q);
    constexpr int PD = 6;
    v4u ur[PD];
    const GAS bf16* ucol = HB + g * GH + 8 * q;
#pragma unroll
    for (int t = 0; t < PD; ++t) { ur[t] = (v4u){0u, 0u, 0u, 0u}; if (q < 2) ur[t] = *(const GAS v4u*)(ucol + (size_t)s5_row(b, dir, tau0 + t) * D); }
    unsigned long long yfn = 0ull, un = 0ull;
    if (MODE == 2) { const int tau = tau0; if (tau >= CTXL) { const size_t o = (size_t)s5_row(b, dir, tau) * D + g * GH + 4 * q;
        yfn = __hip_atomic_load((const GAS unsigned long long*)(YF + o), __ATOMIC_RELAXED, __HIP_MEMORY_SCOPE_AGENT); un = *(const GAS unsigned long long*)(HB + o); } }
#define S5Z_STEP(KS, T, REFILL) do { \
        const bf16x8 ub = __builtin_bit_cast(bf16x8, ur[KS]); \
        if (REFILL) { ur[KS] = (v4u){0u, 0u, 0u, 0u}; if (q < 2) ur[KS] = *(const GAS v4u*)(ucol + (size_t)s5_row(b, dir, tau0 + (T) + PD) * D); } \
        const unsigned long long yfc = yfn, uc = un; \
        if (MODE == 2) { const int tn_ = tau0 + (T) + 1; if ((T) + 1 < S5_T && tn_ >= CTXL) { const size_t o_ = (size_t)s5_row(b, dir, tn_) * D + g * GH + 4 * q; \
            yfn = __hip_atomic_load((const GAS unsigned long long*)(YF + o_), __ATOMIC_RELAXED, __HIP_MEMORY_SCOPE_AGENT); un = *(const GAS unsigned long long*)(HB + o_); } } \
        _Pragma("unroll") for (int pb = 0; pb < 4; ++pb) _Pragma("unroll") for (int i = 0; i < 4; ++i) { const float re = X[2 * pb][i], im = X[2 * pb + 1][i]; \
            X[2 * pb][i] = K.ar[pb][i] * re - K.ai[pb][i] * im; X[2 * pb + 1][i] = K.ar[pb][i] * im + K.ai[pb][i] * re; } \
        _Pragma("unroll") for (int tt = 0; tt < 8; ++tt) X[tt] = __builtin_amdgcn_mfma_f32_16x16x32_bf16(K.abu[tt], ub, X[tt], 0, 0, 0); \
        if (READOUT) { f32x4s y0 = {0.f, 0.f, 0.f, 0.f}, y1 = y0; \
            _Pragma("unroll") for (int s = 0; s < 4; ++s) { v4u w; w.x = pk2(X[2 * s][0], X[2 * s][1]); w.y = pk2(X[2 * s][2], X[2 * s][3]); w.z = pk2(X[2 * s + 1][0], X[2 * s + 1][1]); w.w = pk2(X[2 * s + 1][2], X[2 * s + 1][3]); \
                const bf16x8 xb = __builtin_bit_cast(bf16x8, w); \
                if (s & 1) y1 = __builtin_amdgcn_mfma_f32_16x16x32_bf16(cfr[s], xb, y1, 0, 0, 0); else y0 = __builtin_amdgcn_mfma_f32_16x16x32_bf16(cfr[s], xb, y0, 0, 0, 0); } \
            const int tau = tau0 + (T); \
            if (tau >= CTXL) { f32x4s y = y0 + y1; const size_t o = (size_t)s5_row(b, dir, tau) * D + g * GH + 4 * q; \
                if (MODE == 2) { const f32x4 yf4 = bf4_to_f32((v2u){(unsigned)yfc, (unsigned)(yfc >> 32)}), u4 = bf4_to_f32((v2u){(unsigned)uc, (unsigned)(uc >> 32)}); \
                    _Pragma("unroll") for (int e = 0; e < 4; ++e) y[e] = gelu_tanh_f(dsk[e] * u4[e] + yf4[e] + y[e]); \
                    v2u w; w.x = pk2(y[0], y[1]); w.y = pk2(y[2], y[3]); *(GAS v2u*)(Z + o) = w; } \
                else { v2u w; w.x = pk2(y[0], y[1]); w.y = pk2(y[2], y[3]); *(GAS v2u*)(YF + o) = w; } } } \
    } while (0)
#pragma unroll 1
    for (int t0 = 0; t0 < 24; t0 += PD) {
        S5Z_STEP(0, t0 + 0, true); S5Z_STEP(1, t0 + 1, true); S5Z_STEP(2, t0 + 2, true); S5Z_STEP(3, t0 + 3, true); S5Z_STEP(4, t0 + 4, true); S5Z_STEP(5, t0 + 5, true); }
    S5Z_STEP(0, 24, true); S5Z_STEP(1, 25, true); S5Z_STEP(2, 26, true); S5Z_STEP(3, 27, true); S5Z_STEP(4, 28, false); S5Z_STEP(5, 29, false);
    S5Z_STEP(0, 30, false); S5Z_STEP(1, 31, false); S5Z_STEP(2, 32, false); S5Z_STEP(3, 33, false);
#undef S5Z_STEP
    if (!READOUT) {
#pragma unroll
        for (int pb = 0; pb < 4; ++pb) { const f32x4s re = X[2 * pb], im = X[2 * pb + 1];
            *(LAS f32x4*)(xs + 32 * pb) = (f32x4){re[0], im[0], re[1], im[1]}; *(LAS f32x4*)(xs + 32 * pb + 4) = (f32x4){re[2], im[2], re[3], im[3]}; }
    }
}
__device__ __forceinline__ void s5z_load_cfr(const Frame& F, int gd, int lane, bf16x8 (&cfr)[4]) {
    const int n = lane & 15, q = lane >> 4;
#pragma unroll
    for (int s = 0; s < 4; ++s) { const GAS float* cr = fin(F, I_CRE) + (size_t)(gd * GH + n) * NP + 16 * s + 4 * q; const GAS float* ci = fin(F, I_CIM) + (size_t)(gd * GH + n) * NP + 16 * s + 4 * q;
        const f32x4 a = *(const GAS f32x4*)cr, b = *(const GAS f32x4*)ci; v4u w; w.x = pk2(a[0], a[1]); w.y = pk2(a[2], a[3]); w.z = pk2(-b[0], -b[1]); w.w = pk2(-b[2], -b[3]);
        cfr[s] = __builtin_bit_cast(bf16x8, w); }
}
__device__ __forceinline__ void s5z_fused(Frame& F) {
    LAS float* XS = (LAS float*)F.lds;
    LAS f32x2* AG = (LAS f32x2*)(F.lds + 256 * S5_XP * 4);
    const GAS float* AR = (const GAS float*)(F.ws + WS_SPAR); const GAS float* AI = AR + 2 * NG * NP;
    const int lane = F.lane, seg = F.tid >> 6, p = F.tid & 63;
    for (int wu = F.vcu; wu < 2 * NG; wu += F.G) {
        const int g = wu & 127, b = wu >> 7;
        bf16x8 cz[4];
#pragma unroll
        for (int s = 0; s < 4; ++s) cz[s] = (bf16x8){0, 0, 0, 0, 0, 0, 0, 0};
#pragma unroll 1
        for (int dir = 0; dir < 2; ++dir) { S5Consts K; s5_load_consts(F, dir * NG + g, lane, K); s5z_run<0>(F, K, cz, g, dir, b, F.wave, XS); }
        __syncthreads();
#pragma unroll 1
        for (int dir = 0; dir < 2; ++dir) {
            const int gd = dir * NG + g;
            const double ar = AR[gd * NP + p], ai = AI[gd * NP + p];
            double sr = ar, si = ai, t; t = sr * sr - si * si; si = 2.0 * sr * si; sr = t;
            double pr = sr, pi = si;
            for (int k = 0; k < 4; ++k) { t = sr * sr - si * si; si = 2.0 * sr * si; sr = t; }
            t = pr * sr - pi * si; pi = pr * si + pi * sr; pr = t;
            const float tr = (float)pr, ti = (float)pi;
            double qr = pr, qi = pi; for (int k = 0; k < 4; ++k) { t = qr * qr - qi * qi; qi = 2.0 * qr * qi; qr = t; }
            const float t16r = (float)qr, t16i = (float)qi;
            LAS float* xs = XS + (dir * S5_NCH + seg * 16) * S5_XP + 2 * p;
            f32x2 loc[16];
#pragma unroll
            for (int k = 0; k < 16; ++k) loc[k] = *(const LAS f32x2*)(xs + k * S5_XP);
            float ar_ = 0.f, ai_ = 0.f;
#pragma unroll
            for (int k = 0; k < 16; ++k) { const float nr = tr * ar_ - ti * ai_ + loc[k][0], ni = tr * ai_ + ti * ar_ + loc[k][1]; ar_ = nr; ai_ = ni; }
            AG[seg * 64 + p] = (f32x2){ar_, ai_};
            __syncthreads();
            float cr = 0.f, ci = 0.f;
            for (int s2 = 0; s2 < seg; ++s2) { const f32x2 a = AG[s2 * 64 + p]; const float nr = t16r * cr - t16i * ci + a[0], ni = t16r * ci + t16i * cr + a[1]; cr = nr; ci = ni; }
#pragma unroll
            for (int k = 0; k < 16; ++k) { *(LAS f32x2*)(xs + k * S5_XP) = (f32x2){cr, ci};
                const float nr = tr * cr - ti * ci + loc[k][0], ni = tr * ci + ti * cr + loc[k][1]; cr = nr; ci = ni; }
            __syncthreads();
        }
        { S5Consts K; s5_load_consts(F, g, lane, K); bf16x8 cfr[4]; s5z_load_cfr(F, g, lane, cfr); s5z_run<1>(F, K, cfr, g, 0, b, F.wave, XS); }
        asm volatile("s_waitcnt vmcnt(0)" ::: "memory");
        __syncthreads();
        { S5Consts K; s5_load_consts(F, NG + g, lane, K); bf16x8 cfr[4]; s5z_load_cfr(F, NG + g, lane, cfr); s5z_run<2>(F, K, cfr, g, 1, b, F.wave, XS); }
        __syncthreads();
    }
}

constexpr int ATT_KP = 272, ATT_VP = 528, ATT_VOFF = 256 * ATT_KP;
constexpr int ATT_RPOFF = ATT_VOFF + 128 * ATT_VP;
__device__ __forceinline__ void attn_unit(Frame& F, bool lat, int b, int h, int r, int j, int qrow0, int dv) {
    const int lane = F.lane, n = lane & 15, qd = lane >> 4;
    const GAS bf16* QK = ws_tile(F, T_QK); const GAS bf16* VT = ws_tile(F, T_VT); GAS bf16* AO = ws_tile(F, T_AO);
    const float scale = 0.08838834764831845f * 1.4426950408889634f, NEG = -3.0e38f;
    const int mkey = 8 * (n >> 2) + (n & 3);
    unsigned kb_ = (unsigned)(n * ATT_KP + 16 * qd), vb_ = (unsigned)(ATT_VOFF + n * ATT_VP + 16 * qd);
    asm volatile("" : "+v"(kb_), "+v"(vb_));
    const LAS unsigned char* kbase = F.lds + kb_; const LAS unsigned char* vbase = F.lds + vb_;
    const LAS float* RP = (const LAS float*)(F.lds + ATT_RPOFF);
    bf16x8 qf[4];
    { const GAS bf16* qp = QK + (size_t)(qrow0 + n) * 4096 + h * HD + 8 * qd;
#pragma unroll
      for (int kk = 0; kk < 4; ++kk) qf[kk] = *(const GAS bf16x8*)(qp + 32 * kk); }
    const int rs = min(max(r - 4, 0), 56), cs = min(max(16 * j - 8, 0), 32), qc = 16 * j + n, cst = min(max(qc - 8, 0), 48);
    float S[16][2][4];
    float mx = NEG;
    bf16x8 kf[2][4];
    if (lat && !(dv & 1)) {
        const GAS bf16* kp = QK + (size_t)(b * SEQ + (rs + (n >> 2)) * 64 + cs + (n & 3)) * 4096 + D + h * HD + 8 * qd;
#pragma unroll
        for (int kk = 0; kk < 4; ++kk) kf[0][kk] = *(const GAS bf16x8*)(kp + 32 * kk);
#pragma unroll
        for (int st = 0; st < 16; ++st) { const int blk = st >> 1, hf = st & 1, cg = blk >> 1, rh = blk & 1;
            if (st + 1 < 16) { constexpr int dummy_ = 0; (void)dummy_;
                const int s1 = st + 1, o1 = ((s1 >> 1) & 1) * 256 + (s1 >> 2) * 8 + (s1 & 1) * 4, o0 = rh * 256 + cg * 8 + hf * 4;
                kp += (ptrdiff_t)(o1 - o0) * 4096; asm volatile("" : "+v"(kp));
#pragma unroll
                for (int kk = 0; kk < 4; ++kk) kf[(st + 1) & 1][kk] = *(const GAS bf16x8*)(kp + 32 * kk); }
            f32x4 acc = {0.f, 0.f, 0.f, 0.f};
#pragma unroll
            for (int kk = 0; kk < 4; ++kk) acc = __builtin_amdgcn_mfma_f32_16x16x32_bf16(kf[st & 1][kk], qf[kk], acc, 0, 0, 0);
#pragma unroll
            for (int i = 0; i < 4; ++i) { const int kc = cs + 8 * cg + 4 * hf + i; const bool valid = (unsigned)(kc - cst) < 16u;
                const float sc = acc[i] * scale + RP[(rs + 4 * rh + qd - r + 7) * 31 + (kc - qc + 15)]; const float sv = valid ? sc : NEG;
                S[blk][hf][i] = sv; mx = fmaxf(mx, sv); }
            __builtin_amdgcn_sched_barrier(0); }
    } else {
#pragma unroll
        for (int blk = 0; blk < 8; ++blk)
#pragma unroll
            for (int hf = 0; hf < 2; ++hf)
#pragma unroll
                for (int i = 0; i < 4; ++i) S[blk][hf][i] = NEG;
    }
    if (dv & 2) {
#pragma unroll
        for (int blk = 8; blk < 16; ++blk)
#pragma unroll
            for (int hf = 0; hf < 2; ++hf)
#pragma unroll
                for (int i = 0; i < 4; ++i) { S[blk][hf][i] = 0.f; mx = fmaxf(mx, 0.f); }
    } else {
#pragma unroll
    for (int kk = 0; kk < 4; ++kk) kf[0][kk] = *(const LAS bf16x8*)(kbase + 64 * kk);
#pragma unroll
    for (int st = 0; st < 16; ++st) { const int blk = 8 + (st >> 1), hf = st & 1;
        if (st + 1 < 16) { const LAS unsigned char* kp = kbase + (16 * (st + 1)) * ATT_KP;
#pragma unroll
            for (int kk = 0; kk < 4; ++kk) kf[(st + 1) & 1][kk] = *(const LAS bf16x8*)(kp + 64 * kk); }
        f32x4 acc = {0.f, 0.f, 0.f, 0.f};
#pragma unroll
        for (int kk = 0; kk < 4; ++kk) acc = __builtin_amdgcn_mfma_f32_16x16x32_bf16(kf[st & 1][kk], qf[kk], acc, 0, 0, 0);
#pragma unroll
        for (int i = 0; i < 4; ++i) { const float sv = acc[i] * scale; S[blk][hf][i] = sv; mx = fmaxf(mx, sv); }
        __builtin_amdgcn_sched_barrier(0); }
    }
    mx = fmaxf(mx, __shfl_xor(mx, 16)); mx = fmaxf(mx, __shfl_xor(mx, 32));
    float sum = 0.f; bf16x8 pf[16];
#pragma unroll
    for (int blk = 0; blk < 16; ++blk) { float p[8];
#pragma unroll
        for (int hf = 0; hf < 2; ++hf)
#pragma unroll
            for (int i = 0; i < 4; ++i) { const float e = __builtin_amdgcn_exp2f(S[blk][hf][i] - mx); p[4 * hf + i] = e; sum += e; }
        v4u w; w.x = pk2(p[0], p[1]); w.y = pk2(p[2], p[3]); w.z = pk2(p[4], p[5]); w.w = pk2(p[6], p[7]); pf[blk] = __builtin_bit_cast(bf16x8, w); }
    sum += __shfl_xor(sum, 16); sum += __shfl_xor(sum, 32);
    const float inv = 1.0f / sum;
    f32x4 O[8];
#pragma unroll
    for (int dt = 0; dt < 8; ++dt) O[dt] = (f32x4){0.f, 0.f, 0.f, 0.f};
    bf16x8 vf[2][8];
    if (lat && !(dv & 4)) {
        const GAS bf16* vloc = (dv & 16) ? VT + (size_t)n * NROWS + qd * 8 : VT + (size_t)(h * HD + n) * NROWS + b * SEQ + (cs >> 3) * 512 + (rs + qd) * 8;
        bf16x8 vr[3][8];
#pragma unroll
        for (int dt = 0; dt < 8; ++dt) vr[0][dt] = *(const GAS bf16x8*)(vloc + (size_t)dt * 16 * NROWS);
#pragma unroll
        for (int dt = 0; dt < 8; ++dt) vr[1][dt] = *(const GAS bf16x8*)(vloc + 32 + (size_t)dt * 16 * NROWS);
#pragma unroll
        for (int blk = 0; blk < 8; ++blk) {
            if (blk + 2 < 8) { const int o2 = ((blk + 2) >> 1) * 512 + ((blk + 2) & 1) * 32;
#pragma unroll
                for (int dt = 0; dt < 8; ++dt) vr[(blk + 2) % 3][dt] = *(const GAS bf16x8*)(vloc + o2 + (size_t)dt * 16 * NROWS); }
#pragma unroll
            for (int dt = 0; dt < 8; ++dt) O[dt] = __builtin_amdgcn_mfma_f32_16x16x32_bf16(vr[blk % 3][dt], pf[blk], O[dt], 0, 0, 0);
            __builtin_amdgcn_sched_barrier(0); }
    }
    if (!(dv & 8)) {
#pragma unroll
    for (int dt = 0; dt < 8; ++dt) vf[0][dt] = *(const LAS bf16x8*)(vbase + dt * 16 * ATT_VP);
#pragma unroll
    for (int cb = 0; cb < 8; ++cb) {
        if (cb + 1 < 8) {
#pragma unroll
            for (int dt = 0; dt < 8; ++dt) vf[(cb + 1) & 1][dt] = *(const LAS bf16x8*)(vbase + 64 * (cb + 1) + dt * 16 * ATT_VP); }
#pragma unroll
        for (int dt = 0; dt < 8; ++dt) O[dt] = __builtin_amdgcn_mfma_f32_16x16x32_bf16(vf[cb & 1][dt], pf[8 + cb], O[dt], 0, 0, 0);
        __builtin_amdgcn_sched_barrier(0); }
    }
    GAS bf16* op = AO + (size_t)(qrow0 + n) * D + h * HD + 4 * qd;
#pragma unroll
    for (int dt = 0; dt < 8; ++dt) { v2u w; w.x = pk2(O[dt][0] * inv, O[dt][1] * inv); w.y = pk2(O[dt][2] * inv, O[dt][3] * inv); *(GAS v2u*)(op + 16 * dt) = w; }
}
__device__ __forceinline__ void attn_phase2(Frame& F, int dv) {
    const GAS bf16* QK = ws_tile(F, T_QK); const GAS bf16* VT = ws_tile(F, T_VT);
    for (int wu = F.vcu; wu < 2 * NH * 8; wu += F.G) {
        const int b = wu >> 7, h = (wu >> 3) & 15, ro = wu & 7;
        int tid_ = F.tid; asm volatile("" : "+v"(tid_));
#pragma unroll 2
        for (int i = 0; i < 8; ++i) { const int pc = tid_ + NTHREADS * i;
            { const int key = pc >> 4, c = pc & 15, rho = (key & ~31) + 16 * ((key >> 2) & 1) + 4 * ((key >> 3) & 3) + (key & 3);
              *(LAS v4u*)(F.lds + rho * ATT_KP + 16 * c) = *(const GAS v4u*)(QK + (size_t)(NLAT + b * CTXL + key) * 4096 + D + h * HD + 8 * c); }
            { const int dh = pc >> 5, c = pc & 31;
              *(LAS v4u*)(F.lds + ATT_VOFF + dh * ATT_VP + 16 * c) = *(const GAS v4u*)(VT + (size_t)(h * HD + dh) * NROWS + NLAT + b * CTXL + 8 * c); } }
        for (int i = tid_; i < 15 * 31; i += NTHREADS) ((LAS float*)(F.lds + ATT_RPOFF))[i] = fin(F, I_RPB)[h * 15 * 31 + i] * 1.4426950408889634f;
        __syncthreads();
        int b2 = b, h2 = h; asm volatile("" : "+s"(b2), "+s"(h2));
        const int r = 8 * ro + F.wave;
        const int nu = F.wave < 2 ? 5 : 4;
#pragma unroll 1
        for (int u = 0; u < nu; ++u) { const bool lat = u < 4;
            attn_unit(F, lat, b2, h2, lat ? r : 0, lat ? u : 0, lat ? b2 * SEQ + r * 64 + 16 * u : NLAT + b2 * CTXL + 16 * (2 * ro + F.wave), dv); }
        __syncthreads();
    }
}

constexpr int CV_NIT = (6 + 2 * NE * 3) * 2048;
constexpr int KG_QKV = CV_KG1, KG_WO = CV_KG2, KG_DN0 = CV_KG3, KG_UP0 = CV_KG4;
constexpr int CV_W1 = 8 * (32 - KG_QKV) * CV_N1, CV_W2 = 8 * (32 - KG_WO) * CV_N2, CV_W3 = 8 * (32 - KG_DN0) * CV_N3, CV_W4 = 8 * (32 - KG_UP0) * CV_N4;
constexpr int CV_NIT_MAIN = CV_NIT - 2 * CV_TK;
static_assert(CV_NIT == CV_NIT_ALL, "item count");
constexpr int CV_T4_END = CV_NIT_MAIN - CV_W3, CV_T2_END = CV_T4_END - CV_W4, CV_T1_END = CV_T2_END - CV_W2, CV_P0_END = CV_T1_END - CV_W1;
static_assert(CV_P0_END >= 3 * 2048 && CV_T1_END >= 6 * 2048 && CV_T2_END >= (6 + NE * 3) * 2048, "conversion windows: the QKV weight in the prologue, Wo / GLU weights by the end of the QKV window, every layer-0 expert weight before the layer-0 up GEMM");
__device__ __forceinline__ bool split_role(const Frame& F, int KG, int& cx, int& Gg, int& ci, int& nci) {
    if (F.G != 256) { cx = F.vcu; Gg = F.G; ci = 0; nci = 0; return true; }
    const int x = F.vcu >> 5, k = F.vcu & 31;
    if (k < KG) { cx = x * KG + k; Gg = 8 * KG; ci = 0; nci = 0; return true; }
    ci = x * (32 - KG) + (k - KG); nci = 8 * (32 - KG); cx = 0; Gg = 0; return false;
}
constexpr int NPH = 22;
__global__ void __launch_bounds__(NTHREADS, 2) mk_fwd(Args args) {
    extern __shared__ __attribute__((aligned(16))) unsigned char lds[];
    Frame F;
    F.lds = (LAS unsigned char*)lds; F.ws = (GAS unsigned char*)args.ws; F.out = (GAS float*)args.out;
    F.ap = (const CAS Args*)__builtin_amdgcn_kernarg_segment_ptr();
    F.tid = threadIdx.x; F.lane = F.tid & 63; F.wave = __builtin_amdgcn_readfirstlane(F.tid >> 6);
    F.G = gridDim.x; { const int bx = blockIdx.x; F.vcu = (F.G % 8 == 0) ? (bx % 8) * (F.G / 8) + bx / 8 : bx; }
    const int vcu0 = F.vcu, wave0 = F.wave;
    volatile LAS unsigned* MISC = (volatile LAS unsigned*)(F.lds + MISC_OFF);
    for (int u = F.tid; u < 32; u += NTHREADS) MISC[u] = 0u;
    __syncthreads();
    const int lo = args.ph_lo, hi = args.ph_hi;
    const bool multi = (hi - lo) > 1;
    XcdBarrier bar; bar.bar = (unsigned*)(unsigned char*)(F.ws + WS_CTL) + CW_BAR; bar.x = 0; bar.st = nullptr;
    if (multi) bar = xcd_barrier_post((unsigned*)(unsigned char*)(F.ws + WS_CTL) + CW_BAR, MISC + 8);
#if PROBE
#define IS_T0() ({ unsigned z2_ = 0u; asm volatile("" : "+v"(z2_)); (wave0 == 0 && __builtin_amdgcn_mbcnt_hi(~0u, __builtin_amdgcn_mbcnt_lo(~0u, z2_)) == 0); })
#endif
#define IN(k) ({ int lo_ = lo, hi_ = hi; asm volatile("" : "+s"(lo_), "+s"(hi_)); (lo_ <= (k) && (k) < hi_); })
#if PROBE
#define SEAM13(k) do { if (IN(k) && IN(14)) xcd_barrier(bar); if ((k) == PROBE_B && IS_T0()) { const unsigned long long t_ = wall_clock64(); MISC[18] = (unsigned)t_; MISC[19] = (unsigned)(t_ >> 32); } if (14 == PROBE_A && IS_T0()) { const unsigned long long t_ = wall_clock64(); MISC[16] = (unsigned)t_; MISC[17] = (unsigned)(t_ >> 32); } } while (0)
#else
#define SEAM13(k) do { if (IN(k) && IN(14)) xcd_barrier(bar); } while (0)
#endif
#if PROBE
#define SEAM_SKIP(a, b) do { if (IN(a) && IN(b)) xcd_barrier(bar); if ((a) == PROBE_B && IS_T0()) { const unsigned long long t_ = wall_clock64(); MISC[18] = (unsigned)t_; MISC[19] = (unsigned)(t_ >> 32); } if ((b) == PROBE_A && IS_T0()) { const unsigned long long t_ = wall_clock64(); MISC[16] = (unsigned)t_; MISC[17] = (unsigned)(t_ >> 32); } } while (0)
#else
#define SEAM_SKIP(a, b) do { if (IN(a) && IN(b)) xcd_barrier(bar); } while (0)
#endif
#define REPN(k) (((k) == REPEAT_PH) ? REPEAT_N : 1)
#define PH() do { const CAS Args* a_ = (const CAS Args*)__builtin_amdgcn_kernarg_segment_ptr(); asm volatile("" : "+s"(a_)); F.ap = a_; unsigned char* w_ = args.ws; asm volatile("" : "+s"(w_)); F.ws = (GAS unsigned char*)w_; unsigned z_ = 0u; asm volatile("" : "+v"(z_)); int l_ = __builtin_amdgcn_mbcnt_hi(~0u, __builtin_amdgcn_mbcnt_lo(~0u, z_)); int wv_ = wave0; asm volatile("" : "+s"(wv_)); F.lane = l_; F.wave = wv_; F.tid = wv_ * 64 + l_; int v_ = vcu0; asm volatile("" : "+s"(v_)); F.vcu = v_; } while (0)
#if PROBE
#define SEAM(k) do { if (IN(k) && IN((k) + 1)) xcd_barrier(bar); if ((k) == PROBE_B && IS_T0()) { const unsigned long long t_ = wall_clock64(); MISC[18] = (unsigned)t_; MISC[19] = (unsigned)(t_ >> 32); } if ((k) + 1 == PROBE_A && IS_T0()) { const unsigned long long t_ = wall_clock64(); MISC[16] = (unsigned)t_; MISC[17] = (unsigned)(t_ >> 32); } } while (0)
#else
#define SEAM(k) do { if (IN(k) && IN((k) + 1)) xcd_barrier(bar); } while (0)
#endif

#if PROBE
    if (PROBE_A == 0 && IS_T0()) { const unsigned long long t_ = wall_clock64(); MISC[16] = (unsigned)t_; MISC[17] = (unsigned)(t_ >> 32); }
#endif
    if (IN(0)) for (int rp_ = 0; rp_ < REPN(0); ++rp_) { PH(); p0_mods(F); p0_s5params(F);
#if !S5P_SPREAD
        __syncthreads();
#endif
        p0_weights(F, 0, F.G == 256 ? CV_P0_END : CV_NIT, F.vcu * NWAVES + F.wave, F.G * NWAVES);     __syncthreads(); }
    SEAM(0);
    for (int l = 0; l < 2; ++l) {
        if (l == 0) {
            if (IN(1)) for (int rp_ = 0; rp_ < REPN(1); ++rp_) { PH(); p1_prep(F); }
            SEAM(1);
            if (IN(2)) for (int rp_ = 0; rp_ < REPN(2); ++rp_) { PH(); int cx, Gg, ci, nci; if (split_role(F, KG_QKV, cx, Gg, ci, nci)) { SegSched S; S.init(Gg, cx, 34, 16, T_HB, T_WQKV, 8, 34, T_WQKV + 16, T_HB); EpiQKV E{ws_tile(F, T_QK), ws_tile(F, T_VT)}; run_gemm<EpiQKV, SegSched, false, 0, false>(F, S, E); } else p0_weights(F, CV_P0_END, CV_T1_END, ci * NWAVES + F.wave, nci * NWAVES); }
            SEAM(2);
            if (IN(3)) for (int rp_ = 0; rp_ < REPN(3); ++rp_) { PH();
#if ATTN_NAIVE
                p3_attn_naive(F);
#else
                attn_phase2(F, (rp_ < REPN(3) - 1) ? DUMMY_VARIANT : 0);
#endif
                __syncthreads(); }
            SEAM(3);
            if (IN(4)) for (int rp_ = 0; rp_ < REPN(4); ++rp_) { PH(); int cx, Gg, ci, nci; if (split_role(F, KG_WO, cx, Gg, ci, nci)) { SegSched S; S.init(Gg, cx, 34, 8, T_AO, T_WO, 0, 0, 0, 0); EpiWo E{(GAS bf16*)(F.ws + WS_O)}; run_gemm(F, S, E); } else p0_weights(F, CV_T1_END, CV_T2_END, ci * NWAVES + F.wave, nci * NWAVES); }
            SEAM(4);
        } else {
#if S5_NAIVE
            if (IN(11)) for (int rp_ = 0; rp_ < REPN(11); ++rp_) { PH(); s5_naive(F); }
            SEAM(11); SEAM(12); SEAM(13);
#else
#if S5_FUSE_Z
            if (IN(11)) for (int rp_ = 0; rp_ < REPN(11); ++rp_) { PH(); s5z_fused(F); }
            SEAM_SKIP(11, 15);
#else
            if (IN(11)) for (int rp_ = 0; rp_ < REPN(11); ++rp_) { PH(); s5_fused(F); }
            SEAM13(11);
#endif
#endif
#if !S5_FUSE_Z || S5_NAIVE
            if (IN(14)) for (int rp_ = 0; rp_ < REPN(14); ++rp_) { PH(); zprep_phase(F); }
            SEAM(14);
#endif
            if (IN(15)) for (int rp_ = 0; rp_ < REPN(15); ++rp_) { PH(); SegSched S; S.init(F.G, F.vcu, 32, 16, T_Z, T_WVG, 0, 0, 0, 0); EpiGlu E{(GAS bf16*)(F.ws + WS_O)}; run_gemm(F, S, E); }
            SEAM(15);
        }
        const int pb = l ? 16 : 5;
        if (IN(pb)) for (int rp_ = 0; rp_ < REPN(pb); ++rp_) { PH(); row_phase(F, l, (rp_ < REPN(pb) - 1) ? DUMMY_VARIANT : 0); }
        SEAM(pb);
        if (IN(pb + 1)) for (int rp_ = 0; rp_ < REPN(pb + 1); ++rp_) { PH(); topk_phase(F, l); }
#if !GATHER_IN_GEMM
        SEAM(pb + 1);
#endif
#if !GATHER_IN_GEMM
        if (IN(pb + 2)) for (int rp_ = 0; rp_ < REPN(pb + 2); ++rp_) { PH(); gather_phase(F, l); }
        SEAM(pb + 2);
#else
        SEAM_SKIP(pb + 1, pb + 3);
#endif
        if (IN(pb + 3)) for (int rp_ = 0; rp_ < REPN(pb + 3); ++rp_) { PH(); int cx, Gg, ci, nci; if (split_role(F, l == 0 ? KG_UP0 : 32, cx, Gg, ci, nci)) { MoeSched S; S.init(Gg, cx, l ? 4 : 5, 16, T_XE, T_MOE1 + l * 256); S.ga_idx = (const GAS int*)(F.ws + WS_IDX); S.ga_nrows = NROWS; EpiSwiglu E{ws_tile(F, T_ACT), T_MOE1 + l * 256};
#if GATHER_IN_GEMM
            run_gemm_ga(F, S, E, T_HB);
#else
            run_gemm(F, S, E);
#endif
            } else p0_weights(F, CV_T2_END, CV_T4_END, ci * NWAVES + F.wave, nci * NWAVES);
        }
        SEAM(pb + 3);
        if (IN(pb + 4)) for (int rp_ = 0; rp_ < REPN(pb + 4); ++rp_) { PH(); int cx, Gg, ci, nci; if (split_role(F, l == 0 ? KG_DN0 : 32, cx, Gg, ci, nci)) { MoeSched S; S.init(Gg, cx, l ? 4 : 5, 8, T_ACT, T_MOE2 + l * 128); EpiDown E{(GAS bf16*)(F.ws + WS_YE), (const GAS float*)(F.ws + WS_GATE), T_MOE2 + l * 128}; run_gemm<EpiDown, MoeSched, false, MOE_BAUX>(F, S, E); } else p0_weights(F, CV_T4_END, CV_NIT_MAIN, ci * NWAVES + F.wave, nci * NWAVES); }
        SEAM(pb + 4);
        if (IN(pb + 5)) for (int rp_ = 0; rp_ < REPN(pb + 5); ++rp_) { PH(); combine_phase(F, l); }
        SEAM(pb + 5);
    }
#if PROBE
    if (blockIdx.x == 0 && IS_T0()) { const unsigned long long tA_ = ((unsigned long long)MISC[17] << 32) | MISC[16], tB_ = ((unsigned long long)MISC[19] << 32) | MISC[18]; const float us_ = (float)(tB_ - tA_) * 0.01f; F.out[0] = exp2f(rintf(log2f(us_) * PROBE_Q + PROBE_OFF) / PROBE_Q); }
#endif
#undef IN
#undef SEAM
}

extern "C" void kernel_launch(void* const* d_in, const int* in_sizes, int n_in, void* d_out, int out_size, void* d_ws, size_t ws_size, hipStream_t stream) {
    static int grid = 0;
    if (grid == 0) {
        if (n_in != 25 || out_size != NLAT * D || ws_size < WS_END) { fprintf(stderr, "kernel_launch: unexpected shapes (n_in %d out %d ws %zu)\n", n_in, out_size, ws_size); grid = -1; return; }
        int dev = 0, cus = 0, per_cu = 0;
        if (hipGetDevice(&dev) != hipSuccess || hipDeviceGetAttribute(&cus, hipDeviceAttributeMultiprocessorCount, dev) != hipSuccess) { grid = -1; return; }
        if (hipFuncSetAttribute((const void*)mk_fwd, hipFuncAttributeMaxDynamicSharedMemorySize, LDS_BYTES) != hipSuccess) { fprintf(stderr, "kernel_launch: hipFuncSetAttribute failed\n"); grid = -1; return; }
        if (hipOccupancyMaxActiveBlocksPerMultiprocessor(&per_cu, (const void*)mk_fwd, NTHREADS, LDS_BYTES) != hipSuccess || per_cu < 1) { fprintf(stderr, "kernel_launch: occupancy query reports %d\n", per_cu); }
        (void)hipGetLastError();
        grid = cus;
    }
    if (grid < 0) return;
    (void)hipMemsetAsync((char*)d_ws + WS_CTL, 0, CTL_ZERO_BYTES, stream);
    Args a{};
    for (int i = 0; i < 25; ++i) a.in[i] = (const float*)d_in[i];
    a.out = (float*)d_out; a.ws = (unsigned char*)d_ws;
#if MK_N_LAUNCHES == 1
    a.ph_lo = 0; a.ph_hi = NPH;
    hipLaunchKernelGGL(mk_fwd, dim3(grid), dim3(NTHREADS), LDS_BYTES, stream, a);
#else
    for (int p = 0; p < NPH; ++p) { a.ph_lo = p; a.ph_hi = p + 1; hipLaunchKernelGGL(mk_fwd, dim3(grid), dim3(NTHREADS), LDS_BYTES, stream, a); }
#endif
}
```
